# Optimizing an MI355X kernel written in HIP

```python
import math
import jax, jax.numpy as jnp
from jax import lax
import numpy as np

D_MODEL = 2048
BATCH = 8
SEQ = 2048
DEPTH = 2

CHUNK = 128
NORM_EPS = 1e-5

GMLP_WIDTH = D_MODEL
GMLP_GROUPS = 16
GMLP_GROUP_DIM = GMLP_WIDTH // GMLP_GROUPS
SSD_WIDTH = D_MODEL
SSD_HEAD_DIM = 64
SSD_HEADS = SSD_WIDTH // SSD_HEAD_DIM
SSD_GROUPS = 4
SSD_STATE = 128
SSD_CONV = 4
SSD_BC_DIM = SSD_GROUPS * SSD_STATE
SSD_CONV_DIM = SSD_WIDTH + 2 * SSD_BC_DIM
EVEN_MIX = GMLP_WIDTH + SSD_WIDTH
EVEN_SPLITS = (2 * GMLP_WIDTH,
               3 * GMLP_WIDTH,
               3 * GMLP_WIDTH + SSD_WIDTH,
               3 * GMLP_WIDTH + SSD_WIDTH + SSD_CONV_DIM)
EVEN_IN = EVEN_SPLITS[-1] + SSD_HEADS

DIFF_HEADS = 16
DIFF_HEAD_DIM = 64
DIFF_V_DIM = 2 * DIFF_HEAD_DIM
DIFF_WIDTH = DIFF_HEADS * DIFF_V_DIM
ODD_IN = 4 * DIFF_WIDTH

kernel_name = "hybrid_gmlp_ssd_diffattn_block"


def rms_norm(x, g):
    xf = x.astype(jnp.float32)
    y = xf * lax.rsqrt(jnp.mean(xf * xf, axis=-1, keepdims=True) + NORM_EPS)
    return (y * g.astype(jnp.float32)).astype(x.dtype)


def layer_norm(x, g, b):
    xf = x.astype(jnp.float32)
    mu = jnp.mean(xf, axis=-1, keepdims=True)
    var = jnp.mean(jnp.square(xf - mu), axis=-1, keepdims=True)
    y = (xf - mu) * lax.rsqrt(var + NORM_EPS)
    return (y * g.astype(jnp.float32) + b.astype(jnp.float32)).astype(x.dtype)


def gated_group_rms_norm(y, z, g, n_groups):
    yz = y.astype(jnp.float32) * jax.nn.silu(z.astype(jnp.float32))
    shp = yz.shape
    yz = yz.reshape(shp[:-1] + (n_groups, shp[-1] // n_groups))
    yz = yz * lax.rsqrt(jnp.mean(yz * yz, axis=-1, keepdims=True) + NORM_EPS)
    return (yz.reshape(shp) * g.astype(jnp.float32)).astype(z.dtype)


def causal_depthwise_conv(x, w, bias):
    k = w.shape[0]
    out = lax.conv_general_dilated(
        x, w[:, None, :].astype(x.dtype), window_strides=(1,),
        padding=((k - 1, 0),), dimension_numbers=('NWC', 'WIO', 'NWC'),
        feature_group_count=x.shape[-1])
    return out + bias.astype(x.dtype)


def ssd_chunked_scan(x, dt, a, bmat, cmat):
    b, L, H, P = x.shape
    G, N = bmat.shape[2], bmat.shape[3]
    R = H // G
    nc = L // CHUNK
    xdt = (x.astype(jnp.float32) * dt[..., None]).reshape(b, nc, CHUNK, G, R, P)
    adt = (dt * a).reshape(b, nc, CHUNK, G, R)
    a_cum = jnp.cumsum(adt, axis=2)
    bm = bmat.astype(jnp.float32).reshape(b, nc, CHUNK, G, N)
    cm = cmat.astype(jnp.float32).reshape(b, nc, CHUNK, G, N)
    causal = jnp.tril(jnp.ones((CHUNK, CHUNK), dtype=bool))
    seg = a_cum[:, :, :, None] - a_cum[:, :, None, :]
    decay = jnp.exp(jnp.where(causal[None, None, :, :, None, None], seg, -jnp.inf))
    cb = jnp.einsum('bclgn,bcsgn->bclsg', cm, bm)
    y_diag = jnp.einsum('bclsg,bclsgr,bcsgrp->bclgrp', cb, decay, xdt)
    decay_to_end = jnp.exp(a_cum[:, :, -1:] - a_cum)
    states = jnp.einsum('bclgn,bclgr,bclgrp->bcgrpn', bm, decay_to_end, xdt)
    chunk_decay = jnp.exp(a_cum[:, :, -1])

    def step(carry, inp):
        st, dec = inp
        return carry * dec[..., None, None] + st, carry

    init = jnp.zeros((b, G, R, P, N), jnp.float32)
    _, prev = lax.scan(step, init, (jnp.moveaxis(states, 1, 0), jnp.moveaxis(chunk_decay, 1, 0)))
    prev = jnp.moveaxis(prev, 0, 1)
    y_off = jnp.einsum('bclgn,bcgrpn,bclgr->bclgrp', cm, prev, jnp.exp(a_cum))
    return (y_diag + y_off).reshape(b, L, H, P)


def even_layer(x, norm_g, w_in, gmlp_ln_g, gmlp_ln_b, spatial_w, spatial_b,
               conv_w, conv_b, dt_bias, a_log, d_skip, ssm_norm_g, w_out):
    b, L, _ = x.shape
    h = rms_norm(x, norm_g)
    proj = h @ w_in.astype(h.dtype)
    uv, z_a, z_b, xbc, dt_raw = jnp.split(proj, list(EVEN_SPLITS), axis=-1)

    u, v = jnp.split(jax.nn.gelu(uv), 2, axis=-1)
    v = layer_norm(v, gmlp_ln_g, gmlp_ln_b)
    nc = L // CHUNK
    v = v.reshape(b, nc, CHUNK, GMLP_GROUPS, GMLP_GROUP_DIM)
    causal = jnp.tril(jnp.ones((CHUNK, CHUNK), dtype=bool))
    w_s = jnp.where(causal[None], spatial_w, 0).astype(v.dtype)
    v_mix = jnp.einsum('gts,bnsgc->bntgc', w_s, v) + spatial_b.T.astype(v.dtype)[None, None, :, :, None]
    y_a = u * v_mix.reshape(b, L, GMLP_WIDTH) * jax.nn.silu(z_a)

    xbc = jax.nn.silu(causal_depthwise_conv(xbc, conv_w, conv_b))
    xs, bmat, cmat = jnp.split(xbc, [SSD_WIDTH, SSD_WIDTH + SSD_BC_DIM], axis=-1)
    xs = xs.reshape(b, L, SSD_HEADS, SSD_HEAD_DIM)
    bmat = bmat.reshape(b, L, SSD_GROUPS, SSD_STATE)
    cmat = cmat.reshape(b, L, SSD_GROUPS, SSD_STATE)
    dt = jax.nn.softplus(dt_raw.astype(jnp.float32) + dt_bias.astype(jnp.float32))
    a = -jnp.exp(a_log.astype(jnp.float32))
    y = ssd_chunked_scan(xs, dt, a, bmat, cmat) + d_skip.astype(jnp.float32)[:, None] * xs.astype(jnp.float32)
    y_b = gated_group_rms_norm(y.reshape(b, L, SSD_WIDTH), z_b, ssm_norm_g, SSD_GROUPS)

    y_cat = jnp.concatenate([y_a, y_b.astype(y_a.dtype)], axis=-1)
    return x + (y_cat @ w_out.astype(y_cat.dtype)).astype(x.dtype)


def odd_layer(x, norm_g, w_in, lambda_q1, lambda_k1, lambda_q2, lambda_k2,
              subln_g, w_out, layer_idx):
    b, L, _ = x.shape
    h = rms_norm(x, norm_g)
    proj = h @ w_in.astype(h.dtype)
    q, k, v, gate = jnp.split(proj, 4, axis=-1)
    q = q.reshape(b, L, DIFF_HEADS, 2, DIFF_HEAD_DIM).transpose(0, 2, 3, 1, 4)
    k = k.reshape(b, L, DIFF_HEADS, 2, DIFF_HEAD_DIM).transpose(0, 2, 3, 1, 4)
    v = v.reshape(b, L, DIFF_HEADS, DIFF_V_DIM).transpose(0, 2, 1, 3)

    lambda_init = 0.8 - 0.6 * math.exp(-0.3 * layer_idx)
    lam = (jnp.exp(jnp.sum(lambda_q1.astype(jnp.float32) * lambda_k1.astype(jnp.float32)))
           - jnp.exp(jnp.sum(lambda_q2.astype(jnp.float32) * lambda_k2.astype(jnp.float32)))
           + lambda_init)
    slopes = 2.0 ** (-8.0 * (jnp.arange(DIFF_HEADS, dtype=jnp.float32) + 1.0) / DIFF_HEADS)
    scale = DIFF_HEAD_DIM ** -0.5

    outs = []
    for i in range(L // CHUNK):
        n_k = (i + 1) * CHUNK
        q_blk = q[:, :, :, i * CHUNK:n_k]
        s = jnp.einsum('bhiqd,bhikd->bhiqk', q_blk, k[:, :, :, :n_k]).astype(jnp.float32) * scale
        q_pos = i * CHUNK + jnp.arange(CHUNK)
        dist = (q_pos[:, None] - jnp.arange(n_k)[None, :]).astype(jnp.float32)
        s = s - slopes[:, None, None, None] * dist
        s = jnp.where(dist >= 0, s, -jnp.inf)
        p = jax.nn.softmax(s, axis=-1)
        attn = p[:, :, 0] - lam * p[:, :, 1]
        outs.append(jnp.einsum('bhqk,bhkv->bhqv', attn.astype(v.dtype), v[:, :, :n_k]))
    o = jnp.concatenate(outs, axis=2)
    o = rms_norm(o, subln_g) * (1.0 - lambda_init)
    o = o.transpose(0, 2, 1, 3).reshape(b, L, DIFF_WIDTH) * jax.nn.silu(gate)
    return x + (o @ w_out.astype(o.dtype)).astype(x.dtype)


def setup_inputs(seed: int = 0) -> dict:
    key = jax.random.key(seed)
    ks = jax.random.split(key, 24)
    f32 = jnp.float32
    nrm = lambda k, shp, s: jax.random.normal(k, shp, f32) * s
    x = jax.random.normal(ks[0], (BATCH, SEQ, D_MODEL), f32)
    causal = jnp.tril(jnp.ones((CHUNK, CHUNK), f32))
    dt = jnp.exp(jax.random.uniform(ks[9], (SSD_HEADS,), f32) * (math.log(0.1) - math.log(0.001)) + math.log(0.001))
    return {
        "x": x,
        "l0_norm_g": 1.0 + nrm(ks[1], (D_MODEL,), 0.02),
        "l0_w_in": nrm(ks[2], (D_MODEL, EVEN_IN), D_MODEL ** -0.5),
        "l0_gmlp_ln_g": 1.0 + nrm(ks[3], (GMLP_WIDTH,), 0.02),
        "l0_gmlp_ln_b": nrm(ks[4], (GMLP_WIDTH,), 0.02),
        "l0_spatial_w": nrm(ks[5], (GMLP_GROUPS, CHUNK, CHUNK), 1.0) * causal * lax.rsqrt(jnp.arange(1, CHUNK + 1, dtype=f32))[:, None],
        "l0_spatial_b": 1.0 + nrm(ks[6], (GMLP_GROUPS, CHUNK), 0.1),
        "l0_conv_w": nrm(ks[7], (SSD_CONV, SSD_CONV_DIM), SSD_CONV ** -0.5),
        "l0_conv_b": nrm(ks[8], (SSD_CONV_DIM,), 0.02),
        "l0_dt_bias": dt + jnp.log(-jnp.expm1(-dt)),
        "l0_a_log": jnp.log(jax.random.uniform(ks[10], (SSD_HEADS,), f32, 1.0, 16.0)),
        "l0_d_skip": 1.0 + nrm(ks[11], (SSD_HEADS,), 0.1),
        "l0_ssm_norm_g": 1.0 + nrm(ks[12], (SSD_WIDTH,), 0.02),
        "l0_w_out": nrm(ks[13], (EVEN_MIX, D_MODEL), EVEN_MIX ** -0.5),
        "l1_norm_g": 1.0 + nrm(ks[14], (D_MODEL,), 0.02),
        "l1_w_in": nrm(ks[15], (D_MODEL, ODD_IN), D_MODEL ** -0.5),
        "l1_lambda_q1": nrm(ks[16], (DIFF_HEAD_DIM,), 0.1),
        "l1_lambda_k1": nrm(ks[17], (DIFF_HEAD_DIM,), 0.1),
        "l1_lambda_q2": nrm(ks[18], (DIFF_HEAD_DIM,), 0.1),
        "l1_lambda_k2": nrm(ks[19], (DIFF_HEAD_DIM,), 0.1),
        "l1_subln_g": 1.0 + nrm(ks[20], (DIFF_V_DIM,), 0.02),
        "l1_w_out": nrm(ks[21], (DIFF_WIDTH, D_MODEL), DIFF_WIDTH ** -0.5),
        "final_norm_g": 1.0 + nrm(ks[22], (D_MODEL,), 0.02),
    }


def reference(x, l0_norm_g, l0_w_in, l0_gmlp_ln_g, l0_gmlp_ln_b, l0_spatial_w,
              l0_spatial_b, l0_conv_w, l0_conv_b, l0_dt_bias, l0_a_log, l0_d_skip,
              l0_ssm_norm_g, l0_w_out, l1_norm_g, l1_w_in, l1_lambda_q1,
              l1_lambda_k1, l1_lambda_q2, l1_lambda_k2, l1_subln_g, l1_w_out,
              final_norm_g):
    for layer in range(DEPTH):
        if layer % 2 == 0:
            x = even_layer(x, l0_norm_g, l0_w_in, l0_gmlp_ln_g, l0_gmlp_ln_b,
                           l0_spatial_w, l0_spatial_b, l0_conv_w, l0_conv_b,
                           l0_dt_bias, l0_a_log, l0_d_skip, l0_ssm_norm_g, l0_w_out)
        else:
            x = odd_layer(x, l1_norm_g, l1_w_in, l1_lambda_q1, l1_lambda_k1,
                          l1_lambda_q2, l1_lambda_k2, l1_subln_g, l1_w_out, layer)
    return rms_norm(x, final_norm_g)
```

```cpp
#include <hip/hip_runtime.h>
#include <hip/hip_cooperative_groups.h>
#include <cstdio>
#include <cstdint>
#include <cmath>
namespace cg = cooperative_groups;
namespace pg8 {
#define PG8_LAS __attribute__((address_space(3)))
typedef unsigned short bf16_t;
typedef short bf16x8 __attribute__((ext_vector_type(8)));
typedef float f32x4 __attribute__((ext_vector_type(4)));
typedef unsigned u32x4 __attribute__((ext_vector_type(4)));
constexpr int BM = 256, BK = 64, HALF = 128, HTB = HALF * BK * 2  , STAGE_BYTES = 8 * HTB, NXCD = 8, WGM = 8;

__host__ __device__ __forceinline__ int lds_byte(int r, int c) { const int st = (r >> 4) * 2 + (c >> 5), rr = r & 15, cc = c & 31, ob = rr * 64 + cc * 2; return st * 1024 + (ob ^ (((ob >> 9) & 1) << 5)); }
__host__ __device__ __forceinline__ void stage_rc(int b, int& R, int& C) { const int st = b / 1024, sb = b % 1024, swz = sb ^ (((sb >> 9) & 1) << 5); R = (st >> 1) * 16 + swz / 64; C = (st & 1) * 32 + (swz % 64) / 2; }
__host__ __device__ __forceinline__ int perm32(int rho) { const int n = rho >> 4, i = rho & 15; return 8 * (i >> 2) + 4 * n + (i & 3); }

struct Unit { int pm, pn; };
struct Gemm { const bf16_t* A; const bf16_t* Bt; int M, N, K; };

struct StaticOrder {
    int nM, nN, nwg, G, c;
    __host__ __device__ void init(int M, int N, int G_, int c_) { nM = M / BM; nN = N / BM; nwg = nM * nN; G = G_; c = c_; }
    __host__ __device__ bool next(int i, Unit& u) const {
        const long L = (long)i * G + c; if (L >= nwg) return false;
        int wgid = (int)L; { const int q = nwg / NXCD, r = nwg % NXCD, xcd = wgid % NXCD, off = wgid / NXCD; wgid = (xcd < r ? xcd * (q + 1) : r * (q + 1) + (xcd - r) * q) + off; }
        const int nig = WGM * nN, gid = wgid / nig, fm = gid * WGM, gsz = (nM - fm) < WGM ? (nM - fm) : WGM;
        u.pm = fm + ((wgid % nig) % gsz); u.pn = (wgid % nig) / gsz; return true;
    }
    __device__ __forceinline__ void a_ready(const Unit&) const {}
    __device__ __forceinline__ void done(const Unit&) const {}
};

template <class Epi, class Sched, bool ALIGN_EPI = false, bool SP2 = false>
__device__ __forceinline__ void gemm_phase(PG8_LAS unsigned char* lds, const Gemm g, const Sched& S, const Epi& E) {
    int tid_ = threadIdx.x; asm volatile("" : "+v"(tid_));
    const int tid = tid_, wid = __builtin_amdgcn_readfirstlane(tid >> 6), lane = tid & 63, wr = wid >> 2, wc = wid & 3, fr = lane & 15, fq = lane >> 4;
    const int K = g.K, nt = K / BK;
    unsigned voffA[2], voffB[2];
#pragma unroll
    for (int i = 0; i < 2; ++i) { int R, C; stage_rc(tid * 16 + i * 8192, R, C); const int Rb = Epi::PERM ? ((R & ~31) + perm32(R & 31)) : R;
        voffA[i] = (unsigned)(R * K + C) * 2u; voffB[i] = (unsigned)(Rb * K + C) * 2u; }
    const size_t kstep = (size_t)(BK * 2);
    const size_t hstep = (size_t)HALF * K * 2;
    const size_t tstep = 2 * hstep;
    const unsigned ldsw = (unsigned)wid * 1024u;
    const int aoff = lds_byte(wr * 64 + fr, fq * 8), boff = lds_byte(wc * 32 + fr, fq * 8);
#define PG8_SA(b, h) (((b) * 2 + (h)) * HTB)
#define PG8_SB(b, h) ((4 + (b) * 2 + (h)) * HTB)
#define PG8_STAGE(bufoff, gbase, voff) do { _Pragma("unroll") for (int _i = 0; _i < 2; ++_i) \
        __builtin_amdgcn_global_load_lds((const unsigned*)((const char*)(gbase) + (voff)[_i]), (PG8_LAS unsigned*)(lds + (bufoff) + ldsw + _i * 8192), 16, 0, 0); } while (0)
#define PG8_LDA(dst, b, h) do { _Pragma("unroll") for (int m = 0; m < 4; ++m) _Pragma("unroll") for (int k = 0; k < 2; ++k) dst[m][k] = *(const PG8_LAS bf16x8*)(lds + PG8_SA(b, h) + aoff + m * 2048 + k * 1024); } while (0)
#define PG8_LDB(dst, b, h) do { _Pragma("unroll") for (int n = 0; n < 2; ++n) _Pragma("unroll") for (int k = 0; k < 2; ++k) dst[n][k] = *(const PG8_LAS bf16x8*)(lds + PG8_SB(b, h) + boff + n * 2048 + k * 1024); } while (0)
#define PG8_MMA(ai, bj, At, Bt) do { __builtin_amdgcn_s_setprio(1); _Pragma("unroll") for (int m = 0; m < 4; ++m) _Pragma("unroll") for (int n = 0; n < 2; ++n) _Pragma("unroll") for (int k = 0; k < 2; ++k) \
        acc[ai][bj][m][n] = __builtin_amdgcn_mfma_f32_16x16x32_bf16(Bt[n][k], At[m][k], acc[ai][bj][m][n], 0, 0, 0); __builtin_amdgcn_s_setprio(0); } while (0)
#define PG8_WAIT_V(n) asm volatile("s_waitcnt vmcnt(" #n ")" ::: "memory")
#define PG8_WAIT_L(n) asm volatile("s_waitcnt lgkmcnt(" #n ")" ::: "memory")
#define PG8_BAR __builtin_amdgcn_s_barrier()
#define PG8_SCHED __builtin_amdgcn_sched_barrier(0)
    Unit cur, nxt; int ui = 0;
    if (!S.next(0, cur)) return;
    f32x4 acc[2][2][4][2];
#pragma unroll
    for (int a = 0; a < 2; ++a)
#pragma unroll
        for (int b = 0; b < 2; ++b)
#pragma unroll
            for (int m = 0; m < 4; ++m)
#pragma unroll
                for (int n = 0; n < 2; ++n) acc[a][b][m][n] = (f32x4){0.f, 0.f, 0.f, 0.f};
    bf16x8 At[4][2], B0[2][2], B1[2][2];
    const char* cA = (const char*)g.A + (size_t)cur.pm * tstep; const char* cB = (const char*)g.Bt + (size_t)cur.pn * tstep;
    S.a_ready(cur);
    if constexpr (SP2) {
        PG8_STAGE(PG8_SB(0, 0), cB, voffB); PG8_STAGE(PG8_SB(0, 1), cB + hstep, voffB); PG8_STAGE(PG8_SA(0, 0), cA, voffA); PG8_STAGE(PG8_SA(0, 1), cA + hstep, voffA);
        if (wr == 1) PG8_BAR;
        PG8_WAIT_V(2); PG8_BAR;
        PG8_STAGE(PG8_SB(1, 0), cB + kstep, voffB); PG8_STAGE(PG8_SA(1, 0), cA + kstep, voffA); PG8_STAGE(PG8_SB(1, 1), cB + hstep + kstep, voffB);
        PG8_WAIT_V(6); PG8_BAR;
    } else {
        PG8_STAGE(PG8_SB(0, 0), cB, voffB); PG8_STAGE(PG8_SA(0, 0), cA, voffA); PG8_STAGE(PG8_SB(0, 1), cB + hstep, voffB); PG8_STAGE(PG8_SA(0, 1), cA + hstep, voffA);
        if (wr == 1) PG8_BAR;
        PG8_WAIT_V(4); PG8_BAR;
        PG8_STAGE(PG8_SB(1, 0), cB + kstep, voffB); PG8_STAGE(PG8_SA(1, 0), cA + kstep, voffA); PG8_STAGE(PG8_SB(1, 1), cB + hstep + kstep, voffB);
        PG8_WAIT_V(6); PG8_BAR;
    }
    for (;;) {
        const bool has_next = S.next(ui + 1, nxt);
        const char* nA = has_next ? (const char*)g.A + (size_t)nxt.pm * tstep : cA; const char* nB = has_next ? (const char*)g.Bt + (size_t)nxt.pn * tstep : cB;
        for (int t = 0; t < nt; t += 2) {
            const bool last = (t == nt - 2);
            const char* a1 = cA + (size_t)(t + 1) * kstep;
            const char* a2 = last ? nA : cA + (size_t)(t + 2) * kstep; const char* b2 = last ? nB : cB + (size_t)(t + 2) * kstep;
            const char* a3 = a2 + kstep; const char* b3 = b2 + kstep;
            if (last && has_next) S.a_ready(nxt);
            if constexpr (SP2) {
            PG8_LDB(B0, 0, 0); PG8_LDB(B1, 0, 1); PG8_SCHED; PG8_LDA(At, 0, 0); PG8_STAGE(PG8_SA(1, 1), a1 + hstep, voffA);
            PG8_WAIT_V(8); PG8_WAIT_L(0); PG8_BAR; PG8_MMA(0, 0, At, B0); PG8_MMA(0, 1, At, B1); PG8_BAR; PG8_SCHED;
            PG8_LDA(At, 0, 1); PG8_STAGE(PG8_SB(0, 0), b2, voffB); PG8_STAGE(PG8_SB(0, 1), b2 + hstep, voffB); PG8_STAGE(PG8_SA(0, 0), a2, voffA);
            PG8_WAIT_V(8); PG8_WAIT_L(0); PG8_BAR; PG8_MMA(1, 0, At, B0); PG8_MMA(1, 1, At, B1); PG8_BAR; PG8_SCHED;
            PG8_LDB(B0, 1, 0); PG8_LDB(B1, 1, 1); PG8_SCHED; PG8_LDA(At, 1, 0); PG8_STAGE(PG8_SA(0, 1), a2 + hstep, voffA);
            PG8_WAIT_V(8); PG8_WAIT_L(0); PG8_BAR; PG8_MMA(0, 0, At, B0); PG8_MMA(0, 1, At, B1); PG8_BAR; PG8_SCHED;
            PG8_LDA(At, 1, 1); PG8_STAGE(PG8_SB(1, 0), b3, voffB); PG8_STAGE(PG8_SB(1, 1), b3 + hstep, voffB); PG8_STAGE(PG8_SA(1, 0), a3, voffA);
            PG8_WAIT_V(8); PG8_WAIT_L(0); PG8_BAR; PG8_MMA(1, 0, At, B0); PG8_MMA(1, 1, At, B1); PG8_BAR; PG8_SCHED;
            } else {
            PG8_LDB(B0, 0, 0); PG8_SCHED; PG8_LDA(At, 0, 0); PG8_STAGE(PG8_SA(1, 1), a1 + hstep, voffA);
            PG8_WAIT_L(8); PG8_BAR; PG8_WAIT_L(0); PG8_MMA(0, 0, At, B0); PG8_BAR; PG8_SCHED;
            PG8_LDB(B1, 0, 1); PG8_STAGE(PG8_SB(0, 0), b2, voffB);
            PG8_BAR; PG8_WAIT_L(0); PG8_MMA(0, 1, At, B1); PG8_BAR;
            PG8_LDA(At, 0, 1); PG8_STAGE(PG8_SA(0, 0), a2, voffA);
            PG8_BAR; PG8_WAIT_L(0); PG8_MMA(1, 0, At, B0); PG8_BAR; PG8_SCHED;
            PG8_STAGE(PG8_SB(0, 1), b2 + hstep, voffB);
            PG8_WAIT_V(6); PG8_BAR; PG8_MMA(1, 1, At, B1); PG8_BAR;
            PG8_LDB(B0, 1, 0); PG8_SCHED; PG8_LDA(At, 1, 0); PG8_STAGE(PG8_SA(0, 1), a2 + hstep, voffA);
            PG8_WAIT_L(8); PG8_BAR; PG8_WAIT_L(0); PG8_MMA(0, 0, At, B0); PG8_BAR; PG8_SCHED;
            PG8_LDB(B1, 1, 1); PG8_STAGE(PG8_SB(1, 0), b3, voffB);
            PG8_BAR; PG8_WAIT_L(0); PG8_MMA(0, 1, At, B1); PG8_BAR;
            PG8_LDA(At, 1, 1); PG8_STAGE(PG8_SA(1, 0), a3, voffA);
            PG8_BAR; PG8_WAIT_L(0); PG8_MMA(1, 0, At, B0); PG8_BAR; PG8_SCHED;
            PG8_STAGE(PG8_SB(1, 1), b3 + hstep, voffB);
            PG8_WAIT_V(6); PG8_BAR; PG8_MMA(1, 1, At, B1); PG8_BAR;
            }
        }
        if constexpr (ALIGN_EPI) { if (wr == 0) PG8_BAR; }
        if constexpr (!Epi::AFTER_DRAIN) { E(acc, cur, wr, wc, fr, fq); S.done(cur); }
        if (!has_next) break;
#pragma unroll
        for (int a = 0; a < 2; ++a)
#pragma unroll
            for (int b = 0; b < 2; ++b)
#pragma unroll
                for (int m = 0; m < 4; ++m)
#pragma unroll
                    for (int n = 0; n < 2; ++n) acc[a][b][m][n] = (f32x4){0.f, 0.f, 0.f, 0.f};
        cur = nxt; cA = nA; cB = nB; ++ui;
        if constexpr (ALIGN_EPI) { if (wr == 1) PG8_BAR; }
    }
    PG8_WAIT_V(0);
    if constexpr (!ALIGN_EPI) { if (wr == 0) PG8_BAR; }
    PG8_BAR;
    if constexpr (Epi::AFTER_DRAIN) { E.fused(acc, cur, wr, wc, fr, fq, lds, wid, lane); S.done(cur); }
#undef PG8_SA
#undef PG8_SB
#undef PG8_STAGE
#undef PG8_LDA
#undef PG8_LDB
#undef PG8_MMA
#undef PG8_WAIT_V
#undef PG8_WAIT_L
#undef PG8_BAR
#undef PG8_SCHED
}
}

#define LAS __attribute__((address_space(3)))
typedef unsigned short bf16;
typedef unsigned u32x4 __attribute__((ext_vector_type(4)));
typedef unsigned u32x2 __attribute__((ext_vector_type(2)));
typedef float f32x4 __attribute__((ext_vector_type(4)));
typedef float f32x16 __attribute__((ext_vector_type(16)));
typedef short bf16x8 __attribute__((ext_vector_type(8)));

constexpr int M = 16384, DM = 2048, SEQ = 2048, NBATCH = 8, NCH = 16;
constexpr int N0P = 11520, N0R = 11296;
constexpr float EPS = 1e-5f;
constexpr float LOG2E = 1.4426950408889634f;
constexpr float QSCALE = 0.125f * LOG2E;
constexpr float LAMBDA_INIT = 0.35550906f;
constexpr size_t MiB = 1u << 20;
constexpr size_t WS_ST0 = 0, WS_ST1 = 128 * 1024, WS_ST2 = 192 * 1024, WS_CD = 256 * 1024, WS_LAM = 300 * 1024;
constexpr size_t WS_DT = 1 * MiB, WS_WSP = 3 * MiB, WS_W0IN = 4 * MiB, WS_W0OUT = 49 * MiB, WS_W1IN = 65 * MiB, WS_W1OUT = 97 * MiB;
constexpr size_t WS_YCAT = 105 * MiB, WS_ZA = 233 * MiB, WS_V = 297 * MiB, WS_H0 = 361 * MiB, WS_XT = 425 * MiB, WS_CN = 489 * MiB, WS_END = 505 * MiB;
constexpr size_t WS_Q = WS_YCAT, WS_K = WS_YCAT + 64 * MiB, WS_X1 = WS_ZA, WS_STATES = WS_V, WS_VT = WS_H0, WS_X1B = WS_H0, WS_O = WS_H0, WS_VV = WS_XT;
constexpr size_t DO_XBC = 0, DO_BN = 96 * MiB, DO_BT = 112 * MiB, DO_PREV = 0, DO_G = 0;
constexpr int LDS_BYTES = 147456;

__device__ __forceinline__ unsigned pk2(float lo, float hi) {
    typedef float f2 __attribute__((ext_vector_type(2))); typedef __bf16 b2 __attribute__((ext_vector_type(2)));
    f2 v = {lo, hi}; b2 b = __builtin_convertvector(v, b2); return __builtin_bit_cast(unsigned, b);
}
__device__ __forceinline__ float bflo(unsigned u) { return __uint_as_float(u << 16); }
__device__ __forceinline__ float bfhi(unsigned u) { return __uint_as_float(u & 0xffff0000u); }
__device__ __forceinline__ void unpack8(u32x4 r, float* f) { f[0] = bflo(r.x); f[1] = bfhi(r.x); f[2] = bflo(r.y); f[3] = bfhi(r.y); f[4] = bflo(r.z); f[5] = bfhi(r.z); f[6] = bflo(r.w); f[7] = bfhi(r.w); }
__device__ __forceinline__ u32x4 pack8(const float* f) { u32x4 o; o.x = pk2(f[0], f[1]); o.y = pk2(f[2], f[3]); o.z = pk2(f[4], f[5]); o.w = pk2(f[6], f[7]); return o; }
__device__ __forceinline__ float fexp2(float x) { return __builtin_amdgcn_exp2f(x); }
__device__ __forceinline__ float gelu_f(float x) { const float z = 1.5957691216057308f * (x + 0.044715f * x * x * x); return x / (1.0f + __expf(-z)); }
__device__ __forceinline__ float silu_f(float x) { return x / (1.0f + __expf(-x)); }
__device__ __forceinline__ int crow(int r, int h) { return (r & 3) + 8 * (r >> 2) + 4 * h; }
__device__ __forceinline__ f32x16 mfma32(bf16x8 a, bf16x8 b, f32x16 c) { return __builtin_amdgcn_mfma_f32_32x32x16_bf16(a, b, c, 0, 0, 0); }
__device__ __forceinline__ bf16x8 ld_frag16(const bf16* p) { return __builtin_bit_cast(bf16x8, *(const u32x4*)p); }
__device__ __forceinline__ bf16x8 ld_frag8x2(const bf16* p) { const u32x2 lo = *(const u32x2*)p, hi = *(const u32x2*)(p + 8); u32x4 v; v.x = lo.x; v.y = lo.y; v.z = hi.x; v.w = hi.y; return __builtin_bit_cast(bf16x8, v); }
__device__ __forceinline__ bf16x8 pack_frag(const f32x16& x, int s) {
    u32x4 v; v.x = pk2(x[8 * s], x[8 * s + 1]); v.y = pk2(x[8 * s + 2], x[8 * s + 3]); v.z = pk2(x[8 * s + 4], x[8 * s + 5]); v.w = pk2(x[8 * s + 6], x[8 * s + 7]); return __builtin_bit_cast(bf16x8, v);
}
__device__ __forceinline__ float wave_sum(float v) {
#pragma unroll
    for (int o = 1; o < 64; o <<= 1) v += __shfl_xor(v, o);
    return v;
}
#define LDS_WAIT() asm volatile("s_waitcnt lgkmcnt(0)" ::: "memory")
__device__ __forceinline__ void atomic_addf(float* p, float v) { __hip_atomic_fetch_add(p, v, __ATOMIC_RELAXED, __HIP_MEMORY_SCOPE_AGENT); }

struct Params { const float* in[23]; float* out; unsigned char* ws; };
constexpr int PTAB_OFF = LDS_BYTES - 512;
__device__ __forceinline__ unsigned long long ptab_get(int i) {
    const unsigned long long v = ((const LAS unsigned long long*)(PTAB_OFF))[i];
    const unsigned lo = __builtin_amdgcn_readfirstlane((unsigned)v), hi = __builtin_amdgcn_readfirstlane((unsigned)(v >> 32));
    return ((unsigned long long)hi << 32) | lo;
}
struct PT {
    struct InTab { __device__ __forceinline__ const float* operator[](int i) const { return (const float*)ptab_get(i); } } in;
    float* out; unsigned char* ws;
    __device__ __forceinline__ PT() { out = (float*)ptab_get(23); ws = (unsigned char*)ptab_get(24); }
};

template <int ACT>
__device__ __forceinline__ void epi_tile_bf16(const f32x4 (&acc)[2][2][4][2], bf16* base, int pitch, int col0, int row0, float sc) {
#pragma unroll
    for (int ai = 0; ai < 2; ++ai)
#pragma unroll
        for (int m = 0; m < 4; ++m) {
            bf16* rowp = base + (size_t)(row0 + ai * 128 + m * 16) * pitch + col0;
#pragma unroll
            for (int bj = 0; bj < 2; ++bj) {
                float v[8];
#pragma unroll
                for (int j = 0; j < 4; ++j) { v[j] = acc[ai][bj][m][0][j]; v[4 + j] = acc[ai][bj][m][1][j]; }
#pragma unroll
                for (int j = 0; j < 8; ++j) { if (ACT == 1) v[j] = gelu_f(v[j]); else if (ACT == 2) v[j] = silu_f(v[j]); else if (ACT == 3) v[j] *= sc; }
                *(u32x4*)(rowp + bj * 128) = pack8(v);
            }
        }
}

struct EpiIn0 {
    static constexpr bool PERM = true, AFTER_DRAIN = false;
    bf16 *ycat, *vbuf, *za, *xbc; float *dt, *stats0; const float* dt_bias;
    __device__ __forceinline__ void operator()(const f32x4 (&acc)[2][2][4][2], const pg8::Unit& u, int wr, int wc, int fr, int fq) const {
        const int pn = u.pn, row0 = u.pm * 256 + wr * 64 + fr, cl = wc * 32 + 8 * fq;
        if (pn < 8) { epi_tile_bf16<1>(acc, ycat, 4096, pn * 256 + cl, row0, 1.f); }
        else if (pn < 16) {
#pragma unroll
            for (int ai = 0; ai < 2; ++ai)
#pragma unroll
                for (int m = 0; m < 4; ++m) {
                    const int row = row0 + ai * 128 + m * 16;
                    bf16* rowp = vbuf + (size_t)row * 2048 + (pn - 8) * 256 + cl;
                    float s = 0.f, ss = 0.f;
#pragma unroll
                    for (int bj = 0; bj < 2; ++bj) {
                        float v[8];
#pragma unroll
                        for (int j = 0; j < 4; ++j) { v[j] = gelu_f(acc[ai][bj][m][0][j]); v[4 + j] = gelu_f(acc[ai][bj][m][1][j]); }
#pragma unroll
                        for (int j = 0; j < 8; ++j) { s += v[j]; ss += v[j] * v[j]; }
                        *(u32x4*)(rowp + bj * 128) = pack8(v);
                    }
                    s += __shfl_xor(s, 16); s += __shfl_xor(s, 32); ss += __shfl_xor(ss, 16); ss += __shfl_xor(ss, 32);
                    if (fq == 0) { atomic_addf(stats0 + 2 * row, s); atomic_addf(stats0 + 2 * row + 1, ss); }
                }
        }
        else if (pn < 24) { epi_tile_bf16<2>(acc, za, 2048, (pn - 16) * 256 + cl, row0, 1.f); }
        else if (pn < 32) { epi_tile_bf16<2>(acc, ycat, 4096, 2048 + (pn - 24) * 256 + cl, row0, 1.f); }
        else if (pn < 44) { epi_tile_bf16<0>(acc, xbc, 3072, (pn - 32) * 256 + cl, row0, 1.f); }
        else if (wc == 0) {
            f32x4 b0 = *(const f32x4*)(dt_bias + cl), b1 = *(const f32x4*)(dt_bias + cl + 4);
#pragma unroll
            for (int ai = 0; ai < 2; ++ai)
#pragma unroll
                for (int m = 0; m < 4; ++m) {
                    const int row = row0 + ai * 128 + m * 16;
                    f32x4 v0 = acc[ai][0][m][0] + b0, v1 = acc[ai][0][m][1] + b1;
#pragma unroll
                    for (int j = 0; j < 4; ++j) { v0[j] = v0[j] > 20.f ? v0[j] : log1pf(__expf(v0[j])); v1[j] = v1[j] > 20.f ? v1[j] : log1pf(__expf(v1[j])); }
                    *(f32x4*)(dt + (size_t)row * 32 + cl) = v0; *(f32x4*)(dt + (size_t)row * 32 + cl + 4) = v1;
                }
        }
    }
};

struct EpiRes {
    static constexpr bool PERM = true, AFTER_DRAIN = false;
    const float* resid; float* outf; bf16* outb; float* stats;
    __device__ __forceinline__ void operator()(const f32x4 (&acc)[2][2][4][2], const pg8::Unit& u, int wr, int wc, int fr, int fq) const {
        const int row0 = u.pm * 256 + wr * 64 + fr, col0 = u.pn * 256 + wc * 32 + 8 * fq;
#pragma unroll
        for (int ai = 0; ai < 2; ++ai)
#pragma unroll
            for (int m = 0; m < 4; ++m) {
                const int row = row0 + ai * 128 + m * 16; const size_t off = (size_t)row * 2048 + col0;
                float ss = 0.f;
#pragma unroll
                for (int bj = 0; bj < 2; ++bj) {
                    const f32x4 r0 = *(const f32x4*)(resid + off + bj * 128) + acc[ai][bj][m][0], r1 = *(const f32x4*)(resid + off + bj * 128 + 4) + acc[ai][bj][m][1];
                    *(f32x4*)(outf + off + bj * 128) = r0; *(f32x4*)(outf + off + bj * 128 + 4) = r1;
                    ss += (r0[0] * r0[0] + r0[1] * r0[1]) + (r0[2] * r0[2] + r0[3] * r0[3]) + (r1[0] * r1[0] + r1[1] * r1[1]) + (r1[2] * r1[2] + r1[3] * r1[3]);
                    if (outb) { u32x4 w; w.x = pk2(r0[0], r0[1]); w.y = pk2(r0[2], r0[3]); w.z = pk2(r1[0], r1[1]); w.w = pk2(r1[2], r1[3]); *(u32x4*)(outb + off + bj * 128) = w; }
                }
                ss += __shfl_xor(ss, 16); ss += __shfl_xor(ss, 32);
                if (fq == 0) atomic_addf(stats + row, ss);
            }
    }
};

struct EpiIn1 {
    static constexpr bool PERM = true, AFTER_DRAIN = false;
    bf16 *q, *k, *v, *g; const float* stats1;
    __device__ __forceinline__ void operator()(const f32x4 (&acc)[2][2][4][2], const pg8::Unit& u, int wr, int wc, int fr, int fq) const {
        const int seg = u.pn >> 3, row0 = u.pm * 256 + wr * 64 + fr, col0 = (u.pn & 7) * 256 + wc * 32 + 8 * fq;
        bf16* base = seg == 0 ? q : (seg == 1 ? k : (seg == 2 ? v : g));
        const float sc = seg == 0 ? QSCALE : 1.f;
#pragma unroll
        for (int ai = 0; ai < 2; ++ai)
#pragma unroll
            for (int m = 0; m < 4; ++m) {
                const int row = row0 + ai * 128 + m * 16;
                const float rs = rsqrtf(stats1[row] * (1.f / 2048.f) + EPS) * sc;
                bf16* rowp = base + (size_t)row * 2048 + col0;
#pragma unroll
                for (int bj = 0; bj < 2; ++bj) {
                    float v8[8];
#pragma unroll
                    for (int j = 0; j < 4; ++j) { v8[j] = acc[ai][bj][m][0][j] * rs; v8[4 + j] = acc[ai][bj][m][1][j] * rs; }
                    if (seg == 3) {
#pragma unroll
                        for (int j = 0; j < 8; ++j) v8[j] = silu_f(v8[j]);
                    }
                    *(u32x4*)(rowp + bj * 128) = pack8(v8);
                }
            }
    }
};

__device__ __forceinline__ void transpose_item(const float* W, int K, int N, bf16* WT, LAS float* scr, int item, int lane, const float* kscale) {
    const int nblk = N / 32, kb = item / nblk, nb = item % nblk, k0 = 64 * kb, n0 = 32 * nb;
#pragma unroll 8
    for (int i = 0; i < 32; ++i) { const int kk = 2 * i + (lane >> 5); float v = W[(size_t)(k0 + kk) * N + n0 + (lane & 31)]; if (kscale) v *= kscale[k0 + kk]; scr[kk * 33 + (lane & 31)] = v; }
    LDS_WAIT();
    const int c = lane & 7;
#pragma unroll
    for (int j = 0; j < 4; ++j) { const int n = (lane >> 3) + 8 * j; const LAS float* s = scr + (8 * c) * 33 + n;
        u32x4 o; o.x = pk2(s[0 * 33], s[1 * 33]); o.y = pk2(s[2 * 33], s[3 * 33]); o.z = pk2(s[4 * 33], s[5 * 33]); o.w = pk2(s[6 * 33], s[7 * 33]);
        *(u32x4*)(WT + (size_t)(n0 + n) * K + k0 + 8 * c) = o; }
    LDS_WAIT();
}

__device__ __forceinline__ void phase0(const PT& p, LAS unsigned char* lds, int tid, int lane, int wave) {
    unsigned char* ws = p.ws;
    const int gw = blockIdx.x * 8 + wave, NGW = gridDim.x * 8;
    const int gt = blockIdx.x * 512 + tid, NGT = gridDim.x * 512;
    LAS float* scr = (LAS float*)(lds + wave * 16384);
    for (int i = gt; i < 65536; i += NGT) ((float*)(ws + WS_ST0))[i] = 0.f;
    constexpr int I0 = 32 * (N0R / 32), I1 = 64 * 64, I2 = 32 * 256, I3 = 32 * 64;
    for (int it = gw; it < I0 + I1 + I2 + I3; it += NGW) {
        int r = it;
        if (r < I0) { transpose_item(p.in[2], 2048, N0R, (bf16*)(ws + WS_W0IN), scr, r, lane, nullptr); continue; } r -= I0;
        if (r < I1) { transpose_item(p.in[13], 4096, 2048, (bf16*)(ws + WS_W0OUT), scr, r, lane, nullptr); continue; } r -= I1;
        if (r < I2) { transpose_item(p.in[15], 2048, 8192, (bf16*)(ws + WS_W1IN), scr, r, lane, p.in[14]); continue; } r -= I2;
        transpose_item(p.in[21], 2048, 2048, (bf16*)(ws + WS_W1OUT), scr, r, lane, nullptr);
    }
    for (int i = gt; i < (N0P - N0R) * 2048 / 8; i += NGT) ((u32x4*)((bf16*)(ws + WS_W0IN) + (size_t)N0R * 2048))[i] = (u32x4){0u, 0u, 0u, 0u};
    for (int i = gt; i < 16 * 128 * 128 / 8; i += NGT) {
        const int e = i * 8, t = (e >> 7) & 127, s0 = e & 127; const float* src = p.in[5] + e; float v[8];
#pragma unroll
        for (int j = 0; j < 8; ++j) v[j] = (s0 + j <= t) ? src[j] : 0.f;
        ((u32x4*)(ws + WS_WSP))[i] = pack8(v);
    }
    const float* g0 = p.in[1]; bf16* H0 = (bf16*)(ws + WS_H0);
    for (int m = gw; m < M; m += NGW) {
        const f32x4* xr = (const f32x4*)(p.in[0] + (size_t)m * 2048) + lane; f32x4 v[8]; float s = 0.f;
#pragma unroll
        for (int j = 0; j < 8; ++j) { v[j] = xr[64 * j]; s += (v[j].x * v[j].x + v[j].y * v[j].y) + (v[j].z * v[j].z + v[j].w * v[j].w); }
        const float rs = rsqrtf(wave_sum(s) * (1.f / 2048.f) + EPS);
        u32x2* o = (u32x2*)(H0 + (size_t)m * 2048) + lane;
#pragma unroll
        for (int j = 0; j < 8; ++j) { const f32x4 g = ((const f32x4*)g0)[lane + 64 * j]; u32x2 w; w.x = pk2(v[j].x * rs * g.x, v[j].y * rs * g.y); w.y = pk2(v[j].z * rs * g.z, v[j].w * rs * g.w); o[64 * j] = w; }
    }
}

__device__ __forceinline__ void phase_layout(const PT& p, int tid) {
    unsigned char* ws = p.ws; unsigned char* dob = (unsigned char*)p.out;
    const bf16* Vb = (const bf16*)(ws + WS_V); const float* st0 = (const float*)(ws + WS_ST0);
    const bf16* XBC = (const bf16*)(dob + DO_XBC);
    bf16 *vT = (bf16*)(ws + WS_VT), *xT = (bf16*)(ws + WS_XT), *Bn = (bf16*)(dob + DO_BN), *BT = (bf16*)(dob + DO_BT), *Cn = (bf16*)(ws + WS_CN);
    const int t = tid & 255, so = t >> 4, co = t & 15;
    for (int pi = blockIdx.x * 2 + (tid >> 8); pi < 128 * 40; pi += gridDim.x * 2) {
        const int bc = pi / 40, k = pi % 40; const int tok0 = bc * 128 + so * 8;
        float o[8][8];
        if (k < 16) {
            const int ch0 = k * 128 + co * 8;
            float g[8], bb[8];
#pragma unroll
            for (int j = 0; j < 8; ++j) { g[j] = p.in[3][ch0 + j]; bb[j] = p.in[4][ch0 + j]; }
#pragma unroll
            for (int i = 0; i < 8; ++i) {
                const int row = tok0 + i; float f[8]; unpack8(*(const u32x4*)(Vb + (size_t)row * 2048 + ch0), f);
                const float mu = st0[2 * row] * (1.f / 2048.f), var = st0[2 * row + 1] * (1.f / 2048.f) - mu * mu, rs = rsqrtf(fmaxf(var, 0.f) + EPS);
#pragma unroll
                for (int j = 0; j < 8; ++j) o[i][j] = (f[j] - mu) * rs * g[j] + bb[j];
            }
#pragma unroll
            for (int j = 0; j < 8; ++j) { float c8[8];
#pragma unroll
                for (int i = 0; i < 8; ++i) c8[i] = o[i][j];
                *(u32x4*)(vT + ((size_t)bc * 2048 + ch0 + j) * 128 + so * 8) = pack8(c8); }
        } else {
            const int sc0 = (k - 16) * 128 + co * 8;
            float cw[4][8], cb[8];
#pragma unroll
            for (int j = 0; j < 8; ++j) { cb[j] = p.in[8][sc0 + j];
#pragma unroll
                for (int kk = 0; kk < 4; ++kk) cw[kk][j] = p.in[7][kk * 3072 + sc0 + j]; }
            const int pos0 = (bc & 15) * 128 + so * 8;
            float xw[11][8];
#pragma unroll
            for (int ii = 0; ii < 11; ++ii) {
                if (pos0 - 3 + ii >= 0) unpack8(*(const u32x4*)(XBC + (size_t)(tok0 - 3 + ii) * 3072 + sc0), xw[ii]);
                else {
#pragma unroll
                    for (int j = 0; j < 8; ++j) xw[ii][j] = 0.f;
                }
            }
#pragma unroll
            for (int i = 0; i < 8; ++i)
#pragma unroll
                for (int j = 0; j < 8; ++j) { float a = cb[j];
#pragma unroll
                    for (int kk = 0; kk < 4; ++kk) a += cw[kk][j] * xw[i + kk][j];
                    o[i][j] = silu_f(a); }
            if (k < 32) {
#pragma unroll
                for (int j = 0; j < 8; ++j) { float c8[8];
#pragma unroll
                    for (int i = 0; i < 8; ++i) c8[i] = o[i][j];
                    *(u32x4*)(xT + ((size_t)bc * 2048 + sc0 + j) * 128 + so * 8) = pack8(c8); }
            } else if (k < 36) {
                const int n0 = sc0 - 2048;
#pragma unroll
                for (int i = 0; i < 8; ++i) *(u32x4*)(Bn + (size_t)(tok0 + i) * 512 + n0) = pack8(o[i]);
#pragma unroll
                for (int j = 0; j < 8; ++j) { float c8[8];
#pragma unroll
                    for (int i = 0; i < 8; ++i) c8[i] = o[i][j];
                    *(u32x4*)(BT + ((size_t)bc * 512 + n0 + j) * 128 + so * 8) = pack8(c8); }
            } else {
                const int n0 = sc0 - 2560;
#pragma unroll
                for (int i = 0; i < 8; ++i) *(u32x4*)(Cn + (size_t)(tok0 + i) * 512 + n0) = pack8(o[i]);
            }
        }
    }
}

__device__ __forceinline__ void chunk_cumsum(const float* DT, const float* a_log, int tok0, int hh, int lane, float& d0, float& d1, float& c0, float& c1, float& tot) {
    d0 = DT[(size_t)(tok0 + 2 * lane) * 32 + hh]; d1 = DT[(size_t)(tok0 + 2 * lane + 1) * 32 + hh];
    const float A = -__expf(a_log[hh]); const float x0 = d0 * A, x1 = d1 * A; float ps = x0 + x1;
#pragma unroll
    for (int o = 1; o < 64; o <<= 1) { const float t = __shfl_up(ps, o); if (lane >= o) ps += t; }
    c1 = ps; c0 = ps - x1; tot = __shfl(ps, 63);
}

__device__ __forceinline__ void phase_mix(const PT& p, LAS unsigned char* lds, int tid, int lane, int wave) {
    unsigned char* ws = p.ws; unsigned char* dob = (unsigned char*)p.out;
    const int r32 = lane & 31, h = lane >> 5;
    bf16* Ycat = (bf16*)(ws + WS_YCAT); const bf16* ZA = (const bf16*)(ws + WS_ZA); const bf16* vT = (const bf16*)(ws + WS_VT); const bf16* Wsp = (const bf16*)(ws + WS_WSP);
    const bf16* xT = (const bf16*)(ws + WS_XT); const bf16* BT = (const bf16*)(dob + DO_BT); const float* DT = (const float*)(ws + WS_DT);
    bf16* ST = (bf16*)(ws + WS_STATES); float* CD = (float*)(ws + WS_CD);
    LAS float* wtab = (LAS float*)lds;
    constexpr int NG = 128 * 16, NS = NBATCH * 15 * 4;
    for (int it = blockIdx.x; it < NG + NS; it += gridDim.x) {
        if (it < NG) {
            const int bc = it >> 4, g = it & 15, cb = wave & 3, th = wave >> 2;
            const int ch0 = g * 128 + cb * 32;
            const bf16* ap = vT + ((size_t)bc * 2048 + ch0 + r32) * 128 + 8 * h;
            f32x16 acc[2];
#pragma unroll
            for (int i = 0; i < 16; ++i) { acc[0][i] = 0.f; acc[1][i] = 0.f; }
#pragma unroll
            for (int st = 0; st < 8; ++st) {
                const bf16x8 a = ld_frag16(ap + 16 * st);
#pragma unroll
                for (int t2 = 0; t2 < 2; ++t2) { const int tb = 2 * th + t2;
                    if (st < 2 * (tb + 1)) { const bf16x8 b = ld_frag16(Wsp + ((size_t)g * 128 + tb * 32 + r32) * 128 + 16 * st + 8 * h); acc[t2] = mfma32(a, b, acc[t2]); } }
            }
#pragma unroll
            for (int t2 = 0; t2 < 2; ++t2) {
                const int t = (2 * th + t2) * 32 + r32; const size_t tok = (size_t)bc * 128 + t; const float sb = p.in[6][g * 128 + t];
#pragma unroll
                for (int qd = 0; qd < 4; ++qd) {
                    const int ch = ch0 + 8 * qd + 4 * h;
                    u32x2* up = (u32x2*)(Ycat + tok * 4096 + ch); const u32x2 uu = *up, zz = *(const u32x2*)(ZA + tok * 2048 + ch);
                    const float y0 = bflo(uu.x) * (acc[t2][4 * qd] + sb) * bflo(zz.x), y1 = bfhi(uu.x) * (acc[t2][4 * qd + 1] + sb) * bfhi(zz.x);
                    const float y2 = bflo(uu.y) * (acc[t2][4 * qd + 2] + sb) * bflo(zz.y), y3 = bfhi(uu.y) * (acc[t2][4 * qd + 3] + sb) * bfhi(zz.y);
                    u32x2 w; w.x = pk2(y0, y1); w.y = pk2(y2, y3); *up = w;
                }
            }
        } else {
            const int id = it - NG, b = id / 60, c = (id / 4) % 15, grp = id & 3; const int bc = b * 16 + c, tok0 = bc * 128;
            __syncthreads();
            { const int hh = grp * 8 + wave; float d0, d1, c0, c1, tot; chunk_cumsum(DT, p.in[10], tok0, hh, lane, d0, d1, c0, c1, tot);
              wtab[wave * 128 + 2 * lane] = d0 * __expf(tot - c0); wtab[wave * 128 + 2 * lane + 1] = d1 * __expf(tot - c1);
              if (lane == 0) CD[bc * 32 + hh] = __expf(tot); }
            __syncthreads();
#pragma unroll 1
            for (int tk = 0; tk < 2; ++tk) {
                const int r = (wave >> 1) + 4 * tk, pb = wave & 1, hh = grp * 8 + r;
                const bf16* ap = xT + ((size_t)bc * 2048 + hh * 64 + pb * 32 + r32) * 128 + 8 * h;
                const bf16* bp = BT + ((size_t)bc * 512 + grp * 128 + r32) * 128 + 8 * h;
                f32x16 acc[4];
#pragma unroll
                for (int nb = 0; nb < 4; ++nb)
#pragma unroll
                    for (int i = 0; i < 16; ++i) acc[nb][i] = 0.f;
#pragma unroll
                for (int st = 0; st < 8; ++st) {
                    float f[8]; unpack8(*(const u32x4*)(ap + 16 * st), f);
                    const f32x4 w0 = *(const LAS f32x4*)(wtab + r * 128 + 16 * st + 8 * h), w1 = *(const LAS f32x4*)(wtab + r * 128 + 16 * st + 8 * h + 4);
                    f[0] *= w0.x; f[1] *= w0.y; f[2] *= w0.z; f[3] *= w0.w; f[4] *= w1.x; f[5] *= w1.y; f[6] *= w1.z; f[7] *= w1.w;
                    const bf16x8 a = __builtin_bit_cast(bf16x8, pack8(f));
#pragma unroll
                    for (int nb = 0; nb < 4; ++nb) { const bf16x8 bfr = ld_frag16(bp + (size_t)nb * 32 * 128 + 16 * st); acc[nb] = mfma32(a, bfr, acc[nb]); }
                }
                bf16* sp = ST + ((size_t)(bc * 32 + hh) * 64 + pb * 32) * 128;
#pragma unroll
                for (int nb = 0; nb < 4; ++nb)
#pragma unroll
                    for (int i = 0; i < 16; ++i) sp[(size_t)crow(i, h) * 128 + nb * 32 + r32] = (bf16)(pk2(acc[nb][i], 0.f) & 0xffffu);
            }
        }
    }
}

__device__ __forceinline__ void phase_scan(const PT& p, int tid) {
    unsigned char* ws = p.ws; const bf16* ST = (const bf16*)(ws + WS_STATES); const float* CD = (const float*)(ws + WS_CD); bf16* PV = (bf16*)((unsigned char*)p.out + DO_PREV);
    for (int id = blockIdx.x * 512 + tid; id < NBATCH * 32 * 64 * 16; id += gridDim.x * 512) {
        const int b = id >> 15, rem = id & 32767, hh = rem >> 10;
        float run[8];
#pragma unroll
        for (int j = 0; j < 8; ++j) run[j] = 0.f;
#pragma unroll
        for (int c = 0; c < 16; ++c) {
            const size_t off = ((size_t)(b * 16 + c) * 32 * 64 * 16 + rem) * 8;
            *(u32x4*)(PV + off) = pack8(run);
            if (c < 15) { float s[8]; unpack8(*(const u32x4*)(ST + off), s); const float cd = CD[(b * 16 + c) * 32 + hh];
#pragma unroll
                for (int j = 0; j < 8; ++j) run[j] = run[j] * cd + s[j]; }
        }
    }
}

__device__ __forceinline__ void phase_ssd_y(const PT& p, LAS unsigned char* lds, int tid, int lane, int wave) {
    unsigned char* ws = p.ws; unsigned char* dob = (unsigned char*)p.out;
    const int r32 = lane & 31, h = lane >> 5;
    bf16* Ycat = (bf16*)(ws + WS_YCAT); const bf16* xT = (const bf16*)(ws + WS_XT); const bf16* Bn = (const bf16*)(dob + DO_BN); const bf16* Cn = (const bf16*)(ws + WS_CN);
    const bf16* PV = (const bf16*)(dob + DO_PREV); const float* DT = (const float*)(ws + WS_DT);
    LAS float* acum = (LAS float*)lds; LAS float* dtt = acum + 1024; LAS float* ssqp = dtt + 1024;
    for (int it = blockIdx.x; it < 128 * 4; it += gridDim.x) {
        const int bc = it >> 2, grp = it & 3, tok0 = bc * 128;
        __syncthreads();
        { const int hh = grp * 8 + wave; float d0, d1, c0, c1, tot; chunk_cumsum(DT, p.in[10], tok0, hh, lane, d0, d1, c0, c1, tot);
          acum[wave * 128 + 2 * lane] = c0; acum[wave * 128 + 2 * lane + 1] = c1; dtt[wave * 128 + 2 * lane] = d0; dtt[wave * 128 + 2 * lane + 1] = d1; }
        __syncthreads();
        const int pb = wave >> 2, lb = wave & 3, l = lb * 32 + r32; const size_t tok = (size_t)tok0 + l;
        bf16x8 cf[8];
#pragma unroll
        for (int st = 0; st < 8; ++st) cf[st] = ld_frag16(Cn + tok * 512 + grp * 128 + 16 * st + 8 * h);
        f32x16 X[4];
#pragma unroll
        for (int sb = 0; sb < 4; ++sb) {
#pragma unroll
            for (int i = 0; i < 16; ++i) X[sb][i] = 0.f;
            if (sb <= lb) {
#pragma unroll
                for (int st = 0; st < 8; ++st) X[sb] = mfma32(ld_frag16(Bn + ((size_t)tok0 + sb * 32 + r32) * 512 + grp * 128 + 16 * st + 8 * h), cf[st], X[sb]);
            }
        }
        float ssq = 0.f;
#pragma unroll 1
        for (int r = 0; r < 8; ++r) {
            const int hh = grp * 8 + r;
            f32x16 acc;
#pragma unroll
            for (int i = 0; i < 16; ++i) acc[i] = 0.f;
            const bf16* pp = PV + ((size_t)(bc * 32 + hh) * 64 + pb * 32 + r32) * 128 + 8 * h;
#pragma unroll
            for (int st = 0; st < 8; ++st) acc = mfma32(ld_frag16(pp + 16 * st), cf[st], acc);
            const float al = acum[r * 128 + l]; const float el = __expf(al);
#pragma unroll
            for (int i = 0; i < 16; ++i) acc[i] *= el;
            const bf16* xrow = xT + ((size_t)bc * 2048 + hh * 64 + pb * 32 + r32) * 128 + 4 * h;
#pragma unroll
            for (int sb = 0; sb < 4; ++sb) {
                if (sb <= lb) {
                    f32x16 mm;
#pragma unroll
                    for (int qd = 0; qd < 4; ++qd) {
                        const int s0 = sb * 32 + 8 * qd + 4 * h;
                        const f32x4 as = *(const LAS f32x4*)(acum + r * 128 + s0), ds = *(const LAS f32x4*)(dtt + r * 128 + s0);
#pragma unroll
                        for (int j = 0; j < 4; ++j) { const float v = X[sb][4 * qd + j] * __expf(al - as[j]) * ds[j]; mm[4 * qd + j] = (s0 + j <= l) ? v : 0.f; }
                    }
#pragma unroll
                    for (int s2 = 0; s2 < 2; ++s2) acc = mfma32(ld_frag8x2(xrow + sb * 32 + 16 * s2), pack_frag(mm, s2), acc);
                }
            }
            const float dsk = p.in[11][hh];
#pragma unroll
            for (int qd = 0; qd < 4; ++qd) {
                const int ch = hh * 64 + pb * 32 + 8 * qd + 4 * h;
                const bf16* xc = xT + ((size_t)bc * 2048 + ch) * 128 + l;
                u32x2* yp = (u32x2*)(Ycat + tok * 4096 + 2048 + ch); const u32x2 zz = *yp;
                const float y0 = (acc[4 * qd] + dsk * bflo((unsigned)xc[0])) * bflo(zz.x), y1 = (acc[4 * qd + 1] + dsk * bflo((unsigned)xc[128])) * bfhi(zz.x);
                const float y2 = (acc[4 * qd + 2] + dsk * bflo((unsigned)xc[256])) * bflo(zz.y), y3 = (acc[4 * qd + 3] + dsk * bflo((unsigned)xc[384])) * bfhi(zz.y);
                ssq += (y0 * y0 + y1 * y1) + (y2 * y2 + y3 * y3);
                u32x2 w; w.x = pk2(y0, y1); w.y = pk2(y2, y3); *yp = w;
            }
        }
        ssq += __shfl_xor(ssq, 32);
        if (h == 0) ssqp[pb * 128 + l] = ssq;
        __syncthreads();
        const float rs = rsqrtf((ssqp[l] + ssqp[128 + l]) * (1.f / 512.f) + EPS);
#pragma unroll 1
        for (int r = 0; r < 8; ++r) {
#pragma unroll
            for (int qd = 0; qd < 4; ++qd) {
                const int ch = (grp * 8 + r) * 64 + pb * 32 + 8 * qd + 4 * h;
                u32x2* yp = (u32x2*)(Ycat + tok * 4096 + 2048 + ch); const u32x2 yy = *yp; const f32x4 g = *(const f32x4*)(p.in[12] + ch);
                u32x2 w; w.x = pk2(bflo(yy.x) * rs * g.x, bfhi(yy.x) * rs * g.y); w.y = pk2(bflo(yy.y) * rs * g.z, bfhi(yy.y) * rs * g.w); *yp = w;
            }
        }
    }
}

constexpr int AK_PITCH = 272, AV_PITCH = 272, A_KOFF = 0, A_VOFF = 128 * AK_PITCH, A_XOFF = A_VOFF + 128 * AV_PITCH;
static_assert(A_XOFF + 4 * 16384 <= LDS_BYTES, "attention LDS map");
__device__ __forceinline__ void attn_unit(const PT& p, LAS unsigned char* lds, int tid, int lane, int wave, int b, int hd, int qb, float lam) {
    unsigned char* ws = p.ws;
    const bf16* Qb = (const bf16*)(ws + WS_Q); const bf16* Kb = (const bf16*)(ws + WS_K); const bf16* Vb = (const bf16*)(ws + WS_VV); const bf16* Gb = (const bf16*)((unsigned char*)p.out + DO_G);
    bf16* Ob = (bf16*)(ws + WS_O);
    const int r32 = lane & 31, h = lane >> 5, mp = wave >> 2, wq = wave & 3;
    const int qw0 = qb * 128 + 32 * wq, q = qw0 + r32; const size_t tokq = (size_t)b * SEQ + q, tokb = (size_t)b * SEQ;
    const float slope2 = fexp2(-0.5f * (float)(hd + 1)) * LOG2E;
    bf16x8 qf[4];
#pragma unroll
    for (int ds = 0; ds < 4; ++ds) qf[ds] = ld_frag16(Qb + tokq * 2048 + hd * 128 + mp * 64 + 16 * ds + 8 * h);
    float mrun = -INFINITY, lsum = 0.f;
    f32x16 oT[4];
#pragma unroll
    for (int db = 0; db < 4; ++db)
#pragma unroll
        for (int i = 0; i < 16; ++i) oT[db][i] = 0.f;
    const int ntiles = qb + 1;
    const int kq = tid >> 4, dq = tid & 15;
    u32x4 preV[4], preK[4];
#define PREFETCH(t) do { \
        _Pragma("unroll") for (int i_ = 0; i_ < 4; ++i_) preV[i_] = *(const u32x4*)(Vb + (tokb + (t) * 128 + 4 * kq + i_) * 2048 + hd * 128 + 8 * dq); \
        _Pragma("unroll") for (int i_ = 0; i_ < 4; ++i_) { const int pid_ = tid + 512 * i_, row_ = pid_ >> 4, c16_ = pid_ & 15; preK[i_] = *(const u32x4*)(Kb + (tokb + (t) * 128 + row_) * 2048 + hd * 128 + 8 * c16_); } \
    } while (0)
    PREFETCH(0);
#pragma unroll 1
    for (int t = 0; t < ntiles; ++t) {
        __syncthreads();
        {
            const unsigned w0[4] = {preV[0].x, preV[1].x, preV[2].x, preV[3].x}, w1[4] = {preV[0].y, preV[1].y, preV[2].y, preV[3].y}, w2[4] = {preV[0].z, preV[1].z, preV[2].z, preV[3].z}, w3[4] = {preV[0].w, preV[1].w, preV[2].w, preV[3].w};
#define VT_ST(j, W, HI) { u32x2 o; if (HI) { o.x = (W[0] >> 16) | (W[1] & 0xffff0000u); o.y = (W[2] >> 16) | (W[3] & 0xffff0000u); } else { o.x = (W[0] & 0xffffu) | (W[1] << 16); o.y = (W[2] & 0xffffu) | (W[3] << 16); } \
              *(LAS u32x2*)(lds + A_VOFF + (8 * dq + (j)) * AV_PITCH + 8 * kq) = o; }
            VT_ST(0, w0, 0) VT_ST(1, w0, 1) VT_ST(2, w1, 0) VT_ST(3, w1, 1) VT_ST(4, w2, 0) VT_ST(5, w2, 1) VT_ST(6, w3, 0) VT_ST(7, w3, 1)
#undef VT_ST
#pragma unroll
            for (int i = 0; i < 4; ++i) { const int pid = tid + 512 * i, row = pid >> 4, c16 = pid & 15; *(LAS u32x4*)(lds + A_KOFF + row * AK_PITCH + 16 * c16) = preK[i]; }
        }
        __syncthreads();
        if (t + 1 < ntiles) PREFETCH(t + 1);
#pragma unroll 1
        for (int sub = 0; sub < 2; ++sub) {
            const int kvl = sub * 64, kv0 = t * 128 + kvl;
            if (kv0 <= qw0 + 31) {
                const bool partial = (kv0 + 63 > qw0);
                f32x16 s0, s1;
#pragma unroll
                for (int i = 0; i < 16; ++i) { s0[i] = 0.f; s1[i] = 0.f; }
#pragma unroll
                for (int ds = 0; ds < 4; ++ds) {
                    const bf16x8 a0 = __builtin_bit_cast(bf16x8, *(const LAS u32x4*)(lds + A_KOFF + (kvl + r32) * AK_PITCH + (mp * 64 + 16 * ds + 8 * h) * 2));
                    const bf16x8 a1 = __builtin_bit_cast(bf16x8, *(const LAS u32x4*)(lds + A_KOFF + (kvl + 32 + r32) * AK_PITCH + (mp * 64 + 16 * ds + 8 * h) * 2));
                    s0 = mfma32(a0, qf[ds], s0); s1 = mfma32(a1, qf[ds], s1);
                }
                float mx = -INFINITY;
#pragma unroll
                for (int i = 0; i < 16; ++i) {
                    const int kva = kv0 + crow(i, h), kvb = kva + 32;
                    s0[i] += slope2 * (float)(kva - q); s1[i] += slope2 * (float)(kvb - q);
                    if (partial) { if (kva > q) s0[i] = -INFINITY; if (kvb > q) s1[i] = -INFINITY; }
                    mx = fmaxf(mx, fmaxf(s0[i], s1[i]));
                }
                mx = fmaxf(mx, __shfl_xor(mx, 32));
                const float mnew = fmaxf(mrun, mx), alpha = fexp2(mrun - mnew); mrun = mnew;
                float rs = 0.f;
#pragma unroll
                for (int i = 0; i < 16; ++i) { s0[i] = fexp2(s0[i] - mnew); s1[i] = fexp2(s1[i] - mnew); rs += s0[i] + s1[i]; }
                lsum = lsum * alpha + rs;
#pragma unroll
                for (int db = 0; db < 4; ++db)
#pragma unroll
                    for (int i = 0; i < 16; ++i) oT[db][i] *= alpha;
#pragma unroll
                for (int kb = 0; kb < 2; ++kb)
#pragma unroll
                    for (int s2 = 0; s2 < 2; ++s2) {
                        const bf16x8 pf = pack_frag(kb == 0 ? s0 : s1, s2);
#pragma unroll
                        for (int db = 0; db < 4; ++db) {
                            const LAS unsigned char* vp = lds + A_VOFF + (db * 32 + r32) * AV_PITCH + (kvl + kb * 32 + 16 * s2 + 4 * h) * 2;
                            const u32x2 lo = *(const LAS u32x2*)vp, hi = *(const LAS u32x2*)(vp + 16);
                            u32x4 v; v.x = lo.x; v.y = lo.y; v.z = hi.x; v.w = hi.y;
                            oT[db] = mfma32(__builtin_bit_cast(bf16x8, v), pf, oT[db]);
                        }
                    }
            }
        }
    }
#undef PREFETCH
    const float lt = lsum + __shfl_xor(lsum, 32);
    LAS float* xch = (LAS float*)(lds + A_XOFF + wq * 16384);
    if (mp == 1) { const float sc = lam / lt;
#pragma unroll
        for (int db = 0; db < 4; ++db)
#pragma unroll
            for (int i = 0; i < 16; ++i) xch[(db * 16 + i) * 64 + lane] = oT[db][i] * sc; }
    __syncthreads();
    if (mp == 0) {
        const float i1 = 1.f / lt; float ss = 0.f;
#pragma unroll
        for (int db = 0; db < 4; ++db)
#pragma unroll
            for (int i = 0; i < 16; ++i) { const float o = oT[db][i] * i1 - xch[(db * 16 + i) * 64 + lane]; oT[db][i] = o; ss += o * o; }
        ss += __shfl_xor(ss, 32);
        const float rn = rsqrtf(ss * (1.f / 128.f) + EPS) * (1.f - LAMBDA_INIT);
#pragma unroll
        for (int db = 0; db < 4; ++db)
#pragma unroll
            for (int qd = 0; qd < 4; ++qd) {
                const int d = db * 32 + 8 * qd + 4 * h; const size_t off = tokq * 2048 + hd * 128 + d;
                const u32x2 gg = *(const u32x2*)(Gb + off); const f32x4 sg = *(const f32x4*)(p.in[20] + d);
                u32x2 w; w.x = pk2(oT[db][4 * qd] * rn * sg.x * bflo(gg.x), oT[db][4 * qd + 1] * rn * sg.y * bfhi(gg.x));
                w.y = pk2(oT[db][4 * qd + 2] * rn * sg.z * bflo(gg.y), oT[db][4 * qd + 3] * rn * sg.w * bfhi(gg.y));
                *(u32x2*)(Ob + off) = w;
            }
    }
}

__device__ __forceinline__ void phase_attn(const PT& p, LAS unsigned char* lds, int tid, int lane, int wave) {
    const float s1 = wave_sum(p.in[16][lane] * p.in[17][lane]), s2 = wave_sum(p.in[18][lane] * p.in[19][lane]);
    const float lam = __expf(s1) - __expf(s2) + LAMBDA_INIT;
#pragma unroll 1
    for (int u = blockIdx.x; u < NBATCH * 16 * 8; u += gridDim.x) {
        const int j = u & 7, hd = (u >> 3) & 15, b = u >> 7;
#pragma unroll 1
        for (int k = 0; k < 2; ++k) attn_unit(p, lds, tid, lane, wave, b, hd, k == 0 ? 15 - j : j, lam);
    }
}

__device__ __forceinline__ void phase_final(const PT& p, int lane, int wave) {
    const float* st2 = (const float*)(p.ws + WS_ST2); const float* g = p.in[22];
    for (int m = blockIdx.x * 8 + wave; m < M; m += gridDim.x * 8) {
        const float rs = rsqrtf(st2[m] * (1.f / 2048.f) + EPS);
        f32x4* xr = (f32x4*)(p.out + (size_t)m * 2048) + lane;
#pragma unroll
        for (int j = 0; j < 8; ++j) { const f32x4 gg = ((const f32x4*)g)[lane + 64 * j]; f32x4 v = xr[64 * j]; v.x *= rs * gg.x; v.y *= rs * gg.y; v.z *= rs * gg.z; v.w *= rs * gg.w; xr[64 * j] = v; }
    }
}

__global__ void __launch_bounds__(512) fwd_megakernel(Params pa) {
    extern __shared__ __attribute__((aligned(16))) unsigned char lds_raw[];
    cg::grid_group grid = cg::this_grid();
    LAS unsigned char* lds = (LAS unsigned char*)lds_raw;
    if (threadIdx.x < 25) {
        unsigned long long v = 0;
#pragma unroll
        for (int i = 0; i < 23; ++i) if ((int)threadIdx.x == i) v = (unsigned long long)pa.in[i];
        if (threadIdx.x == 23) v = (unsigned long long)pa.out;
        if (threadIdx.x == 24) v = (unsigned long long)pa.ws;
        ((LAS unsigned long long*)(lds + PTAB_OFF))[threadIdx.x] = v;
    }
    __syncthreads();
#ifndef PHMASK
#define PHMASK 0x3ff
#endif
#define PH(n) (((PHMASK) >> (n)) & 1)
#define TLW int tid_ = threadIdx.x; asm volatile("" : "+v"(tid_)); const int tid = tid_, lane = tid & 63, wave = __builtin_amdgcn_readfirstlane(tid >> 6); (void)tid; (void)lane; (void)wave
#define GRIDV const int G = gridDim.x, c = blockIdx.x
    if (PH(0)) { PT p; TLW; phase0(p, lds, tid, lane, wave); }
    grid.sync();
    if (PH(1)) {
        PT p; GRIDV; unsigned char* ws = p.ws; unsigned char* dob = (unsigned char*)p.out;
        pg8::Gemm g{(const pg8::bf16_t*)(ws + WS_H0), (const pg8::bf16_t*)(ws + WS_W0IN), M, N0P, 2048}; pg8::StaticOrder S; S.init(M, N0P, G, c);
        EpiIn0 E{(bf16*)(ws + WS_YCAT), (bf16*)(ws + WS_V), (bf16*)(ws + WS_ZA), (bf16*)(dob + DO_XBC), (float*)(ws + WS_DT), (float*)(ws + WS_ST0), p.in[9]};
        pg8::gemm_phase<EpiIn0, pg8::StaticOrder, true, true>(lds, g, S, E);
    }
    grid.sync();
    if (PH(2)) { PT p; TLW; phase_layout(p, tid); }
    grid.sync();
    if (PH(3)) { PT p; TLW; phase_mix(p, lds, tid, lane, wave); }
    grid.sync();
    if (PH(4)) { PT p; TLW; phase_scan(p, tid); }
    grid.sync();
    if (PH(5)) { PT p; TLW; phase_ssd_y(p, lds, tid, lane, wave); }
    grid.sync();
    if (PH(6)) {
        PT p; GRIDV; unsigned char* ws = p.ws;
        pg8::Gemm g{(const pg8::bf16_t*)(ws + WS_YCAT), (const pg8::bf16_t*)(ws + WS_W0OUT), M, 2048, 4096}; pg8::StaticOrder S; S.init(M, 2048, G, c);
        EpiRes E{p.in[0], (float*)(ws + WS_X1), (bf16*)(ws + WS_X1B), (float*)(ws + WS_ST1)};
        pg8::gemm_phase<EpiRes, pg8::StaticOrder, true, true>(lds, g, S, E);
    }
    grid.sync();
    if (PH(6)) {
        PT p; GRIDV; unsigned char* ws = p.ws; unsigned char* dob = (unsigned char*)p.out;
        pg8::Gemm g{(const pg8::bf16_t*)(ws + WS_X1B), (const pg8::bf16_t*)(ws + WS_W1IN), M, 8192, 2048}; pg8::StaticOrder S; S.init(M, 8192, G, c);
        EpiIn1 E{(bf16*)(ws + WS_Q), (bf16*)(ws + WS_K), (bf16*)(ws + WS_VV), (bf16*)(dob + DO_G), (const float*)(ws + WS_ST1)};
        pg8::gemm_phase<EpiIn1, pg8::StaticOrder, true, true>(lds, g, S, E);
    }
    grid.sync();
    if (PH(7)) { PT p; TLW; phase_attn(p, lds, tid, lane, wave); }
    grid.sync();
    if (PH(8)) {
        PT p; GRIDV; unsigned char* ws = p.ws;
        pg8::Gemm g{(const pg8::bf16_t*)(ws + WS_O), (const pg8::bf16_t*)(ws + WS_W1OUT), M, 2048, 2048}; pg8::StaticOrder S; S.init(M, 2048, G, c);
        EpiRes E{(const float*)(ws + WS_X1), p.out, nullptr, (float*)(ws + WS_ST2)};
        pg8::gemm_phase<EpiRes, pg8::StaticOrder, true, true>(lds, g, S, E);
    }
    grid.sync();
    if (PH(9)) { PT p; TLW; phase_final(p, lane, wave); }
}

extern "C" void kernel_launch(void* const* d_in, const int* in_sizes, int n_in, void* d_out, int out_size, void* d_ws, size_t ws_size, hipStream_t stream) {
    static int grid = 0;
    if (grid == 0) {
        if (n_in != 23 || out_size != M * DM || ws_size < WS_END) { fprintf(stderr, "kernel_launch: unexpected shapes (n_in %d out %d ws %zu)\n", n_in, out_size, ws_size); grid = -1; return; }
        int dev = 0, cus = 0, per_cu = 0;
        hipGetDevice(&dev); hipDeviceGetAttribute(&cus, hipDeviceAttributeMultiprocessorCount, dev);
        hipFuncSetAttribute((const void*)fwd_megakernel, hipFuncAttributeMaxDynamicSharedMemorySize, LDS_BYTES);
        hipOccupancyMaxActiveBlocksPerMultiprocessor(&per_cu, (const void*)fwd_megakernel, 512, LDS_BYTES);
        if (per_cu < 1) { fprintf(stderr, "kernel_launch: occupancy query says %d blocks per CU\n", per_cu); per_cu = 1; }
        (void)hipGetLastError();
        grid = cus;
    }
    if (grid < 0) return;
    Params p{};
    for (int i = 0; i < 23; ++i) p.in[i] = (const float*)d_in[i];
    p.out = (float*)d_out; p.ws = (unsigned char*)d_ws;
    void* args[] = {&p};
    hipError_t e = hipLaunchCooperativeKernel((const void*)fwd_megakernel, dim3(grid), dim3(512), args, LDS_BYTES, stream);
    if (e != hipSuccess) fprintf(stderr, "cooperative launch failed: %s (grid %d)\n", hipGetErrorString(e), grid);
}
```

```cpp
#include <hip/hip_runtime.h>
#include <hip/hip_cooperative_groups.h>
#include <cstdio>
#include <cstdint>
#include <cmath>
namespace cg = cooperative_groups;
namespace pg8 {
#define PG8_LAS __attribute__((address_space(3)))
typedef unsigned short bf16_t;
typedef short bf16x8 __attribute__((ext_vector_type(8)));
typedef float f32x4 __attribute__((ext_vector_type(4)));
typedef unsigned u32x4 __attribute__((ext_vector_type(4)));
constexpr int BM = 256, BK = 64, HALF = 128, HTB = HALF * BK * 2  , STAGE_BYTES = 8 * HTB, NXCD = 8, WGM = 8;

__host__ __device__ __forceinline__ int lds_byte(int r, int c) { const int st = (r >> 4) * 2 + (c >> 5), rr = r & 15, cc = c & 31, ob = rr * 64 + cc * 2; return st * 1024 + (ob ^ (((ob >> 9) & 1) << 5)); }
__host__ __device__ __forceinline__ void stage_rc(int b, int& R, int& C) { const int st = b / 1024, sb = b % 1024, swz = sb ^ (((sb >> 9) & 1) << 5); R = (st >> 1) * 16 + swz / 64; C = (st & 1) * 32 + (swz % 64) / 2; }
__host__ __device__ __forceinline__ int perm32(int rho) { const int n = rho >> 4, i = rho & 15; return 8 * (i >> 2) + 4 * n + (i & 3); }

struct Unit { int pm, pn; };
struct Gemm { const bf16_t* A; const bf16_t* Bt; int M, N, K; };

struct StaticOrder {
    int nM, nN, nwg, G, c;
    __host__ __device__ void init(int M, int N, int G_, int c_) { nM = M / BM; nN = N / BM; nwg = nM * nN; G = G_; c = c_; }
    __host__ __device__ bool next(int i, Unit& u) const {
        const long L = (long)i * G + c; if (L >= nwg) return false;
        int wgid = (int)L; { const int q = nwg / NXCD, r = nwg % NXCD, xcd = wgid % NXCD, off = wgid / NXCD; wgid = (xcd < r ? xcd * (q + 1) : r * (q + 1) + (xcd - r) * q) + off; }
        const int nig = WGM * nN, gid = wgid / nig, fm = gid * WGM, gsz = (nM - fm) < WGM ? (nM - fm) : WGM;
        u.pm = fm + ((wgid % nig) % gsz); u.pn = (wgid % nig) / gsz; return true;
    }
    __device__ __forceinline__ void a_ready(const Unit&) const {}
    __device__ __forceinline__ void done(const Unit&) const {}
};

template <class Epi, class Sched, bool ALIGN_EPI = false, bool SP2 = false>
__device__ __forceinline__ void gemm_phase(PG8_LAS unsigned char* lds, const Gemm g, const Sched& S, const Epi& E) {
    int tid_ = threadIdx.x; asm volatile("" : "+v"(tid_));
    const int tid = tid_, wid = __builtin_amdgcn_readfirstlane(tid >> 6), lane = tid & 63, wr = wid >> 2, wc = wid & 3, fr = lane & 15, fq = lane >> 4;
    const int K = g.K, nt = K / BK;
    unsigned voffA[2], voffB[2];
#pragma unroll
    for (int i = 0; i < 2; ++i) { int R, C; stage_rc(tid * 16 + i * 8192, R, C); const int Rb = Epi::PERM ? ((R & ~31) + perm32(R & 31)) : R;
        voffA[i] = (unsigned)(R * K + C) * 2u; voffB[i] = (unsigned)(Rb * K + C) * 2u; }
    const size_t kstep = (size_t)(BK * 2);
    const size_t hstep = (size_t)HALF * K * 2;
    const size_t tstep = 2 * hstep;
    const unsigned ldsw = (unsigned)wid * 1024u;
    const int aoff = lds_byte(wr * 64 + fr, fq * 8), boff = lds_byte(wc * 32 + fr, fq * 8);
#define PG8_SA(b, h) (((b) * 2 + (h)) * HTB)
#define PG8_SB(b, h) ((4 + (b) * 2 + (h)) * HTB)
#define PG8_STAGE(bufoff, gbase, voff) do { _Pragma("unroll") for (int _i = 0; _i < 2; ++_i) \
        __builtin_amdgcn_global_load_lds((const unsigned*)((const char*)(gbase) + (voff)[_i]), (PG8_LAS unsigned*)(lds + (bufoff) + ldsw + _i * 8192), 16, 0, 0); } while (0)
#define PG8_LDA(dst, b, h) do { _Pragma("unroll") for (int m = 0; m < 4; ++m) _Pragma("unroll") for (int k = 0; k < 2; ++k) dst[m][k] = *(const PG8_LAS bf16x8*)(lds + PG8_SA(b, h) + aoff + m * 2048 + k * 1024); } while (0)
#define PG8_LDB(dst, b, h) do { _Pragma("unroll") for (int n = 0; n < 2; ++n) _Pragma("unroll") for (int k = 0; k < 2; ++k) dst[n][k] = *(const PG8_LAS bf16x8*)(lds + PG8_SB(b, h) + boff + n * 2048 + k * 1024); } while (0)
#define PG8_MMA(ai, bj, At, Bt) do { __builtin_amdgcn_s_setprio(1); _Pragma("unroll") for (int m = 0; m < 4; ++m) _Pragma("unroll") for (int n = 0; n < 2; ++n) _Pragma("unroll") for (int k = 0; k < 2; ++k) \
        acc[ai][bj][m][n] = __builtin_amdgcn_mfma_f32_16x16x32_bf16(Bt[n][k], At[m][k], acc[ai][bj][m][n], 0, 0, 0); __builtin_amdgcn_s_setprio(0); } while (0)
#define PG8_WAIT_V(n) asm volatile("s_waitcnt vmcnt(" #n ")" ::: "memory")
#define PG8_WAIT_L(n) asm volatile("s_waitcnt lgkmcnt(" #n ")" ::: "memory")
#define PG8_BAR __builtin_amdgcn_s_barrier()
#define PG8_SCHED __builtin_amdgcn_sched_barrier(0)
    Unit cur, nxt; int ui = 0;
    if (!S.next(0, cur)) return;
    f32x4 acc[2][2][4][2];
#pragma unroll
    for (int a = 0; a < 2; ++a)
#pragma unroll
        for (int b = 0; b < 2; ++b)
#pragma unroll
            for (int m = 0; m < 4; ++m)
#pragma unroll
                for (int n = 0; n < 2; ++n) acc[a][b][m][n] = (f32x4){0.f, 0.f, 0.f, 0.f};
    bf16x8 At[4][2], B0[2][2], B1[2][2];
    const char* cA = (const char*)g.A + (size_t)cur.pm * tstep; const char* cB = (const char*)g.Bt + (size_t)cur.pn * tstep;
    S.a_ready(cur);
    if constexpr (SP2) {
        PG8_STAGE(PG8_SB(0, 0), cB, voffB); PG8_STAGE(PG8_SB(0, 1), cB + hstep, voffB); PG8_STAGE(PG8_SA(0, 0), cA, voffA); PG8_STAGE(PG8_SA(0, 1), cA + hstep, voffA);
        if (wr == 1) PG8_BAR;
        PG8_WAIT_V(2); PG8_BAR;
        PG8_STAGE(PG8_SB(1, 0), cB + kstep, voffB); PG8_STAGE(PG8_SA(1, 0), cA + kstep, voffA); PG8_STAGE(PG8_SB(1, 1), cB + hstep + kstep, voffB);
        PG8_WAIT_V(6); PG8_BAR;
    } else {
        PG8_STAGE(PG8_SB(0, 0), cB, voffB); PG8_STAGE(PG8_SA(0, 0), cA, voffA); PG8_STAGE(PG8_SB(0, 1), cB + hstep, voffB); PG8_STAGE(PG8_SA(0, 1), cA + hstep, voffA);
        if (wr == 1) PG8_BAR;
        PG8_WAIT_V(4); PG8_BAR;
        PG8_STAGE(PG8_SB(1, 0), cB + kstep, voffB); PG8_STAGE(PG8_SA(1, 0), cA + kstep, voffA); PG8_STAGE(PG8_SB(1, 1), cB + hstep + kstep, voffB);
        PG8_WAIT_V(6); PG8_BAR;
    }
    for (;;) {
        const bool has_next = S.next(ui + 1, nxt);
        const char* nA = has_next ? (const char*)g.A + (size_t)nxt.pm * tstep : cA; const char* nB = has_next ? (const char*)g.Bt + (size_t)nxt.pn * tstep : cB;
        for (int t = 0; t < nt; t += 2) {
            const bool last = (t == nt - 2);
            const char* a1 = cA + (size_t)(t + 1) * kstep;
            const char* a2 = last ? nA : cA + (size_t)(t + 2) * kstep; const char* b2 = last ? nB : cB + (size_t)(t + 2) * kstep;
            const char* a3 = a2 + kstep; const char* b3 = b2 + kstep;
            if (last && has_next) S.a_ready(nxt);
            if constexpr (SP2) {
            PG8_LDB(B0, 0, 0); PG8_LDB(B1, 0, 1); PG8_SCHED; PG8_LDA(At, 0, 0); PG8_STAGE(PG8_SA(1, 1), a1 + hstep, voffA);
            PG8_WAIT_V(8); PG8_WAIT_L(0); PG8_BAR; PG8_MMA(0, 0, At, B0); PG8_MMA(0, 1, At, B1); PG8_BAR; PG8_SCHED;
            PG8_LDA(At, 0, 1); PG8_STAGE(PG8_SB(0, 0), b2, voffB); PG8_STAGE(PG8_SB(0, 1), b2 + hstep, voffB); PG8_STAGE(PG8_SA(0, 0), a2, voffA);
            PG8_WAIT_V(8); PG8_WAIT_L(0); PG8_BAR; PG8_MMA(1, 0, At, B0); PG8_MMA(1, 1, At, B1); PG8_BAR; PG8_SCHED;
            PG8_LDB(B0, 1, 0); PG8_LDB(B1, 1, 1); PG8_SCHED; PG8_LDA(At, 1, 0); PG8_STAGE(PG8_SA(0, 1), a2 + hstep, voffA);
            PG8_WAIT_V(8); PG8_WAIT_L(0); PG8_BAR; PG8_MMA(0, 0, At, B0); PG8_MMA(0, 1, At, B1); PG8_BAR; PG8_SCHED;
            PG8_LDA(At, 1, 1); PG8_STAGE(PG8_SB(1, 0), b3, voffB); PG8_STAGE(PG8_SB(1, 1), b3 + hstep, voffB); PG8_STAGE(PG8_SA(1, 0), a3, voffA);
            PG8_WAIT_V(8); PG8_WAIT_L(0); PG8_BAR; PG8_MMA(1, 0, At, B0); PG8_MMA(1, 1, At, B1); PG8_BAR; PG8_SCHED;
            } else {
            PG8_LDB(B0, 0, 0); PG8_SCHED; PG8_LDA(At, 0, 0); PG8_STAGE(PG8_SA(1, 1), a1 + hstep, voffA);
            PG8_WAIT_L(8); PG8_BAR; PG8_WAIT_L(0); PG8_MMA(0, 0, At, B0); PG8_BAR; PG8_SCHED;
            PG8_LDB(B1, 0, 1); PG8_STAGE(PG8_SB(0, 0), b2, voffB);
            PG8_BAR; PG8_WAIT_L(0); PG8_MMA(0, 1, At, B1); PG8_BAR;
            PG8_LDA(At, 0, 1); PG8_STAGE(PG8_SA(0, 0), a2, voffA);
            PG8_BAR; PG8_WAIT_L(0); PG8_MMA(1, 0, At, B0); PG8_BAR; PG8_SCHED;
            PG8_STAGE(PG8_SB(0, 1), b2 + hstep, voffB);
            PG8_WAIT_V(6); PG8_BAR; PG8_MMA(1, 1, At, B1); PG8_BAR;
            PG8_LDB(B0, 1, 0); PG8_SCHED; PG8_LDA(At, 1, 0); PG8_STAGE(PG8_SA(0, 1), a2 + hstep, voffA);
            PG8_WAIT_L(8); PG8_BAR; PG8_WAIT_L(0); PG8_MMA(0, 0, At, B0); PG8_BAR; PG8_SCHED;
            PG8_LDB(B1, 1, 1); PG8_STAGE(PG8_SB(1, 0), b3, voffB);
            PG8_BAR; PG8_WAIT_L(0); PG8_MMA(0, 1, At, B1); PG8_BAR;
            PG8_LDA(At, 1, 1); PG8_STAGE(PG8_SA(1, 0), a3, voffA);
            PG8_BAR; PG8_WAIT_L(0); PG8_MMA(1, 0, At, B0); PG8_BAR; PG8_SCHED;
            PG8_STAGE(PG8_SB(1, 1), b3 + hstep, voffB);
            PG8_WAIT_V(6); PG8_BAR; PG8_MMA(1, 1, At, B1); PG8_BAR;
            }
        }
        if constexpr (ALIGN_EPI) { if (wr == 0) PG8_BAR; }
        if constexpr (!Epi::AFTER_DRAIN) { E(acc, cur, wr, wc, fr, fq); S.done(cur); }
        if (!has_next) break;
#pragma unroll
        for (int a = 0; a < 2; ++a)
#pragma unroll
            for (int b = 0; b < 2; ++b)
#pragma unroll
                for (int m = 0; m < 4; ++m)
#pragma unroll
                    for (int n = 0; n < 2; ++n) acc[a][b][m][n] = (f32x4){0.f, 0.f, 0.f, 0.f};
        cur = nxt; cA = nA; cB = nB; ++ui;
        if constexpr (ALIGN_EPI) { if (wr == 1) PG8_BAR; }
    }
    PG8_WAIT_V(0);
    if constexpr (!ALIGN_EPI) { if (wr == 0) PG8_BAR; }
    PG8_BAR;
    if constexpr (Epi::AFTER_DRAIN) { E.fused(acc, cur, wr, wc, fr, fq, lds, wid, lane); S.done(cur); }
#undef PG8_SA
#undef PG8_SB
#undef PG8_STAGE
#undef PG8_LDA
#undef PG8_LDB
#undef PG8_MMA
#undef PG8_WAIT_V
#undef PG8_WAIT_L
#undef PG8_BAR
#undef PG8_SCHED
}
}

#define LAS __attribute__((address_space(3)))
typedef unsigned short bf16;
typedef unsigned u32x4 __attribute__((ext_vector_type(4)));
typedef unsigned u32x2 __attribute__((ext_vector_type(2)));
typedef float f32x4 __attribute__((ext_vector_type(4)));
typedef float f32x16 __attribute__((ext_vector_type(16)));
typedef short bf16x8 __attribute__((ext_vector_type(8)));

constexpr int M = 16384, DM = 2048, SEQ = 2048, NBATCH = 8, NCH = 16;
constexpr int N0P = 11520, N0R = 11296;
constexpr float EPS = 1e-5f;
constexpr float LOG2E = 1.4426950408889634f;
constexpr float QSCALE = 0.125f * LOG2E;
constexpr float LAMBDA_INIT = 0.35550906f;
constexpr size_t MiB = 1u << 20;
constexpr size_t WS_ST0 = 0, WS_ST1 = 128 * 1024, WS_ST2 = 192 * 1024, WS_CD = 256 * 1024, WS_LAM = 300 * 1024;
constexpr size_t WS_DT = 1 * MiB, WS_WSP = 3 * MiB, WS_W0IN = 4 * MiB, WS_W0OUT = 49 * MiB, WS_W1IN = 65 * MiB, WS_W1OUT = 97 * MiB;
constexpr size_t WS_YCAT = 105 * MiB, WS_ZA = 233 * MiB, WS_V = 297 * MiB, WS_H0 = 361 * MiB, WS_XT = 425 * MiB, WS_CN = 489 * MiB, WS_END = 505 * MiB;
constexpr size_t WS_Q = WS_YCAT, WS_K = WS_YCAT + 64 * MiB, WS_X1 = WS_ZA, WS_STATES = WS_V, WS_VT = WS_H0, WS_X1B = WS_H0, WS_O = WS_H0, WS_VV = WS_XT;
constexpr size_t DO_XBC = 0, DO_BN = 96 * MiB, DO_BT = 112 * MiB, DO_PREV = 0, DO_G = 0;
constexpr int LDS_BYTES = 147456;

__device__ __forceinline__ unsigned pk2(float lo, float hi) {
    typedef float f2 __attribute__((ext_vector_type(2))); typedef __bf16 b2 __attribute__((ext_vector_type(2)));
    f2 v = {lo, hi}; b2 b = __builtin_convertvector(v, b2); return __builtin_bit_cast(unsigned, b);
}
__device__ __forceinline__ float bflo(unsigned u) { return __uint_as_float(u << 16); }
__device__ __forceinline__ float bfhi(unsigned u) { return __uint_as_float(u & 0xffff0000u); }
__device__ __forceinline__ void unpack8(u32x4 r, float* f) { f[0] = bflo(r.x); f[1] = bfhi(r.x); f[2] = bflo(r.y); f[3] = bfhi(r.y); f[4] = bflo(r.z); f[5] = bfhi(r.z); f[6] = bflo(r.w); f[7] = bfhi(r.w); }
__device__ __forceinline__ u32x4 pack8(const float* f) { u32x4 o; o.x = pk2(f[0], f[1]); o.y = pk2(f[2], f[3]); o.z = pk2(f[4], f[5]); o.w = pk2(f[6], f[7]); return o; }
__device__ __forceinline__ float fexp2(float x) { return __builtin_amdgcn_exp2f(x); }
__device__ __forceinline__ float gelu_f(float x) { const float z = 1.5957691216057308f * (x + 0.044715f * x * x * x); return x * __builtin_amdgcn_rcpf(1.0f + __expf(-z)); }
__device__ __forceinline__ float silu_f(float x) { return x * __builtin_amdgcn_rcpf(1.0f + __expf(-x)); }
__device__ __forceinline__ int crow(int r, int h) { return (r & 3) + 8 * (r >> 2) + 4 * h; }
__device__ __forceinline__ f32x16 mfma32(bf16x8 a, bf16x8 b, f32x16 c) { return __builtin_amdgcn_mfma_f32_32x32x16_bf16(a, b, c, 0, 0, 0); }
__device__ __forceinline__ bf16x8 ld_frag16(const bf16* p) { return __builtin_bit_cast(bf16x8, *(const u32x4*)p); }
__device__ __forceinline__ bf16x8 ld_frag8x2(const bf16* p) { const u32x2 lo = *(const u32x2*)p, hi = *(const u32x2*)(p + 8); u32x4 v; v.x = lo.x; v.y = lo.y; v.z = hi.x; v.w = hi.y; return __builtin_bit_cast(bf16x8, v); }
__device__ __forceinline__ bf16x8 pack_frag(const f32x16& x, int s) {
    u32x4 v; v.x = pk2(x[8 * s], x[8 * s + 1]); v.y = pk2(x[8 * s + 2], x[8 * s + 3]); v.z = pk2(x[8 * s + 4], x[8 * s + 5]); v.w = pk2(x[8 * s + 6], x[8 * s + 7]); return __builtin_bit_cast(bf16x8, v);
}
__device__ __forceinline__ float wave_sum(float v) {
#pragma unroll
    for (int o = 1; o < 64; o <<= 1) v += __shfl_xor(v, o);
    return v;
}
#define LDS_WAIT() asm volatile("s_waitcnt lgkmcnt(0)" ::: "memory")
__device__ __forceinline__ void atomic_addf(float* p, float v) { __hip_atomic_fetch_add(p, v, __ATOMIC_RELAXED, __HIP_MEMORY_SCOPE_AGENT); }

struct Params { const float* in[23]; float* out; unsigned char* ws; };
constexpr int PTAB_OFF = LDS_BYTES - 512;
__device__ __forceinline__ unsigned long long ptab_get(int i) {
    const unsigned long long v = ((const LAS unsigned long long*)(PTAB_OFF))[i];
    const unsigned lo = __builtin_amdgcn_readfirstlane((unsigned)v), hi = __builtin_amdgcn_readfirstlane((unsigned)(v >> 32));
    return ((unsigned long long)hi << 32) | lo;
}
struct PT {
    struct InTab { __device__ __forceinline__ const float* operator[](int i) const { return (const float*)(const __attribute__((address_space(1))) float*)ptab_get(i); } } in;
    float* out; unsigned char* ws;
    __device__ __forceinline__ PT() { out = (float*)(__attribute__((address_space(1))) float*)ptab_get(23); ws = (unsigned char*)(__attribute__((address_space(1))) unsigned char*)ptab_get(24); }
};

template <int ACT>
__device__ __forceinline__ void epi_tile_bf16(const f32x4 (&acc)[2][2][4][2], bf16* base, int pitch, int col0, int row0, float sc) {
#pragma unroll
    for (int ai = 0; ai < 2; ++ai)
#pragma unroll
        for (int m = 0; m < 4; ++m) {
            bf16* rowp = base + (size_t)(row0 + ai * 128 + m * 16) * pitch + col0;
#pragma unroll
            for (int bj = 0; bj < 2; ++bj) {
                float v[8];
#pragma unroll
                for (int j = 0; j < 4; ++j) { v[j] = acc[ai][bj][m][0][j]; v[4 + j] = acc[ai][bj][m][1][j]; }
#pragma unroll
                for (int j = 0; j < 8; ++j) { if (ACT == 1) v[j] = gelu_f(v[j]); else if (ACT == 2) v[j] = silu_f(v[j]); else if (ACT == 3) v[j] *= sc; }
                *(u32x4*)(rowp + bj * 128) = pack8(v);
            }
        }
}

struct EpiIn0 {
    static constexpr bool PERM = true, AFTER_DRAIN = false;
    bf16 *ycat, *vbuf, *za, *xbc; float *dt, *stats0; const float* dt_bias;
    __device__ __forceinline__ void operator()(const f32x4 (&acc)[2][2][4][2], const pg8::Unit& u, int wr, int wc, int fr, int fq) const {
        const int pn = u.pn, row0 = u.pm * 256 + wr * 64 + fr, cl = wc * 32 + 8 * fq;
        if (pn < 8) { epi_tile_bf16<1>(acc, ycat, 4096, pn * 256 + cl, row0, 1.f); }
        else if (pn < 16) {
#pragma unroll
            for (int ai = 0; ai < 2; ++ai)
#pragma unroll
                for (int m = 0; m < 4; ++m) {
                    const int row = row0 + ai * 128 + m * 16;
                    bf16* rowp = vbuf + (size_t)row * 2048 + (pn - 8) * 256 + cl;
                    float s = 0.f, ss = 0.f;
#pragma unroll
                    for (int bj = 0; bj < 2; ++bj) {
                        float v[8];
#pragma unroll
                        for (int j = 0; j < 4; ++j) { v[j] = gelu_f(acc[ai][bj][m][0][j]); v[4 + j] = gelu_f(acc[ai][bj][m][1][j]); }
#pragma unroll
                        for (int j = 0; j < 8; ++j) { s += v[j]; ss += v[j] * v[j]; }
                        *(u32x4*)(rowp + bj * 128) = pack8(v);
                    }
                    s += __shfl_xor(s, 16); s += __shfl_xor(s, 32); ss += __shfl_xor(ss, 16); ss += __shfl_xor(ss, 32);
                    if (fq == 0) { atomic_addf(stats0 + 2 * row, s); atomic_addf(stats0 + 2 * row + 1, ss); }
                }
        }
        else if (pn < 24) { epi_tile_bf16<2>(acc, za, 2048, (pn - 16) * 256 + cl, row0, 1.f); }
        else if (pn < 32) { epi_tile_bf16<2>(acc, ycat, 4096, 2048 + (pn - 24) * 256 + cl, row0, 1.f); }
        else if (pn < 44) { epi_tile_bf16<0>(acc, xbc, 3072, (pn - 32) * 256 + cl, row0, 1.f); }
        else if (wc == 0) {
            f32x4 b0 = *(const f32x4*)(dt_bias + cl), b1 = *(const f32x4*)(dt_bias + cl + 4);
#pragma unroll
            for (int ai = 0; ai < 2; ++ai)
#pragma unroll
                for (int m = 0; m < 4; ++m) {
                    const int row = row0 + ai * 128 + m * 16;
                    f32x4 v0 = acc[ai][0][m][0] + b0, v1 = acc[ai][0][m][1] + b1;
#pragma unroll
                    for (int j = 0; j < 4; ++j) { v0[j] = v0[j] > 20.f ? v0[j] : log1pf(__expf(v0[j])); v1[j] = v1[j] > 20.f ? v1[j] : log1pf(__expf(v1[j])); }
                    *(f32x4*)(dt + (size_t)row * 32 + cl) = v0; *(f32x4*)(dt + (size_t)row * 32 + cl + 4) = v1;
                }
        }
    }
};

struct EpiRes {
    static constexpr bool PERM = true, AFTER_DRAIN = false;
    const float* resid; float* outf; bf16* outb; float* stats;
    __device__ __forceinline__ void operator()(const f32x4 (&acc)[2][2][4][2], const pg8::Unit& u, int wr, int wc, int fr, int fq) const {
        const int row0 = u.pm * 256 + wr * 64 + fr, col0 = u.pn * 256 + wc * 32 + 8 * fq;
#pragma unroll
        for (int ai = 0; ai < 2; ++ai)
#pragma unroll
            for (int m = 0; m < 4; ++m) {
                const int row = row0 + ai * 128 + m * 16; const size_t off = (size_t)row * 2048 + col0;
                float ss = 0.f;
#pragma unroll
                for (int bj = 0; bj < 2; ++bj) {
                    const f32x4 r0 = *(const f32x4*)(resid + off + bj * 128) + acc[ai][bj][m][0], r1 = *(const f32x4*)(resid + off + bj * 128 + 4) + acc[ai][bj][m][1];
                    *(f32x4*)(outf + off + bj * 128) = r0; *(f32x4*)(outf + off + bj * 128 + 4) = r1;
                    ss += (r0[0] * r0[0] + r0[1] * r0[1]) + (r0[2] * r0[2] + r0[3] * r0[3]) + (r1[0] * r1[0] + r1[1] * r1[1]) + (r1[2] * r1[2] + r1[3] * r1[3]);
                    if (outb) { u32x4 w; w.x = pk2(r0[0], r0[1]); w.y = pk2(r0[2], r0[3]); w.z = pk2(r1[0], r1[1]); w.w = pk2(r1[2], r1[3]); *(u32x4*)(outb + off + bj * 128) = w; }
                }
                ss += __shfl_xor(ss, 16); ss += __shfl_xor(ss, 32);
                if (fq == 0) atomic_addf(stats + row, ss);
            }
    }
};

struct EpiIn1 {
    static constexpr bool PERM = true, AFTER_DRAIN = false;
    bf16 *q, *k, *v, *g; const float* stats1;
    __device__ __forceinline__ void operator()(const f32x4 (&acc)[2][2][4][2], const pg8::Unit& u, int wr, int wc, int fr, int fq) const {
        const int seg = u.pn >> 3, row0 = u.pm * 256 + wr * 64 + fr, col0 = (u.pn & 7) * 256 + wc * 32 + 8 * fq;
        bf16* base = seg == 0 ? q : (seg == 1 ? k : (seg == 2 ? v : g));
        const float sc = seg == 0 ? QSCALE : 1.f;
#pragma unroll
        for (int ai = 0; ai < 2; ++ai)
#pragma unroll
            for (int m = 0; m < 4; ++m) {
                const int row = row0 + ai * 128 + m * 16;
                const float rs = rsqrtf(stats1[row] * (1.f / 2048.f) + EPS) * sc;
                bf16* rowp = base + (size_t)row * 2048 + col0;
#pragma unroll
                for (int bj = 0; bj < 2; ++bj) {
                    float v8[8];
#pragma unroll
                    for (int j = 0; j < 4; ++j) { v8[j] = acc[ai][bj][m][0][j] * rs; v8[4 + j] = acc[ai][bj][m][1][j] * rs; }
                    if (seg == 3) {
#pragma unroll
                        for (int j = 0; j < 8; ++j) v8[j] = silu_f(v8[j]);
                    }
                    *(u32x4*)(rowp + bj * 128) = pack8(v8);
                }
            }
    }
};

__device__ __forceinline__ void transpose_item(const float* W, int K, int N, bf16* WT, LAS float* scr, int item, int lane, const float* kscale) {
    const int nblk = N / 32, kb = item / nblk, nb = item % nblk, k0 = 64 * kb, n0 = 32 * nb;
#pragma unroll 8
    for (int i = 0; i < 32; ++i) { const int kk = 2 * i + (lane >> 5); float v = W[(size_t)(k0 + kk) * N + n0 + (lane & 31)]; if (kscale) v *= kscale[k0 + kk]; scr[kk * 33 + (lane & 31)] = v; }
    LDS_WAIT();
    const int c = lane & 7;
#pragma unroll
    for (int j = 0; j < 4; ++j) { const int n = (lane >> 3) + 8 * j; const LAS float* s = scr + (8 * c) * 33 + n;
        u32x4 o; o.x = pk2(s[0 * 33], s[1 * 33]); o.y = pk2(s[2 * 33], s[3 * 33]); o.z = pk2(s[4 * 33], s[5 * 33]); o.w = pk2(s[6 * 33], s[7 * 33]);
        *(u32x4*)(WT + (size_t)(n0 + n) * K + k0 + 8 * c) = o; }
    LDS_WAIT();
}

__device__ __forceinline__ void phase0(const PT& p, LAS unsigned char* lds, int tid, int lane, int wave) {
    unsigned char* ws = p.ws;
    const int gw = blockIdx.x * 8 + wave, NGW = gridDim.x * 8;
    const int gt = blockIdx.x * 512 + tid, NGT = gridDim.x * 512;
    LAS float* scr = (LAS float*)(lds + wave * 16384);
    for (int i = gt; i < 65536; i += NGT) ((float*)(ws + WS_ST0))[i] = 0.f;
    constexpr int I0 = 32 * (N0R / 32), I1 = 64 * 64, I2 = 32 * 256, I3 = 32 * 64;
    for (int it = gw; it < I0 + I1 + I2 + I3; it += NGW) {
        int r = it;
        if (r < I0) { transpose_item(p.in[2], 2048, N0R, (bf16*)(ws + WS_W0IN), scr, r, lane, nullptr); continue; } r -= I0;
        if (r < I1) { transpose_item(p.in[13], 4096, 2048, (bf16*)(ws + WS_W0OUT), scr, r, lane, nullptr); continue; } r -= I1;
        if (r < I2) { transpose_item(p.in[15], 2048, 8192, (bf16*)(ws + WS_W1IN), scr, r, lane, p.in[14]); continue; } r -= I2;
        transpose_item(p.in[21], 2048, 2048, (bf16*)(ws + WS_W1OUT), scr, r, lane, nullptr);
    }
    for (int i = gt; i < (N0P - N0R) * 2048 / 8; i += NGT) ((u32x4*)((bf16*)(ws + WS_W0IN) + (size_t)N0R * 2048))[i] = (u32x4){0u, 0u, 0u, 0u};
    for (int i = gt; i < 16 * 128 * 128 / 8; i += NGT) {
        const int e = i * 8, t = (e >> 7) & 127, s0 = e & 127; const float* src = p.in[5] + e; float v[8];
#pragma unroll
        for (int j = 0; j < 8; ++j) v[j] = (s0 + j <= t) ? src[j] : 0.f;
        ((u32x4*)(ws + WS_WSP))[i] = pack8(v);
    }
    const float* g0 = p.in[1]; bf16* H0 = (bf16*)(ws + WS_H0);
    for (int m = gw; m < M; m += NGW) {
        const f32x4* xr = (const f32x4*)(p.in[0] + (size_t)m * 2048) + lane; f32x4 v[8]; float s = 0.f;
#pragma unroll
        for (int j = 0; j < 8; ++j) { v[j] = xr[64 * j]; s += (v[j].x * v[j].x + v[j].y * v[j].y) + (v[j].z * v[j].z + v[j].w * v[j].w); }
        const float rs = rsqrtf(wave_sum(s) * (1.f / 2048.f) + EPS);
        u32x2* o = (u32x2*)(H0 + (size_t)m * 2048) + lane;
#pragma unroll
        for (int j = 0; j < 8; ++j) { const f32x4 g = ((const f32x4*)g0)[lane + 64 * j]; u32x2 w; w.x = pk2(v[j].x * rs * g.x, v[j].y * rs * g.y); w.y = pk2(v[j].z * rs * g.z, v[j].w * rs * g.w); o[64 * j] = w; }
    }
}

__device__ __forceinline__ void phase_layout(const PT& p, int tid) {
    unsigned char* ws = p.ws; unsigned char* dob = (unsigned char*)p.out;
    const bf16* Vb = (const bf16*)(ws + WS_V); const float* st0 = (const float*)(ws + WS_ST0);
    const bf16* XBC = (const bf16*)(dob + DO_XBC);
    bf16 *vT = (bf16*)(ws + WS_VT), *xT = (bf16*)(ws + WS_XT), *Bn = (bf16*)(dob + DO_BN), *BT = (bf16*)(dob + DO_BT), *Cn = (bf16*)(ws + WS_CN);
    const int t = tid & 255, so = t >> 4, co = t & 15;
    for (int pi = blockIdx.x * 2 + (tid >> 8); pi < 128 * 40; pi += gridDim.x * 2) {
        const int bc = pi / 40, k = pi % 40; const int tok0 = bc * 128 + so * 8;
        float o[8][8];
        if (k < 16) {
            const int ch0 = k * 128 + co * 8;
            float g[8], bb[8];
#pragma unroll
            for (int j = 0; j < 8; ++j) { g[j] = p.in[3][ch0 + j]; bb[j] = p.in[4][ch0 + j]; }
#pragma unroll
            for (int i = 0; i < 8; ++i) {
                const int row = tok0 + i; float f[8]; unpack8(*(const u32x4*)(Vb + (size_t)row * 2048 + ch0), f);
                const float mu = st0[2 * row] * (1.f / 2048.f), var = st0[2 * row + 1] * (1.f / 2048.f) - mu * mu, rs = rsqrtf(fmaxf(var, 0.f) + EPS);
#pragma unroll
                for (int j = 0; j < 8; ++j) o[i][j] = (f[j] - mu) * rs * g[j] + bb[j];
            }
#pragma unroll
            for (int j = 0; j < 8; ++j) { float c8[8];
#pragma unroll
                for (int i = 0; i < 8; ++i) c8[i] = o[i][j];
                *(u32x4*)(vT + ((size_t)bc * 2048 + ch0 + j) * 128 + so * 8) = pack8(c8); }
        } else {
            const int sc0 = (k - 16) * 128 + co * 8;
            float cw[4][8], cb[8];
#pragma unroll
            for (int j = 0; j < 8; ++j) { cb[j] = p.in[8][sc0 + j];
#pragma unroll
                for (int kk = 0; kk < 4; ++kk) cw[kk][j] = p.in[7][kk * 3072 + sc0 + j]; }
            const int pos0 = (bc & 15) * 128 + so * 8;
            float xw[11][8];
#pragma unroll
            for (int ii = 0; ii < 11; ++ii) {
                if (pos0 - 3 + ii >= 0) unpack8(*(const u32x4*)(XBC + (size_t)(tok0 - 3 + ii) * 3072 + sc0), xw[ii]);
                else {
#pragma unroll
                    for (int j = 0; j < 8; ++j) xw[ii][j] = 0.f;
                }
            }
#pragma unroll
            for (int i = 0; i < 8; ++i)
#pragma unroll
                for (int j = 0; j < 8; ++j) { float a = cb[j];
#pragma unroll
                    for (int kk = 0; kk < 4; ++kk) a += cw[kk][j] * xw[i + kk][j];
                    o[i][j] = silu_f(a); }
            if (k < 32) {
#pragma unroll
                for (int j = 0; j < 8; ++j) { float c8[8];
#pragma unroll
                    for (int i = 0; i < 8; ++i) c8[i] = o[i][j];
                    *(u32x4*)(xT + ((size_t)bc * 2048 + sc0 + j) * 128 + so * 8) = pack8(c8); }
            } else if (k < 36) {
                const int n0 = sc0 - 2048;
#pragma unroll
                for (int i = 0; i < 8; ++i) *(u32x4*)(Bn + (size_t)(tok0 + i) * 512 + n0) = pack8(o[i]);
#pragma unroll
                for (int j = 0; j < 8; ++j) { float c8[8];
#pragma unroll
                    for (int i = 0; i < 8; ++i) c8[i] = o[i][j];
                    *(u32x4*)(BT + ((size_t)bc * 512 + n0 + j) * 128 + so * 8) = pack8(c8); }
            } else {
                const int n0 = sc0 - 2560;
#pragma unroll
                for (int i = 0; i < 8; ++i) *(u32x4*)(Cn + (size_t)(tok0 + i) * 512 + n0) = pack8(o[i]);
            }
        }
    }
}

__device__ __forceinline__ void chunk_cumsum(const float* DT, const float* a_log, int tok0, int hh, int lane, float& d0, float& d1, float& c0, float& c1, float& tot) {
    d0 = DT[(size_t)(tok0 + 2 * lane) * 32 + hh]; d1 = DT[(size_t)(tok0 + 2 * lane + 1) * 32 + hh];
    const float A = -__expf(a_log[hh]); const float x0 = d0 * A, x1 = d1 * A; float ps = x0 + x1;
#pragma unroll
    for (int o = 1; o < 64; o <<= 1) { const float t = __shfl_up(ps, o); if (lane >= o) ps += t; }
    c1 = ps; c0 = ps - x1; tot = __shfl(ps, 63);
}

__device__ __forceinline__ void phase_mix(const PT& p, LAS unsigned char* lds, int tid, int lane, int wave) {
    unsigned char* ws = p.ws; unsigned char* dob = (unsigned char*)p.out;
    const int r32 = lane & 31, h = lane >> 5;
    bf16* Ycat = (bf16*)(ws + WS_YCAT); const bf16* ZA = (const bf16*)(ws + WS_ZA); const bf16* vT = (const bf16*)(ws + WS_VT); const bf16* Wsp = (const bf16*)(ws + WS_WSP);
    const bf16* xT = (const bf16*)(ws + WS_XT); const bf16* BT = (const bf16*)(dob + DO_BT); const float* DT = (const float*)(ws + WS_DT);
    bf16* ST = (bf16*)(ws + WS_STATES); float* CD = (float*)(ws + WS_CD);
    LAS float* wtab = (LAS float*)lds;
    constexpr int NG = 128 * 16, NS = NBATCH * 15 * 4;
    for (int it = blockIdx.x; it < NG + NS; it += gridDim.x) {
        if (it < NG) {
            const int bc = it >> 4, g = it & 15, cb = wave & 3, th = wave >> 2;
            const int ch0 = g * 128 + cb * 32;
            const bf16* ap = vT + ((size_t)bc * 2048 + ch0 + r32) * 128 + 8 * h;
            f32x16 acc[2];
#pragma unroll
            for (int i = 0; i < 16; ++i) { acc[0][i] = 0.f; acc[1][i] = 0.f; }
#pragma unroll
            for (int st = 0; st < 8; ++st) {
                const bf16x8 a = ld_frag16(ap + 16 * st);
#pragma unroll
                for (int t2 = 0; t2 < 2; ++t2) { const int tb = 2 * th + t2;
                    if (st < 2 * (tb + 1)) { const bf16x8 b = ld_frag16(Wsp + ((size_t)g * 128 + tb * 32 + r32) * 128 + 16 * st + 8 * h); acc[t2] = mfma32(a, b, acc[t2]); } }
            }
#pragma unroll
            for (int t2 = 0; t2 < 2; ++t2) {
                const int t = (2 * th + t2) * 32 + r32; const size_t tok = (size_t)bc * 128 + t; const float sb = p.in[6][g * 128 + t];
#pragma unroll
                for (int qd = 0; qd < 4; ++qd) {
                    const int ch = ch0 + 8 * qd + 4 * h;
                    u32x2* up = (u32x2*)(Ycat + tok * 4096 + ch); const u32x2 uu = *up, zz = *(const u32x2*)(ZA + tok * 2048 + ch);
                    const float y0 = bflo(uu.x) * (acc[t2][4 * qd] + sb) * bflo(zz.x), y1 = bfhi(uu.x) * (acc[t2][4 * qd + 1] + sb) * bfhi(zz.x);
                    const float y2 = bflo(uu.y) * (acc[t2][4 * qd + 2] + sb) * bflo(zz.y), y3 = bfhi(uu.y) * (acc[t2][4 * qd + 3] + sb) * bfhi(zz.y);
                    u32x2 w; w.x = pk2(y0, y1); w.y = pk2(y2, y3); *up = w;
                }
            }
        } else {
            const int id = it - NG, b = id / 60, c = (id / 4) % 15, grp = id & 3; const int bc = b * 16 + c, tok0 = bc * 128;
            __syncthreads();
            { const int hh = grp * 8 + wave; float d0, d1, c0, c1, tot; chunk_cumsum(DT, p.in[10], tok0, hh, lane, d0, d1, c0, c1, tot);
              wtab[wave * 128 + 2 * lane] = d0 * __expf(tot - c0); wtab[wave * 128 + 2 * lane + 1] = d1 * __expf(tot - c1);
              if (lane == 0) CD[bc * 32 + hh] = __expf(tot); }
            __syncthreads();
#pragma unroll 1
            for (int tk = 0; tk < 2; ++tk) {
                const int r = (wave >> 1) + 4 * tk, pb = wave & 1, hh = grp * 8 + r;
                const bf16* ap = xT + ((size_t)bc * 2048 + hh * 64 + pb * 32 + r32) * 128 + 8 * h;
                const bf16* bp = BT + ((size_t)bc * 512 + grp * 128 + r32) * 128 + 8 * h;
                f32x16 acc[4];
#pragma unroll
                for (int nb = 0; nb < 4; ++nb)
#pragma unroll
                    for (int i = 0; i < 16; ++i) acc[nb][i] = 0.f;
#pragma unroll
                for (int st = 0; st < 8; ++st) {
                    float f[8]; unpack8(*(const u32x4*)(ap + 16 * st), f);
                    const f32x4 w0 = *(const LAS f32x4*)(wtab + r * 128 + 16 * st + 8 * h), w1 = *(const LAS f32x4*)(wtab + r * 128 + 16 * st + 8 * h + 4);
                    f[0] *= w0.x; f[1] *= w0.y; f[2] *= w0.z; f[3] *= w0.w; f[4] *= w1.x; f[5] *= w1.y; f[6] *= w1.z; f[7] *= w1.w;
                    const bf16x8 a = __builtin_bit_cast(bf16x8, pack8(f));
#pragma unroll
                    for (int nb = 0; nb < 4; ++nb) { const bf16x8 bfr = ld_frag16(bp + (size_t)nb * 32 * 128 + 16 * st); acc[nb] = mfma32(a, bfr, acc[nb]); }
                }
                bf16* sp = ST + ((size_t)(bc * 32 + hh) * 64 + pb * 32) * 128;
#pragma unroll
                for (int nb = 0; nb < 4; ++nb)
#pragma unroll
                    for (int i = 0; i < 16; ++i) sp[(size_t)crow(i, h) * 128 + nb * 32 + r32] = (bf16)(pk2(acc[nb][i], 0.f) & 0xffffu);
            }
        }
    }
}

__device__ __forceinline__ void phase_scan(const PT& p, int tid) {
    unsigned char* ws = p.ws; const bf16* ST = (const bf16*)(ws + WS_STATES); const float* CD = (const float*)(ws + WS_CD); bf16* PV = (bf16*)((unsigned char*)p.out + DO_PREV);
    for (int id = blockIdx.x * 512 + tid; id < NBATCH * 32 * 64 * 16; id += gridDim.x * 512) {
        const int b = id >> 15, rem = id & 32767, hh = rem >> 10;
        float run[8];
#pragma unroll
        for (int j = 0; j < 8; ++j) run[j] = 0.f;
#pragma unroll
        for (int c = 0; c < 16; ++c) {
            const size_t off = ((size_t)(b * 16 + c) * 32 * 64 * 16 + rem) * 8;
            *(u32x4*)(PV + off) = pack8(run);
            if (c < 15) { float s[8]; unpack8(*(const u32x4*)(ST + off), s); const float cd = CD[(b * 16 + c) * 32 + hh];
#pragma unroll
                for (int j = 0; j < 8; ++j) run[j] = run[j] * cd + s[j]; }
        }
    }
}

__device__ __forceinline__ void phase_ssd_y(const PT& p, LAS unsigned char* lds, int tid, int lane, int wave) {
    unsigned char* ws = p.ws; unsigned char* dob = (unsigned char*)p.out;
    const int r32 = lane & 31, h = lane >> 5;
    bf16* Ycat = (bf16*)(ws + WS_YCAT); const bf16* xT = (const bf16*)(ws + WS_XT); const bf16* Bn = (const bf16*)(dob + DO_BN); const bf16* Cn = (const bf16*)(ws + WS_CN);
    const bf16* PV = (const bf16*)(dob + DO_PREV); const float* DT = (const float*)(ws + WS_DT);
    LAS float* acum = (LAS float*)lds; LAS float* dtt = acum + 1024; LAS float* ssqp = dtt + 1024;
    for (int it = blockIdx.x; it < 128 * 4; it += gridDim.x) {
        const int bc = it >> 2, grp = it & 3, tok0 = bc * 128;
        __syncthreads();
        { const int hh = grp * 8 + wave; float d0, d1, c0, c1, tot; chunk_cumsum(DT, p.in[10], tok0, hh, lane, d0, d1, c0, c1, tot);
          acum[wave * 128 + 2 * lane] = c0; acum[wave * 128 + 2 * lane + 1] = c1; dtt[wave * 128 + 2 * lane] = d0; dtt[wave * 128 + 2 * lane + 1] = d1; }
        __syncthreads();
        const int pb = wave >> 2, lb = wave & 3, l = lb * 32 + r32; const size_t tok = (size_t)tok0 + l;
        bf16x8 cf[8];
#pragma unroll
        for (int st = 0; st < 8; ++st) cf[st] = ld_frag16(Cn + tok * 512 + grp * 128 + 16 * st + 8 * h);
        f32x16 X[4];
#pragma unroll
        for (int sb = 0; sb < 4; ++sb) {
#pragma unroll
            for (int i = 0; i < 16; ++i) X[sb][i] = 0.f;
            if (sb <= lb) {
#pragma unroll
                for (int st = 0; st < 8; ++st) X[sb] = mfma32(ld_frag16(Bn + ((size_t)tok0 + sb * 32 + r32) * 512 + grp * 128 + 16 * st + 8 * h), cf[st], X[sb]);
            }
        }
        float ssq = 0.f;
#pragma unroll 1
        for (int r = 0; r < 8; ++r) {
            const int hh = grp * 8 + r;
            f32x16 acc;
#pragma unroll
            for (int i = 0; i < 16; ++i) acc[i] = 0.f;
            const bf16* pp = PV + ((size_t)(bc * 32 + hh) * 64 + pb * 32 + r32) * 128 + 8 * h;
#pragma unroll
            for (int st = 0; st < 8; ++st) acc = mfma32(ld_frag16(pp + 16 * st), cf[st], acc);
            const float al = acum[r * 128 + l]; const float el = __expf(al);
#pragma unroll
            for (int i = 0; i < 16; ++i) acc[i] *= el;
            const bf16* xrow = xT + ((size_t)bc * 2048 + hh * 64 + pb * 32 + r32) * 128 + 4 * h;
#pragma unroll
            for (int sb = 0; sb < 4; ++sb) {
                if (sb <= lb) {
                    f32x16 mm;
#pragma unroll
                    for (int qd = 0; qd < 4; ++qd) {
                        const int s0 = sb * 32 + 8 * qd + 4 * h;
                        const f32x4 as = *(const LAS f32x4*)(acum + r * 128 + s0), ds = *(const LAS f32x4*)(dtt + r * 128 + s0);
#pragma unroll
                        for (int j = 0; j < 4; ++j) { const float v = X[sb][4 * qd + j] * __expf(al - as[j]) * ds[j]; mm[4 * qd + j] = (s0 + j <= l) ? v : 0.f; }
                    }
#pragma unroll
                    for (int s2 = 0; s2 < 2; ++s2) acc = mfma32(ld_frag8x2(xrow + sb * 32 + 16 * s2), pack_frag(mm, s2), acc);
                }
            }
            const float dsk = p.in[11][hh];
#pragma unroll
            for (int qd = 0; qd < 4; ++qd) {
                const int ch = hh * 64 + pb * 32 + 8 * qd + 4 * h;
                const bf16* xc = xT + ((size_t)bc * 2048 + ch) * 128 + l;
                u32x2* yp = (u32x2*)(Ycat + tok * 4096 + 2048 + ch); const u32x2 zz = *yp;
                const float y0 = (acc[4 * qd] + dsk * bflo((unsigned)xc[0])) * bflo(zz.x), y1 = (acc[4 * qd + 1] + dsk * bflo((unsigned)xc[128])) * bfhi(zz.x);
                const float y2 = (acc[4 * qd + 2] + dsk * bflo((unsigned)xc[256])) * bflo(zz.y), y3 = (acc[4 * qd + 3] + dsk * bflo((unsigned)xc[384])) * bfhi(zz.y);
                ssq += (y0 * y0 + y1 * y1) + (y2 * y2 + y3 * y3);
                u32x2 w; w.x = pk2(y0, y1); w.y = pk2(y2, y3); *yp = w;
            }
        }
        ssq += __shfl_xor(ssq, 32);
        if (h == 0) ssqp[pb * 128 + l] = ssq;
        __syncthreads();
        const float rs = rsqrtf((ssqp[l] + ssqp[128 + l]) * (1.f / 512.f) + EPS);
#pragma unroll 1
        for (int r = 0; r < 8; ++r) {
#pragma unroll
            for (int qd = 0; qd < 4; ++qd) {
                const int ch = (grp * 8 + r) * 64 + pb * 32 + 8 * qd + 4 * h;
                u32x2* yp = (u32x2*)(Ycat + tok * 4096 + 2048 + ch); const u32x2 yy = *yp; const f32x4 g = *(const f32x4*)(p.in[12] + ch);
                u32x2 w; w.x = pk2(bflo(yy.x) * rs * g.x, bfhi(yy.x) * rs * g.y); w.y = pk2(bflo(yy.y) * rs * g.z, bfhi(yy.y) * rs * g.w); *yp = w;
            }
        }
    }
}

constexpr int AK_PITCH = 272, AV_PITCH = 272, A_KOFF = 0, A_VOFF = 128 * AK_PITCH, A_XOFF = A_VOFF + 128 * AV_PITCH;
static_assert(A_XOFF + 4 * 16384 <= LDS_BYTES, "attention LDS map");
__device__ __forceinline__ void attn_unit(const PT& p, LAS unsigned char* lds, int tid, int lane, int wave, int b, int hd, int qb, float lam) {
    unsigned char* ws = p.ws;
    const bf16* Qb = (const bf16*)(ws + WS_Q); const bf16* Kb = (const bf16*)(ws + WS_K); const bf16* Vb = (const bf16*)(ws + WS_VV); const bf16* Gb = (const bf16*)((unsigned char*)p.out + DO_G);
    bf16* Ob = (bf16*)(ws + WS_O);
    const int r32 = lane & 31, h = lane >> 5, mp = wave >> 2, wq = wave & 3;
    const int qw0 = qb * 128 + 32 * wq, q = qw0 + r32; const size_t tokq = (size_t)b * SEQ + q, tokb = (size_t)b * SEQ;
    const float slope2 = fexp2(-0.5f * (float)(hd + 1)) * LOG2E;
    bf16x8 qf[4];
#pragma unroll
    for (int ds = 0; ds < 4; ++ds) qf[ds] = ld_frag16(Qb + tokq * 2048 + hd * 128 + mp * 64 + 16 * ds + 8 * h);
    float mrun = -INFINITY, lsum = 0.f;
    f32x16 oT[4];
#pragma unroll
    for (int db = 0; db < 4; ++db)
#pragma unroll
        for (int i = 0; i < 16; ++i) oT[db][i] = 0.f;
    const int ntiles = qb + 1;
    const int kq = tid >> 4, dq = tid & 15;
    u32x4 preV[4], preK[4];
#define PREFETCH(t) do { \
        _Pragma("unroll") for (int i_ = 0; i_ < 4; ++i_) preV[i_] = *(const u32x4*)(Vb + (tokb + (t) * 128 + 4 * kq + i_) * 2048 + hd * 128 + 8 * dq); \
        _Pragma("unroll") for (int i_ = 0; i_ < 4; ++i_) { const int pid_ = tid + 512 * i_, row_ = pid_ >> 4, c16_ = pid_ & 15; preK[i_] = *(const u32x4*)(Kb + (tokb + (t) * 128 + row_) * 2048 + hd * 128 + 8 * c16_); } \
    } while (0)
    PREFETCH(0);
#pragma unroll 1
    for (int t = 0; t < ntiles; ++t) {
        __syncthreads();
        {
            const unsigned w0[4] = {preV[0].x, preV[1].x, preV[2].x, preV[3].x}, w1[4] = {preV[0].y, preV[1].y, preV[2].y, preV[3].y}, w2[4] = {preV[0].z, preV[1].z, preV[2].z, preV[3].z}, w3[4] = {preV[0].w, preV[1].w, preV[2].w, preV[3].w};
#define VT_ST(j, W, HI) { u32x2 o; if (HI) { o.x = (W[0] >> 16) | (W[1] & 0xffff0000u); o.y = (W[2] >> 16) | (W[3] & 0xffff0000u); } else { o.x = (W[0] & 0xffffu) | (W[1] << 16); o.y = (W[2] & 0xffffu) | (W[3] << 16); } \
              *(LAS u32x2*)(lds + A_VOFF + (8 * dq + (j)) * AV_PITCH + 8 * kq) = o; }
            VT_ST(0, w0, 0) VT_ST(1, w0, 1) VT_ST(2, w1, 0) VT_ST(3, w1, 1) VT_ST(4, w2, 0) VT_ST(5, w2, 1) VT_ST(6, w3, 0) VT_ST(7, w3, 1)
#undef VT_ST
#pragma unroll
            for (int i = 0; i < 4; ++i) { const int pid = tid + 512 * i, row = pid >> 4, c16 = pid & 15; *(LAS u32x4*)(lds + A_KOFF + row * AK_PITCH + 16 * c16) = preK[i]; }
        }
        __syncthreads();
        if (t + 1 < ntiles) PREFETCH(t + 1);
#pragma unroll 1
        for (int sub = 0; sub < 2; ++sub) {
            const int kvl = sub * 64, kv0 = t * 128 + kvl;
            if (kv0 <= qw0 + 31) {
                const bool partial = (kv0 + 63 > qw0);
                f32x16 s0, s1;
#pragma unroll
                for (int i = 0; i < 16; ++i) { s0[i] = 0.f; s1[i] = 0.f; }
#pragma unroll
                for (int ds = 0; ds < 4; ++ds) {
                    const bf16x8 a0 = __builtin_bit_cast(bf16x8, *(const LAS u32x4*)(lds + A_KOFF + (kvl + r32) * AK_PITCH + (mp * 64 + 16 * ds + 8 * h) * 2));
                    const bf16x8 a1 = __builtin_bit_cast(bf16x8, *(const LAS u32x4*)(lds + A_KOFF + (kvl + 32 + r32) * AK_PITCH + (mp * 64 + 16 * ds + 8 * h) * 2));
                    s0 = mfma32(a0, qf[ds], s0); s1 = mfma32(a1, qf[ds], s1);
                }
                float mx = -INFINITY;
#pragma unroll
                for (int i = 0; i < 16; ++i) {
                    const int kva = kv0 + crow(i, h), kvb = kva + 32;
                    s0[i] += slope2 * (float)(kva - q); s1[i] += slope2 * (float)(kvb - q);
                    if (partial) { if (kva > q) s0[i] = -INFINITY; if (kvb > q) s1[i] = -INFINITY; }
                    mx = fmaxf(mx, fmaxf(s0[i], s1[i]));
                }
                mx = fmaxf(mx, __shfl_xor(mx, 32));
                const float mnew = fmaxf(mrun, mx), alpha = fexp2(mrun - mnew); mrun = mnew;
                float rs = 0.f;
#pragma unroll
                for (int i = 0; i < 16; ++i) { s0[i] = fexp2(s0[i] - mnew); s1[i] = fexp2(s1[i] - mnew); rs += s0[i] + s1[i]; }
                lsum = lsum * alpha + rs;
#pragma unroll
                for (int db = 0; db < 4; ++db)
#pragma unroll
                    for (int i = 0; i < 16; ++i) oT[db][i] *= alpha;
#pragma unroll
                for (int kb = 0; kb < 2; ++kb)
#pragma unroll
                    for (int s2 = 0; s2 < 2; ++s2) {
                        const bf16x8 pf = pack_frag(kb == 0 ? s0 : s1, s2);
#pragma unroll
                        for (int db = 0; db < 4; ++db) {
                            const LAS unsigned char* vp = lds + A_VOFF + (db * 32 + r32) * AV_PITCH + (kvl + kb * 32 + 16 * s2 + 4 * h) * 2;
                            const u32x2 lo = *(const LAS u32x2*)vp, hi = *(const LAS u32x2*)(vp + 16);
                            u32x4 v; v.x = lo.x; v.y = lo.y; v.z = hi.x; v.w = hi.y;
                            oT[db] = mfma32(__builtin_bit_cast(bf16x8, v), pf, oT[db]);
                        }
                    }
            }
        }
    }
#undef PREFETCH
    const float lt = lsum + __shfl_xor(lsum, 32);
    LAS float* xch = (LAS float*)(lds + A_XOFF + wq * 16384);
    if (mp == 1) { const float sc = lam / lt;
#pragma unroll
        for (int db = 0; db < 4; ++db)
#pragma unroll
            for (int i = 0; i < 16; ++i) xch[(db * 16 + i) * 64 + lane] = oT[db][i] * sc; }
    __syncthreads();
    if (mp == 0) {
        const float i1 = 1.f / lt; float ss = 0.f;
#pragma unroll
        for (int db = 0; db < 4; ++db)
#pragma unroll
            for (int i = 0; i < 16; ++i) { const float o = oT[db][i] * i1 - xch[(db * 16 + i) * 64 + lane]; oT[db][i] = o; ss += o * o; }
        ss += __shfl_xor(ss, 32);
        const float rn = rsqrtf(ss * (1.f / 128.f) + EPS) * (1.f - LAMBDA_INIT);
#pragma unroll
        for (int db = 0; db < 4; ++db)
#pragma unroll
            for (int qd = 0; qd < 4; ++qd) {
                const int d = db * 32 + 8 * qd + 4 * h; const size_t off = tokq * 2048 + hd * 128 + d;
                const u32x2 gg = *(const u32x2*)(Gb + off); const f32x4 sg = *(const f32x4*)(p.in[20] + d);
                u32x2 w; w.x = pk2(oT[db][4 * qd] * rn * sg.x * bflo(gg.x), oT[db][4 * qd + 1] * rn * sg.y * bfhi(gg.x));
                w.y = pk2(oT[db][4 * qd + 2] * rn * sg.z * bflo(gg.y), oT[db][4 * qd + 3] * rn * sg.w * bfhi(gg.y));
                *(u32x2*)(Ob + off) = w;
            }
    }
}

__device__ __forceinline__ void phase_attn(const PT& p, LAS unsigned char* lds, int tid, int lane, int wave) {
    const float s1 = wave_sum(p.in[16][lane] * p.in[17][lane]), s2 = wave_sum(p.in[18][lane] * p.in[19][lane]);
    const float lam = __expf(s1) - __expf(s2) + LAMBDA_INIT;
#pragma unroll 1
    for (int u = blockIdx.x; u < NBATCH * 16 * 8; u += gridDim.x) {
        const int j = u & 7, hd = (u >> 3) & 15, b = u >> 7;
#pragma unroll 1
        for (int k = 0; k < 2; ++k) attn_unit(p, lds, tid, lane, wave, b, hd, k == 0 ? 15 - j : j, lam);
    }
}

__device__ __forceinline__ void phase_final(const PT& p, int lane, int wave) {
    const float* st2 = (const float*)(p.ws + WS_ST2); const float* g = p.in[22];
    for (int m = blockIdx.x * 8 + wave; m < M; m += gridDim.x * 8) {
        const float rs = rsqrtf(st2[m] * (1.f / 2048.f) + EPS);
        f32x4* xr = (f32x4*)(p.out + (size_t)m * 2048) + lane;
#pragma unroll
        for (int j = 0; j < 8; ++j) { const f32x4 gg = ((const f32x4*)g)[lane + 64 * j]; f32x4 v = xr[64 * j]; v.x *= rs * gg.x; v.y *= rs * gg.y; v.z *= rs * gg.z; v.w *= rs * gg.w; xr[64 * j] = v; }
    }
}

__global__ void __launch_bounds__(512) fwd_megakernel(Params pa) {
    extern __shared__ __attribute__((aligned(16))) unsigned char lds_raw[];
    cg::grid_group grid = cg::this_grid();
    LAS unsigned char* lds = (LAS unsigned char*)lds_raw;
    if (threadIdx.x < 25) {
        unsigned long long v = 0;
#pragma unroll
        for (int i = 0; i < 23; ++i) if ((int)threadIdx.x == i) v = (unsigned long long)pa.in[i];
        if (threadIdx.x == 23) v = (unsigned long long)pa.out;
        if (threadIdx.x == 24) v = (unsigned long long)pa.ws;
        ((LAS unsigned long long*)(lds + PTAB_OFF))[threadIdx.x] = v;
    }
    __syncthreads();
#ifndef PHMASK
#define PHMASK 0x3ff
#endif
#define PH(n) (((PHMASK) >> (n)) & 1)
#define TLW int tid_ = threadIdx.x; asm volatile("" : "+v"(tid_)); const int tid = tid_, lane = tid & 63, wave = __builtin_amdgcn_readfirstlane(tid >> 6); (void)tid; (void)lane; (void)wave
#define GRIDV const int G = gridDim.x, c = blockIdx.x
    if (PH(0)) { PT p; TLW; phase0(p, lds, tid, lane, wave); }
    grid.sync();
    if (PH(1)) {
        PT p; GRIDV; unsigned char* ws = p.ws; unsigned char* dob = (unsigned char*)p.out;
        pg8::Gemm g{(const pg8::bf16_t*)(ws + WS_H0), (const pg8::bf16_t*)(ws + WS_W0IN), M, N0P, 2048}; pg8::StaticOrder S; S.init(M, N0P, G, c);
        EpiIn0 E{(bf16*)(ws + WS_YCAT), (bf16*)(ws + WS_V), (bf16*)(ws + WS_ZA), (bf16*)(dob + DO_XBC), (float*)(ws + WS_DT), (float*)(ws + WS_ST0), p.in[9]};
        pg8::gemm_phase<EpiIn0, pg8::StaticOrder, true, true>(lds, g, S, E);
    }
    grid.sync();
    if (PH(2)) { PT p; TLW; phase_layout(p, tid); }
    grid.sync();
    if (PH(3)) { PT p; TLW; phase_mix(p, lds, tid, lane, wave); }
    grid.sync();
    if (PH(4)) { PT p; TLW; phase_scan(p, tid); }
    grid.sync();
    if (PH(5)) { PT p; TLW; phase_ssd_y(p, lds, tid, lane, wave); }
    grid.sync();
    if (PH(6)) {
        PT p; GRIDV; unsigned char* ws = p.ws;
        pg8::Gemm g{(const pg8::bf16_t*)(ws + WS_YCAT), (const pg8::bf16_t*)(ws + WS_W0OUT), M, 2048, 4096}; pg8::StaticOrder S; S.init(M, 2048, G, c);
        EpiRes E{p.in[0], (float*)(ws + WS_X1), (bf16*)(ws + WS_X1B), (float*)(ws + WS_ST1)};
        pg8::gemm_phase<EpiRes, pg8::StaticOrder, true, true>(lds, g, S, E);
    }
    grid.sync();
    if (PH(6)) {
        PT p; GRIDV; unsigned char* ws = p.ws; unsigned char* dob = (unsigned char*)p.out;
        pg8::Gemm g{(const pg8::bf16_t*)(ws + WS_X1B), (const pg8::bf16_t*)(ws + WS_W1IN), M, 8192, 2048}; pg8::StaticOrder S; S.init(M, 8192, G, c);
        EpiIn1 E{(bf16*)(ws + WS_Q), (bf16*)(ws + WS_K), (bf16*)(ws + WS_VV), (bf16*)(dob + DO_G), (const float*)(ws + WS_ST1)};
        pg8::gemm_phase<EpiIn1, pg8::StaticOrder, true, true>(lds, g, S, E);
    }
    grid.sync();
    if (PH(7)) { PT p; TLW; phase_attn(p, lds, tid, lane, wave); }
    grid.sync();
    if (PH(8)) {
        PT p; GRIDV; unsigned char* ws = p.ws;
        pg8::Gemm g{(const pg8::bf16_t*)(ws + WS_O), (const pg8::bf16_t*)(ws + WS_W1OUT), M, 2048, 2048}; pg8::StaticOrder S; S.init(M, 2048, G, c);
        EpiRes E{(const float*)(ws + WS_X1), p.out, nullptr, (float*)(ws + WS_ST2)};
        pg8::gemm_phase<EpiRes, pg8::StaticOrder, true, true>(lds, g, S, E);
    }
    grid.sync();
    if (PH(9)) { PT p; TLW; phase_final(p, lane, wave); }
}

extern "C" void kernel_launch(void* const* d_in, const int* in_sizes, int n_in, void* d_out, int out_size, void* d_ws, size_t ws_size, hipStream_t stream) {
    static int grid = 0;
    if (grid == 0) {
        if (n_in != 23 || out_size != M * DM || ws_size < WS_END) { fprintf(stderr, "kernel_launch: unexpected shapes (n_in %d out %d ws %zu)\n", n_in, out_size, ws_size); grid = -1; return; }
        int dev = 0, cus = 0, per_cu = 0;
        hipGetDevice(&dev); hipDeviceGetAttribute(&cus, hipDeviceAttributeMultiprocessorCount, dev);
        hipFuncSetAttribute((const void*)fwd_megakernel, hipFuncAttributeMaxDynamicSharedMemorySize, LDS_BYTES);
        hipOccupancyMaxActiveBlocksPerMultiprocessor(&per_cu, (const void*)fwd_megakernel, 512, LDS_BYTES);
        if (per_cu < 1) { fprintf(stderr, "kernel_launch: occupancy query says %d blocks per CU\n", per_cu); per_cu = 1; }
        (void)hipGetLastError();
        grid = cus;
    }
    if (grid < 0) return;
    Params p{};
    for (int i = 0; i < 23; ++i) p.in[i] = (const float*)d_in[i];
    p.out = (float*)d_out; p.ws = (unsigned char*)d_ws;
    void* args[] = {&p};
    hipError_t e = hipLaunchCooperativeKernel((const void*)fwd_megakernel, dim3(grid), dim3(512), args, LDS_BYTES, stream);
    if (e != hipSuccess) fprintf(stderr, "cooperative launch failed: %s (grid %d)\n", hipGetErrorString(e), grid);
}
```

```cpp
#include <hip/hip_runtime.h>
#include <hip/hip_cooperative_groups.h>
#include <cstdio>
#include <cstdint>
#include <cmath>
namespace cg = cooperative_groups;
namespace pg8 {
#define PG8_LAS __attribute__((address_space(3)))
typedef unsigned short bf16_t;
typedef short bf16x8 __attribute__((ext_vector_type(8)));
typedef float f32x4 __attribute__((ext_vector_type(4)));
typedef unsigned u32x4 __attribute__((ext_vector_type(4)));
constexpr int BM = 256, BK = 64, HALF = 128, HTB = HALF * BK * 2  , STAGE_BYTES = 8 * HTB, NXCD = 8, WGM = 8;

__host__ __device__ __forceinline__ int lds_byte(int r, int c) { const int st = (r >> 4) * 2 + (c >> 5), rr = r & 15, cc = c & 31, ob = rr * 64 + cc * 2; return st * 1024 + (ob ^ (((ob >> 9) & 1) << 5)); }
__host__ __device__ __forceinline__ void stage_rc(int b, int& R, int& C) { const int st = b / 1024, sb = b % 1024, swz = sb ^ (((sb >> 9) & 1) << 5); R = (st >> 1) * 16 + swz / 64; C = (st & 1) * 32 + (swz % 64) / 2; }
__host__ __device__ __forceinline__ int perm32(int rho) { const int n = rho >> 4, i = rho & 15; return 8 * (i >> 2) + 4 * n + (i & 3); }

struct Unit { int pm, pn; };
struct Gemm { const bf16_t* A; const bf16_t* Bt; int M, N, K; };

struct StaticOrder {
    int nM, nN, nwg, G, c;
    __host__ __device__ void init(int M, int N, int G_, int c_) { nM = M / BM; nN = N / BM; nwg = nM * nN; G = G_; c = c_; }
    __host__ __device__ bool next(int i, Unit& u) const {
        const long L = (long)i * G + c; if (L >= nwg) return false;
        int wgid = (int)L; { const int q = nwg / NXCD, r = nwg % NXCD, xcd = wgid % NXCD, off = wgid / NXCD; wgid = (xcd < r ? xcd * (q + 1) : r * (q + 1) + (xcd - r) * q) + off; }
        const int nig = WGM * nN, gid = wgid / nig, fm = gid * WGM, gsz = (nM - fm) < WGM ? (nM - fm) : WGM;
        u.pm = fm + ((wgid % nig) % gsz); u.pn = (wgid % nig) / gsz; return true;
    }
    __device__ __forceinline__ void a_ready(const Unit&) const {}
    __device__ __forceinline__ void done(const Unit&) const {}
};

template <class Epi, class Sched, bool ALIGN_EPI = false, bool SP2 = false>
__device__ __forceinline__ void gemm_phase(PG8_LAS unsigned char* lds, const Gemm g, const Sched& S, const Epi& E) {
    int tid_ = threadIdx.x; asm volatile("" : "+v"(tid_));
    const int tid = tid_, wid = __builtin_amdgcn_readfirstlane(tid >> 6), lane = tid & 63, wr = wid >> 2, wc = wid & 3, fr = lane & 15, fq = lane >> 4;
    const int K = g.K, nt = K / BK;
    unsigned voffA[2], voffB[2];
#pragma unroll
    for (int i = 0; i < 2; ++i) { int R, C; stage_rc(tid * 16 + i * 8192, R, C); const int Rb = Epi::PERM ? ((R & ~31) + perm32(R & 31)) : R;
        voffA[i] = (unsigned)(R * K + C) * 2u; voffB[i] = (unsigned)(Rb * K + C) * 2u; }
    const size_t kstep = (size_t)(BK * 2);
    const size_t hstep = (size_t)HALF * K * 2;
    const size_t tstep = 2 * hstep;
    const unsigned ldsw = (unsigned)wid * 1024u;
    const int aoff = lds_byte(wr * 64 + fr, fq * 8), boff = lds_byte(wc * 32 + fr, fq * 8);
#define PG8_SA(b, h) (((b) * 2 + (h)) * HTB)
#define PG8_SB(b, h) ((4 + (b) * 2 + (h)) * HTB)
#define PG8_STAGE(bufoff, gbase, voff) do { _Pragma("unroll") for (int _i = 0; _i < 2; ++_i) \
        __builtin_amdgcn_global_load_lds((const unsigned*)((const char*)(gbase) + (voff)[_i]), (PG8_LAS unsigned*)(lds + (bufoff) + ldsw + _i * 8192), 16, 0, 0); } while (0)
#define PG8_LDA(dst, b, h) do { _Pragma("unroll") for (int m = 0; m < 4; ++m) _Pragma("unroll") for (int k = 0; k < 2; ++k) dst[m][k] = *(const PG8_LAS bf16x8*)(lds + PG8_SA(b, h) + aoff + m * 2048 + k * 1024); } while (0)
#define PG8_LDB(dst, b, h) do { _Pragma("unroll") for (int n = 0; n < 2; ++n) _Pragma("unroll") for (int k = 0; k < 2; ++k) dst[n][k] = *(const PG8_LAS bf16x8*)(lds + PG8_SB(b, h) + boff + n * 2048 + k * 1024); } while (0)
#define PG8_MMA(ai, bj, At, Bt) do { __builtin_amdgcn_s_setprio(1); _Pragma("unroll") for (int m = 0; m < 4; ++m) _Pragma("unroll") for (int n = 0; n < 2; ++n) _Pragma("unroll") for (int k = 0; k < 2; ++k) \
        acc[ai][bj][m][n] = __builtin_amdgcn_mfma_f32_16x16x32_bf16(Bt[n][k], At[m][k], acc[ai][bj][m][n], 0, 0, 0); __builtin_amdgcn_s_setprio(0); } while (0)
#define PG8_WAIT_V(n) asm volatile("s_waitcnt vmcnt(" #n ")" ::: "memory")
#define PG8_WAIT_L(n) asm volatile("s_waitcnt lgkmcnt(" #n ")" ::: "memory")
#define PG8_BAR __builtin_amdgcn_s_barrier()
#define PG8_SCHED __builtin_amdgcn_sched_barrier(0)
    Unit cur, nxt; int ui = 0;
    if (!S.next(0, cur)) return;
    f32x4 acc[2][2][4][2];
#pragma unroll
    for (int a = 0; a < 2; ++a)
#pragma unroll
        for (int b = 0; b < 2; ++b)
#pragma unroll
            for (int m = 0; m < 4; ++m)
#pragma unroll
                for (int n = 0; n < 2; ++n) acc[a][b][m][n] = (f32x4){0.f, 0.f, 0.f, 0.f};
    bf16x8 At[4][2], B0[2][2], B1[2][2];
    const char* cA = (const char*)g.A + (size_t)cur.pm * tstep; const char* cB = (const char*)g.Bt + (size_t)cur.pn * tstep;
    S.a_ready(cur);
    if constexpr (SP2) {
        PG8_STAGE(PG8_SB(0, 0), cB, voffB); PG8_STAGE(PG8_SB(0, 1), cB + hstep, voffB); PG8_STAGE(PG8_SA(0, 0), cA, voffA); PG8_STAGE(PG8_SA(0, 1), cA + hstep, voffA);
        if (wr == 1) PG8_BAR;
        PG8_WAIT_V(2); PG8_BAR;
        PG8_STAGE(PG8_SB(1, 0), cB + kstep, voffB); PG8_STAGE(PG8_SA(1, 0), cA + kstep, voffA); PG8_STAGE(PG8_SB(1, 1), cB + hstep + kstep, voffB);
        PG8_WAIT_V(6); PG8_BAR;
    } else {
        PG8_STAGE(PG8_SB(0, 0), cB, voffB); PG8_STAGE(PG8_SA(0, 0), cA, voffA); PG8_STAGE(PG8_SB(0, 1), cB + hstep, voffB); PG8_STAGE(PG8_SA(0, 1), cA + hstep, voffA);
        if (wr == 1) PG8_BAR;
        PG8_WAIT_V(4); PG8_BAR;
        PG8_STAGE(PG8_SB(1, 0), cB + kstep, voffB); PG8_STAGE(PG8_SA(1, 0), cA + kstep, voffA); PG8_STAGE(PG8_SB(1, 1), cB + hstep + kstep, voffB);
        PG8_WAIT_V(6); PG8_BAR;
    }
    for (;;) {
        const bool has_next = S.next(ui + 1, nxt);
        const char* nA = has_next ? (const char*)g.A + (size_t)nxt.pm * tstep : cA; const char* nB = has_next ? (const char*)g.Bt + (size_t)nxt.pn * tstep : cB;
        for (int t = 0; t < nt; t += 2) {
            const bool last = (t == nt - 2);
            const char* a1 = cA + (size_t)(t + 1) * kstep;
            const char* a2 = last ? nA : cA + (size_t)(t + 2) * kstep; const char* b2 = last ? nB : cB + (size_t)(t + 2) * kstep;
            const char* a3 = a2 + kstep; const char* b3 = b2 + kstep;
            if (last && has_next) S.a_ready(nxt);
            if constexpr (SP2) {
            PG8_LDB(B0, 0, 0); PG8_LDB(B1, 0, 1); PG8_SCHED; PG8_LDA(At, 0, 0); PG8_STAGE(PG8_SA(1, 1), a1 + hstep, voffA);
            PG8_WAIT_V(8); PG8_WAIT_L(0); PG8_BAR; PG8_MMA(0, 0, At, B0); PG8_MMA(0, 1, At, B1); PG8_BAR; PG8_SCHED;
            PG8_LDA(At, 0, 1); PG8_STAGE(PG8_SB(0, 0), b2, voffB); PG8_STAGE(PG8_SB(0, 1), b2 + hstep, voffB); PG8_STAGE(PG8_SA(0, 0), a2, voffA);
            PG8_WAIT_V(8); PG8_WAIT_L(0); PG8_BAR; PG8_MMA(1, 0, At, B0); PG8_MMA(1, 1, At, B1); PG8_BAR; PG8_SCHED;
            PG8_LDB(B0, 1, 0); PG8_LDB(B1, 1, 1); PG8_SCHED; PG8_LDA(At, 1, 0); PG8_STAGE(PG8_SA(0, 1), a2 + hstep, voffA);
            PG8_WAIT_V(8); PG8_WAIT_L(0); PG8_BAR; PG8_MMA(0, 0, At, B0); PG8_MMA(0, 1, At, B1); PG8_BAR; PG8_SCHED;
            PG8_LDA(At, 1, 1); PG8_STAGE(PG8_SB(1, 0), b3, voffB); PG8_STAGE(PG8_SB(1, 1), b3 + hstep, voffB); PG8_STAGE(PG8_SA(1, 0), a3, voffA);
            PG8_WAIT_V(8); PG8_WAIT_L(0); PG8_BAR; PG8_MMA(1, 0, At, B0); PG8_MMA(1, 1, At, B1); PG8_BAR; PG8_SCHED;
            } else {
            PG8_LDB(B0, 0, 0); PG8_SCHED; PG8_LDA(At, 0, 0); PG8_STAGE(PG8_SA(1, 1), a1 + hstep, voffA);
            PG8_WAIT_L(8); PG8_BAR; PG8_WAIT_L(0); PG8_MMA(0, 0, At, B0); PG8_BAR; PG8_SCHED;
            PG8_LDB(B1, 0, 1); PG8_STAGE(PG8_SB(0, 0), b2, voffB);
            PG8_BAR; PG8_WAIT_L(0); PG8_MMA(0, 1, At, B1); PG8_BAR;
            PG8_LDA(At, 0, 1); PG8_STAGE(PG8_SA(0, 0), a2, voffA);
            PG8_BAR; PG8_WAIT_L(0); PG8_MMA(1, 0, At, B0); PG8_BAR; PG8_SCHED;
            PG8_STAGE(PG8_SB(0, 1), b2 + hstep, voffB);
            PG8_WAIT_V(6); PG8_BAR; PG8_MMA(1, 1, At, B1); PG8_BAR;
            PG8_LDB(B0, 1, 0); PG8_SCHED; PG8_LDA(At, 1, 0); PG8_STAGE(PG8_SA(0, 1), a2 + hstep, voffA);
            PG8_WAIT_L(8); PG8_BAR; PG8_WAIT_L(0); PG8_MMA(0, 0, At, B0); PG8_BAR; PG8_SCHED;
            PG8_LDB(B1, 1, 1); PG8_STAGE(PG8_SB(1, 0), b3, voffB);
            PG8_BAR; PG8_WAIT_L(0); PG8_MMA(0, 1, At, B1); PG8_BAR;
            PG8_LDA(At, 1, 1); PG8_STAGE(PG8_SA(1, 0), a3, voffA);
            PG8_BAR; PG8_WAIT_L(0); PG8_MMA(1, 0, At, B0); PG8_BAR; PG8_SCHED;
            PG8_STAGE(PG8_SB(1, 1), b3 + hstep, voffB);
            PG8_WAIT_V(6); PG8_BAR; PG8_MMA(1, 1, At, B1); PG8_BAR;
            }
        }
        if constexpr (ALIGN_EPI) { if (wr == 0) PG8_BAR; }
        if constexpr (!Epi::AFTER_DRAIN) { E(acc, cur, wr, wc, fr, fq); S.done(cur); }
        if (!has_next) break;
#pragma unroll
        for (int a = 0; a < 2; ++a)
#pragma unroll
            for (int b = 0; b < 2; ++b)
#pragma unroll
                for (int m = 0; m < 4; ++m)
#pragma unroll
                    for (int n = 0; n < 2; ++n) acc[a][b][m][n] = (f32x4){0.f, 0.f, 0.f, 0.f};
        cur = nxt; cA = nA; cB = nB; ++ui;
        if constexpr (ALIGN_EPI) { if (wr == 1) PG8_BAR; }
    }
    PG8_WAIT_V(0);
    if constexpr (!ALIGN_EPI) { if (wr == 0) PG8_BAR; }
    PG8_BAR;
    if constexpr (Epi::AFTER_DRAIN) { E.fused(acc, cur, wr, wc, fr, fq, lds, wid, lane); S.done(cur); }
#undef PG8_SA
#undef PG8_SB
#undef PG8_STAGE
#undef PG8_LDA
#undef PG8_LDB
#undef PG8_MMA
#undef PG8_WAIT_V
#undef PG8_WAIT_L
#undef PG8_BAR
#undef PG8_SCHED
}
}

#define LAS __attribute__((address_space(3)))
typedef unsigned short bf16;
typedef unsigned u32x4 __attribute__((ext_vector_type(4)));
typedef unsigned u32x2 __attribute__((ext_vector_type(2)));
typedef float f32x4 __attribute__((ext_vector_type(4)));
typedef float f32x16 __attribute__((ext_vector_type(16)));
typedef short bf16x8 __attribute__((ext_vector_type(8)));

constexpr int M = 16384, DM = 2048, SEQ = 2048, NBATCH = 8, NCH = 16;
constexpr int N0P = 11520, N0R = 11296;
constexpr float EPS = 1e-5f;
constexpr float LOG2E = 1.4426950408889634f;
constexpr float QSCALE = 0.125f * LOG2E;
constexpr float LAMBDA_INIT = 0.35550906f;
constexpr size_t MiB = 1u << 20;
constexpr size_t WS_ST0 = 0, WS_ST1 = 128 * 1024, WS_ST2 = 192 * 1024, WS_CD = 256 * 1024, WS_LAM = 300 * 1024;
constexpr size_t WS_DT = 1 * MiB, WS_WSP = 3 * MiB, WS_W0IN = 4 * MiB, WS_W0OUT = 49 * MiB, WS_W1IN = 65 * MiB, WS_W1OUT = 97 * MiB;
constexpr size_t WS_YCAT = 105 * MiB, WS_ZA = 233 * MiB, WS_V = 297 * MiB, WS_H0 = 361 * MiB, WS_XT = 425 * MiB, WS_CN = 489 * MiB, WS_END = 505 * MiB;
constexpr size_t WS_Q = WS_YCAT, WS_K = WS_YCAT + 64 * MiB, WS_X1 = WS_ZA, WS_STATES = WS_V, WS_VT = WS_H0, WS_X1B = WS_H0, WS_O = WS_H0, WS_VV = WS_XT;
constexpr size_t DO_XBC = 0, DO_BN = 96 * MiB, DO_BT = 112 * MiB, DO_PREV = 0, DO_G = 0;
constexpr int LDS_BYTES = 147456;

__device__ __forceinline__ unsigned pk2(float lo, float hi) {
    typedef float f2 __attribute__((ext_vector_type(2))); typedef __bf16 b2 __attribute__((ext_vector_type(2)));
    f2 v = {lo, hi}; b2 b = __builtin_convertvector(v, b2); return __builtin_bit_cast(unsigned, b);
}
__device__ __forceinline__ float bflo(unsigned u) { return __uint_as_float(u << 16); }
__device__ __forceinline__ float bfhi(unsigned u) { return __uint_as_float(u & 0xffff0000u); }
__device__ __forceinline__ void unpack8(u32x4 r, float* f) { f[0] = bflo(r.x); f[1] = bfhi(r.x); f[2] = bflo(r.y); f[3] = bfhi(r.y); f[4] = bflo(r.z); f[5] = bfhi(r.z); f[6] = bflo(r.w); f[7] = bfhi(r.w); }
__device__ __forceinline__ u32x4 pack8(const float* f) { u32x4 o; o.x = pk2(f[0], f[1]); o.y = pk2(f[2], f[3]); o.z = pk2(f[4], f[5]); o.w = pk2(f[6], f[7]); return o; }
__device__ __forceinline__ float fexp2(float x) { return __builtin_amdgcn_exp2f(x); }
__device__ __forceinline__ float gelu_f(float x) { const float z = 1.5957691216057308f * (x + 0.044715f * x * x * x); return x * __builtin_amdgcn_rcpf(1.0f + __expf(-z)); }
__device__ __forceinline__ float silu_f(float x) { return x * __builtin_amdgcn_rcpf(1.0f + __expf(-x)); }
__device__ __forceinline__ int crow(int r, int h) { return (r & 3) + 8 * (r >> 2) + 4 * h; }
__device__ __forceinline__ f32x16 mfma32(bf16x8 a, bf16x8 b, f32x16 c) { return __builtin_amdgcn_mfma_f32_32x32x16_bf16(a, b, c, 0, 0, 0); }
__device__ __forceinline__ bf16x8 ld_frag16(const bf16* p) { return __builtin_bit_cast(bf16x8, *(const u32x4*)p); }
__device__ __forceinline__ bf16x8 ld_frag8x2(const bf16* p) { const u32x2 lo = *(const u32x2*)p, hi = *(const u32x2*)(p + 8); u32x4 v; v.x = lo.x; v.y = lo.y; v.z = hi.x; v.w = hi.y; return __builtin_bit_cast(bf16x8, v); }
__device__ __forceinline__ bf16x8 pack_frag(const f32x16& x, int s) {
    u32x4 v; v.x = pk2(x[8 * s], x[8 * s + 1]); v.y = pk2(x[8 * s + 2], x[8 * s + 3]); v.z = pk2(x[8 * s + 4], x[8 * s + 5]); v.w = pk2(x[8 * s + 6], x[8 * s + 7]); return __builtin_bit_cast(bf16x8, v);
}
__device__ __forceinline__ float wave_sum(float v) {
#pragma unroll
    for (int o = 1; o < 64; o <<= 1) v += __shfl_xor(v, o);
    return v;
}
#define LDS_WAIT() asm volatile("s_waitcnt lgkmcnt(0)" ::: "memory")
__device__ __forceinline__ void atomic_addf(float* p, float v) { __hip_atomic_fetch_add(p, v, __ATOMIC_RELAXED, __HIP_MEMORY_SCOPE_AGENT); }

struct Params { const float* in[23]; float* out; unsigned char* ws; };
constexpr int PTAB_OFF = LDS_BYTES - 512;
__device__ __forceinline__ unsigned long long ptab_get(int i) {
    const unsigned long long v = ((const LAS unsigned long long*)(PTAB_OFF))[i];
    const unsigned lo = __builtin_amdgcn_readfirstlane((unsigned)v), hi = __builtin_amdgcn_readfirstlane((unsigned)(v >> 32));
    return ((unsigned long long)hi << 32) | lo;
}
struct PT {
    struct InTab { __device__ __forceinline__ const float* operator[](int i) const { return (const float*)(const __attribute__((address_space(1))) float*)ptab_get(i); } } in;
    float* out; unsigned char* ws;
    __device__ __forceinline__ PT() { out = (float*)(__attribute__((address_space(1))) float*)ptab_get(23); ws = (unsigned char*)(__attribute__((address_space(1))) unsigned char*)ptab_get(24); }
};

template <int ACT>
__device__ __forceinline__ void epi_tile_bf16(const f32x4 (&acc)[2][2][4][2], bf16* base, int pitch, int col0, int row0, float sc) {
#pragma unroll
    for (int ai = 0; ai < 2; ++ai)
#pragma unroll
        for (int m = 0; m < 4; ++m) {
            bf16* rowp = base + (size_t)(row0 + ai * 128 + m * 16) * pitch + col0;
#pragma unroll
            for (int bj = 0; bj < 2; ++bj) {
                float v[8];
#pragma unroll
                for (int j = 0; j < 4; ++j) { v[j] = acc[ai][bj][m][0][j]; v[4 + j] = acc[ai][bj][m][1][j]; }
#pragma unroll
                for (int j = 0; j < 8; ++j) { if (ACT == 1) v[j] = gelu_f(v[j]); else if (ACT == 2) v[j] = silu_f(v[j]); else if (ACT == 3) v[j] *= sc; }
                *(u32x4*)(rowp + bj * 128) = pack8(v);
            }
        }
}

struct EpiIn0 {
    static constexpr bool PERM = true, AFTER_DRAIN = false;
    bf16 *ycat, *vbuf, *za, *xbc; float *dt, *stats0; const float* dt_bias;
    __device__ __forceinline__ void operator()(const f32x4 (&acc)[2][2][4][2], const pg8::Unit& u, int wr, int wc, int fr, int fq) const {
        const int pn = u.pn, row0 = u.pm * 256 + wr * 64 + fr, cl = wc * 32 + 8 * fq;
        if (pn < 8) { epi_tile_bf16<1>(acc, ycat, 4096, pn * 256 + cl, row0, 1.f); }
        else if (pn < 16) {
#pragma unroll
            for (int ai = 0; ai < 2; ++ai)
#pragma unroll
                for (int m = 0; m < 4; ++m) {
                    const int row = row0 + ai * 128 + m * 16;
                    bf16* rowp = vbuf + (size_t)row * 2048 + (pn - 8) * 256 + cl;
                    float s = 0.f, ss = 0.f;
#pragma unroll
                    for (int bj = 0; bj < 2; ++bj) {
                        float v[8];
#pragma unroll
                        for (int j = 0; j < 4; ++j) { v[j] = gelu_f(acc[ai][bj][m][0][j]); v[4 + j] = gelu_f(acc[ai][bj][m][1][j]); }
#pragma unroll
                        for (int j = 0; j < 8; ++j) { s += v[j]; ss += v[j] * v[j]; }
                        *(u32x4*)(rowp + bj * 128) = pack8(v);
                    }
                    s += __shfl_xor(s, 16); s += __shfl_xor(s, 32); ss += __shfl_xor(ss, 16); ss += __shfl_xor(ss, 32);
                    if (fq == 0) { atomic_addf(stats0 + 2 * row, s); atomic_addf(stats0 + 2 * row + 1, ss); }
                }
        }
        else if (pn < 24) { epi_tile_bf16<2>(acc, za, 2048, (pn - 16) * 256 + cl, row0, 1.f); }
        else if (pn < 32) { epi_tile_bf16<2>(acc, ycat, 4096, 2048 + (pn - 24) * 256 + cl, row0, 1.f); }
        else if (pn < 44) { epi_tile_bf16<0>(acc, xbc, 3072, (pn - 32) * 256 + cl, row0, 1.f); }
        else if (wc == 0) {
            f32x4 b0 = *(const f32x4*)(dt_bias + cl), b1 = *(const f32x4*)(dt_bias + cl + 4);
#pragma unroll
            for (int ai = 0; ai < 2; ++ai)
#pragma unroll
                for (int m = 0; m < 4; ++m) {
                    const int row = row0 + ai * 128 + m * 16;
                    f32x4 v0 = acc[ai][0][m][0] + b0, v1 = acc[ai][0][m][1] + b1;
#pragma unroll
                    for (int j = 0; j < 4; ++j) { v0[j] = v0[j] > 20.f ? v0[j] : log1pf(__expf(v0[j])); v1[j] = v1[j] > 20.f ? v1[j] : log1pf(__expf(v1[j])); }
                    *(f32x4*)(dt + (size_t)row * 32 + cl) = v0; *(f32x4*)(dt + (size_t)row * 32 + cl + 4) = v1;
                }
        }
    }
};

struct EpiRes {
    static constexpr bool PERM = true, AFTER_DRAIN = false;
    const float* resid; float* outf; bf16* outb; float* stats;
    __device__ __forceinline__ void operator()(const f32x4 (&acc)[2][2][4][2], const pg8::Unit& u, int wr, int wc, int fr, int fq) const {
        const int row0 = u.pm * 256 + wr * 64 + fr, col0 = u.pn * 256 + wc * 32 + 8 * fq;
#pragma unroll
        for (int ai = 0; ai < 2; ++ai)
#pragma unroll
            for (int m = 0; m < 4; ++m) {
                const int row = row0 + ai * 128 + m * 16; const size_t off = (size_t)row * 2048 + col0;
                float ss = 0.f;
#pragma unroll
                for (int bj = 0; bj < 2; ++bj) {
                    const f32x4 r0 = *(const f32x4*)(resid + off + bj * 128) + acc[ai][bj][m][0], r1 = *(const f32x4*)(resid + off + bj * 128 + 4) + acc[ai][bj][m][1];
                    *(f32x4*)(outf + off + bj * 128) = r0; *(f32x4*)(outf + off + bj * 128 + 4) = r1;
                    ss += (r0[0] * r0[0] + r0[1] * r0[1]) + (r0[2] * r0[2] + r0[3] * r0[3]) + (r1[0] * r1[0] + r1[1] * r1[1]) + (r1[2] * r1[2] + r1[3] * r1[3]);
                    if (outb) { u32x4 w; w.x = pk2(r0[0], r0[1]); w.y = pk2(r0[2], r0[3]); w.z = pk2(r1[0], r1[1]); w.w = pk2(r1[2], r1[3]); *(u32x4*)(outb + off + bj * 128) = w; }
                }
                ss += __shfl_xor(ss, 16); ss += __shfl_xor(ss, 32);
                if (fq == 0) atomic_addf(stats + row, ss);
            }
    }
};

struct EpiIn1 {
    static constexpr bool PERM = true, AFTER_DRAIN = false;
    bf16 *q, *k, *v, *g; const float* stats1;
    __device__ __forceinline__ void operator()(const f32x4 (&acc)[2][2][4][2], const pg8::Unit& u, int wr, int wc, int fr, int fq) const {
        const int seg = u.pn >> 3, row0 = u.pm * 256 + wr * 64 + fr, col0 = (u.pn & 7) * 256 + wc * 32 + 8 * fq;
        bf16* base = seg == 0 ? q : (seg == 1 ? k : (seg == 2 ? v : g));
        const float sc = seg == 0 ? QSCALE : 1.f;
#pragma unroll
        for (int ai = 0; ai < 2; ++ai)
#pragma unroll
            for (int m = 0; m < 4; ++m) {
                const int row = row0 + ai * 128 + m * 16;
                const float rs = rsqrtf(stats1[row] * (1.f / 2048.f) + EPS) * sc;
                bf16* rowp = base + (size_t)row * 2048 + col0;
#pragma unroll
                for (int bj = 0; bj < 2; ++bj) {
                    float v8[8];
#pragma unroll
                    for (int j = 0; j < 4; ++j) { v8[j] = acc[ai][bj][m][0][j] * rs; v8[4 + j] = acc[ai][bj][m][1][j] * rs; }
                    if (seg == 3) {
#pragma unroll
                        for (int j = 0; j < 8; ++j) v8[j] = silu_f(v8[j]);
                    }
                    *(u32x4*)(rowp + bj * 128) = pack8(v8);
                }
            }
    }
};

__device__ __forceinline__ void transpose_item(const float* W, int K, int N, bf16* WT, LAS float* scr, int item, int lane, const float* kscale) {
    const int nblk = N / 32, kb = item / nblk, nb = item % nblk, k0 = 64 * kb, n0 = 32 * nb;
#pragma unroll 8
    for (int i = 0; i < 32; ++i) { const int kk = 2 * i + (lane >> 5); float v = W[(size_t)(k0 + kk) * N + n0 + (lane & 31)]; if (kscale) v *= kscale[k0 + kk]; scr[kk * 33 + (lane & 31)] = v; }
    LDS_WAIT();
    const int c = lane & 7;
#pragma unroll
    for (int j = 0; j < 4; ++j) { const int n = (lane >> 3) + 8 * j; const LAS float* s = scr + (8 * c) * 33 + n;
        u32x4 o; o.x = pk2(s[0 * 33], s[1 * 33]); o.y = pk2(s[2 * 33], s[3 * 33]); o.z = pk2(s[4 * 33], s[5 * 33]); o.w = pk2(s[6 * 33], s[7 * 33]);
        *(u32x4*)(WT + (size_t)(n0 + n) * K + k0 + 8 * c) = o; }
    LDS_WAIT();
}

__device__ __forceinline__ void phase0(const PT& p, LAS unsigned char* lds, int tid, int lane, int wave) {
    unsigned char* ws = p.ws;
    const int gw = blockIdx.x * 8 + wave, NGW = gridDim.x * 8;
    const int gt = blockIdx.x * 512 + tid, NGT = gridDim.x * 512;
    LAS float* scr = (LAS float*)(lds + wave * 16384);
    for (int i = gt; i < 65536; i += NGT) ((float*)(ws + WS_ST0))[i] = 0.f;
    constexpr int I0 = 32 * (N0R / 32), I1 = 64 * 64, I2 = 32 * 256, I3 = 32 * 64;
    for (int it = gw; it < I0 + I1 + I2 + I3; it += NGW) {
        int r = it;
        if (r < I0) { transpose_item(p.in[2], 2048, N0R, (bf16*)(ws + WS_W0IN), scr, r, lane, nullptr); continue; } r -= I0;
        if (r < I1) { transpose_item(p.in[13], 4096, 2048, (bf16*)(ws + WS_W0OUT), scr, r, lane, nullptr); continue; } r -= I1;
        if (r < I2) { transpose_item(p.in[15], 2048, 8192, (bf16*)(ws + WS_W1IN), scr, r, lane, p.in[14]); continue; } r -= I2;
        transpose_item(p.in[21], 2048, 2048, (bf16*)(ws + WS_W1OUT), scr, r, lane, nullptr);
    }
    for (int i = gt; i < (N0P - N0R) * 2048 / 8; i += NGT) ((u32x4*)((bf16*)(ws + WS_W0IN) + (size_t)N0R * 2048))[i] = (u32x4){0u, 0u, 0u, 0u};
    for (int i = gt; i < 16 * 128 * 128 / 8; i += NGT) {
        const int e = i * 8, t = (e >> 7) & 127, s0 = e & 127; const float* src = p.in[5] + e; float v[8];
#pragma unroll
        for (int j = 0; j < 8; ++j) v[j] = (s0 + j <= t) ? src[j] : 0.f;
        ((u32x4*)(ws + WS_WSP))[i] = pack8(v);
    }
    const float* g0 = p.in[1]; bf16* H0 = (bf16*)(ws + WS_H0);
    for (int m = gw; m < M; m += NGW) {
        const f32x4* xr = (const f32x4*)(p.in[0] + (size_t)m * 2048) + lane; f32x4 v[8]; float s = 0.f;
#pragma unroll
        for (int j = 0; j < 8; ++j) { v[j] = xr[64 * j]; s += (v[j].x * v[j].x + v[j].y * v[j].y) + (v[j].z * v[j].z + v[j].w * v[j].w); }
        const float rs = rsqrtf(wave_sum(s) * (1.f / 2048.f) + EPS);
        u32x2* o = (u32x2*)(H0 + (size_t)m * 2048) + lane;
#pragma unroll
        for (int j = 0; j < 8; ++j) { const f32x4 g = ((const f32x4*)g0)[lane + 64 * j]; u32x2 w; w.x = pk2(v[j].x * rs * g.x, v[j].y * rs * g.y); w.y = pk2(v[j].z * rs * g.z, v[j].w * rs * g.w); o[64 * j] = w; }
    }
}

__device__ __forceinline__ void phase_layout(const PT& p, int tid) {
    unsigned char* ws = p.ws; unsigned char* dob = (unsigned char*)p.out;
    const bf16* Vb = (const bf16*)(ws + WS_V); const float* st0 = (const float*)(ws + WS_ST0);
    const bf16* XBC = (const bf16*)(dob + DO_XBC);
    bf16 *vT = (bf16*)(ws + WS_VT), *xT = (bf16*)(ws + WS_XT), *Bn = (bf16*)(dob + DO_BN), *BT = (bf16*)(dob + DO_BT), *Cn = (bf16*)(ws + WS_CN);
    const int t = tid & 255, so = t >> 4, co = t & 15;
    for (int pi = blockIdx.x * 2 + (tid >> 8); pi < 128 * 40; pi += gridDim.x * 2) {
        const int bc = pi / 40, k = pi % 40; const int tok0 = bc * 128 + so * 8;
        float o[8][8];
        if (k < 16) {
            const int ch0 = k * 128 + co * 8;
            float g[8], bb[8];
#pragma unroll
            for (int j = 0; j < 8; ++j) { g[j] = p.in[3][ch0 + j]; bb[j] = p.in[4][ch0 + j]; }
#pragma unroll
            for (int i = 0; i < 8; ++i) {
                const int row = tok0 + i; float f[8]; unpack8(*(const u32x4*)(Vb + (size_t)row * 2048 + ch0), f);
                const float mu = st0[2 * row] * (1.f / 2048.f), var = st0[2 * row + 1] * (1.f / 2048.f) - mu * mu, rs = rsqrtf(fmaxf(var, 0.f) + EPS);
#pragma unroll
                for (int j = 0; j < 8; ++j) o[i][j] = (f[j] - mu) * rs * g[j] + bb[j];
            }
#pragma unroll
            for (int j = 0; j < 8; ++j) { float c8[8];
#pragma unroll
                for (int i = 0; i < 8; ++i) c8[i] = o[i][j];
                *(u32x4*)(vT + ((size_t)bc * 2048 + ch0 + j) * 128 + so * 8) = pack8(c8); }
        } else {
            const int sc0 = (k - 16) * 128 + co * 8;
            float cw[4][8], cb[8];
#pragma unroll
            for (int j = 0; j < 8; ++j) { cb[j] = p.in[8][sc0 + j];
#pragma unroll
                for (int kk = 0; kk < 4; ++kk) cw[kk][j] = p.in[7][kk * 3072 + sc0 + j]; }
            const int pos0 = (bc & 15) * 128 + so * 8;
            float xw[11][8];
#pragma unroll
            for (int ii = 0; ii < 11; ++ii) {
                if (pos0 - 3 + ii >= 0) unpack8(*(const u32x4*)(XBC + (size_t)(tok0 - 3 + ii) * 3072 + sc0), xw[ii]);
                else {
#pragma unroll
                    for (int j = 0; j < 8; ++j) xw[ii][j] = 0.f;
                }
            }
#pragma unroll
            for (int i = 0; i < 8; ++i)
#pragma unroll
                for (int j = 0; j < 8; ++j) { float a = cb[j];
#pragma unroll
                    for (int kk = 0; kk < 4; ++kk) a += cw[kk][j] * xw[i + kk][j];
                    o[i][j] = silu_f(a); }
            if (k < 32) {
#pragma unroll
                for (int j = 0; j < 8; ++j) { float c8[8];
#pragma unroll
                    for (int i = 0; i < 8; ++i) c8[i] = o[i][j];
                    *(u32x4*)(xT + ((size_t)bc * 2048 + sc0 + j) * 128 + so * 8) = pack8(c8); }
            } else if (k < 36) {
                const int n0 = sc0 - 2048;
#pragma unroll
                for (int i = 0; i < 8; ++i) *(u32x4*)(Bn + (size_t)(tok0 + i) * 512 + n0) = pack8(o[i]);
#pragma unroll
                for (int j = 0; j < 8; ++j) { float c8[8];
#pragma unroll
                    for (int i = 0; i < 8; ++i) c8[i] = o[i][j];
                    *(u32x4*)(BT + ((size_t)bc * 512 + n0 + j) * 128 + so * 8) = pack8(c8); }
            } else {
                const int n0 = sc0 - 2560;
#pragma unroll
                for (int i = 0; i < 8; ++i) *(u32x4*)(Cn + (size_t)(tok0 + i) * 512 + n0) = pack8(o[i]);
            }
        }
    }
}

__device__ __forceinline__ void chunk_cumsum(const float* DT, const float* a_log, int tok0, int hh, int lane, float& d0, float& d1, float& c0, float& c1, float& tot) {
    d0 = DT[(size_t)(tok0 + 2 * lane) * 32 + hh]; d1 = DT[(size_t)(tok0 + 2 * lane + 1) * 32 + hh];
    const float A = -__expf(a_log[hh]); const float x0 = d0 * A, x1 = d1 * A; float ps = x0 + x1;
#pragma unroll
    for (int o = 1; o < 64; o <<= 1) { const float t = __shfl_up(ps, o); if (lane >= o) ps += t; }
    c1 = ps; c0 = ps - x1; tot = __shfl(ps, 63);
}

__device__ __forceinline__ void phase_mix(const PT& p, LAS unsigned char* lds, int tid, int lane, int wave) {
    unsigned char* ws = p.ws; unsigned char* dob = (unsigned char*)p.out;
    const int r32 = lane & 31, h = lane >> 5;
    bf16* Ycat = (bf16*)(ws + WS_YCAT); const bf16* ZA = (const bf16*)(ws + WS_ZA); const bf16* vT = (const bf16*)(ws + WS_VT); const bf16* Wsp = (const bf16*)(ws + WS_WSP);
    const bf16* xT = (const bf16*)(ws + WS_XT); const bf16* BT = (const bf16*)(dob + DO_BT); const float* DT = (const float*)(ws + WS_DT);
    bf16* ST = (bf16*)(ws + WS_STATES); float* CD = (float*)(ws + WS_CD);
    LAS float* wtab = (LAS float*)lds;
    constexpr int NG = 128 * 16, NS = NBATCH * 15 * 4;
    for (int it = blockIdx.x; it < NG + NS; it += gridDim.x) {
        if (it < NG) {
            const int bc = it >> 4, g = it & 15, cb = wave & 3, th = wave >> 2;
            const int ch0 = g * 128 + cb * 32;
            const bf16* ap = vT + ((size_t)bc * 2048 + ch0 + r32) * 128 + 8 * h;
            f32x16 acc[2];
#pragma unroll
            for (int i = 0; i < 16; ++i) { acc[0][i] = 0.f; acc[1][i] = 0.f; }
#pragma unroll
            for (int st = 0; st < 8; ++st) {
                const bf16x8 a = ld_frag16(ap + 16 * st);
#pragma unroll
                for (int t2 = 0; t2 < 2; ++t2) { const int tb = 2 * th + t2;
                    if (st < 2 * (tb + 1)) { const bf16x8 b = ld_frag16(Wsp + ((size_t)g * 128 + tb * 32 + r32) * 128 + 16 * st + 8 * h); acc[t2] = mfma32(a, b, acc[t2]); } }
            }
#pragma unroll
            for (int t2 = 0; t2 < 2; ++t2) {
                const int t = (2 * th + t2) * 32 + r32; const size_t tok = (size_t)bc * 128 + t; const float sb = p.in[6][g * 128 + t];
#pragma unroll
                for (int qd = 0; qd < 4; ++qd) {
                    const int ch = ch0 + 8 * qd + 4 * h;
                    u32x2* up = (u32x2*)(Ycat + tok * 4096 + ch); const u32x2 uu = *up, zz = *(const u32x2*)(ZA + tok * 2048 + ch);
                    const float y0 = bflo(uu.x) * (acc[t2][4 * qd] + sb) * bflo(zz.x), y1 = bfhi(uu.x) * (acc[t2][4 * qd + 1] + sb) * bfhi(zz.x);
                    const float y2 = bflo(uu.y) * (acc[t2][4 * qd + 2] + sb) * bflo(zz.y), y3 = bfhi(uu.y) * (acc[t2][4 * qd + 3] + sb) * bfhi(zz.y);
                    u32x2 w; w.x = pk2(y0, y1); w.y = pk2(y2, y3); *up = w;
                }
            }
        } else {
            const int id = it - NG, b = id / 60, c = (id / 4) % 15, grp = id & 3; const int bc = b * 16 + c, tok0 = bc * 128;
            __syncthreads();
            { const int hh = grp * 8 + wave; float d0, d1, c0, c1, tot; chunk_cumsum(DT, p.in[10], tok0, hh, lane, d0, d1, c0, c1, tot);
              wtab[wave * 128 + 2 * lane] = d0 * __expf(tot - c0); wtab[wave * 128 + 2 * lane + 1] = d1 * __expf(tot - c1);
              if (lane == 0) CD[bc * 32 + hh] = __expf(tot); }
            __syncthreads();
#pragma unroll 1
            for (int tk = 0; tk < 2; ++tk) {
                const int r = (wave >> 1) + 4 * tk, pb = wave & 1, hh = grp * 8 + r;
                const bf16* ap = xT + ((size_t)bc * 2048 + hh * 64 + pb * 32 + r32) * 128 + 8 * h;
                const bf16* bp = BT + ((size_t)bc * 512 + grp * 128 + r32) * 128 + 8 * h;
                f32x16 acc[4];
#pragma unroll
                for (int nb = 0; nb < 4; ++nb)
#pragma unroll
                    for (int i = 0; i < 16; ++i) acc[nb][i] = 0.f;
#pragma unroll
                for (int st = 0; st < 8; ++st) {
                    float f[8]; unpack8(*(const u32x4*)(ap + 16 * st), f);
                    const f32x4 w0 = *(const LAS f32x4*)(wtab + r * 128 + 16 * st + 8 * h), w1 = *(const LAS f32x4*)(wtab + r * 128 + 16 * st + 8 * h + 4);
                    f[0] *= w0.x; f[1] *= w0.y; f[2] *= w0.z; f[3] *= w0.w; f[4] *= w1.x; f[5] *= w1.y; f[6] *= w1.z; f[7] *= w1.w;
                    const bf16x8 a = __builtin_bit_cast(bf16x8, pack8(f));
#pragma unroll
                    for (int nb = 0; nb < 4; ++nb) { const bf16x8 bfr = ld_frag16(bp + (size_t)nb * 32 * 128 + 16 * st); acc[nb] = mfma32(a, bfr, acc[nb]); }
                }
                bf16* sp = ST + ((size_t)(bc * 32 + hh) * 64 + pb * 32) * 128;
#pragma unroll
                for (int nb = 0; nb < 4; ++nb)
#pragma unroll
                    for (int i = 0; i < 16; ++i) sp[(size_t)crow(i, h) * 128 + nb * 32 + r32] = (bf16)(pk2(acc[nb][i], 0.f) & 0xffffu);
            }
        }
    }
}

__device__ __forceinline__ void phase_scan(const PT& p, int tid) {
    unsigned char* ws = p.ws; const bf16* ST = (const bf16*)(ws + WS_STATES); const float* CD = (const float*)(ws + WS_CD); bf16* PV = (bf16*)((unsigned char*)p.out + DO_PREV);
    for (int id = blockIdx.x * 512 + tid; id < NBATCH * 32 * 64 * 16; id += gridDim.x * 512) {
        const int b = id >> 15, rem = id & 32767, hh = rem >> 10;
        float run[8];
#pragma unroll
        for (int j = 0; j < 8; ++j) run[j] = 0.f;
#pragma unroll
        for (int c = 0; c < 16; ++c) {
            const size_t off = ((size_t)(b * 16 + c) * 32 * 64 * 16 + rem) * 8;
            *(u32x4*)(PV + off) = pack8(run);
            if (c < 15) { float s[8]; unpack8(*(const u32x4*)(ST + off), s); const float cd = CD[(b * 16 + c) * 32 + hh];
#pragma unroll
                for (int j = 0; j < 8; ++j) run[j] = run[j] * cd + s[j]; }
        }
    }
}

__device__ __forceinline__ void phase_ssd_y(const PT& p, LAS unsigned char* lds, int tid, int lane, int wave) {
    unsigned char* ws = p.ws; unsigned char* dob = (unsigned char*)p.out;
    const int r32 = lane & 31, h = lane >> 5;
    bf16* Ycat = (bf16*)(ws + WS_YCAT); const bf16* xT = (const bf16*)(ws + WS_XT); const bf16* Bn = (const bf16*)(dob + DO_BN); const bf16* Cn = (const bf16*)(ws + WS_CN);
    const bf16* PV = (const bf16*)(dob + DO_PREV); const float* DT = (const float*)(ws + WS_DT);
    LAS float* acum = (LAS float*)lds; LAS float* dtt = acum + 1024; LAS float* ssqp = dtt + 1024;
    for (int it = blockIdx.x; it < 128 * 4; it += gridDim.x) {
        const int bc = it >> 2, grp = it & 3, tok0 = bc * 128;
        __syncthreads();
        { const int hh = grp * 8 + wave; float d0, d1, c0, c1, tot; chunk_cumsum(DT, p.in[10], tok0, hh, lane, d0, d1, c0, c1, tot);
          acum[wave * 128 + 2 * lane] = c0; acum[wave * 128 + 2 * lane + 1] = c1; dtt[wave * 128 + 2 * lane] = d0; dtt[wave * 128 + 2 * lane + 1] = d1; }
        __syncthreads();
        const int pb = wave >> 2, lb = wave & 3, l = lb * 32 + r32; const size_t tok = (size_t)tok0 + l;
        bf16x8 cf[8];
#pragma unroll
        for (int st = 0; st < 8; ++st) cf[st] = ld_frag16(Cn + tok * 512 + grp * 128 + 16 * st + 8 * h);
        f32x16 X[4];
#pragma unroll
        for (int sb = 0; sb < 4; ++sb) {
#pragma unroll
            for (int i = 0; i < 16; ++i) X[sb][i] = 0.f;
            if (sb <= lb) {
#pragma unroll
                for (int st = 0; st < 8; ++st) X[sb] = mfma32(ld_frag16(Bn + ((size_t)tok0 + sb * 32 + r32) * 512 + grp * 128 + 16 * st + 8 * h), cf[st], X[sb]);
            }
        }
        float ssq = 0.f;
#pragma unroll 1
        for (int r = 0; r < 8; ++r) {
            const int hh = grp * 8 + r;
            f32x16 acc;
#pragma unroll
            for (int i = 0; i < 16; ++i) acc[i] = 0.f;
            const bf16* pp = PV + ((size_t)(bc * 32 + hh) * 64 + pb * 32 + r32) * 128 + 8 * h;
#pragma unroll
            for (int st = 0; st < 8; ++st) acc = mfma32(ld_frag16(pp + 16 * st), cf[st], acc);
            const float al = acum[r * 128 + l]; const float el = __expf(al);
#pragma unroll
            for (int i = 0; i < 16; ++i) acc[i] *= el;
            const bf16* xrow = xT + ((size_t)bc * 2048 + hh * 64 + pb * 32 + r32) * 128 + 4 * h;
#pragma unroll
            for (int sb = 0; sb < 4; ++sb) {
                if (sb <= lb) {
                    f32x16 mm;
#pragma unroll
                    for (int qd = 0; qd < 4; ++qd) {
                        const int s0 = sb * 32 + 8 * qd + 4 * h;
                        const f32x4 as = *(const LAS f32x4*)(acum + r * 128 + s0), ds = *(const LAS f32x4*)(dtt + r * 128 + s0);
#pragma unroll
                        for (int j = 0; j < 4; ++j) { const float v = X[sb][4 * qd + j] * __expf(al - as[j]) * ds[j]; mm[4 * qd + j] = (s0 + j <= l) ? v : 0.f; }
                    }
#pragma unroll
                    for (int s2 = 0; s2 < 2; ++s2) acc = mfma32(ld_frag8x2(xrow + sb * 32 + 16 * s2), pack_frag(mm, s2), acc);
                }
            }
            const float dsk = p.in[11][hh];
#pragma unroll
            for (int qd = 0; qd < 4; ++qd) {
                const int ch = hh * 64 + pb * 32 + 8 * qd + 4 * h;
                const bf16* xc = xT + ((size_t)bc * 2048 + ch) * 128 + l;
                u32x2* yp = (u32x2*)(Ycat + tok * 4096 + 2048 + ch); const u32x2 zz = *yp;
                const float y0 = (acc[4 * qd] + dsk * bflo((unsigned)xc[0])) * bflo(zz.x), y1 = (acc[4 * qd + 1] + dsk * bflo((unsigned)xc[128])) * bfhi(zz.x);
                const float y2 = (acc[4 * qd + 2] + dsk * bflo((unsigned)xc[256])) * bflo(zz.y), y3 = (acc[4 * qd + 3] + dsk * bflo((unsigned)xc[384])) * bfhi(zz.y);
                ssq += (y0 * y0 + y1 * y1) + (y2 * y2 + y3 * y3);
                u32x2 w; w.x = pk2(y0, y1); w.y = pk2(y2, y3); *yp = w;
            }
        }
        ssq += __shfl_xor(ssq, 32);
        if (h == 0) ssqp[pb * 128 + l] = ssq;
        __syncthreads();
        const float rs = rsqrtf((ssqp[l] + ssqp[128 + l]) * (1.f / 512.f) + EPS);
#pragma unroll 1
        for (int r = 0; r < 8; ++r) {
#pragma unroll
            for (int qd = 0; qd < 4; ++qd) {
                const int ch = (grp * 8 + r) * 64 + pb * 32 + 8 * qd + 4 * h;
                u32x2* yp = (u32x2*)(Ycat + tok * 4096 + 2048 + ch); const u32x2 yy = *yp; const f32x4 g = *(const f32x4*)(p.in[12] + ch);
                u32x2 w; w.x = pk2(bflo(yy.x) * rs * g.x, bfhi(yy.x) * rs * g.y); w.y = pk2(bflo(yy.y) * rs * g.z, bfhi(yy.y) * rs * g.w); *yp = w;
            }
        }
    }
}

constexpr int AK_PITCH = 272, AV_PITCH = 272, A_KOFF = 0, A_VOFF = 128 * AK_PITCH, A_XOFF = A_VOFF + 128 * AV_PITCH;
static_assert(A_XOFF + 4 * 16384 <= PTAB_OFF, "attention LDS map");
typedef short v4i16_t __attribute__((ext_vector_type(4)));
__device__ __forceinline__ float max3f(float a, float b, float c) { return fmaxf(fmaxf(a, b), c); }
__device__ __forceinline__ void attn_unit(const PT& p, LAS unsigned char* lds, int tid, int lane, int wave, int b, int hd, int qb, float lam) {
    unsigned char* ws = p.ws;
    const bf16* Qb = (const bf16*)(ws + WS_Q); const bf16* Kb = (const bf16*)(ws + WS_K); const bf16* Vb = (const bf16*)(ws + WS_VV); const bf16* Gb = (const bf16*)((unsigned char*)p.out + DO_G);
    bf16* Ob = (bf16*)(ws + WS_O);
    const int r32 = lane & 31, h = lane >> 5, mp = wave >> 2, wq = wave & 3;
    const int qw0 = qb * 128 + 32 * wq, q = qw0 + r32; const unsigned tokq = (unsigned)(b * SEQ + q), tokb = (unsigned)(b * SEQ);
    const float slope2 = fexp2(-0.5f * (float)(hd + 1)) * LOG2E;
    bf16x8 qf[4];
#pragma unroll
    for (int ds = 0; ds < 4; ++ds) qf[ds] = ld_frag16(Qb + (tokq * 2048u + (unsigned)(hd * 128 + mp * 64 + 16 * ds + 8 * h)));
    float mrun = -INFINITY, lsum = 0.f;
    f32x16 oT[4];
#pragma unroll
    for (int db = 0; db < 4; ++db)
#pragma unroll
        for (int i = 0; i < 16; ++i) oT[db][i] = 0.f;
    const int ntiles = qb + 1;
    u32x4 preV[4], preK[4];
#define PREFETCH(t) do { \
        _Pragma("unroll") for (int i_ = 0; i_ < 4; ++i_) { const int pid_ = tid + 512 * i_, row_ = pid_ >> 4, c16_ = pid_ & 15; const unsigned go_ = (tokb + (unsigned)((t) * 128 + row_)) * 2048u + (unsigned)(hd * 128 + 8 * c16_); \
            preK[i_] = *(const u32x4*)(Kb + go_); preV[i_] = *(const u32x4*)(Vb + go_); } \
    } while (0)
    PREFETCH(0);
    const LAS unsigned char* kbase = lds + A_KOFF + r32 * AK_PITCH + (mp * 64 + 8 * h) * 2;
    const LAS unsigned char* vbase = lds + A_VOFF + (4 * h + ((lane & 15) >> 2)) * AV_PITCH + ((lane >> 4) & 1) * 32 + (lane & 3) * 8;
#pragma unroll 1
    for (int t = 0; t < ntiles; ++t) {
        __syncthreads();
#pragma unroll
        for (int i = 0; i < 4; ++i) { const int pid = tid + 512 * i, row = pid >> 4, c16 = pid & 15;
            *(LAS u32x4*)(lds + A_KOFF + row * AK_PITCH + 16 * c16) = preK[i]; *(LAS u32x4*)(lds + A_VOFF + row * AV_PITCH + 16 * c16) = preV[i]; }
        __syncthreads();
        if (t + 1 < ntiles) PREFETCH(t + 1);
        const bool diag = (t == qb);
#pragma unroll 1
        for (int sub = 0; sub < 2; ++sub) {
            const int nact = diag ? min(2, max(0, wq + 1 - 2 * sub)) : 2;
            if (nact > 0) {
                const float bq = slope2 * (float)(t * 128 + sub * 64 + 4 * h - q);
                const LAS unsigned char* kb0 = kbase + sub * 64 * AK_PITCH; const LAS unsigned char* vb0 = vbase + sub * 64 * AV_PITCH;
                f32x16 s[2];
#pragma unroll
                for (int kb = 0; kb < 2; ++kb) {
                    if (kb < nact) {
                        const float bk = bq + slope2 * (float)(32 * kb);
#pragma unroll
                        for (int i = 0; i < 16; ++i) s[kb][i] = bk + slope2 * (float)((i & 3) + 8 * (i >> 2));
#pragma unroll
                        for (int ds = 0; ds < 4; ++ds) s[kb] = mfma32(__builtin_bit_cast(bf16x8, *(const LAS u32x4*)(kb0 + kb * 32 * AK_PITCH + ds * 32)), qf[ds], s[kb]);
                    } else {
#pragma unroll
                        for (int i = 0; i < 16; ++i) s[kb][i] = -INFINITY;
                    }
                }
                if (diag) {
#pragma unroll
                    for (int kb = 0; kb < 2; ++kb) if (2 * sub + kb == wq) {
#pragma unroll
                        for (int i = 0; i < 16; ++i) if (crow(i, h) > r32) s[kb][i] = -INFINITY; }
                }
                float mx = -INFINITY;
#pragma unroll
                for (int kb = 0; kb < 2; ++kb)
#pragma unroll
                    for (int i = 0; i < 16; i += 2) mx = max3f(mx, s[kb][i], s[kb][i + 1]);
                mx = fmaxf(mx, __shfl_xor(mx, 32));
                const float mnew = fmaxf(mrun, mx), alpha = fexp2(mrun - mnew); mrun = mnew;
                float rs = 0.f;
#pragma unroll
                for (int kb = 0; kb < 2; ++kb)
#pragma unroll
                    for (int i = 0; i < 16; ++i) { s[kb][i] = fexp2(s[kb][i] - mnew); rs += s[kb][i]; }
                lsum = lsum * alpha + rs;
                if (__builtin_amdgcn_ballot_w64(alpha != 1.0f) != 0ull) {
#pragma unroll
                    for (int db = 0; db < 4; ++db)
#pragma unroll
                        for (int i = 0; i < 16; ++i) oT[db][i] *= alpha;
                }
#pragma unroll
                for (int kb = 0; kb < 2; ++kb) if (kb < nact) {
#pragma unroll
                    for (int s2 = 0; s2 < 2; ++s2) {
                        const bf16x8 pf = pack_frag(s[kb], s2);
#pragma unroll
                        for (int db = 0; db < 4; ++db) {
                            const LAS unsigned char* vp = vb0 + (kb * 32 + 16 * s2) * AV_PITCH + db * 64;
                            const v4i16_t lo = __builtin_amdgcn_ds_read_tr16_b64_v4i16((LAS v4i16_t*)vp), hi = __builtin_amdgcn_ds_read_tr16_b64_v4i16((LAS v4i16_t*)(vp + 8 * AV_PITCH));
                            const bf16x8 vf = {lo[0], lo[1], lo[2], lo[3], hi[0], hi[1], hi[2], hi[3]};
                            oT[db] = mfma32(vf, pf, oT[db]);
                        }
                    }
                }
            }
        }
    }
#undef PREFETCH
    const float lt = lsum + __shfl_xor(lsum, 32);
    LAS float* xch = (LAS float*)(lds + A_XOFF + wq * 16384);
    if (mp == 1) { const float sc = lam / lt;
#pragma unroll
        for (int db = 0; db < 4; ++db)
#pragma unroll
            for (int i = 0; i < 16; ++i) xch[(db * 16 + i) * 64 + lane] = oT[db][i] * sc; }
    __syncthreads();
    if (mp == 0) {
        const float i1 = 1.f / lt; float ss = 0.f;
#pragma unroll
        for (int db = 0; db < 4; ++db)
#pragma unroll
            for (int i = 0; i < 16; ++i) { const float o = oT[db][i] * i1 - xch[(db * 16 + i) * 64 + lane]; oT[db][i] = o; ss += o * o; }
        ss += __shfl_xor(ss, 32);
        const float rn = rsqrtf(ss * (1.f / 128.f) + EPS) * (1.f - LAMBDA_INIT);
#pragma unroll
        for (int db = 0; db < 4; ++db)
#pragma unroll
            for (int qd = 0; qd < 4; ++qd) {
                const int d = db * 32 + 8 * qd + 4 * h; const unsigned off = tokq * 2048u + (unsigned)(hd * 128 + d);
                const u32x2 gg = *(const u32x2*)(Gb + off); const f32x4 sg = *(const f32x4*)(p.in[20] + d);
                u32x2 w; w.x = pk2(oT[db][4 * qd] * rn * sg.x * bflo(gg.x), oT[db][4 * qd + 1] * rn * sg.y * bfhi(gg.x));
                w.y = pk2(oT[db][4 * qd + 2] * rn * sg.z * bflo(gg.y), oT[db][4 * qd + 3] * rn * sg.w * bfhi(gg.y));
                *(u32x2*)(Ob + off) = w;
            }
    }
}

__device__ __forceinline__ void phase_attn(const PT& p, LAS unsigned char* lds, int tid, int lane, int wave) {
    const float s1 = wave_sum(p.in[16][lane] * p.in[17][lane]), s2 = wave_sum(p.in[18][lane] * p.in[19][lane]);
    const float lam = __expf(s1) - __expf(s2) + LAMBDA_INIT;
#pragma unroll 1
    for (int u = blockIdx.x; u < NBATCH * 16 * 8; u += gridDim.x) {
        const int j = u & 7, hd = (u >> 3) & 15, b = u >> 7;
#pragma unroll 1
        for (int k = 0; k < 2; ++k) attn_unit(p, lds, tid, lane, wave, b, hd, k == 0 ? 15 - j : j, lam);
    }
}

__device__ __forceinline__ void phase_final(const PT& p, int lane, int wave) {
    const float* st2 = (const float*)(p.ws + WS_ST2); const float* g = p.in[22];
    for (int m = blockIdx.x * 8 + wave; m < M; m += gridDim.x * 8) {
        const float rs = rsqrtf(st2[m] * (1.f / 2048.f) + EPS);
        f32x4* xr = (f32x4*)(p.out + (size_t)m * 2048) + lane;
#pragma unroll
        for (int j = 0; j < 8; ++j) { const f32x4 gg = ((const f32x4*)g)[lane + 64 * j]; f32x4 v = xr[64 * j]; v.x *= rs * gg.x; v.y *= rs * gg.y; v.z *= rs * gg.z; v.w *= rs * gg.w; xr[64 * j] = v; }
    }
}

__global__ void __launch_bounds__(512) fwd_megakernel(Params pa) {
    extern __shared__ __attribute__((aligned(16))) unsigned char lds_raw[];
    cg::grid_group grid = cg::this_grid();
    LAS unsigned char* lds = (LAS unsigned char*)lds_raw;
    if (threadIdx.x < 25) {
        unsigned long long v = 0;
#pragma unroll
        for (int i = 0; i < 23; ++i) if ((int)threadIdx.x == i) v = (unsigned long long)pa.in[i];
        if (threadIdx.x == 23) v = (unsigned long long)pa.out;
        if (threadIdx.x == 24) v = (unsigned long long)pa.ws;
        ((LAS unsigned long long*)(lds + PTAB_OFF))[threadIdx.x] = v;
    }
    __syncthreads();
#ifndef PHMASK
#define PHMASK 0x3ff
#endif
#define PH(n) (((PHMASK) >> (n)) & 1)
#define TLW int tid_ = threadIdx.x; asm volatile("" : "+v"(tid_)); const int tid = tid_, lane = tid & 63, wave = __builtin_amdgcn_readfirstlane(tid >> 6); (void)tid; (void)lane; (void)wave
#define GRIDV const int G = gridDim.x, c = blockIdx.x
    if (PH(0)) { PT p; TLW; phase0(p, lds, tid, lane, wave); }
    grid.sync();
    if (PH(1)) {
        PT p; GRIDV; unsigned char* ws = p.ws; unsigned char* dob = (unsigned char*)p.out;
        pg8::Gemm g{(const pg8::bf16_t*)(ws + WS_H0), (const pg8::bf16_t*)(ws + WS_W0IN), M, N0P, 2048}; pg8::StaticOrder S; S.init(M, N0P, G, c);
        EpiIn0 E{(bf16*)(ws + WS_YCAT), (bf16*)(ws + WS_V), (bf16*)(ws + WS_ZA), (bf16*)(dob + DO_XBC), (float*)(ws + WS_DT), (float*)(ws + WS_ST0), p.in[9]};
        pg8::gemm_phase<EpiIn0, pg8::StaticOrder, true, true>(lds, g, S, E);
    }
    grid.sync();
    if (PH(2)) { PT p; TLW; phase_layout(p, tid); }
    grid.sync();
    if (PH(3)) { PT p; TLW; phase_mix(p, lds, tid, lane, wave); }
    grid.sync();
    if (PH(4)) { PT p; TLW; phase_scan(p, tid); }
    grid.sync();
    if (PH(5)) { PT p; TLW; phase_ssd_y(p, lds, tid, lane, wave); }
    grid.sync();
    if (PH(6)) {
        PT p; GRIDV; unsigned char* ws = p.ws;
        pg8::Gemm g{(const pg8::bf16_t*)(ws + WS_YCAT), (const pg8::bf16_t*)(ws + WS_W0OUT), M, 2048, 4096}; pg8::StaticOrder S; S.init(M, 2048, G, c);
        EpiRes E{p.in[0], (float*)(ws + WS_X1), (bf16*)(ws + WS_X1B), (float*)(ws + WS_ST1)};
        pg8::gemm_phase<EpiRes, pg8::StaticOrder, true, true>(lds, g, S, E);
    }
    grid.sync();
    if (PH(6)) {
        PT p; GRIDV; unsigned char* ws = p.ws; unsigned char* dob = (unsigned char*)p.out;
        pg8::Gemm g{(const pg8::bf16_t*)(ws + WS_X1B), (const pg8::bf16_t*)(ws + WS_W1IN), M, 8192, 2048}; pg8::StaticOrder S; S.init(M, 8192, G, c);
        EpiIn1 E{(bf16*)(ws + WS_Q), (bf16*)(ws + WS_K), (bf16*)(ws + WS_VV), (bf16*)(dob + DO_G), (const float*)(ws + WS_ST1)};
        pg8::gemm_phase<EpiIn1, pg8::StaticOrder, true, true>(lds, g, S, E);
    }
    grid.sync();
    if (PH(7)) { PT p; TLW; phase_attn(p, lds, tid, lane, wave); }
    grid.sync();
    if (PH(8)) {
        PT p; GRIDV; unsigned char* ws = p.ws;
        pg8::Gemm g{(const pg8::bf16_t*)(ws + WS_O), (const pg8::bf16_t*)(ws + WS_W1OUT), M, 2048, 2048}; pg8::StaticOrder S; S.init(M, 2048, G, c);
        EpiRes E{(const float*)(ws + WS_X1), p.out, nullptr, (float*)(ws + WS_ST2)};
        pg8::gemm_phase<EpiRes, pg8::StaticOrder, true, true>(lds, g, S, E);
    }
    grid.sync();
    if (PH(9)) { PT p; TLW; phase_final(p, lane, wave); }
}

extern "C" void kernel_launch(void* const* d_in, const int* in_sizes, int n_in, void* d_out, int out_size, void* d_ws, size_t ws_size, hipStream_t stream) {
    static int grid = 0;
    if (grid == 0) {
        if (n_in != 23 || out_size != M * DM || ws_size < WS_END) { fprintf(stderr, "kernel_launch: unexpected shapes (n_in %d out %d ws %zu)\n", n_in, out_size, ws_size); grid = -1; return; }
        int dev = 0, cus = 0, per_cu = 0;
        hipGetDevice(&dev); hipDeviceGetAttribute(&cus, hipDeviceAttributeMultiprocessorCount, dev);
        hipFuncSetAttribute((const void*)fwd_megakernel, hipFuncAttributeMaxDynamicSharedMemorySize, LDS_BYTES);
        hipOccupancyMaxActiveBlocksPerMultiprocessor(&per_cu, (const void*)fwd_megakernel, 512, LDS_BYTES);
        if (per_cu < 1) { fprintf(stderr, "kernel_launch: occupancy query says %d blocks per CU\n", per_cu); per_cu = 1; }
        (void)hipGetLastError();
        grid = cus;
    }
    if (grid < 0) return;
    Params p{};
    for (int i = 0; i < 23; ++i) p.in[i] = (const float*)d_in[i];
    p.out = (float*)d_out; p.ws = (unsigned char*)d_ws;
    void* args[] = {&p};
    hipError_t e = hipLaunchCooperativeKernel((const void*)fwd_megakernel, dim3(grid), dim3(512), args, LDS_BYTES, stream);
    if (e != hipSuccess) fprintf(stderr, "cooperative launch failed: %s (grid %d)\n", hipGetErrorString(e), grid);
}
```

```cpp
#include <hip/hip_runtime.h>
#include <hip/hip_cooperative_groups.h>
#include <cstdio>
#include <cstdint>
#include <cmath>
namespace cg = cooperative_groups;
namespace pg8 {
#define PG8_LAS __attribute__((address_space(3)))
typedef unsigned short bf16_t;
typedef short bf16x8 __attribute__((ext_vector_type(8)));
typedef float f32x4 __attribute__((ext_vector_type(4)));
typedef unsigned u32x4 __attribute__((ext_vector_type(4)));
constexpr int BM = 256, BK = 64, HALF = 128, HTB = HALF * BK * 2  , STAGE_BYTES = 8 * HTB, NXCD = 8, WGM = 8;

__host__ __device__ __forceinline__ int lds_byte(int r, int c) { const int st = (r >> 4) * 2 + (c >> 5), rr = r & 15, cc = c & 31, ob = rr * 64 + cc * 2; return st * 1024 + (ob ^ (((ob >> 9) & 1) << 5)); }
__host__ __device__ __forceinline__ void stage_rc(int b, int& R, int& C) { const int st = b / 1024, sb = b % 1024, swz = sb ^ (((sb >> 9) & 1) << 5); R = (st >> 1) * 16 + swz / 64; C = (st & 1) * 32 + (swz % 64) / 2; }
__host__ __device__ __forceinline__ int perm32(int rho) { const int n = rho >> 4, i = rho & 15; return 8 * (i >> 2) + 4 * n + (i & 3); }

struct Unit { int pm, pn; };
struct Gemm { const bf16_t* A; const bf16_t* Bt; int M, N, K; };

struct StaticOrder {
    int nM, nN, nwg, G, c;
    __host__ __device__ void init(int M, int N, int G_, int c_) { nM = M / BM; nN = N / BM; nwg = nM * nN; G = G_; c = c_; }
    __host__ __device__ bool next(int i, Unit& u) const {
        const long L = (long)i * G + c; if (L >= nwg) return false;
        int wgid = (int)L; { const int q = nwg / NXCD, r = nwg % NXCD, xcd = wgid % NXCD, off = wgid / NXCD; wgid = (xcd < r ? xcd * (q + 1) : r * (q + 1) + (xcd - r) * q) + off; }
        const int nig = WGM * nN, gid = wgid / nig, fm = gid * WGM, gsz = (nM - fm) < WGM ? (nM - fm) : WGM;
        u.pm = fm + ((wgid % nig) % gsz); u.pn = (wgid % nig) / gsz; return true;
    }
    __device__ __forceinline__ void a_ready(const Unit&) const {}
    __device__ __forceinline__ void done(const Unit&) const {}
};

template <class Epi, class Sched, bool ALIGN_EPI = false, bool SP2 = false>
__device__ __forceinline__ void gemm_phase(PG8_LAS unsigned char* lds, const Gemm g, const Sched& S, const Epi& E) {
    int tid_ = threadIdx.x; asm volatile("" : "+v"(tid_));
    const int tid = tid_, wid = __builtin_amdgcn_readfirstlane(tid >> 6), lane = tid & 63, wr = wid >> 2, wc = wid & 3, fr = lane & 15, fq = lane >> 4;
    const int K = g.K, nt = K / BK;
    unsigned voffA[2], voffB[2];
#pragma unroll
    for (int i = 0; i < 2; ++i) { int R, C; stage_rc(tid * 16 + i * 8192, R, C); const int Rb = Epi::PERM ? ((R & ~31) + perm32(R & 31)) : R;
        voffA[i] = (unsigned)(R * K + C) * 2u; voffB[i] = (unsigned)(Rb * K + C) * 2u; }
    const size_t kstep = (size_t)(BK * 2);
    const size_t hstep = (size_t)HALF * K * 2;
    const size_t tstep = 2 * hstep;
    const unsigned ldsw = (unsigned)wid * 1024u;
    const int aoff = lds_byte(wr * 64 + fr, fq * 8), boff = lds_byte(wc * 32 + fr, fq * 8);
#define PG8_SA(b, h) (((b) * 2 + (h)) * HTB)
#define PG8_SB(b, h) ((4 + (b) * 2 + (h)) * HTB)
#define PG8_STAGE(bufoff, gbase, voff) do { _Pragma("unroll") for (int _i = 0; _i < 2; ++_i) \
        __builtin_amdgcn_global_load_lds((const unsigned*)((const char*)(gbase) + (voff)[_i]), (PG8_LAS unsigned*)(lds + (bufoff) + ldsw + _i * 8192), 16, 0, 0); } while (0)
#define PG8_LDA(dst, b, h) do { _Pragma("unroll") for (int m = 0; m < 4; ++m) _Pragma("unroll") for (int k = 0; k < 2; ++k) dst[m][k] = *(const PG8_LAS bf16x8*)(lds + PG8_SA(b, h) + aoff + m * 2048 + k * 1024); } while (0)
#define PG8_LDB(dst, b, h) do { _Pragma("unroll") for (int n = 0; n < 2; ++n) _Pragma("unroll") for (int k = 0; k < 2; ++k) dst[n][k] = *(const PG8_LAS bf16x8*)(lds + PG8_SB(b, h) + boff + n * 2048 + k * 1024); } while (0)
#define PG8_MMA(ai, bj, At, Bt) do { __builtin_amdgcn_s_setprio(1); _Pragma("unroll") for (int m = 0; m < 4; ++m) _Pragma("unroll") for (int n = 0; n < 2; ++n) _Pragma("unroll") for (int k = 0; k < 2; ++k) \
        acc[ai][bj][m][n] = __builtin_amdgcn_mfma_f32_16x16x32_bf16(Bt[n][k], At[m][k], acc[ai][bj][m][n], 0, 0, 0); __builtin_amdgcn_s_setprio(0); } while (0)
#define PG8_WAIT_V(n) asm volatile("s_waitcnt vmcnt(" #n ")" ::: "memory")
#define PG8_WAIT_L(n) asm volatile("s_waitcnt lgkmcnt(" #n ")" ::: "memory")
#define PG8_BAR __builtin_amdgcn_s_barrier()
#define PG8_SCHED __builtin_amdgcn_sched_barrier(0)
    Unit cur, nxt; int ui = 0;
    if (!S.next(0, cur)) return;
    f32x4 acc[2][2][4][2];
#pragma unroll
    for (int a = 0; a < 2; ++a)
#pragma unroll
        for (int b = 0; b < 2; ++b)
#pragma unroll
            for (int m = 0; m < 4; ++m)
#pragma unroll
                for (int n = 0; n < 2; ++n) acc[a][b][m][n] = (f32x4){0.f, 0.f, 0.f, 0.f};
    bf16x8 At[4][2], B0[2][2], B1[2][2];
    const char* cA = (const char*)g.A + (size_t)cur.pm * tstep; const char* cB = (const char*)g.Bt + (size_t)cur.pn * tstep;
    S.a_ready(cur);
    if constexpr (SP2) {
        PG8_STAGE(PG8_SB(0, 0), cB, voffB); PG8_STAGE(PG8_SB(0, 1), cB + hstep, voffB); PG8_STAGE(PG8_SA(0, 0), cA, voffA); PG8_STAGE(PG8_SA(0, 1), cA + hstep, voffA);
        if (wr == 1) PG8_BAR;
        PG8_WAIT_V(2); PG8_BAR;
        PG8_STAGE(PG8_SB(1, 0), cB + kstep, voffB); PG8_STAGE(PG8_SA(1, 0), cA + kstep, voffA); PG8_STAGE(PG8_SB(1, 1), cB + hstep + kstep, voffB);
        PG8_WAIT_V(6); PG8_BAR;
    } else {
        PG8_STAGE(PG8_SB(0, 0), cB, voffB); PG8_STAGE(PG8_SA(0, 0), cA, voffA); PG8_STAGE(PG8_SB(0, 1), cB + hstep, voffB); PG8_STAGE(PG8_SA(0, 1), cA + hstep, voffA);
        if (wr == 1) PG8_BAR;
        PG8_WAIT_V(4); PG8_BAR;
        PG8_STAGE(PG8_SB(1, 0), cB + kstep, voffB); PG8_STAGE(PG8_SA(1, 0), cA + kstep, voffA); PG8_STAGE(PG8_SB(1, 1), cB + hstep + kstep, voffB);
        PG8_WAIT_V(6); PG8_BAR;
    }
    for (;;) {
        const bool has_next = S.next(ui + 1, nxt);
        const char* nA = has_next ? (const char*)g.A + (size_t)nxt.pm * tstep : cA; const char* nB = has_next ? (const char*)g.Bt + (size_t)nxt.pn * tstep : cB;
        for (int t = 0; t < nt; t += 2) {
            const bool last = (t == nt - 2);
            const char* a1 = cA + (size_t)(t + 1) * kstep;
            const char* a2 = last ? nA : cA + (size_t)(t + 2) * kstep; const char* b2 = last ? nB : cB + (size_t)(t + 2) * kstep;
            const char* a3 = a2 + kstep; const char* b3 = b2 + kstep;
            if (last && has_next) S.a_ready(nxt);
            if constexpr (SP2) {
            PG8_LDB(B0, 0, 0); PG8_LDB(B1, 0, 1); PG8_SCHED; PG8_LDA(At, 0, 0); PG8_STAGE(PG8_SA(1, 1), a1 + hstep, voffA);
            PG8_WAIT_V(8); PG8_WAIT_L(0); PG8_BAR; PG8_MMA(0, 0, At, B0); PG8_MMA(0, 1, At, B1); PG8_BAR; PG8_SCHED;
            PG8_LDA(At, 0, 1); PG8_STAGE(PG8_SB(0, 0), b2, voffB); PG8_STAGE(PG8_SB(0, 1), b2 + hstep, voffB); PG8_STAGE(PG8_SA(0, 0), a2, voffA);
            PG8_WAIT_V(8); PG8_WAIT_L(0); PG8_BAR; PG8_MMA(1, 0, At, B0); PG8_MMA(1, 1, At, B1); PG8_BAR; PG8_SCHED;
            PG8_LDB(B0, 1, 0); PG8_LDB(B1, 1, 1); PG8_SCHED; PG8_LDA(At, 1, 0); PG8_STAGE(PG8_SA(0, 1), a2 + hstep, voffA);
            PG8_WAIT_V(8); PG8_WAIT_L(0); PG8_BAR; PG8_MMA(0, 0, At, B0); PG8_MMA(0, 1, At, B1); PG8_BAR; PG8_SCHED;
            PG8_LDA(At, 1, 1); PG8_STAGE(PG8_SB(1, 0), b3, voffB); PG8_STAGE(PG8_SB(1, 1), b3 + hstep, voffB); PG8_STAGE(PG8_SA(1, 0), a3, voffA);
            PG8_WAIT_V(8); PG8_WAIT_L(0); PG8_BAR; PG8_MMA(1, 0, At, B0); PG8_MMA(1, 1, At, B1); PG8_BAR; PG8_SCHED;
            } else {
            PG8_LDB(B0, 0, 0); PG8_SCHED; PG8_LDA(At, 0, 0); PG8_STAGE(PG8_SA(1, 1), a1 + hstep, voffA);
            PG8_WAIT_L(8); PG8_BAR; PG8_WAIT_L(0); PG8_MMA(0, 0, At, B0); PG8_BAR; PG8_SCHED;
            PG8_LDB(B1, 0, 1); PG8_STAGE(PG8_SB(0, 0), b2, voffB);
            PG8_BAR; PG8_WAIT_L(0); PG8_MMA(0, 1, At, B1); PG8_BAR;
            PG8_LDA(At, 0, 1); PG8_STAGE(PG8_SA(0, 0), a2, voffA);
            PG8_BAR; PG8_WAIT_L(0); PG8_MMA(1, 0, At, B0); PG8_BAR; PG8_SCHED;
            PG8_STAGE(PG8_SB(0, 1), b2 + hstep, voffB);
            PG8_WAIT_V(6); PG8_BAR; PG8_MMA(1, 1, At, B1); PG8_BAR;
            PG8_LDB(B0, 1, 0); PG8_SCHED; PG8_LDA(At, 1, 0); PG8_STAGE(PG8_SA(0, 1), a2 + hstep, voffA);
            PG8_WAIT_L(8); PG8_BAR; PG8_WAIT_L(0); PG8_MMA(0, 0, At, B0); PG8_BAR; PG8_SCHED;
            PG8_LDB(B1, 1, 1); PG8_STAGE(PG8_SB(1, 0), b3, voffB);
            PG8_BAR; PG8_WAIT_L(0); PG8_MMA(0, 1, At, B1); PG8_BAR;
            PG8_LDA(At, 1, 1); PG8_STAGE(PG8_SA(1, 0), a3, voffA);
            PG8_BAR; PG8_WAIT_L(0); PG8_MMA(1, 0, At, B0); PG8_BAR; PG8_SCHED;
            PG8_STAGE(PG8_SB(1, 1), b3 + hstep, voffB);
            PG8_WAIT_V(6); PG8_BAR; PG8_MMA(1, 1, At, B1); PG8_BAR;
            }
        }
        if constexpr (ALIGN_EPI) { if (wr == 0) PG8_BAR; }
        if constexpr (!Epi::AFTER_DRAIN) { E(acc, cur, wr, wc, fr, fq); S.done(cur); }
        if (!has_next) break;
#pragma unroll
        for (int a = 0; a < 2; ++a)
#pragma unroll
            for (int b = 0; b < 2; ++b)
#pragma unroll
                for (int m = 0; m < 4; ++m)
#pragma unroll
                    for (int n = 0; n < 2; ++n) acc[a][b][m][n] = (f32x4){0.f, 0.f, 0.f, 0.f};
        cur = nxt; cA = nA; cB = nB; ++ui;
        if constexpr (ALIGN_EPI) { if (wr == 1) PG8_BAR; }
    }
    PG8_WAIT_V(0);
    if constexpr (!ALIGN_EPI) { if (wr == 0) PG8_BAR; }
    PG8_BAR;
    if constexpr (Epi::AFTER_DRAIN) { E.fused(acc, cur, wr, wc, fr, fq, lds, wid, lane); S.done(cur); }
#undef PG8_SA
#undef PG8_SB
#undef PG8_STAGE
#undef PG8_LDA
#undef PG8_LDB
#undef PG8_MMA
#undef PG8_WAIT_V
#undef PG8_WAIT_L
#undef PG8_BAR
#undef PG8_SCHED
}
}

#define LAS __attribute__((address_space(3)))
typedef unsigned short bf16;
typedef unsigned u32x4 __attribute__((ext_vector_type(4)));
typedef unsigned u32x2 __attribute__((ext_vector_type(2)));
typedef float f32x4 __attribute__((ext_vector_type(4)));
typedef float f32x16 __attribute__((ext_vector_type(16)));
typedef short bf16x8 __attribute__((ext_vector_type(8)));

constexpr int M = 16384, DM = 2048, SEQ = 2048, NBATCH = 8, NCH = 16;
constexpr int N0P = 11264, N0R = 11296;
constexpr float EPS = 1e-5f;
constexpr float LOG2E = 1.4426950408889634f;
constexpr float QSCALE = 0.125f * LOG2E;
constexpr float LAMBDA_INIT = 0.35550906f;
constexpr size_t MiB = 1u << 20;
constexpr size_t WS_ST0 = 0, WS_ST1 = 128 * 1024, WS_ST2 = 192 * 1024, WS_CD = 256 * 1024, WS_LAM = 300 * 1024;
constexpr size_t WS_DT = 1 * MiB, WS_WSP = 3 * MiB, WS_W0IN = 4 * MiB, WS_W0OUT = 49 * MiB, WS_W1IN = 65 * MiB, WS_W1OUT = 97 * MiB;
constexpr size_t WS_YCAT = 105 * MiB, WS_ZA = 233 * MiB, WS_V = 297 * MiB, WS_H0 = 361 * MiB, WS_XT = 425 * MiB, WS_CN = 489 * MiB, WS_END = 505 * MiB;
constexpr size_t WS_Q = WS_YCAT, WS_K = WS_YCAT + 64 * MiB, WS_X1 = WS_ZA, WS_STATES = WS_V, WS_VT = WS_H0, WS_X1B = WS_H0, WS_O = WS_H0, WS_VV = WS_XT;
constexpr size_t DO_XBC = 0, DO_BN = 96 * MiB, DO_BT = 112 * MiB, DO_PREV = 0, DO_G = 0;
constexpr int LDS_BYTES = 147456;

__device__ __forceinline__ unsigned pk2(float lo, float hi) {
    typedef float f2 __attribute__((ext_vector_type(2))); typedef __bf16 b2 __attribute__((ext_vector_type(2)));
    f2 v = {lo, hi}; b2 b = __builtin_convertvector(v, b2); return __builtin_bit_cast(unsigned, b);
}
__device__ __forceinline__ float bflo(unsigned u) { return __uint_as_float(u << 16); }
__device__ __forceinline__ float bfhi(unsigned u) { return __uint_as_float(u & 0xffff0000u); }
__device__ __forceinline__ void unpack8(u32x4 r, float* f) { f[0] = bflo(r.x); f[1] = bfhi(r.x); f[2] = bflo(r.y); f[3] = bfhi(r.y); f[4] = bflo(r.z); f[5] = bfhi(r.z); f[6] = bflo(r.w); f[7] = bfhi(r.w); }
__device__ __forceinline__ u32x4 pack8(const float* f) { u32x4 o; o.x = pk2(f[0], f[1]); o.y = pk2(f[2], f[3]); o.z = pk2(f[4], f[5]); o.w = pk2(f[6], f[7]); return o; }
__device__ __forceinline__ float fexp2(float x) { return __builtin_amdgcn_exp2f(x); }
__device__ __forceinline__ float gelu_f(float x) { const float z = 1.5957691216057308f * (x + 0.044715f * x * x * x); return x * __builtin_amdgcn_rcpf(1.0f + __expf(-z)); }
__device__ __forceinline__ float silu_f(float x) { return x * __builtin_amdgcn_rcpf(1.0f + __expf(-x)); }
__device__ __forceinline__ int crow(int r, int h) { return (r & 3) + 8 * (r >> 2) + 4 * h; }
__device__ __forceinline__ f32x16 mfma32(bf16x8 a, bf16x8 b, f32x16 c) { return __builtin_amdgcn_mfma_f32_32x32x16_bf16(a, b, c, 0, 0, 0); }
__device__ __forceinline__ bf16x8 ld_frag16(const bf16* p) { return __builtin_bit_cast(bf16x8, *(const u32x4*)p); }
__device__ __forceinline__ bf16x8 ld_frag8x2(const bf16* p) { const u32x2 lo = *(const u32x2*)p, hi = *(const u32x2*)(p + 8); u32x4 v; v.x = lo.x; v.y = lo.y; v.z = hi.x; v.w = hi.y; return __builtin_bit_cast(bf16x8, v); }
__device__ __forceinline__ bf16x8 pack_frag(const f32x16& x, int s) {
    u32x4 v; v.x = pk2(x[8 * s], x[8 * s + 1]); v.y = pk2(x[8 * s + 2], x[8 * s + 3]); v.z = pk2(x[8 * s + 4], x[8 * s + 5]); v.w = pk2(x[8 * s + 6], x[8 * s + 7]); return __builtin_bit_cast(bf16x8, v);
}
__device__ __forceinline__ float wave_sum(float v) {
#pragma unroll
    for (int o = 1; o < 64; o <<= 1) v += __shfl_xor(v, o);
    return v;
}
#define LDS_WAIT() asm volatile("s_waitcnt lgkmcnt(0)" ::: "memory")
__device__ __forceinline__ void atomic_addf(float* p, float v) { __hip_atomic_fetch_add(p, v, __ATOMIC_RELAXED, __HIP_MEMORY_SCOPE_AGENT); }

struct Params { const float* in[23]; float* out; unsigned char* ws; };
constexpr int PTAB_OFF = LDS_BYTES - 512;
__device__ __forceinline__ unsigned long long ptab_get(int i) {
    const unsigned long long v = ((const LAS unsigned long long*)(PTAB_OFF))[i];
    const unsigned lo = __builtin_amdgcn_readfirstlane((unsigned)v), hi = __builtin_amdgcn_readfirstlane((unsigned)(v >> 32));
    return ((unsigned long long)hi << 32) | lo;
}
struct PT {
    struct InTab { __device__ __forceinline__ const float* operator[](int i) const { return (const float*)(const __attribute__((address_space(1))) float*)ptab_get(i); } } in;
    float* out; unsigned char* ws;
    __device__ __forceinline__ PT() { out = (float*)(__attribute__((address_space(1))) float*)ptab_get(23); ws = (unsigned char*)(__attribute__((address_space(1))) unsigned char*)ptab_get(24); }
};

template <int ACT>
__device__ __forceinline__ void epi_tile_bf16(const f32x4 (&acc)[2][2][4][2], bf16* base, int pitch, int col0, int row0, float sc) {
#pragma unroll
    for (int ai = 0; ai < 2; ++ai)
#pragma unroll
        for (int m = 0; m < 4; ++m) {
            bf16* rowp = base + (size_t)(row0 + ai * 128 + m * 16) * pitch + col0;
#pragma unroll
            for (int bj = 0; bj < 2; ++bj) {
                float v[8];
#pragma unroll
                for (int j = 0; j < 4; ++j) { v[j] = acc[ai][bj][m][0][j]; v[4 + j] = acc[ai][bj][m][1][j]; }
#pragma unroll
                for (int j = 0; j < 8; ++j) { if (ACT == 1) v[j] = gelu_f(v[j]); else if (ACT == 2) v[j] = silu_f(v[j]); else if (ACT == 3) v[j] *= sc; }
                *(u32x4*)(rowp + bj * 128) = pack8(v);
            }
        }
}

struct EpiIn0 {
    static constexpr bool PERM = true, AFTER_DRAIN = false;
    bf16 *ycat, *vbuf, *za, *xbc; float* stats0;
    __device__ __forceinline__ void operator()(const f32x4 (&acc)[2][2][4][2], const pg8::Unit& u, int wr, int wc, int fr, int fq) const {
        const int pn = u.pn, row0 = u.pm * 256 + wr * 64 + fr, cl = wc * 32 + 8 * fq;
        if (pn < 8) { epi_tile_bf16<1>(acc, ycat, 4096, pn * 256 + cl, row0, 1.f); }
        else if (pn < 16) {
#pragma unroll
            for (int ai = 0; ai < 2; ++ai)
#pragma unroll
                for (int m = 0; m < 4; ++m) {
                    const int row = row0 + ai * 128 + m * 16;
                    bf16* rowp = vbuf + (size_t)row * 2048 + (pn - 8) * 256 + cl;
                    float s = 0.f, ss = 0.f;
#pragma unroll
                    for (int bj = 0; bj < 2; ++bj) {
                        float v[8];
#pragma unroll
                        for (int j = 0; j < 4; ++j) { v[j] = gelu_f(acc[ai][bj][m][0][j]); v[4 + j] = gelu_f(acc[ai][bj][m][1][j]); }
#pragma unroll
                        for (int j = 0; j < 8; ++j) { s += v[j]; ss += v[j] * v[j]; }
                        *(u32x4*)(rowp + bj * 128) = pack8(v);
                    }
                    s += __shfl_xor(s, 16); s += __shfl_xor(s, 32); ss += __shfl_xor(ss, 16); ss += __shfl_xor(ss, 32);
                    if (fq == 0) { atomic_addf(stats0 + 2 * row, s); atomic_addf(stats0 + 2 * row + 1, ss); }
                }
        }
        else if (pn < 24) { epi_tile_bf16<2>(acc, za, 2048, (pn - 16) * 256 + cl, row0, 1.f); }
        else if (pn < 32) { epi_tile_bf16<2>(acc, ycat, 4096, 2048 + (pn - 24) * 256 + cl, row0, 1.f); }
        else { epi_tile_bf16<0>(acc, xbc, 3072, (pn - 32) * 256 + cl, row0, 1.f); }
    }
};

__device__ __forceinline__ void dt_tasks(const PT& p, int lane, int wave) {
    if (wave >= 2) return;
    unsigned char* ws = p.ws; const bf16* H0 = (const bf16*)(ws + WS_H0); const bf16* Wdt = (const bf16*)(ws + WS_W0IN) + (size_t)11264 * 2048; float* DT = (float*)(ws + WS_DT);
    const int r32 = lane & 31, h = lane >> 5;
    for (int task = wave * gridDim.x + blockIdx.x; task < 512; task += 2 * gridDim.x) {
        const bf16* ap = Wdt + (size_t)r32 * 2048 + 8 * h; const bf16* bp = H0 + (size_t)(task * 32 + r32) * 2048 + 8 * h;
        f32x16 acc;
#pragma unroll
        for (int i = 0; i < 16; ++i) acc[i] = 0.f;
#pragma unroll 8
        for (int st = 0; st < 128; ++st) acc = mfma32(ld_frag16(ap + 16 * st), ld_frag16(bp + 16 * st), acc);
#pragma unroll
        for (int qd = 0; qd < 4; ++qd) {
            const int j0 = 8 * qd + 4 * h; const f32x4 bb = *(const f32x4*)(p.in[9] + j0); f32x4 v;
#pragma unroll
            for (int j = 0; j < 4; ++j) { const float x = acc[4 * qd + j] + bb[j]; v[j] = x > 20.f ? x : log1pf(__expf(x)); }
            *(f32x4*)(DT + (size_t)(task * 32 + r32) * 32 + j0) = v;
        }
    }
}

struct EpiRes {
    static constexpr bool PERM = true, AFTER_DRAIN = false;
    const float* resid; float* outf; bf16* outb; float* stats;
    __device__ __forceinline__ void operator()(const f32x4 (&acc)[2][2][4][2], const pg8::Unit& u, int wr, int wc, int fr, int fq) const {
        const int row0 = u.pm * 256 + wr * 64 + fr, col0 = u.pn * 256 + wc * 32 + 8 * fq;
#pragma unroll
        for (int ai = 0; ai < 2; ++ai)
#pragma unroll
            for (int m = 0; m < 4; ++m) {
                const int row = row0 + ai * 128 + m * 16; const size_t off = (size_t)row * 2048 + col0;
                float ss = 0.f;
#pragma unroll
                for (int bj = 0; bj < 2; ++bj) {
                    const f32x4 r0 = *(const f32x4*)(resid + off + bj * 128) + acc[ai][bj][m][0], r1 = *(const f32x4*)(resid + off + bj * 128 + 4) + acc[ai][bj][m][1];
                    *(f32x4*)(outf + off + bj * 128) = r0; *(f32x4*)(outf + off + bj * 128 + 4) = r1;
                    ss += (r0[0] * r0[0] + r0[1] * r0[1]) + (r0[2] * r0[2] + r0[3] * r0[3]) + (r1[0] * r1[0] + r1[1] * r1[1]) + (r1[2] * r1[2] + r1[3] * r1[3]);
                    if (outb) { u32x4 w; w.x = pk2(r0[0], r0[1]); w.y = pk2(r0[2], r0[3]); w.z = pk2(r1[0], r1[1]); w.w = pk2(r1[2], r1[3]); *(u32x4*)(outb + off + bj * 128) = w; }
                }
                ss += __shfl_xor(ss, 16); ss += __shfl_xor(ss, 32);
                if (fq == 0) atomic_addf(stats + row, ss);
            }
    }
};

struct EpiIn1 {
    static constexpr bool PERM = true, AFTER_DRAIN = false;
    bf16 *q, *k, *v, *g; const float* stats1;
    __device__ __forceinline__ void operator()(const f32x4 (&acc)[2][2][4][2], const pg8::Unit& u, int wr, int wc, int fr, int fq) const {
        const int seg = u.pn >> 3, row0 = u.pm * 256 + wr * 64 + fr, col0 = (u.pn & 7) * 256 + wc * 32 + 8 * fq;
        bf16* base = seg == 0 ? q : (seg == 1 ? k : (seg == 2 ? v : g));
        const float sc = seg == 0 ? QSCALE : 1.f;
#pragma unroll
        for (int ai = 0; ai < 2; ++ai)
#pragma unroll
            for (int m = 0; m < 4; ++m) {
                const int row = row0 + ai * 128 + m * 16;
                const float rs = rsqrtf(stats1[row] * (1.f / 2048.f) + EPS) * sc;
                bf16* rowp = base + (size_t)row * 2048 + col0;
#pragma unroll
                for (int bj = 0; bj < 2; ++bj) {
                    float v8[8];
#pragma unroll
                    for (int j = 0; j < 4; ++j) { v8[j] = acc[ai][bj][m][0][j] * rs; v8[4 + j] = acc[ai][bj][m][1][j] * rs; }
                    if (seg == 3) {
#pragma unroll
                        for (int j = 0; j < 8; ++j) v8[j] = silu_f(v8[j]);
                    }
                    *(u32x4*)(rowp + bj * 128) = pack8(v8);
                }
            }
    }
};

__device__ __forceinline__ void transpose_item(const float* W, int K, int N, bf16* WT, int item, int lane, const float* kscale) {
    const int nblk = N / 32, kb = item / nblk, nb = item % nblk, kq = lane & 7, c4 = lane >> 3;
    const int k0 = 64 * kb + 8 * kq, n0 = 32 * nb + 4 * c4;
    f32x4 v[8];
#pragma unroll
    for (int i = 0; i < 8; ++i) v[i] = *(const f32x4*)(W + (size_t)(k0 + i) * N + n0);
    if (kscale) {
        const f32x4 g0 = *(const f32x4*)(kscale + k0), g1 = *(const f32x4*)(kscale + k0 + 4);
#pragma unroll
        for (int i = 0; i < 4; ++i) { v[i] = v[i] * g0[i]; v[4 + i] = v[4 + i] * g1[i]; }
    }
#pragma unroll
    for (int j = 0; j < 4; ++j) {
        u32x4 o; o.x = pk2(v[0][j], v[1][j]); o.y = pk2(v[2][j], v[3][j]); o.z = pk2(v[4][j], v[5][j]); o.w = pk2(v[6][j], v[7][j]);
        *(u32x4*)(WT + (size_t)(n0 + j) * K + k0) = o;
    }
}

__device__ __forceinline__ void phase0(const PT& p, LAS unsigned char* lds, int tid, int lane, int wave) {
    unsigned char* ws = p.ws;
    const int gw = blockIdx.x * 8 + wave, NGW = gridDim.x * 8;
    const int gt = blockIdx.x * 512 + tid, NGT = gridDim.x * 512;
    for (int i = gt; i < 65536; i += NGT) ((float*)(ws + WS_ST0))[i] = 0.f;
    constexpr int I0 = 32 * (N0R / 32), I1 = 64 * 64, I2 = 32 * 256, I3 = 32 * 64;
    for (int it = gw; it < I0 + I1 + I2 + I3; it += NGW) {
        int r = it;
        if (r < I0) { transpose_item(p.in[2], 2048, N0R, (bf16*)(ws + WS_W0IN), r, lane, nullptr); continue; } r -= I0;
        if (r < I1) { transpose_item(p.in[13], 4096, 2048, (bf16*)(ws + WS_W0OUT), r, lane, nullptr); continue; } r -= I1;
        if (r < I2) { transpose_item(p.in[15], 2048, 8192, (bf16*)(ws + WS_W1IN), r, lane, p.in[14]); continue; } r -= I2;
        transpose_item(p.in[21], 2048, 2048, (bf16*)(ws + WS_W1OUT), r, lane, nullptr);
    }
    for (int i = gt; i < 16 * 128 * 128 / 8; i += NGT) {
        const int e = i * 8, t = (e >> 7) & 127, s0 = e & 127; const float* src = p.in[5] + e; float v[8];
#pragma unroll
        for (int j = 0; j < 8; ++j) v[j] = (s0 + j <= t) ? src[j] : 0.f;
        ((u32x4*)(ws + WS_WSP))[i] = pack8(v);
    }
    const float* g0 = p.in[1]; bf16* H0 = (bf16*)(ws + WS_H0);
    for (int m = gw; m < M; m += NGW) {
        const f32x4* xr = (const f32x4*)(p.in[0] + (size_t)m * 2048) + lane; f32x4 v[8]; float s = 0.f;
#pragma unroll
        for (int j = 0; j < 8; ++j) { v[j] = xr[64 * j]; s += (v[j].x * v[j].x + v[j].y * v[j].y) + (v[j].z * v[j].z + v[j].w * v[j].w); }
        const float rs = rsqrtf(wave_sum(s) * (1.f / 2048.f) + EPS);
        u32x2* o = (u32x2*)(H0 + (size_t)m * 2048) + lane;
#pragma unroll
        for (int j = 0; j < 8; ++j) { const f32x4 g = ((const f32x4*)g0)[lane + 64 * j]; u32x2 w; w.x = pk2(v[j].x * rs * g.x, v[j].y * rs * g.y); w.y = pk2(v[j].z * rs * g.z, v[j].w * rs * g.w); o[64 * j] = w; }
    }
}

__device__ __forceinline__ void phase_layout(const PT& p, int tid) {
    unsigned char* ws = p.ws; unsigned char* dob = (unsigned char*)p.out;
    const bf16* Vb = (const bf16*)(ws + WS_V); const float* st0 = (const float*)(ws + WS_ST0);
    const bf16* XBC = (const bf16*)(dob + DO_XBC);
    bf16 *vT = (bf16*)(ws + WS_VT), *xT = (bf16*)(ws + WS_XT), *Bn = (bf16*)(dob + DO_BN), *BT = (bf16*)(dob + DO_BT), *Cn = (bf16*)(ws + WS_CN);
    const int t = tid & 255, so = t >> 4, co = t & 15;
    for (int pi = blockIdx.x * 2 + (tid >> 8); pi < 128 * 40; pi += gridDim.x * 2) {
        const int bc = pi / 40, k = pi % 40; const int tok0 = bc * 128 + so * 8;
        float o[8][8];
        if (k < 16) {
            const int ch0 = k * 128 + co * 8;
            float g[8], bb[8];
#pragma unroll
            for (int j = 0; j < 8; ++j) { g[j] = p.in[3][ch0 + j]; bb[j] = p.in[4][ch0 + j]; }
#pragma unroll
            for (int i = 0; i < 8; ++i) {
                const int row = tok0 + i; float f[8]; unpack8(*(const u32x4*)(Vb + (size_t)row * 2048 + ch0), f);
                const float mu = st0[2 * row] * (1.f / 2048.f), var = st0[2 * row + 1] * (1.f / 2048.f) - mu * mu, rs = rsqrtf(fmaxf(var, 0.f) + EPS);
#pragma unroll
                for (int j = 0; j < 8; ++j) o[i][j] = (f[j] - mu) * rs * g[j] + bb[j];
            }
#pragma unroll
            for (int j = 0; j < 8; ++j) { float c8[8];
#pragma unroll
                for (int i = 0; i < 8; ++i) c8[i] = o[i][j];
                *(u32x4*)(vT + ((size_t)bc * 2048 + ch0 + j) * 128 + so * 8) = pack8(c8); }
        } else {
            const int sc0 = (k - 16) * 128 + co * 8;
            float cw[4][8], cb[8];
#pragma unroll
            for (int j = 0; j < 8; ++j) { cb[j] = p.in[8][sc0 + j];
#pragma unroll
                for (int kk = 0; kk < 4; ++kk) cw[kk][j] = p.in[7][kk * 3072 + sc0 + j]; }
            const int pos0 = (bc & 15) * 128 + so * 8;
            float xw[11][8];
#pragma unroll
            for (int ii = 0; ii < 11; ++ii) {
                if (pos0 - 3 + ii >= 0) unpack8(*(const u32x4*)(XBC + (size_t)(tok0 - 3 + ii) * 3072 + sc0), xw[ii]);
                else {
#pragma unroll
                    for (int j = 0; j < 8; ++j) xw[ii][j] = 0.f;
                }
            }
#pragma unroll
            for (int i = 0; i < 8; ++i)
#pragma unroll
                for (int j = 0; j < 8; ++j) { float a = cb[j];
#pragma unroll
                    for (int kk = 0; kk < 4; ++kk) a += cw[kk][j] * xw[i + kk][j];
                    o[i][j] = silu_f(a); }
            if (k < 32) {
#pragma unroll
                for (int j = 0; j < 8; ++j) { float c8[8];
#pragma unroll
                    for (int i = 0; i < 8; ++i) c8[i] = o[i][j];
                    *(u32x4*)(xT + ((size_t)bc * 2048 + sc0 + j) * 128 + so * 8) = pack8(c8); }
            } else if (k < 36) {
                const int n0 = sc0 - 2048;
#pragma unroll
                for (int i = 0; i < 8; ++i) *(u32x4*)(Bn + (size_t)(tok0 + i) * 512 + n0) = pack8(o[i]);
#pragma unroll
                for (int j = 0; j < 8; ++j) { float c8[8];
#pragma unroll
                    for (int i = 0; i < 8; ++i) c8[i] = o[i][j];
                    *(u32x4*)(BT + ((size_t)bc * 512 + n0 + j) * 128 + so * 8) = pack8(c8); }
            } else {
                const int n0 = sc0 - 2560;
#pragma unroll
                for (int i = 0; i < 8; ++i) *(u32x4*)(Cn + (size_t)(tok0 + i) * 512 + n0) = pack8(o[i]);
            }
        }
    }
}

__device__ __forceinline__ void chunk_cumsum(const float* DT, const float* a_log, int tok0, int hh, int lane, float& d0, float& d1, float& c0, float& c1, float& tot) {
    d0 = DT[(size_t)(tok0 + 2 * lane) * 32 + hh]; d1 = DT[(size_t)(tok0 + 2 * lane + 1) * 32 + hh];
    const float A = -__expf(a_log[hh]); const float x0 = d0 * A, x1 = d1 * A; float ps = x0 + x1;
#pragma unroll
    for (int o = 1; o < 64; o <<= 1) { const float t = __shfl_up(ps, o); if (lane >= o) ps += t; }
    c1 = ps; c0 = ps - x1; tot = __shfl(ps, 63);
}

__device__ __forceinline__ void phase_mix(const PT& p, LAS unsigned char* lds, int tid, int lane, int wave) {
    unsigned char* ws = p.ws; unsigned char* dob = (unsigned char*)p.out;
    const int r32 = lane & 31, h = lane >> 5;
    bf16* Ycat = (bf16*)(ws + WS_YCAT); const bf16* ZA = (const bf16*)(ws + WS_ZA); const bf16* vT = (const bf16*)(ws + WS_VT); const bf16* Wsp = (const bf16*)(ws + WS_WSP);
    const bf16* xT = (const bf16*)(ws + WS_XT); const bf16* BT = (const bf16*)(dob + DO_BT); const float* DT = (const float*)(ws + WS_DT);
    bf16* ST = (bf16*)(ws + WS_STATES); float* CD = (float*)(ws + WS_CD);
    LAS float* wtab = (LAS float*)lds;
    constexpr int NG = 128 * 16, NS = NBATCH * 15 * 4;
    for (int it = blockIdx.x; it < NG + NS; it += gridDim.x) {
        if (it < NG) {
            const int bc = it >> 4, g = it & 15, cb = wave & 3, th = wave >> 2;
            const int ch0 = g * 128 + cb * 32;
            const bf16* ap = vT + ((size_t)bc * 2048 + ch0 + r32) * 128 + 8 * h;
            f32x16 acc[2];
#pragma unroll
            for (int i = 0; i < 16; ++i) { acc[0][i] = 0.f; acc[1][i] = 0.f; }
#pragma unroll
            for (int st = 0; st < 8; ++st) {
                const bf16x8 a = ld_frag16(ap + 16 * st);
#pragma unroll
                for (int t2 = 0; t2 < 2; ++t2) { const int tb = 2 * th + t2;
                    if (st < 2 * (tb + 1)) { const bf16x8 b = ld_frag16(Wsp + ((size_t)g * 128 + tb * 32 + r32) * 128 + 16 * st + 8 * h); acc[t2] = mfma32(a, b, acc[t2]); } }
            }
#pragma unroll
            for (int t2 = 0; t2 < 2; ++t2) {
                const int t = (2 * th + t2) * 32 + r32; const size_t tok = (size_t)bc * 128 + t; const float sb = p.in[6][g * 128 + t];
#pragma unroll
                for (int qd = 0; qd < 4; ++qd) {
                    const int ch = ch0 + 8 * qd + 4 * h;
                    u32x2* up = (u32x2*)(Ycat + tok * 4096 + ch); const u32x2 uu = *up, zz = *(const u32x2*)(ZA + tok * 2048 + ch);
                    const float y0 = bflo(uu.x) * (acc[t2][4 * qd] + sb) * bflo(zz.x), y1 = bfhi(uu.x) * (acc[t2][4 * qd + 1] + sb) * bfhi(zz.x);
                    const float y2 = bflo(uu.y) * (acc[t2][4 * qd + 2] + sb) * bflo(zz.y), y3 = bfhi(uu.y) * (acc[t2][4 * qd + 3] + sb) * bfhi(zz.y);
                    u32x2 w; w.x = pk2(y0, y1); w.y = pk2(y2, y3); *up = w;
                }
            }
        } else {
            const int id = it - NG, b = id / 60, c = (id / 4) % 15, grp = id & 3; const int bc = b * 16 + c, tok0 = bc * 128;
            __syncthreads();
            { const int hh = grp * 8 + wave; float d0, d1, c0, c1, tot; chunk_cumsum(DT, p.in[10], tok0, hh, lane, d0, d1, c0, c1, tot);
              wtab[wave * 128 + 2 * lane] = d0 * __expf(tot - c0); wtab[wave * 128 + 2 * lane + 1] = d1 * __expf(tot - c1);
              if (lane == 0) CD[bc * 32 + hh] = __expf(tot); }
            __syncthreads();
#pragma unroll 1
            for (int tk = 0; tk < 2; ++tk) {
                const int r = (wave >> 1) + 4 * tk, pb = wave & 1, hh = grp * 8 + r;
                const bf16* ap = xT + ((size_t)bc * 2048 + hh * 64 + pb * 32 + r32) * 128 + 8 * h;
                const bf16* bp = BT + ((size_t)bc * 512 + grp * 128 + r32) * 128 + 8 * h;
                f32x16 acc[4];
#pragma unroll
                for (int nb = 0; nb < 4; ++nb)
#pragma unroll
                    for (int i = 0; i < 16; ++i) acc[nb][i] = 0.f;
#pragma unroll
                for (int st = 0; st < 8; ++st) {
                    float f[8]; unpack8(*(const u32x4*)(ap + 16 * st), f);
                    const f32x4 w0 = *(const LAS f32x4*)(wtab + r * 128 + 16 * st + 8 * h), w1 = *(const LAS f32x4*)(wtab + r * 128 + 16 * st + 8 * h + 4);
                    f[0] *= w0.x; f[1] *= w0.y; f[2] *= w0.z; f[3] *= w0.w; f[4] *= w1.x; f[5] *= w1.y; f[6] *= w1.z; f[7] *= w1.w;
                    const bf16x8 a = __builtin_bit_cast(bf16x8, pack8(f));
#pragma unroll
                    for (int nb = 0; nb < 4; ++nb) { const bf16x8 bfr = ld_frag16(bp + (size_t)nb * 32 * 128 + 16 * st); acc[nb] = mfma32(a, bfr, acc[nb]); }
                }
                bf16* sp = ST + ((size_t)(bc * 32 + hh) * 64 + pb * 32) * 128;
#pragma unroll
                for (int nb = 0; nb < 4; ++nb)
#pragma unroll
                    for (int i = 0; i < 16; ++i) sp[(size_t)crow(i, h) * 128 + nb * 32 + r32] = (bf16)(pk2(acc[nb][i], 0.f) & 0xffffu);
            }
        }
    }
}

__device__ __forceinline__ void phase_scan(const PT& p, int tid) {
    unsigned char* ws = p.ws; const bf16* ST = (const bf16*)(ws + WS_STATES); const float* CD = (const float*)(ws + WS_CD); bf16* PV = (bf16*)((unsigned char*)p.out + DO_PREV);
    for (int id = blockIdx.x * 512 + tid; id < NBATCH * 32 * 64 * 16; id += gridDim.x * 512) {
        const int b = id >> 15, rem = id & 32767, hh = rem >> 10;
        float run[8];
#pragma unroll
        for (int j = 0; j < 8; ++j) run[j] = 0.f;
#pragma unroll
        for (int c = 0; c < 16; ++c) {
            const size_t off = ((size_t)(b * 16 + c) * 32 * 64 * 16 + rem) * 8;
            *(u32x4*)(PV + off) = pack8(run);
            if (c < 15) { float s[8]; unpack8(*(const u32x4*)(ST + off), s); const float cd = CD[(b * 16 + c) * 32 + hh];
#pragma unroll
                for (int j = 0; j < 8; ++j) run[j] = run[j] * cd + s[j]; }
        }
    }
}

__device__ __forceinline__ void phase_ssd_y(const PT& p, LAS unsigned char* lds, int tid, int lane, int wave) {
    unsigned char* ws = p.ws; unsigned char* dob = (unsigned char*)p.out;
    const int r32 = lane & 31, h = lane >> 5;
    bf16* Ycat = (bf16*)(ws + WS_YCAT); const bf16* xT = (const bf16*)(ws + WS_XT); const bf16* Bn = (const bf16*)(dob + DO_BN); const bf16* Cn = (const bf16*)(ws + WS_CN);
    const bf16* PV = (const bf16*)(dob + DO_PREV); const float* DT = (const float*)(ws + WS_DT);
    LAS float* acum = (LAS float*)lds; LAS float* dtt = acum + 1024; LAS float* ssqp = dtt + 1024;
    for (int it = blockIdx.x; it < 128 * 4; it += gridDim.x) {
        const int bc = it >> 2, grp = it & 3, tok0 = bc * 128;
        __syncthreads();
        { const int hh = grp * 8 + wave; float d0, d1, c0, c1, tot; chunk_cumsum(DT, p.in[10], tok0, hh, lane, d0, d1, c0, c1, tot);
          acum[wave * 128 + 2 * lane] = c0; acum[wave * 128 + 2 * lane + 1] = c1; dtt[wave * 128 + 2 * lane] = d0; dtt[wave * 128 + 2 * lane + 1] = d1; }
        __syncthreads();
        const int pb = wave >> 2, lb = wave & 3, l = lb * 32 + r32; const size_t tok = (size_t)tok0 + l;
        bf16x8 cf[8];
#pragma unroll
        for (int st = 0; st < 8; ++st) cf[st] = ld_frag16(Cn + tok * 512 + grp * 128 + 16 * st + 8 * h);
        f32x16 X[4];
#pragma unroll
        for (int sb = 0; sb < 4; ++sb) {
#pragma unroll
            for (int i = 0; i < 16; ++i) X[sb][i] = 0.f;
            if (sb <= lb) {
#pragma unroll
                for (int st = 0; st < 8; ++st) X[sb] = mfma32(ld_frag16(Bn + ((size_t)tok0 + sb * 32 + r32) * 512 + grp * 128 + 16 * st + 8 * h), cf[st], X[sb]);
            }
        }
        float ssq = 0.f;
#pragma unroll 1
        for (int r = 0; r < 8; ++r) {
            const int hh = grp * 8 + r;
            f32x16 acc;
#pragma unroll
            for (int i = 0; i < 16; ++i) acc[i] = 0.f;
            const bf16* pp = PV + ((size_t)(bc * 32 + hh) * 64 + pb * 32 + r32) * 128 + 8 * h;
#pragma unroll
            for (int st = 0; st < 8; ++st) acc = mfma32(ld_frag16(pp + 16 * st), cf[st], acc);
            const float al = acum[r * 128 + l]; const float el = __expf(al);
#pragma unroll
            for (int i = 0; i < 16; ++i) acc[i] *= el;
            const bf16* xrow = xT + ((size_t)bc * 2048 + hh * 64 + pb * 32 + r32) * 128 + 4 * h;
#pragma unroll
            for (int sb = 0; sb < 4; ++sb) {
                if (sb <= lb) {
                    f32x16 mm;
#pragma unroll
                    for (int qd = 0; qd < 4; ++qd) {
                        const int s0 = sb * 32 + 8 * qd + 4 * h;
                        const f32x4 as = *(const LAS f32x4*)(acum + r * 128 + s0), ds = *(const LAS f32x4*)(dtt + r * 128 + s0);
#pragma unroll
                        for (int j = 0; j < 4; ++j) { const float v = X[sb][4 * qd + j] * __expf(al - as[j]) * ds[j]; mm[4 * qd + j] = (s0 + j <= l) ? v : 0.f; }
                    }
#pragma unroll
                    for (int s2 = 0; s2 < 2; ++s2) acc = mfma32(ld_frag8x2(xrow + sb * 32 + 16 * s2), pack_frag(mm, s2), acc);
                }
            }
            const float dsk = p.in[11][hh];
#pragma unroll
            for (int qd = 0; qd < 4; ++qd) {
                const int ch = hh * 64 + pb * 32 + 8 * qd + 4 * h;
                const bf16* xc = xT + ((size_t)bc * 2048 + ch) * 128 + l;
                u32x2* yp = (u32x2*)(Ycat + tok * 4096 + 2048 + ch); const u32x2 zz = *yp;
                const float y0 = (acc[4 * qd] + dsk * bflo((unsigned)xc[0])) * bflo(zz.x), y1 = (acc[4 * qd + 1] + dsk * bflo((unsigned)xc[128])) * bfhi(zz.x);
                const float y2 = (acc[4 * qd + 2] + dsk * bflo((unsigned)xc[256])) * bflo(zz.y), y3 = (acc[4 * qd + 3] + dsk * bflo((unsigned)xc[384])) * bfhi(zz.y);
                ssq += (y0 * y0 + y1 * y1) + (y2 * y2 + y3 * y3);
                u32x2 w; w.x = pk2(y0, y1); w.y = pk2(y2, y3); *yp = w;
            }
        }
        ssq += __shfl_xor(ssq, 32);
        if (h == 0) ssqp[pb * 128 + l] = ssq;
        __syncthreads();
        const float rs = rsqrtf((ssqp[l] + ssqp[128 + l]) * (1.f / 512.f) + EPS);
#pragma unroll 1
        for (int r = 0; r < 8; ++r) {
#pragma unroll
            for (int qd = 0; qd < 4; ++qd) {
                const int ch = (grp * 8 + r) * 64 + pb * 32 + 8 * qd + 4 * h;
                u32x2* yp = (u32x2*)(Ycat + tok * 4096 + 2048 + ch); const u32x2 yy = *yp; const f32x4 g = *(const f32x4*)(p.in[12] + ch);
                u32x2 w; w.x = pk2(bflo(yy.x) * rs * g.x, bfhi(yy.x) * rs * g.y); w.y = pk2(bflo(yy.y) * rs * g.z, bfhi(yy.y) * rs * g.w); *yp = w;
            }
        }
    }
}

constexpr int AK_PITCH = 272, AV_PITCH = 272, A_KOFF = 0, A_VOFF = 128 * AK_PITCH, A_STAGE = A_VOFF + 128 * AV_PITCH;
static_assert(2 * A_STAGE <= PTAB_OFF && 4 * 16384 <= A_STAGE, "attention LDS map");
typedef short v4i16_t __attribute__((ext_vector_type(4)));
__device__ __forceinline__ float max3f(float a, float b, float c) { return fmaxf(fmaxf(a, b), c); }
__device__ __forceinline__ void attn_unit(const PT& p, LAS unsigned char* lds, int tid, int lane, int wave, int b, int hd, int qb, float lam) {
    unsigned char* ws = p.ws;
    const bf16* Qb = (const bf16*)(ws + WS_Q); const bf16* Kb = (const bf16*)(ws + WS_K); const bf16* Vb = (const bf16*)(ws + WS_VV); const bf16* Gb = (const bf16*)((unsigned char*)p.out + DO_G);
    bf16* Ob = (bf16*)(ws + WS_O);
    const int r32 = lane & 31, h = lane >> 5, mp = wave >> 2, wq = wave & 3;
    const int qw0 = qb * 128 + 32 * wq, q = qw0 + r32; const unsigned tokq = (unsigned)(b * SEQ + q), tokb = (unsigned)(b * SEQ);
    const float slope2 = fexp2(-0.5f * (float)(hd + 1)) * LOG2E;
    bf16x8 qf[4];
#pragma unroll
    for (int ds = 0; ds < 4; ++ds) qf[ds] = ld_frag16(Qb + (tokq * 2048u + (unsigned)(hd * 128 + mp * 64 + 16 * ds + 8 * h)));
    float mrun = -INFINITY, lsum = 0.f;
    f32x16 oT[4];
#pragma unroll
    for (int db = 0; db < 4; ++db)
#pragma unroll
        for (int i = 0; i < 16; ++i) oT[db][i] = 0.f;
    const int ntiles = qb + 1;
    u32x4 preV[4], preK[4];
#define PREFETCH(t) do { \
        _Pragma("unroll") for (int i_ = 0; i_ < 4; ++i_) { const int pid_ = tid + 512 * i_, row_ = pid_ >> 4, c16_ = pid_ & 15; const unsigned go_ = (tokb + (unsigned)((t) * 128 + row_)) * 2048u + (unsigned)(hd * 128 + 8 * c16_); \
            preK[i_] = *(const u32x4*)(Kb + go_); preV[i_] = *(const u32x4*)(Vb + go_); } \
    } while (0)
    PREFETCH(0);
    const LAS unsigned char* kbase0 = lds + A_KOFF + r32 * AK_PITCH + (mp * 64 + 8 * h) * 2;
    const LAS unsigned char* vbase0 = lds + A_VOFF + (4 * h + ((lane & 15) >> 2)) * AV_PITCH + ((lane >> 4) & 1) * 32 + (lane & 3) * 8;
#define STAGE_WRITE(stg) do { \
        _Pragma("unroll") for (int i_ = 0; i_ < 4; ++i_) { const int pid_ = tid + 512 * i_, row_ = pid_ >> 4, c16_ = pid_ & 15; \
            *(LAS u32x4*)(lds + (stg) * A_STAGE + A_KOFF + row_ * AK_PITCH + 16 * c16_) = preK[i_]; *(LAS u32x4*)(lds + (stg) * A_STAGE + A_VOFF + row_ * AV_PITCH + 16 * c16_) = preV[i_]; } \
    } while (0)
    __syncthreads();
    STAGE_WRITE(0);
    asm volatile("" : "+v"(qf[0]), "+v"(qf[1]), "+v"(qf[2]), "+v"(qf[3]));
    __syncthreads();
#pragma unroll 1
    for (int t = 0; t < ntiles; ++t) {
        const int stg = t & 1;
        if (t + 1 < ntiles) PREFETCH(t + 1);
        const LAS unsigned char* kbase = kbase0 + stg * A_STAGE; const LAS unsigned char* vbase = vbase0 + stg * A_STAGE;
        const bool diag = (t == qb);
#pragma unroll 1
        for (int sub = 0; sub < 2; ++sub) {
            const int nact = diag ? min(2, max(0, wq + 1 - 2 * sub)) : 2;
            if (nact > 0) {
                const float bq = slope2 * (float)(t * 128 + sub * 64 + 4 * h - q);
                const LAS unsigned char* kb0 = kbase + sub * 64 * AK_PITCH; const LAS unsigned char* vb0 = vbase + sub * 64 * AV_PITCH;
                f32x16 s[2];
#pragma unroll
                for (int kb = 0; kb < 2; ++kb) {
                    if (kb < nact) {
                        const float bk = bq + slope2 * (float)(32 * kb);
#pragma unroll
                        for (int i = 0; i < 16; ++i) s[kb][i] = bk + slope2 * (float)((i & 3) + 8 * (i >> 2));
#pragma unroll
                        for (int ds = 0; ds < 4; ++ds) s[kb] = mfma32(__builtin_bit_cast(bf16x8, *(const LAS u32x4*)(kb0 + kb * 32 * AK_PITCH + ds * 32)), qf[ds], s[kb]);
                    } else {
#pragma unroll
                        for (int i = 0; i < 16; ++i) s[kb][i] = -INFINITY;
                    }
                }
                if (diag) {
#pragma unroll
                    for (int kb = 0; kb < 2; ++kb) if (2 * sub + kb == wq) {
#pragma unroll
                        for (int i = 0; i < 16; ++i) if (crow(i, h) > r32) s[kb][i] = -INFINITY; }
                }
                float mx = -INFINITY;
#pragma unroll
                for (int kb = 0; kb < 2; ++kb)
#pragma unroll
                    for (int i = 0; i < 16; i += 2) mx = max3f(mx, s[kb][i], s[kb][i + 1]);
                mx = fmaxf(mx, __shfl_xor(mx, 32));
                const float mnew = fmaxf(mrun, mx), alpha = fexp2(mrun - mnew); mrun = mnew;
                float rs = 0.f;
#pragma unroll
                for (int kb = 0; kb < 2; ++kb)
#pragma unroll
                    for (int i = 0; i < 16; ++i) { s[kb][i] = fexp2(s[kb][i] - mnew); rs += s[kb][i]; }
                lsum = lsum * alpha + rs;
                if (__builtin_amdgcn_ballot_w64(alpha != 1.0f) != 0ull) {
#pragma unroll
                    for (int db = 0; db < 4; ++db)
#pragma unroll
                        for (int i = 0; i < 16; ++i) oT[db][i] *= alpha;
                }
#pragma unroll
                for (int kb = 0; kb < 2; ++kb) if (kb < nact) {
#pragma unroll
                    for (int s2 = 0; s2 < 2; ++s2) {
                        const bf16x8 pf = pack_frag(s[kb], s2);
#pragma unroll
                        for (int db = 0; db < 4; ++db) {
                            const LAS unsigned char* vp = vb0 + (kb * 32 + 16 * s2) * AV_PITCH + db * 64;
                            const v4i16_t lo = __builtin_amdgcn_ds_read_tr16_b64_v4i16((LAS v4i16_t*)vp), hi = __builtin_amdgcn_ds_read_tr16_b64_v4i16((LAS v4i16_t*)(vp + 8 * AV_PITCH));
                            const bf16x8 vf = {lo[0], lo[1], lo[2], lo[3], hi[0], hi[1], hi[2], hi[3]};
                            oT[db] = mfma32(vf, pf, oT[db]);
                        }
                    }
                }
            }
        }
        if (t + 1 < ntiles) STAGE_WRITE(stg ^ 1);
        __syncthreads();
    }
#undef PREFETCH
#undef STAGE_WRITE
    const float lt = lsum + __shfl_xor(lsum, 32);
    LAS float* xch = (LAS float*)(lds + (ntiles & 1) * A_STAGE + wq * 16384);
    if (mp == 1) { const float sc = lam / lt;
#pragma unroll
        for (int db = 0; db < 4; ++db)
#pragma unroll
            for (int i = 0; i < 16; ++i) xch[(db * 16 + i) * 64 + lane] = oT[db][i] * sc; }
    __syncthreads();
    if (mp == 0) {
        const float i1 = 1.f / lt; float ss = 0.f;
#pragma unroll
        for (int db = 0; db < 4; ++db)
#pragma unroll
            for (int i = 0; i < 16; ++i) { const float o = oT[db][i] * i1 - xch[(db * 16 + i) * 64 + lane]; oT[db][i] = o; ss += o * o; }
        ss += __shfl_xor(ss, 32);
        const float rn = rsqrtf(ss * (1.f / 128.f) + EPS) * (1.f - LAMBDA_INIT);
#pragma unroll
        for (int db = 0; db < 4; ++db)
#pragma unroll
            for (int qd = 0; qd < 4; ++qd) {
                const int d = db * 32 + 8 * qd + 4 * h; const unsigned off = tokq * 2048u + (unsigned)(hd * 128 + d);
                const u32x2 gg = *(const u32x2*)(Gb + off); const f32x4 sg = *(const f32x4*)(p.in[20] + d);
                u32x2 w; w.x = pk2(oT[db][4 * qd] * rn * sg.x * bflo(gg.x), oT[db][4 * qd + 1] * rn * sg.y * bfhi(gg.x));
                w.y = pk2(oT[db][4 * qd + 2] * rn * sg.z * bflo(gg.y), oT[db][4 * qd + 3] * rn * sg.w * bfhi(gg.y));
                *(u32x2*)(Ob + off) = w;
            }
    }
}

__device__ __forceinline__ void phase_attn(const PT& p, LAS unsigned char* lds, int tid, int lane, int wave) {
    const float s1 = wave_sum(p.in[16][lane] * p.in[17][lane]), s2 = wave_sum(p.in[18][lane] * p.in[19][lane]);
    const float lam = __expf(s1) - __expf(s2) + LAMBDA_INIT;
#pragma unroll 1
    for (int u = blockIdx.x; u < NBATCH * 16 * 8; u += gridDim.x) {
        const int j = u & 7, hd = (u >> 3) & 15, b = u >> 7;
#pragma unroll 1
        for (int k = 0; k < 2; ++k) attn_unit(p, lds, tid, lane, wave, b, hd, k == 0 ? 15 - j : j, lam);
    }
}

__device__ __forceinline__ void phase_final(const PT& p, int lane, int wave) {
    const float* st2 = (const float*)(p.ws + WS_ST2); const float* g = p.in[22];
    for (int m = blockIdx.x * 8 + wave; m < M; m += gridDim.x * 8) {
        const float rs = rsqrtf(st2[m] * (1.f / 2048.f) + EPS);
        f32x4* xr = (f32x4*)(p.out + (size_t)m * 2048) + lane;
#pragma unroll
        for (int j = 0; j < 8; ++j) { const f32x4 gg = ((const f32x4*)g)[lane + 64 * j]; f32x4 v = xr[64 * j]; v.x *= rs * gg.x; v.y *= rs * gg.y; v.z *= rs * gg.z; v.w *= rs * gg.w; xr[64 * j] = v; }
    }
}

__global__ void __launch_bounds__(512) fwd_megakernel(Params pa) {
    extern __shared__ __attribute__((aligned(16))) unsigned char lds_raw[];
    cg::grid_group grid = cg::this_grid();
    LAS unsigned char* lds = (LAS unsigned char*)lds_raw;
    if (threadIdx.x < 25) {
        unsigned long long v = 0;
#pragma unroll
        for (int i = 0; i < 23; ++i) if ((int)threadIdx.x == i) v = (unsigned long long)pa.in[i];
        if (threadIdx.x == 23) v = (unsigned long long)pa.out;
        if (threadIdx.x == 24) v = (unsigned long long)pa.ws;
        ((LAS unsigned long long*)(lds + PTAB_OFF))[threadIdx.x] = v;
    }
    __syncthreads();
#ifndef PHMASK
#define PHMASK 0x3ff
#endif
#define PH(n) (((PHMASK) >> (n)) & 1)
#define TLW int tid_ = threadIdx.x; asm volatile("" : "+v"(tid_)); const int tid = tid_, lane = tid & 63, wave = __builtin_amdgcn_readfirstlane(tid >> 6); (void)tid; (void)lane; (void)wave
#define GRIDV const int G = gridDim.x, c = blockIdx.x
    if (PH(0)) { PT p; TLW; phase0(p, lds, tid, lane, wave); }
    grid.sync();
    if (PH(1)) {
        PT p; GRIDV; unsigned char* ws = p.ws; unsigned char* dob = (unsigned char*)p.out;
        pg8::Gemm g{(const pg8::bf16_t*)(ws + WS_H0), (const pg8::bf16_t*)(ws + WS_W0IN), M, N0P, 2048}; pg8::StaticOrder S; S.init(M, N0P, G, c);
        EpiIn0 E{(bf16*)(ws + WS_YCAT), (bf16*)(ws + WS_V), (bf16*)(ws + WS_ZA), (bf16*)(dob + DO_XBC), (float*)(ws + WS_ST0)};
        pg8::gemm_phase<EpiIn0, pg8::StaticOrder, true, true>(lds, g, S, E);
        { TLW; dt_tasks(p, lane, wave); }
    }
    grid.sync();
    if (PH(2)) { PT p; TLW; phase_layout(p, tid); }
    grid.sync();
    if (PH(3)) { PT p; TLW; phase_mix(p, lds, tid, lane, wave); }
    grid.sync();
    if (PH(4)) { PT p; TLW; phase_scan(p, tid); }
    grid.sync();
    if (PH(5)) { PT p; TLW; phase_ssd_y(p, lds, tid, lane, wave); }
    grid.sync();
    if (PH(6)) {
        PT p; GRIDV; unsigned char* ws = p.ws;
        pg8::Gemm g{(const pg8::bf16_t*)(ws + WS_YCAT), (const pg8::bf16_t*)(ws + WS_W0OUT), M, 2048, 4096}; pg8::StaticOrder S; S.init(M, 2048, G, c);
        EpiRes E{p.in[0], (float*)(ws + WS_X1), (bf16*)(ws + WS_X1B), (float*)(ws + WS_ST1)};
        pg8::gemm_phase<EpiRes, pg8::StaticOrder, true, true>(lds, g, S, E);
    }
    grid.sync();
    if (PH(6)) {
        PT p; GRIDV; unsigned char* ws = p.ws; unsigned char* dob = (unsigned char*)p.out;
        pg8::Gemm g{(const pg8::bf16_t*)(ws + WS_X1B), (const pg8::bf16_t*)(ws + WS_W1IN), M, 8192, 2048}; pg8::StaticOrder S; S.init(M, 8192, G, c);
        EpiIn1 E{(bf16*)(ws + WS_Q), (bf16*)(ws + WS_K), (bf16*)(ws + WS_VV), (bf16*)(dob + DO_G), (const float*)(ws + WS_ST1)};
        pg8::gemm_phase<EpiIn1, pg8::StaticOrder, true, true>(lds, g, S, E);
    }
    grid.sync();
    if (PH(7)) { PT p; TLW; phase_attn(p, lds, tid, lane, wave); }
    grid.sync();
    if (PH(8)) {
        PT p; GRIDV; unsigned char* ws = p.ws;
        pg8::Gemm g{(const pg8::bf16_t*)(ws + WS_O), (const pg8::bf16_t*)(ws + WS_W1OUT), M, 2048, 2048}; pg8::StaticOrder S; S.init(M, 2048, G, c);
        EpiRes E{(const float*)(ws + WS_X1), p.out, nullptr, (float*)(ws + WS_ST2)};
        pg8::gemm_phase<EpiRes, pg8::StaticOrder, true, true>(lds, g, S, E);
    }
    grid.sync();
    if (PH(9)) { PT p; TLW; phase_final(p, lane, wave); }
}

extern "C" void kernel_launch(void* const* d_in, const int* in_sizes, int n_in, void* d_out, int out_size, void* d_ws, size_t ws_size, hipStream_t stream) {
    static int grid = 0;
    if (grid == 0) {
        if (n_in != 23 || out_size != M * DM || ws_size < WS_END) { fprintf(stderr, "kernel_launch: unexpected shapes (n_in %d out %d ws %zu)\n", n_in, out_size, ws_size); grid = -1; return; }
        int dev = 0, cus = 0, per_cu = 0;
        hipGetDevice(&dev); hipDeviceGetAttribute(&cus, hipDeviceAttributeMultiprocessorCount, dev);
        hipFuncSetAttribute((const void*)fwd_megakernel, hipFuncAttributeMaxDynamicSharedMemorySize, LDS_BYTES);
        hipOccupancyMaxActiveBlocksPerMultiprocessor(&per_cu, (const void*)fwd_megakernel, 512, LDS_BYTES);
        if (per_cu < 1) { fprintf(stderr, "kernel_launch: occupancy query says %d blocks per CU\n", per_cu); per_cu = 1; }
        (void)hipGetLastError();
        grid = cus;
    }
    if (grid < 0) return;
    Params p{};
    for (int i = 0; i < 23; ++i) p.in[i] = (const float*)d_in[i];
    p.out = (float*)d_out; p.ws = (unsigned char*)d_ws;
    void* args[] = {&p};
    hipError_t e = hipLaunchCooperativeKernel((const void*)fwd_megakernel, dim3(grid), dim3(512), args, LDS_BYTES, stream);
    if (e != hipSuccess) fprintf(stderr, "cooperative launch failed: %s (grid %d)\n", hipGetErrorString(e), grid);
}
```

```cpp
#include <hip/hip_runtime.h>
#include <hip/hip_cooperative_groups.h>
#include <cstdio>
#include <cstdint>
#include <cmath>
namespace cg = cooperative_groups;
namespace pg8 {
#define PG8_LAS __attribute__((address_space(3)))
typedef unsigned short bf16_t;
typedef short bf16x8 __attribute__((ext_vector_type(8)));
typedef float f32x4 __attribute__((ext_vector_type(4)));
typedef unsigned u32x4 __attribute__((ext_vector_type(4)));
constexpr int BM = 256, BK = 64, HALF = 128, HTB = HALF * BK * 2  , STAGE_BYTES = 8 * HTB, NXCD = 8, WGM = 8;

__host__ __device__ __forceinline__ int lds_byte(int r, int c) { const int st = (r >> 4) * 2 + (c >> 5), rr = r & 15, cc = c & 31, ob = rr * 64 + cc * 2; return st * 1024 + (ob ^ (((ob >> 9) & 1) << 5)); }
__host__ __device__ __forceinline__ void stage_rc(int b, int& R, int& C) { const int st = b / 1024, sb = b % 1024, swz = sb ^ (((sb >> 9) & 1) << 5); R = (st >> 1) * 16 + swz / 64; C = (st & 1) * 32 + (swz % 64) / 2; }
__host__ __device__ __forceinline__ int perm32(int rho) { const int n = rho >> 4, i = rho & 15; return 8 * (i >> 2) + 4 * n + (i & 3); }

struct Unit { int pm, pn; };
struct Gemm { const bf16_t* A; const bf16_t* Bt; int M, N, K; };

struct StaticOrder {
    int nM, nN, nwg, G, c;
    __host__ __device__ void init(int M, int N, int G_, int c_) { nM = M / BM; nN = N / BM; nwg = nM * nN; G = G_; c = c_; }
    __host__ __device__ bool next(int i, Unit& u) const {
        const long L = (long)i * G + c; if (L >= nwg) return false;
        int wgid = (int)L; { const int q = nwg / NXCD, r = nwg % NXCD, xcd = wgid % NXCD, off = wgid / NXCD; wgid = (xcd < r ? xcd * (q + 1) : r * (q + 1) + (xcd - r) * q) + off; }
        const int nig = WGM * nN, gid = wgid / nig, fm = gid * WGM, gsz = (nM - fm) < WGM ? (nM - fm) : WGM;
        u.pm = fm + ((wgid % nig) % gsz); u.pn = (wgid % nig) / gsz; return true;
    }
    __device__ __forceinline__ void a_ready(const Unit&) const {}
    __device__ __forceinline__ void done(const Unit&) const {}
};

template <class Epi, class Sched, bool ALIGN_EPI = false, bool SP2 = false>
__device__ __forceinline__ void gemm_phase(PG8_LAS unsigned char* lds, const Gemm g, const Sched& S, const Epi& E) {
    int tid_ = threadIdx.x; asm volatile("" : "+v"(tid_));
    const int tid = tid_, wid = __builtin_amdgcn_readfirstlane(tid >> 6), lane = tid & 63, wr = wid >> 2, wc = wid & 3, fr = lane & 15, fq = lane >> 4;
    const int K = g.K, nt = K / BK;
    unsigned voffA[2], voffB[2];
#pragma unroll
    for (int i = 0; i < 2; ++i) { int R, C; stage_rc(tid * 16 + i * 8192, R, C); const int Rb = Epi::PERM ? ((R & ~31) + perm32(R & 31)) : R;
        voffA[i] = (unsigned)(R * K + C) * 2u; voffB[i] = (unsigned)(Rb * K + C) * 2u; }
    const size_t kstep = (size_t)(BK * 2);
    const size_t hstep = (size_t)HALF * K * 2;
    const size_t tstep = 2 * hstep;
    const unsigned ldsw = (unsigned)wid * 1024u;
    const int aoff = lds_byte(wr * 64 + fr, fq * 8), boff = lds_byte(wc * 32 + fr, fq * 8);
#define PG8_SA(b, h) (((b) * 2 + (h)) * HTB)
#define PG8_SB(b, h) ((4 + (b) * 2 + (h)) * HTB)
#define PG8_STAGE(bufoff, gbase, voff) do { _Pragma("unroll") for (int _i = 0; _i < 2; ++_i) \
        __builtin_amdgcn_global_load_lds((const unsigned*)((const char*)(gbase) + (voff)[_i]), (PG8_LAS unsigned*)(lds + (bufoff) + ldsw + _i * 8192), 16, 0, 0); } while (0)
#define PG8_LDA(dst, b, h) do { _Pragma("unroll") for (int m = 0; m < 4; ++m) _Pragma("unroll") for (int k = 0; k < 2; ++k) dst[m][k] = *(const PG8_LAS bf16x8*)(lds + PG8_SA(b, h) + aoff + m * 2048 + k * 1024); } while (0)
#define PG8_LDB(dst, b, h) do { _Pragma("unroll") for (int n = 0; n < 2; ++n) _Pragma("unroll") for (int k = 0; k < 2; ++k) dst[n][k] = *(const PG8_LAS bf16x8*)(lds + PG8_SB(b, h) + boff + n * 2048 + k * 1024); } while (0)
#define PG8_MMA(ai, bj, At, Bt) do { __builtin_amdgcn_s_setprio(1); _Pragma("unroll") for (int m = 0; m < 4; ++m) _Pragma("unroll") for (int n = 0; n < 2; ++n) _Pragma("unroll") for (int k = 0; k < 2; ++k) \
        acc[ai][bj][m][n] = __builtin_amdgcn_mfma_f32_16x16x32_bf16(Bt[n][k], At[m][k], acc[ai][bj][m][n], 0, 0, 0); __builtin_amdgcn_s_setprio(0); } while (0)
#define PG8_WAIT_V(n) asm volatile("s_waitcnt vmcnt(" #n ")" ::: "memory")
#define PG8_WAIT_L(n) asm volatile("s_waitcnt lgkmcnt(" #n ")" ::: "memory")
#define PG8_BAR __builtin_amdgcn_s_barrier()
#define PG8_SCHED __builtin_amdgcn_sched_barrier(0)
    Unit cur, nxt; int ui = 0;
    if (!S.next(0, cur)) return;
    f32x4 acc[2][2][4][2];
#pragma unroll
    for (int a = 0; a < 2; ++a)
#pragma unroll
        for (int b = 0; b < 2; ++b)
#pragma unroll
            for (int m = 0; m < 4; ++m)
#pragma unroll
                for (int n = 0; n < 2; ++n) acc[a][b][m][n] = (f32x4){0.f, 0.f, 0.f, 0.f};
    bf16x8 At[4][2], B0[2][2], B1[2][2];
    const char* cA = (const char*)g.A + (size_t)cur.pm * tstep; const char* cB = (const char*)g.Bt + (size_t)cur.pn * tstep;
    S.a_ready(cur);
    if constexpr (SP2) {
        PG8_STAGE(PG8_SB(0, 0), cB, voffB); PG8_STAGE(PG8_SB(0, 1), cB + hstep, voffB); PG8_STAGE(PG8_SA(0, 0), cA, voffA); PG8_STAGE(PG8_SA(0, 1), cA + hstep, voffA);
        if (wr == 1) PG8_BAR;
        PG8_WAIT_V(2); PG8_BAR;
        PG8_STAGE(PG8_SB(1, 0), cB + kstep, voffB); PG8_STAGE(PG8_SA(1, 0), cA + kstep, voffA); PG8_STAGE(PG8_SB(1, 1), cB + hstep + kstep, voffB);
        PG8_WAIT_V(6); PG8_BAR;
    } else {
        PG8_STAGE(PG8_SB(0, 0), cB, voffB); PG8_STAGE(PG8_SA(0, 0), cA, voffA); PG8_STAGE(PG8_SB(0, 1), cB + hstep, voffB); PG8_STAGE(PG8_SA(0, 1), cA + hstep, voffA);
        if (wr == 1) PG8_BAR;
        PG8_WAIT_V(4); PG8_BAR;
        PG8_STAGE(PG8_SB(1, 0), cB + kstep, voffB); PG8_STAGE(PG8_SA(1, 0), cA + kstep, voffA); PG8_STAGE(PG8_SB(1, 1), cB + hstep + kstep, voffB);
        PG8_WAIT_V(6); PG8_BAR;
    }
    for (;;) {
        const bool has_next = S.next(ui + 1, nxt);
        const char* nA = has_next ? (const char*)g.A + (size_t)nxt.pm * tstep : cA; const char* nB = has_next ? (const char*)g.Bt + (size_t)nxt.pn * tstep : cB;
        for (int t = 0; t < nt; t += 2) {
            const bool last = (t == nt - 2);
            const char* a1 = cA + (size_t)(t + 1) * kstep;
            const char* a2 = last ? nA : cA + (size_t)(t + 2) * kstep; const char* b2 = last ? nB : cB + (size_t)(t + 2) * kstep;
            const char* a3 = a2 + kstep; const char* b3 = b2 + kstep;
            if (last && has_next) S.a_ready(nxt);
            if constexpr (SP2) {
            PG8_LDB(B0, 0, 0); PG8_LDB(B1, 0, 1); PG8_SCHED; PG8_LDA(At, 0, 0); PG8_STAGE(PG8_SA(1, 1), a1 + hstep, voffA);
            PG8_WAIT_V(8); PG8_WAIT_L(0); PG8_BAR; PG8_MMA(0, 0, At, B0); PG8_MMA(0, 1, At, B1); PG8_BAR; PG8_SCHED;
            PG8_LDA(At, 0, 1); PG8_STAGE(PG8_SB(0, 0), b2, voffB); PG8_STAGE(PG8_SB(0, 1), b2 + hstep, voffB); PG8_STAGE(PG8_SA(0, 0), a2, voffA);
            PG8_WAIT_V(8); PG8_WAIT_L(0); PG8_BAR; PG8_MMA(1, 0, At, B0); PG8_MMA(1, 1, At, B1); PG8_BAR; PG8_SCHED;
            PG8_LDB(B0, 1, 0); PG8_LDB(B1, 1, 1); PG8_SCHED; PG8_LDA(At, 1, 0); PG8_STAGE(PG8_SA(0, 1), a2 + hstep, voffA);
            PG8_WAIT_V(8); PG8_WAIT_L(0); PG8_BAR; PG8_MMA(0, 0, At, B0); PG8_MMA(0, 1, At, B1); PG8_BAR; PG8_SCHED;
            PG8_LDA(At, 1, 1); PG8_STAGE(PG8_SB(1, 0), b3, voffB); PG8_STAGE(PG8_SB(1, 1), b3 + hstep, voffB); PG8_STAGE(PG8_SA(1, 0), a3, voffA);
            PG8_WAIT_V(8); PG8_WAIT_L(0); PG8_BAR; PG8_MMA(1, 0, At, B0); PG8_MMA(1, 1, At, B1); PG8_BAR; PG8_SCHED;
            } else {
            PG8_LDB(B0, 0, 0); PG8_SCHED; PG8_LDA(At, 0, 0); PG8_STAGE(PG8_SA(1, 1), a1 + hstep, voffA);
            PG8_WAIT_L(8); PG8_BAR; PG8_WAIT_L(0); PG8_MMA(0, 0, At, B0); PG8_BAR; PG8_SCHED;
            PG8_LDB(B1, 0, 1); PG8_STAGE(PG8_SB(0, 0), b2, voffB);
            PG8_BAR; PG8_WAIT_L(0); PG8_MMA(0, 1, At, B1); PG8_BAR;
            PG8_LDA(At, 0, 1); PG8_STAGE(PG8_SA(0, 0), a2, voffA);
            PG8_BAR; PG8_WAIT_L(0); PG8_MMA(1, 0, At, B0); PG8_BAR; PG8_SCHED;
            PG8_STAGE(PG8_SB(0, 1), b2 + hstep, voffB);
            PG8_WAIT_V(6); PG8_BAR; PG8_MMA(1, 1, At, B1); PG8_BAR;
            PG8_LDB(B0, 1, 0); PG8_SCHED; PG8_LDA(At, 1, 0); PG8_STAGE(PG8_SA(0, 1), a2 + hstep, voffA);
            PG8_WAIT_L(8); PG8_BAR; PG8_WAIT_L(0); PG8_MMA(0, 0, At, B0); PG8_BAR; PG8_SCHED;
            PG8_LDB(B1, 1, 1); PG8_STAGE(PG8_SB(1, 0), b3, voffB);
            PG8_BAR; PG8_WAIT_L(0); PG8_MMA(0, 1, At, B1); PG8_BAR;
            PG8_LDA(At, 1, 1); PG8_STAGE(PG8_SA(1, 0), a3, voffA);
            PG8_BAR; PG8_WAIT_L(0); PG8_MMA(1, 0, At, B0); PG8_BAR; PG8_SCHED;
            PG8_STAGE(PG8_SB(1, 1), b3 + hstep, voffB);
            PG8_WAIT_V(6); PG8_BAR; PG8_MMA(1, 1, At, B1); PG8_BAR;
            }
        }
        if constexpr (ALIGN_EPI) { if (wr == 0) PG8_BAR; }
        if constexpr (!Epi::AFTER_DRAIN) { E(acc, cur, wr, wc, fr, fq); S.done(cur); }
        if (!has_next) break;
#pragma unroll
        for (int a = 0; a < 2; ++a)
#pragma unroll
            for (int b = 0; b < 2; ++b)
#pragma unroll
                for (int m = 0; m < 4; ++m)
#pragma unroll
                    for (int n = 0; n < 2; ++n) acc[a][b][m][n] = (f32x4){0.f, 0.f, 0.f, 0.f};
        cur = nxt; cA = nA; cB = nB; ++ui;
        if constexpr (ALIGN_EPI) { if (wr == 1) PG8_BAR; }
    }
    PG8_WAIT_V(0);
    if constexpr (!ALIGN_EPI) { if (wr == 0) PG8_BAR; }
    PG8_BAR;
    if constexpr (Epi::AFTER_DRAIN) { E.fused(acc, cur, wr, wc, fr, fq, lds, wid, lane); S.done(cur); }
#undef PG8_SA
#undef PG8_SB
#undef PG8_STAGE
#undef PG8_LDA
#undef PG8_LDB
#undef PG8_MMA
#undef PG8_WAIT_V
#undef PG8_WAIT_L
#undef PG8_BAR
#undef PG8_SCHED
}
}

#define LAS __attribute__((address_space(3)))
typedef unsigned short bf16;
typedef unsigned u32x4 __attribute__((ext_vector_type(4)));
typedef unsigned u32x2 __attribute__((ext_vector_type(2)));
typedef float f32x4 __attribute__((ext_vector_type(4)));
typedef float f32x16 __attribute__((ext_vector_type(16)));
typedef short bf16x8 __attribute__((ext_vector_type(8)));

constexpr int M = 16384, DM = 2048, SEQ = 2048, NBATCH = 8, NCH = 16;
constexpr int N0P = 11264, N0R = 11296;
constexpr float EPS = 1e-5f;
constexpr float LOG2E = 1.4426950408889634f;
constexpr float QSCALE = 0.125f * LOG2E;
constexpr float LAMBDA_INIT = 0.35550906f;
constexpr size_t MiB = 1u << 20;
constexpr size_t WS_ST0 = 0, WS_ST1 = 128 * 1024, WS_ST2 = 192 * 1024, WS_CD = 256 * 1024, WS_LAM = 300 * 1024;
constexpr size_t WS_DT = 1 * MiB, WS_WSP = 3 * MiB, WS_W0IN = 4 * MiB, WS_W0OUT = 49 * MiB, WS_W1IN = 65 * MiB, WS_W1OUT = 97 * MiB;
constexpr size_t WS_YCAT = 105 * MiB, WS_ZA = 233 * MiB, WS_V = 297 * MiB, WS_H0 = 361 * MiB, WS_XT = 425 * MiB, WS_CN = 489 * MiB, WS_END = 505 * MiB;
constexpr size_t WS_Q = WS_YCAT, WS_K = WS_YCAT + 64 * MiB, WS_X1 = WS_ZA, WS_STATES = WS_V, WS_VT = WS_H0, WS_X1B = WS_H0, WS_O = WS_H0, WS_VV = WS_XT;
constexpr size_t DO_XBC = 0, DO_BN = 96 * MiB, DO_BT = 112 * MiB, DO_PREV = 0, DO_G = 0;
constexpr int LDS_BYTES = 147456;

__device__ __forceinline__ unsigned pk2(float lo, float hi) {
    typedef float f2 __attribute__((ext_vector_type(2))); typedef __bf16 b2 __attribute__((ext_vector_type(2)));
    f2 v = {lo, hi}; b2 b = __builtin_convertvector(v, b2); return __builtin_bit_cast(unsigned, b);
}
__device__ __forceinline__ float bflo(unsigned u) { return __uint_as_float(u << 16); }
__device__ __forceinline__ float bfhi(unsigned u) { return __uint_as_float(u & 0xffff0000u); }
__device__ __forceinline__ void unpack8(u32x4 r, float* f) { f[0] = bflo(r.x); f[1] = bfhi(r.x); f[2] = bflo(r.y); f[3] = bfhi(r.y); f[4] = bflo(r.z); f[5] = bfhi(r.z); f[6] = bflo(r.w); f[7] = bfhi(r.w); }
__device__ __forceinline__ u32x4 pack8(const float* f) { u32x4 o; o.x = pk2(f[0], f[1]); o.y = pk2(f[2], f[3]); o.z = pk2(f[4], f[5]); o.w = pk2(f[6], f[7]); return o; }
__device__ __forceinline__ float fexp2(float x) { return __builtin_amdgcn_exp2f(x); }
__device__ __forceinline__ float gelu_f(float x) { const float z = 1.5957691216057308f * (x + 0.044715f * x * x * x); return x * __builtin_amdgcn_rcpf(1.0f + __expf(-z)); }
__device__ __forceinline__ float silu_f(float x) { return x * __builtin_amdgcn_rcpf(1.0f + __expf(-x)); }
__device__ __forceinline__ int crow(int r, int h) { return (r & 3) + 8 * (r >> 2) + 4 * h; }
__device__ __forceinline__ f32x16 mfma32(bf16x8 a, bf16x8 b, f32x16 c) { return __builtin_amdgcn_mfma_f32_32x32x16_bf16(a, b, c, 0, 0, 0); }
__device__ __forceinline__ bf16x8 ld_frag16(const bf16* p) { return __builtin_bit_cast(bf16x8, *(const u32x4*)p); }
__device__ __forceinline__ bf16x8 ld_frag8x2(const bf16* p) { const u32x2 lo = *(const u32x2*)p, hi = *(const u32x2*)(p + 8); u32x4 v; v.x = lo.x; v.y = lo.y; v.z = hi.x; v.w = hi.y; return __builtin_bit_cast(bf16x8, v); }
__device__ __forceinline__ bf16x8 pack_frag(const f32x16& x, int s) {
    u32x4 v; v.x = pk2(x[8 * s], x[8 * s + 1]); v.y = pk2(x[8 * s + 2], x[8 * s + 3]); v.z = pk2(x[8 * s + 4], x[8 * s + 5]); v.w = pk2(x[8 * s + 6], x[8 * s + 7]); return __builtin_bit_cast(bf16x8, v);
}
__device__ __forceinline__ float wave_sum(float v) {
#pragma unroll
    for (int o = 1; o < 64; o <<= 1) v += __shfl_xor(v, o);
    return v;
}
#define LDS_WAIT() asm volatile("s_waitcnt lgkmcnt(0)" ::: "memory")
__device__ __forceinline__ void atomic_addf(float* p, float v) { __hip_atomic_fetch_add(p, v, __ATOMIC_RELAXED, __HIP_MEMORY_SCOPE_AGENT); }

struct Params { const float* in[23]; float* out; unsigned char* ws; };
constexpr int PTAB_OFF = LDS_BYTES - 512;
__device__ __forceinline__ unsigned long long ptab_get(int i) {
    const unsigned long long v = ((const LAS unsigned long long*)(PTAB_OFF))[i];
    const unsigned lo = __builtin_amdgcn_readfirstlane((unsigned)v), hi = __builtin_amdgcn_readfirstlane((unsigned)(v >> 32));
    return ((unsigned long long)hi << 32) | lo;
}
struct PT {
    struct InTab { __device__ __forceinline__ const float* operator[](int i) const { return (const float*)(const __attribute__((address_space(1))) float*)ptab_get(i); } } in;
    float* out; unsigned char* ws;
    __device__ __forceinline__ PT() { out = (float*)(__attribute__((address_space(1))) float*)ptab_get(23); ws = (unsigned char*)(__attribute__((address_space(1))) unsigned char*)ptab_get(24); }
};

template <int ACT>
__device__ __forceinline__ void epi_tile_bf16(const f32x4 (&acc)[2][2][4][2], bf16* base, int pitch, int col0, int row0, float sc) {
#pragma unroll
    for (int ai = 0; ai < 2; ++ai)
#pragma unroll
        for (int m = 0; m < 4; ++m) {
            bf16* rowp = base + (size_t)(row0 + ai * 128 + m * 16) * pitch + col0;
#pragma unroll
            for (int bj = 0; bj < 2; ++bj) {
                float v[8];
#pragma unroll
                for (int j = 0; j < 4; ++j) { v[j] = acc[ai][bj][m][0][j]; v[4 + j] = acc[ai][bj][m][1][j]; }
#pragma unroll
                for (int j = 0; j < 8; ++j) { if (ACT == 1) v[j] = gelu_f(v[j]); else if (ACT == 2) v[j] = silu_f(v[j]); else if (ACT == 3) v[j] *= sc; }
                *(u32x4*)(rowp + bj * 128) = pack8(v);
            }
        }
}

struct EpiIn0 {
    static constexpr bool PERM = true, AFTER_DRAIN = false;
    bf16 *ycat, *vbuf, *za, *xbc; float* stats0;
    __device__ __forceinline__ void operator()(const f32x4 (&acc)[2][2][4][2], const pg8::Unit& u, int wr, int wc, int fr, int fq) const {
        const int pn = u.pn, row0 = u.pm * 256 + wr * 64 + fr, cl = wc * 32 + 8 * fq;
        if (pn < 8) { epi_tile_bf16<1>(acc, ycat, 4096, pn * 256 + cl, row0, 1.f); }
        else if (pn < 16) {
#pragma unroll
            for (int ai = 0; ai < 2; ++ai)
#pragma unroll
                for (int m = 0; m < 4; ++m) {
                    const int row = row0 + ai * 128 + m * 16;
                    bf16* rowp = vbuf + (size_t)row * 2048 + (pn - 8) * 256 + cl;
                    float s = 0.f, ss = 0.f;
#pragma unroll
                    for (int bj = 0; bj < 2; ++bj) {
                        float v[8];
#pragma unroll
                        for (int j = 0; j < 4; ++j) { v[j] = gelu_f(acc[ai][bj][m][0][j]); v[4 + j] = gelu_f(acc[ai][bj][m][1][j]); }
#pragma unroll
                        for (int j = 0; j < 8; ++j) { s += v[j]; ss += v[j] * v[j]; }
                        *(u32x4*)(rowp + bj * 128) = pack8(v);
                    }
                    s += __shfl_xor(s, 16); s += __shfl_xor(s, 32); ss += __shfl_xor(ss, 16); ss += __shfl_xor(ss, 32);
                    if (fq == 0) { atomic_addf(stats0 + 2 * row, s); atomic_addf(stats0 + 2 * row + 1, ss); }
                }
        }
        else if (pn < 24) { epi_tile_bf16<2>(acc, za, 2048, (pn - 16) * 256 + cl, row0, 1.f); }
        else if (pn < 32) { epi_tile_bf16<2>(acc, ycat, 4096, 2048 + (pn - 24) * 256 + cl, row0, 1.f); }
        else { epi_tile_bf16<0>(acc, xbc, 3072, (pn - 32) * 256 + cl, row0, 1.f); }
    }
};

__device__ __forceinline__ void dt_tasks(const PT& p, int lane, int wave) {
    if (wave >= 2) return;
    unsigned char* ws = p.ws; const bf16* H0 = (const bf16*)(ws + WS_H0); const bf16* Wdt = (const bf16*)(ws + WS_W0IN) + (size_t)11264 * 2048; float* DT = (float*)(ws + WS_DT);
    const int r32 = lane & 31, h = lane >> 5;
    for (int task = wave * gridDim.x + blockIdx.x; task < 512; task += 2 * gridDim.x) {
        const bf16* ap = Wdt + (size_t)r32 * 2048 + 8 * h; const bf16* bp = H0 + (size_t)(task * 32 + r32) * 2048 + 8 * h;
        f32x16 acc;
#pragma unroll
        for (int i = 0; i < 16; ++i) acc[i] = 0.f;
#pragma unroll 8
        for (int st = 0; st < 128; ++st) acc = mfma32(ld_frag16(ap + 16 * st), ld_frag16(bp + 16 * st), acc);
#pragma unroll
        for (int qd = 0; qd < 4; ++qd) {
            const int j0 = 8 * qd + 4 * h; const f32x4 bb = *(const f32x4*)(p.in[9] + j0); f32x4 v;
#pragma unroll
            for (int j = 0; j < 4; ++j) { const float x = acc[4 * qd + j] + bb[j]; v[j] = x > 20.f ? x : log1pf(__expf(x)); }
            *(f32x4*)(DT + (size_t)(task * 32 + r32) * 32 + j0) = v;
        }
    }
}

struct EpiRes {
    static constexpr bool PERM = true, AFTER_DRAIN = false;
    const float* resid; float* outf; bf16* outb; float* stats;
    __device__ __forceinline__ void operator()(const f32x4 (&acc)[2][2][4][2], const pg8::Unit& u, int wr, int wc, int fr, int fq) const {
        const int row0 = u.pm * 256 + wr * 64 + fr, col0 = u.pn * 256 + wc * 32 + 8 * fq;
#pragma unroll
        for (int ai = 0; ai < 2; ++ai)
#pragma unroll
            for (int m = 0; m < 4; ++m) {
                const int row = row0 + ai * 128 + m * 16; const size_t off = (size_t)row * 2048 + col0;
                float ss = 0.f;
#pragma unroll
                for (int bj = 0; bj < 2; ++bj) {
                    const f32x4 r0 = *(const f32x4*)(resid + off + bj * 128) + acc[ai][bj][m][0], r1 = *(const f32x4*)(resid + off + bj * 128 + 4) + acc[ai][bj][m][1];
                    *(f32x4*)(outf + off + bj * 128) = r0; *(f32x4*)(outf + off + bj * 128 + 4) = r1;
                    ss += (r0[0] * r0[0] + r0[1] * r0[1]) + (r0[2] * r0[2] + r0[3] * r0[3]) + (r1[0] * r1[0] + r1[1] * r1[1]) + (r1[2] * r1[2] + r1[3] * r1[3]);
                    if (outb) { u32x4 w; w.x = pk2(r0[0], r0[1]); w.y = pk2(r0[2], r0[3]); w.z = pk2(r1[0], r1[1]); w.w = pk2(r1[2], r1[3]); *(u32x4*)(outb + off + bj * 128) = w; }
                }
                ss += __shfl_xor(ss, 16); ss += __shfl_xor(ss, 32);
                if (fq == 0) atomic_addf(stats + row, ss);
            }
    }
};

struct EpiIn1 {
    static constexpr bool PERM = true, AFTER_DRAIN = false;
    bf16 *q, *k, *v, *g; const float* stats1;
    __device__ __forceinline__ void operator()(const f32x4 (&acc)[2][2][4][2], const pg8::Unit& u, int wr, int wc, int fr, int fq) const {
        const int seg = u.pn >> 3, row0 = u.pm * 256 + wr * 64 + fr, col0 = (u.pn & 7) * 256 + wc * 32 + 8 * fq;
        bf16* base = seg == 0 ? q : (seg == 1 ? k : (seg == 2 ? v : g));
        const float sc = seg == 0 ? QSCALE : 1.f;
#pragma unroll
        for (int ai = 0; ai < 2; ++ai)
#pragma unroll
            for (int m = 0; m < 4; ++m) {
                const int row = row0 + ai * 128 + m * 16;
                const float rs = rsqrtf(stats1[row] * (1.f / 2048.f) + EPS) * sc;
                bf16* rowp = base + (size_t)row * 2048 + col0;
#pragma unroll
                for (int bj = 0; bj < 2; ++bj) {
                    float v8[8];
#pragma unroll
                    for (int j = 0; j < 4; ++j) { v8[j] = acc[ai][bj][m][0][j] * rs; v8[4 + j] = acc[ai][bj][m][1][j] * rs; }
                    if (seg == 3) {
#pragma unroll
                        for (int j = 0; j < 8; ++j) v8[j] = silu_f(v8[j]);
                    }
                    *(u32x4*)(rowp + bj * 128) = pack8(v8);
                }
            }
    }
};

__device__ __forceinline__ void transpose_item(const float* W, int K, int N, bf16* WT, int item, int lane, const float* kscale) {
    const int nblk = N / 32, kb = item / nblk, nb = item % nblk, kq = lane & 7, c4 = lane >> 3;
    const int k0 = 64 * kb + 8 * kq, n0 = 32 * nb + 4 * c4;
    f32x4 v[8];
#pragma unroll
    for (int i = 0; i < 8; ++i) v[i] = *(const f32x4*)(W + (size_t)(k0 + i) * N + n0);
    if (kscale) {
        const f32x4 g0 = *(const f32x4*)(kscale + k0), g1 = *(const f32x4*)(kscale + k0 + 4);
#pragma unroll
        for (int i = 0; i < 4; ++i) { v[i] = v[i] * g0[i]; v[4 + i] = v[4 + i] * g1[i]; }
    }
#pragma unroll
    for (int j = 0; j < 4; ++j) {
        u32x4 o; o.x = pk2(v[0][j], v[1][j]); o.y = pk2(v[2][j], v[3][j]); o.z = pk2(v[4][j], v[5][j]); o.w = pk2(v[6][j], v[7][j]);
        *(u32x4*)(WT + (size_t)(n0 + j) * K + k0) = o;
    }
}

__device__ __forceinline__ void phase0(const PT& p, LAS unsigned char* lds, int tid, int lane, int wave) {
    unsigned char* ws = p.ws;
    const int gw = blockIdx.x * 8 + wave, NGW = gridDim.x * 8;
    const int gt = blockIdx.x * 512 + tid, NGT = gridDim.x * 512;
    for (int i = gt; i < 65536; i += NGT) ((float*)(ws + WS_ST0))[i] = 0.f;
    constexpr int I0 = 32 * (N0R / 32), I1 = 64 * 64, I2 = 32 * 256, I3 = 32 * 64;
    for (int it = gw; it < I0 + I1 + I2 + I3; it += NGW) {
        int r = it;
        if (r < I0) { transpose_item(p.in[2], 2048, N0R, (bf16*)(ws + WS_W0IN), r, lane, nullptr); continue; } r -= I0;
        if (r < I1) { transpose_item(p.in[13], 4096, 2048, (bf16*)(ws + WS_W0OUT), r, lane, nullptr); continue; } r -= I1;
        if (r < I2) { transpose_item(p.in[15], 2048, 8192, (bf16*)(ws + WS_W1IN), r, lane, p.in[14]); continue; } r -= I2;
        transpose_item(p.in[21], 2048, 2048, (bf16*)(ws + WS_W1OUT), r, lane, nullptr);
    }
    for (int i = gt; i < 16 * 128 * 128 / 8; i += NGT) {
        const int e = i * 8, t = (e >> 7) & 127, s0 = e & 127; const float* src = p.in[5] + e; float v[8];
#pragma unroll
        for (int j = 0; j < 8; ++j) v[j] = (s0 + j <= t) ? src[j] : 0.f;
        ((u32x4*)(ws + WS_WSP))[i] = pack8(v);
    }
    const float* g0 = p.in[1]; bf16* H0 = (bf16*)(ws + WS_H0);
    for (int m = gw; m < M; m += NGW) {
        const f32x4* xr = (const f32x4*)(p.in[0] + (size_t)m * 2048) + lane; f32x4 v[8]; float s = 0.f;
#pragma unroll
        for (int j = 0; j < 8; ++j) { v[j] = xr[64 * j]; s += (v[j].x * v[j].x + v[j].y * v[j].y) + (v[j].z * v[j].z + v[j].w * v[j].w); }
        const float rs = rsqrtf(wave_sum(s) * (1.f / 2048.f) + EPS);
        u32x2* o = (u32x2*)(H0 + (size_t)m * 2048) + lane;
#pragma unroll
        for (int j = 0; j < 8; ++j) { const f32x4 g = ((const f32x4*)g0)[lane + 64 * j]; u32x2 w; w.x = pk2(v[j].x * rs * g.x, v[j].y * rs * g.y); w.y = pk2(v[j].z * rs * g.z, v[j].w * rs * g.w); o[64 * j] = w; }
    }
}

__device__ __forceinline__ void phase_layout(const PT& p, int tid) {
    unsigned char* ws = p.ws; unsigned char* dob = (unsigned char*)p.out;
    const bf16* Vb = (const bf16*)(ws + WS_V); const float* st0 = (const float*)(ws + WS_ST0);
    const bf16* XBC = (const bf16*)(dob + DO_XBC);
    bf16 *vT = (bf16*)(ws + WS_VT), *xT = (bf16*)(ws + WS_XT), *Bn = (bf16*)(dob + DO_BN), *BT = (bf16*)(dob + DO_BT), *Cn = (bf16*)(ws + WS_CN);
    const int t = tid & 255, so = t >> 4, co = t & 15;
    for (int pi = blockIdx.x * 2 + (tid >> 8); pi < 128 * 40; pi += gridDim.x * 2) {
        const int bc = pi / 40, k = pi % 40; const int tok0 = bc * 128 + so * 8;
        float o[8][8];
        if (k < 16) {
            const int ch0 = k * 128 + co * 8;
            float g[8], bb[8];
#pragma unroll
            for (int j = 0; j < 8; ++j) { g[j] = p.in[3][ch0 + j]; bb[j] = p.in[4][ch0 + j]; }
#pragma unroll
            for (int i = 0; i < 8; ++i) {
                const int row = tok0 + i; float f[8]; unpack8(*(const u32x4*)(Vb + (size_t)row * 2048 + ch0), f);
                const float mu = st0[2 * row] * (1.f / 2048.f), var = st0[2 * row + 1] * (1.f / 2048.f) - mu * mu, rs = rsqrtf(fmaxf(var, 0.f) + EPS);
#pragma unroll
                for (int j = 0; j < 8; ++j) o[i][j] = (f[j] - mu) * rs * g[j] + bb[j];
            }
#pragma unroll
            for (int j = 0; j < 8; ++j) { float c8[8];
#pragma unroll
                for (int i = 0; i < 8; ++i) c8[i] = o[i][j];
                *(u32x4*)(vT + ((size_t)bc * 2048 + ch0 + j) * 128 + so * 8) = pack8(c8); }
        } else {
            const int sc0 = (k - 16) * 128 + co * 8;
            float cw[4][8], cb[8];
#pragma unroll
            for (int j = 0; j < 8; ++j) { cb[j] = p.in[8][sc0 + j];
#pragma unroll
                for (int kk = 0; kk < 4; ++kk) cw[kk][j] = p.in[7][kk * 3072 + sc0 + j]; }
            const int pos0 = (bc & 15) * 128 + so * 8;
            float xw[11][8];
#pragma unroll
            for (int ii = 0; ii < 11; ++ii) {
                if (pos0 - 3 + ii >= 0) unpack8(*(const u32x4*)(XBC + (size_t)(tok0 - 3 + ii) * 3072 + sc0), xw[ii]);
                else {
#pragma unroll
                    for (int j = 0; j < 8; ++j) xw[ii][j] = 0.f;
                }
            }
#pragma unroll
            for (int i = 0; i < 8; ++i)
#pragma unroll
                for (int j = 0; j < 8; ++j) { float a = cb[j];
#pragma unroll
                    for (int kk = 0; kk < 4; ++kk) a += cw[kk][j] * xw[i + kk][j];
                    o[i][j] = silu_f(a); }
            if (k < 32) {
#pragma unroll
                for (int j = 0; j < 8; ++j) { float c8[8];
#pragma unroll
                    for (int i = 0; i < 8; ++i) c8[i] = o[i][j];
                    *(u32x4*)(xT + ((size_t)bc * 2048 + sc0 + j) * 128 + so * 8) = pack8(c8); }
            } else if (k < 36) {
                const int n0 = sc0 - 2048;
#pragma unroll
                for (int i = 0; i < 8; ++i) *(u32x4*)(Bn + (size_t)(tok0 + i) * 512 + n0) = pack8(o[i]);
#pragma unroll
                for (int j = 0; j < 8; ++j) { float c8[8];
#pragma unroll
                    for (int i = 0; i < 8; ++i) c8[i] = o[i][j];
                    *(u32x4*)(BT + ((size_t)bc * 512 + n0 + j) * 128 + so * 8) = pack8(c8); }
            } else {
                const int n0 = sc0 - 2560;
#pragma unroll
                for (int i = 0; i < 8; ++i) *(u32x4*)(Cn + (size_t)(tok0 + i) * 512 + n0) = pack8(o[i]);
            }
        }
    }
}

__device__ __forceinline__ void chunk_cumsum(const float* DT, const float* a_log, int tok0, int hh, int lane, float& d0, float& d1, float& c0, float& c1, float& tot) {
    d0 = DT[(size_t)(tok0 + 2 * lane) * 32 + hh]; d1 = DT[(size_t)(tok0 + 2 * lane + 1) * 32 + hh];
    const float A = -__expf(a_log[hh]); const float x0 = d0 * A, x1 = d1 * A; float ps = x0 + x1;
#pragma unroll
    for (int o = 1; o < 64; o <<= 1) { const float t = __shfl_up(ps, o); if (lane >= o) ps += t; }
    c1 = ps; c0 = ps - x1; tot = __shfl(ps, 63);
}

__device__ __forceinline__ void phase_mix(const PT& p, LAS unsigned char* lds, int tid, int lane, int wave) {
    unsigned char* ws = p.ws; unsigned char* dob = (unsigned char*)p.out;
    const int r32 = lane & 31, h = lane >> 5;
    bf16* Ycat = (bf16*)(ws + WS_YCAT); const bf16* ZA = (const bf16*)(ws + WS_ZA); const bf16* vT = (const bf16*)(ws + WS_VT); const bf16* Wsp = (const bf16*)(ws + WS_WSP);
    const bf16* xT = (const bf16*)(ws + WS_XT); const bf16* BT = (const bf16*)(dob + DO_BT); const float* DT = (const float*)(ws + WS_DT);
    bf16* ST = (bf16*)(ws + WS_STATES); float* CD = (float*)(ws + WS_CD);
    LAS float* wtab = (LAS float*)lds;
    constexpr int NG = 128 * 16, NS = NBATCH * 15 * 4;
    for (int it = blockIdx.x; it < NG + NS; it += gridDim.x) {
        if (it < NG) {
            const int bc = it >> 4, g = it & 15, cb = wave & 3, th = wave >> 2;
            const int ch0 = g * 128 + cb * 32;
            const bf16* ap = vT + ((size_t)bc * 2048 + ch0 + r32) * 128 + 8 * h;
            f32x16 acc[2];
#pragma unroll
            for (int i = 0; i < 16; ++i) { acc[0][i] = 0.f; acc[1][i] = 0.f; }
#pragma unroll
            for (int st = 0; st < 8; ++st) {
                const bf16x8 a = ld_frag16(ap + 16 * st);
#pragma unroll
                for (int t2 = 0; t2 < 2; ++t2) { const int tb = 2 * th + t2;
                    if (st < 2 * (tb + 1)) { const bf16x8 b = ld_frag16(Wsp + ((size_t)g * 128 + tb * 32 + r32) * 128 + 16 * st + 8 * h); acc[t2] = mfma32(a, b, acc[t2]); } }
            }
#pragma unroll
            for (int t2 = 0; t2 < 2; ++t2) {
                const int t = (2 * th + t2) * 32 + r32; const size_t tok = (size_t)bc * 128 + t; const float sb = p.in[6][g * 128 + t];
#pragma unroll
                for (int qd = 0; qd < 4; ++qd) {
                    const int ch = ch0 + 8 * qd + 4 * h;
                    u32x2* up = (u32x2*)(Ycat + tok * 4096 + ch); const u32x2 uu = *up, zz = *(const u32x2*)(ZA + tok * 2048 + ch);
                    const float y0 = bflo(uu.x) * (acc[t2][4 * qd] + sb) * bflo(zz.x), y1 = bfhi(uu.x) * (acc[t2][4 * qd + 1] + sb) * bfhi(zz.x);
                    const float y2 = bflo(uu.y) * (acc[t2][4 * qd + 2] + sb) * bflo(zz.y), y3 = bfhi(uu.y) * (acc[t2][4 * qd + 3] + sb) * bfhi(zz.y);
                    u32x2 w; w.x = pk2(y0, y1); w.y = pk2(y2, y3); *up = w;
                }
            }
        } else {
            const int id = it - NG, b = id / 60, c = (id / 4) % 15, grp = id & 3; const int bc = b * 16 + c, tok0 = bc * 128;
            __syncthreads();
            { const int hh = grp * 8 + wave; float d0, d1, c0, c1, tot; chunk_cumsum(DT, p.in[10], tok0, hh, lane, d0, d1, c0, c1, tot);
              wtab[wave * 128 + 2 * lane] = d0 * __expf(tot - c0); wtab[wave * 128 + 2 * lane + 1] = d1 * __expf(tot - c1);
              if (lane == 0) CD[bc * 32 + hh] = __expf(tot); }
            __syncthreads();
#pragma unroll 1
            for (int tk = 0; tk < 2; ++tk) {
                const int r = (wave >> 1) + 4 * tk, pb = wave & 1, hh = grp * 8 + r;
                const bf16* ap = xT + ((size_t)bc * 2048 + hh * 64 + pb * 32 + r32) * 128 + 8 * h;
                const bf16* bp = BT + ((size_t)bc * 512 + grp * 128 + r32) * 128 + 8 * h;
                f32x16 acc[4];
#pragma unroll
                for (int nb = 0; nb < 4; ++nb)
#pragma unroll
                    for (int i = 0; i < 16; ++i) acc[nb][i] = 0.f;
#pragma unroll
                for (int st = 0; st < 8; ++st) {
                    float f[8]; unpack8(*(const u32x4*)(ap + 16 * st), f);
                    const f32x4 w0 = *(const LAS f32x4*)(wtab + r * 128 + 16 * st + 8 * h), w1 = *(const LAS f32x4*)(wtab + r * 128 + 16 * st + 8 * h + 4);
                    f[0] *= w0.x; f[1] *= w0.y; f[2] *= w0.z; f[3] *= w0.w; f[4] *= w1.x; f[5] *= w1.y; f[6] *= w1.z; f[7] *= w1.w;
                    const bf16x8 a = __builtin_bit_cast(bf16x8, pack8(f));
#pragma unroll
                    for (int nb = 0; nb < 4; ++nb) { const bf16x8 bfr = ld_frag16(bp + (size_t)nb * 32 * 128 + 16 * st); acc[nb] = mfma32(a, bfr, acc[nb]); }
                }
                bf16* sp = ST + ((size_t)(bc * 32 + hh) * 64 + pb * 32) * 128;
#pragma unroll
                for (int nb = 0; nb < 4; ++nb)
#pragma unroll
                    for (int i = 0; i < 16; ++i) sp[(size_t)crow(i, h) * 128 + nb * 32 + r32] = (bf16)(pk2(acc[nb][i], 0.f) & 0xffffu);
            }
        }
    }
}

__device__ __forceinline__ void phase_scan(const PT& p, int tid) {
    unsigned char* ws = p.ws; const bf16* ST = (const bf16*)(ws + WS_STATES); const float* CD = (const float*)(ws + WS_CD); bf16* PV = (bf16*)((unsigned char*)p.out + DO_PREV);
    for (int id = blockIdx.x * 512 + tid; id < NBATCH * 32 * 64 * 16; id += gridDim.x * 512) {
        const int b = id >> 15, rem = id & 32767, hh = rem >> 10;
        float run[8];
#pragma unroll
        for (int j = 0; j < 8; ++j) run[j] = 0.f;
#pragma unroll
        for (int c = 0; c < 16; ++c) {
            const size_t off = ((size_t)(b * 16 + c) * 32 * 64 * 16 + rem) * 8;
            *(u32x4*)(PV + off) = pack8(run);
            if (c < 15) { float s[8]; unpack8(*(const u32x4*)(ST + off), s); const float cd = CD[(b * 16 + c) * 32 + hh];
#pragma unroll
                for (int j = 0; j < 8; ++j) run[j] = run[j] * cd + s[j]; }
        }
    }
}

__device__ __forceinline__ void phase_ssd_y(const PT& p, LAS unsigned char* lds, int tid, int lane, int wave) {
    unsigned char* ws = p.ws; unsigned char* dob = (unsigned char*)p.out;
    const int r32 = lane & 31, h = lane >> 5;
    bf16* Ycat = (bf16*)(ws + WS_YCAT); const bf16* xT = (const bf16*)(ws + WS_XT); const bf16* Bn = (const bf16*)(dob + DO_BN); const bf16* Cn = (const bf16*)(ws + WS_CN);
    const bf16* PV = (const bf16*)(dob + DO_PREV); const float* DT = (const float*)(ws + WS_DT);
    LAS float* acum = (LAS float*)lds; LAS float* dtt = acum + 1024; LAS float* ssqp = dtt + 1024;
    for (int it = blockIdx.x; it < 128 * 4; it += gridDim.x) {
        const int bc = it >> 2, grp = it & 3, tok0 = bc * 128;
        __syncthreads();
        { const int hh = grp * 8 + wave; float d0, d1, c0, c1, tot; chunk_cumsum(DT, p.in[10], tok0, hh, lane, d0, d1, c0, c1, tot);
          acum[wave * 128 + 2 * lane] = c0; acum[wave * 128 + 2 * lane + 1] = c1; dtt[wave * 128 + 2 * lane] = d0; dtt[wave * 128 + 2 * lane + 1] = d1; }
        __syncthreads();
        const int pb = wave >> 2, lb = wave & 3, l = lb * 32 + r32; const size_t tok = (size_t)tok0 + l;
        bf16x8 cf[8];
#pragma unroll
        for (int st = 0; st < 8; ++st) cf[st] = ld_frag16(Cn + tok * 512 + grp * 128 + 16 * st + 8 * h);
        f32x16 X[4];
#pragma unroll
        for (int sb = 0; sb < 4; ++sb) {
#pragma unroll
            for (int i = 0; i < 16; ++i) X[sb][i] = 0.f;
            if (sb <= lb) {
#pragma unroll
                for (int st = 0; st < 8; ++st) X[sb] = mfma32(ld_frag16(Bn + ((size_t)tok0 + sb * 32 + r32) * 512 + grp * 128 + 16 * st + 8 * h), cf[st], X[sb]);
            }
        }
        float ssq = 0.f;
#pragma unroll 1
        for (int r = 0; r < 8; ++r) {
            const int hh = grp * 8 + r;
            f32x16 acc;
#pragma unroll
            for (int i = 0; i < 16; ++i) acc[i] = 0.f;
            const bf16* pp = PV + ((size_t)(bc * 32 + hh) * 64 + pb * 32 + r32) * 128 + 8 * h;
#pragma unroll
            for (int st = 0; st < 8; ++st) acc = mfma32(ld_frag16(pp + 16 * st), cf[st], acc);
            const float al = acum[r * 128 + l]; const float el = __expf(al);
#pragma unroll
            for (int i = 0; i < 16; ++i) acc[i] *= el;
            const bf16* xrow = xT + ((size_t)bc * 2048 + hh * 64 + pb * 32 + r32) * 128 + 4 * h;
#pragma unroll
            for (int sb = 0; sb < 4; ++sb) {
                if (sb <= lb) {
                    f32x16 mm;
#pragma unroll
                    for (int qd = 0; qd < 4; ++qd) {
                        const int s0 = sb * 32 + 8 * qd + 4 * h;
                        const f32x4 as = *(const LAS f32x4*)(acum + r * 128 + s0), ds = *(const LAS f32x4*)(dtt + r * 128 + s0);
#pragma unroll
                        for (int j = 0; j < 4; ++j) { const float v = X[sb][4 * qd + j] * __expf(al - as[j]) * ds[j]; mm[4 * qd + j] = (s0 + j <= l) ? v : 0.f; }
                    }
#pragma unroll
                    for (int s2 = 0; s2 < 2; ++s2) acc = mfma32(ld_frag8x2(xrow + sb * 32 + 16 * s2), pack_frag(mm, s2), acc);
                }
            }
            const float dsk = p.in[11][hh];
#pragma unroll
            for (int qd = 0; qd < 4; ++qd) {
                const int ch = hh * 64 + pb * 32 + 8 * qd + 4 * h;
                const bf16* xc = xT + ((size_t)bc * 2048 + ch) * 128 + l;
                u32x2* yp = (u32x2*)(Ycat + tok * 4096 + 2048 + ch); const u32x2 zz = *yp;
                const float y0 = (acc[4 * qd] + dsk * bflo((unsigned)xc[0])) * bflo(zz.x), y1 = (acc[4 * qd + 1] + dsk * bflo((unsigned)xc[128])) * bfhi(zz.x);
                const float y2 = (acc[4 * qd + 2] + dsk * bflo((unsigned)xc[256])) * bflo(zz.y), y3 = (acc[4 * qd + 3] + dsk * bflo((unsigned)xc[384])) * bfhi(zz.y);
                ssq += (y0 * y0 + y1 * y1) + (y2 * y2 + y3 * y3);
                u32x2 w; w.x = pk2(y0, y1); w.y = pk2(y2, y3); *yp = w;
            }
        }
        ssq += __shfl_xor(ssq, 32);
        if (h == 0) ssqp[pb * 128 + l] = ssq;
        __syncthreads();
        const float rs = rsqrtf((ssqp[l] + ssqp[128 + l]) * (1.f / 512.f) + EPS);
#pragma unroll 1
        for (int r = 0; r < 8; ++r) {
#pragma unroll
            for (int qd = 0; qd < 4; ++qd) {
                const int ch = (grp * 8 + r) * 64 + pb * 32 + 8 * qd + 4 * h;
                u32x2* yp = (u32x2*)(Ycat + tok * 4096 + 2048 + ch); const u32x2 yy = *yp; const f32x4 g = *(const f32x4*)(p.in[12] + ch);
                u32x2 w; w.x = pk2(bflo(yy.x) * rs * g.x, bfhi(yy.x) * rs * g.y); w.y = pk2(bflo(yy.y) * rs * g.z, bfhi(yy.y) * rs * g.w); *yp = w;
            }
        }
    }
}

constexpr int AK_PITCH = 272, AV_PITCH = 272, A_KOFF = 0, A_VOFF = 128 * AK_PITCH, A_STAGE = A_VOFF + 128 * AV_PITCH;
static_assert(2 * A_STAGE <= PTAB_OFF && 4 * 16384 <= A_STAGE, "attention LDS map");
typedef short v4i16_t __attribute__((ext_vector_type(4)));
__device__ __forceinline__ float max3f(float a, float b, float c) { return fmaxf(fmaxf(a, b), c); }
__device__ __forceinline__ void attn_unit(const PT& p, LAS unsigned char* lds, int tid, int lane, int wave, int b, int hd, int qb, float lam) {
    unsigned char* ws = p.ws;
    const bf16* Qb = (const bf16*)(ws + WS_Q); const bf16* Kb = (const bf16*)(ws + WS_K); const bf16* Vb = (const bf16*)(ws + WS_VV); const bf16* Gb = (const bf16*)((unsigned char*)p.out + DO_G);
    bf16* Ob = (bf16*)(ws + WS_O);
    const int r32 = lane & 31, h = lane >> 5, mp = wave >> 2, wq = wave & 3;
    const int qw0 = qb * 128 + 32 * wq, q = qw0 + r32; const unsigned tokq = (unsigned)(b * SEQ + q), tokb = (unsigned)(b * SEQ);
    const float slope2 = fexp2(-0.5f * (float)(hd + 1)) * LOG2E;
    bf16x8 qf[4];
#pragma unroll
    for (int ds = 0; ds < 4; ++ds) qf[ds] = ld_frag16(Qb + (tokq * 2048u + (unsigned)(hd * 128 + mp * 64 + 16 * ds + 8 * h)));
    float mrun = -INFINITY, lsum = 0.f;
    f32x16 oT[4];
#pragma unroll
    for (int db = 0; db < 4; ++db)
#pragma unroll
        for (int i = 0; i < 16; ++i) oT[db][i] = 0.f;
    const int ntiles = qb + 1;
    u32x4 preV[4], preK[4];
#define PREFETCH(t) do { \
        _Pragma("unroll") for (int i_ = 0; i_ < 4; ++i_) { const int pid_ = tid + 512 * i_, row_ = pid_ >> 4, c16_ = pid_ & 15; const unsigned go_ = (tokb + (unsigned)((t) * 128 + row_)) * 2048u + (unsigned)(hd * 128 + 8 * c16_); \
            preK[i_] = *(const u32x4*)(Kb + go_); preV[i_] = *(const u32x4*)(Vb + go_); } \
    } while (0)
    PREFETCH(0);
    const LAS unsigned char* kbase0 = lds + A_KOFF + r32 * AK_PITCH + (mp * 64 + 8 * h) * 2;
    const LAS unsigned char* vbase0 = lds + A_VOFF + (4 * h + ((lane & 15) >> 2)) * AV_PITCH + ((lane >> 4) & 1) * 32 + (lane & 3) * 8;
#define STAGE_WRITE(stg) do { \
        _Pragma("unroll") for (int i_ = 0; i_ < 4; ++i_) { const int pid_ = tid + 512 * i_, row_ = pid_ >> 4, c16_ = pid_ & 15; \
            *(LAS u32x4*)(lds + (stg) * A_STAGE + A_KOFF + row_ * AK_PITCH + 16 * c16_) = preK[i_]; *(LAS u32x4*)(lds + (stg) * A_STAGE + A_VOFF + row_ * AV_PITCH + 16 * c16_) = preV[i_]; } \
    } while (0)
    __syncthreads();
    STAGE_WRITE(0);
    asm volatile("" : "+v"(qf[0]), "+v"(qf[1]), "+v"(qf[2]), "+v"(qf[3]));
    __syncthreads();
#pragma unroll 1
    for (int t = 0; t < ntiles; ++t) {
        const int stg = t & 1;
        if (t + 1 < ntiles) PREFETCH(t + 1);
        const LAS unsigned char* kbase = kbase0 + stg * A_STAGE; const LAS unsigned char* vbase = vbase0 + stg * A_STAGE;
        const bool diag = (t == qb);
#pragma unroll 1
        for (int sub = 0; sub < 2; ++sub) {
            const int nact = diag ? min(2, max(0, wq + 1 - 2 * sub)) : 2;
            if (nact > 0) {
                const float bq = slope2 * (float)(t * 128 + sub * 64 + 4 * h - q);
                const LAS unsigned char* kb0 = kbase + sub * 64 * AK_PITCH; const LAS unsigned char* vb0 = vbase + sub * 64 * AV_PITCH;
                f32x16 s[2];
#pragma unroll
                for (int kb = 0; kb < 2; ++kb) {
                    if (kb < nact) {
                        const float bk = bq + slope2 * (float)(32 * kb);
#pragma unroll
                        for (int i = 0; i < 16; ++i) s[kb][i] = bk + slope2 * (float)((i & 3) + 8 * (i >> 2));
#pragma unroll
                        for (int ds = 0; ds < 4; ++ds) s[kb] = mfma32(__builtin_bit_cast(bf16x8, *(const LAS u32x4*)(kb0 + kb * 32 * AK_PITCH + ds * 32)), qf[ds], s[kb]);
                    } else {
#pragma unroll
                        for (int i = 0; i < 16; ++i) s[kb][i] = -INFINITY;
                    }
                }
                if (diag) {
#pragma unroll
                    for (int kb = 0; kb < 2; ++kb) if (2 * sub + kb == wq) {
#pragma unroll
                        for (int i = 0; i < 16; ++i) if (crow(i, h) > r32) s[kb][i] = -INFINITY; }
                }
                float mx = -INFINITY;
#pragma unroll
                for (int kb = 0; kb < 2; ++kb)
#pragma unroll
                    for (int i = 0; i < 16; i += 2) mx = max3f(mx, s[kb][i], s[kb][i + 1]);
                mx = fmaxf(mx, __shfl_xor(mx, 32));
                const float mnew = fmaxf(mrun, mx), alpha = fexp2(mrun - mnew); mrun = mnew;
                float rs = 0.f;
#pragma unroll
                for (int kb = 0; kb < 2; ++kb)
#pragma unroll
                    for (int i = 0; i < 16; ++i) { s[kb][i] = fexp2(s[kb][i] - mnew); rs += s[kb][i]; }
                lsum = lsum * alpha + rs;
                if (__builtin_amdgcn_ballot_w64(alpha != 1.0f) != 0ull) {
#pragma unroll
                    for (int db = 0; db < 4; ++db)
#pragma unroll
                        for (int i = 0; i < 16; ++i) oT[db][i] *= alpha;
                }
#pragma unroll
                for (int kb = 0; kb < 2; ++kb) if (kb < nact) {
#pragma unroll
                    for (int s2 = 0; s2 < 2; ++s2) {
                        const bf16x8 pf = pack_frag(s[kb], s2);
#pragma unroll
                        for (int db = 0; db < 4; ++db) {
                            const LAS unsigned char* vp = vb0 + (kb * 32 + 16 * s2) * AV_PITCH + db * 64;
                            const v4i16_t lo = __builtin_amdgcn_ds_read_tr16_b64_v4i16((LAS v4i16_t*)vp), hi = __builtin_amdgcn_ds_read_tr16_b64_v4i16((LAS v4i16_t*)(vp + 8 * AV_PITCH));
                            const bf16x8 vf = {lo[0], lo[1], lo[2], lo[3], hi[0], hi[1], hi[2], hi[3]};
                            oT[db] = mfma32(vf, pf, oT[db]);
                        }
                    }
                }
            }
        }
        if (t + 1 < ntiles) STAGE_WRITE(stg ^ 1);
        __syncthreads();
    }
#undef PREFETCH
#undef STAGE_WRITE
    const float lt = lsum + __shfl_xor(lsum, 32);
    LAS float* xch = (LAS float*)(lds + (ntiles & 1) * A_STAGE + wq * 16384);
    if (mp == 1) { const float sc = lam / lt;
#pragma unroll
        for (int db = 0; db < 4; ++db)
#pragma unroll
            for (int i = 0; i < 16; ++i) xch[(db * 16 + i) * 64 + lane] = oT[db][i] * sc; }
    __syncthreads();
    if (mp == 0) {
        const float i1 = 1.f / lt; float ss = 0.f;
#pragma unroll
        for (int db = 0; db < 4; ++db)
#pragma unroll
            for (int i = 0; i < 16; ++i) { const float o = oT[db][i] * i1 - xch[(db * 16 + i) * 64 + lane]; oT[db][i] = o; ss += o * o; }
        ss += __shfl_xor(ss, 32);
        const float rn = rsqrtf(ss * (1.f / 128.f) + EPS) * (1.f - LAMBDA_INIT);
#pragma unroll
        for (int db = 0; db < 4; ++db)
#pragma unroll
            for (int qd = 0; qd < 4; ++qd) {
                const int d = db * 32 + 8 * qd + 4 * h; const unsigned off = tokq * 2048u + (unsigned)(hd * 128 + d);
                const u32x2 gg = *(const u32x2*)(Gb + off); const f32x4 sg = *(const f32x4*)(p.in[20] + d);
                u32x2 w; w.x = pk2(oT[db][4 * qd] * rn * sg.x * bflo(gg.x), oT[db][4 * qd + 1] * rn * sg.y * bfhi(gg.x));
                w.y = pk2(oT[db][4 * qd + 2] * rn * sg.z * bflo(gg.y), oT[db][4 * qd + 3] * rn * sg.w * bfhi(gg.y));
                *(u32x2*)(Ob + off) = w;
            }
    }
}

__device__ __forceinline__ void phase_attn(const PT& p, LAS unsigned char* lds, int tid, int lane, int wave) {
    const float s1 = wave_sum(p.in[16][lane] * p.in[17][lane]), s2 = wave_sum(p.in[18][lane] * p.in[19][lane]);
    const float lam = __expf(s1) - __expf(s2) + LAMBDA_INIT;
#pragma unroll 1
    for (int u = blockIdx.x; u < NBATCH * 16 * 8; u += gridDim.x) {
        const int j = u & 7, hd = (u >> 3) & 15, b = u >> 7;
#pragma unroll 1
        for (int k = 0; k < 2; ++k) attn_unit(p, lds, tid, lane, wave, b, hd, k == 0 ? 15 - j : j, lam);
    }
}

__device__ __forceinline__ void phase_final(const PT& p, int lane, int wave) {
    const float* st2 = (const float*)(p.ws + WS_ST2); const float* g = p.in[22];
    for (int m = blockIdx.x * 8 + wave; m < M; m += gridDim.x * 8) {
        const float rs = rsqrtf(st2[m] * (1.f / 2048.f) + EPS);
        f32x4* xr = (f32x4*)(p.out + (size_t)m * 2048) + lane;
#pragma unroll
        for (int j = 0; j < 8; ++j) { const f32x4 gg = ((const f32x4*)g)[lane + 64 * j]; f32x4 v = xr[64 * j]; v.x *= rs * gg.x; v.y *= rs * gg.y; v.z *= rs * gg.z; v.w *= rs * gg.w; xr[64 * j] = v; }
    }
}

constexpr size_t WS_BAR = 384 * 1024;
constexpr int XBST_OFF = PTAB_OFF + 256;
typedef __attribute__((address_space(1))) unsigned gu32;
#define XB_TMO      128
#define XB_XCNT(j)  (256  + 64 * (j))
#define XB_XSUB(j)  (1280 + 64 * (j))
#define XB_XGEN(j)  (2304 + 64 * (j))
#define XB_TOP      3328
#define XB_TOPGEN   3392
#define XCD_BAR_WORDS 3456
#define XB_SPIN_CAP (1u << 18)

__device__ __forceinline__ unsigned xb_ld(unsigned* p)              { return __hip_atomic_load(p, __ATOMIC_RELAXED, __HIP_MEMORY_SCOPE_AGENT); }
__device__ __forceinline__ unsigned xb_add(unsigned* p, unsigned v) { return __hip_atomic_fetch_add(p, v, __ATOMIC_RELAXED, __HIP_MEMORY_SCOPE_AGENT); }
__device__ __forceinline__ unsigned xb_xcc_id() { return (unsigned)__builtin_amdgcn_s_getreg((3 << 11) | 20) & 0xFu; }
#define XB_SPIN(cond, bar) do { unsigned _sp = 0; while (cond) { __builtin_amdgcn_s_sleep(1); \
    if ((++_sp & 255u) == 0u) { if (xb_ld(&(bar)[XB_TMO])) break; if (_sp > XB_SPIN_CAP) { atomicAdd(&(bar)[XB_TMO], 1u); break; } } } } while (0)

struct XcdBarrier {
    unsigned* bar; unsigned x;
    volatile LAS unsigned* st;
};

__device__ __forceinline__ XcdBarrier xcd_barrier_post(unsigned* bar, volatile LAS unsigned* st) {
    XcdBarrier b; b.bar = bar; b.x = xb_xcc_id(); b.st = st;
    if (threadIdx.x == 0) (void)xb_add(&bar[XB_XCNT(b.x)], 1u);
    return b;
}
__device__ __forceinline__ void xcd_barrier_complete(unsigned* bar, unsigned x, unsigned& nloc, unsigned& nx) {
    const unsigned G = gridDim.x * gridDim.y * gridDim.z;
    unsigned sum, cnt, mine, sp = 0u;
    for (;;) {
        sum = 0u; cnt = 0u; mine = 0u;
#pragma unroll
        for (unsigned j = 0; j < 16; ++j) { const unsigned c = xb_ld(&bar[XB_XCNT(j)]); sum += c; cnt += (c > 0u) ? 1u : 0u; mine = (j == x) ? c : mine; }
        if (sum == G) break;
        __builtin_amdgcn_s_sleep(1);
        if ((++sp & 255u) == 0u) { if (xb_ld(&bar[XB_TMO])) break; if (sp > XB_SPIN_CAP) { atomicAdd(&bar[XB_TMO], 1u); break; } }
    }
    nloc = mine > 0u ? mine : 1u; nx = cnt > 0u ? cnt : 1u;
}

__device__ __forceinline__ void xcd_barrier(const XcdBarrier& b) {
    asm volatile("s_waitcnt vmcnt(0)" ::: "memory");
    __syncthreads();
    if (threadIdx.x == 0) {
        unsigned* bar = b.bar;
        __builtin_amdgcn_s_waitcnt(0);
        unsigned nloc = b.st[0], nx = b.st[1];
        if (nloc == 0u) { xcd_barrier_complete(bar, b.x, nloc, nx); b.st[0] = nloc; b.st[1] = nx; }
        const unsigned old = xb_add(&bar[XB_XSUB(b.x)], 1u);
        const unsigned gen = old / nloc;
        if (old + 1u == (gen + 1u) * nloc) {
            __builtin_amdgcn_fence(__ATOMIC_RELEASE, "agent");
            asm volatile("s_waitcnt vmcnt(0)" ::: "memory");
            const unsigned og = xb_add(&bar[XB_TOP], 1u);
            const unsigned tg = og / nx;
            if (og + 1u == (tg + 1u) * nx) xb_add(&bar[XB_TOPGEN], 1u);
            else XB_SPIN(xb_ld(&bar[XB_TOPGEN]) == tg, bar);
            __builtin_amdgcn_fence(__ATOMIC_ACQUIRE, "agent");
            xb_add(&bar[XB_XGEN(b.x)], 1u);
            asm volatile("s_waitcnt vmcnt(0)" ::: "memory");
        } else {
            XB_SPIN(xb_ld(&bar[XB_XGEN(b.x)]) == gen, bar);
            __builtin_amdgcn_fence(__ATOMIC_ACQUIRE, "agent");
            asm volatile("s_waitcnt vmcnt(0)" ::: "memory");
        }
    }
    __syncthreads();
}

__global__ void __launch_bounds__(512) fwd_megakernel(Params pa) {
    extern __shared__ __attribute__((aligned(16))) unsigned char lds_raw[];
    cg::grid_group grid = cg::this_grid();
    LAS unsigned char* lds = (LAS unsigned char*)lds_raw;
    if (threadIdx.x < 25) {
        unsigned long long v = 0;
#pragma unroll
        for (int i = 0; i < 23; ++i) if ((int)threadIdx.x == i) v = (unsigned long long)pa.in[i];
        if (threadIdx.x == 23) v = (unsigned long long)pa.out;
        if (threadIdx.x == 24) v = (unsigned long long)pa.ws;
        ((LAS unsigned long long*)(lds + PTAB_OFF))[threadIdx.x] = v;
    }
    if (threadIdx.x < 2) ((LAS unsigned*)(lds + XBST_OFF))[threadIdx.x] = 0u;
    __syncthreads();
    const XcdBarrier bar = xcd_barrier_post((unsigned*)(pa.ws + WS_BAR), (volatile LAS unsigned*)(lds + XBST_OFF));
#ifndef PHMASK
#define PHMASK 0x3ff
#endif
#define PH(n) (((PHMASK) >> (n)) & 1)
#define TLW int tid_ = threadIdx.x; asm volatile("" : "+v"(tid_)); const int tid = tid_, lane = tid & 63, wave = __builtin_amdgcn_readfirstlane(tid >> 6); (void)tid; (void)lane; (void)wave
#define GRIDV const int G = gridDim.x, c = blockIdx.x
    if (PH(0)) { PT p; TLW; phase0(p, lds, tid, lane, wave); }
    grid.sync();
    if (PH(1)) {
        PT p; GRIDV; unsigned char* ws = p.ws; unsigned char* dob = (unsigned char*)p.out;
        pg8::Gemm g{(const pg8::bf16_t*)(ws + WS_H0), (const pg8::bf16_t*)(ws + WS_W0IN), M, N0P, 2048}; pg8::StaticOrder S; S.init(M, N0P, G, c);
        EpiIn0 E{(bf16*)(ws + WS_YCAT), (bf16*)(ws + WS_V), (bf16*)(ws + WS_ZA), (bf16*)(dob + DO_XBC), (float*)(ws + WS_ST0)};
        pg8::gemm_phase<EpiIn0, pg8::StaticOrder, true, true>(lds, g, S, E);
        { TLW; dt_tasks(p, lane, wave); }
    }
    xcd_barrier(bar);
    if (PH(2)) { PT p; TLW; phase_layout(p, tid); }
    xcd_barrier(bar);
    if (PH(3)) { PT p; TLW; phase_mix(p, lds, tid, lane, wave); }
    xcd_barrier(bar);
    if (PH(4)) { PT p; TLW; phase_scan(p, tid); }
    xcd_barrier(bar);
    if (PH(5)) { PT p; TLW; phase_ssd_y(p, lds, tid, lane, wave); }
    xcd_barrier(bar);
    if (PH(6)) {
        PT p; GRIDV; unsigned char* ws = p.ws;
        pg8::Gemm g{(const pg8::bf16_t*)(ws + WS_YCAT), (const pg8::bf16_t*)(ws + WS_W0OUT), M, 2048, 4096}; pg8::StaticOrder S; S.init(M, 2048, G, c);
        EpiRes E{p.in[0], (float*)(ws + WS_X1), (bf16*)(ws + WS_X1B), (float*)(ws + WS_ST1)};
        pg8::gemm_phase<EpiRes, pg8::StaticOrder, true, true>(lds, g, S, E);
    }
    xcd_barrier(bar);
    if (PH(6)) {
        PT p; GRIDV; unsigned char* ws = p.ws; unsigned char* dob = (unsigned char*)p.out;
        pg8::Gemm g{(const pg8::bf16_t*)(ws + WS_X1B), (const pg8::bf16_t*)(ws + WS_W1IN), M, 8192, 2048}; pg8::StaticOrder S; S.init(M, 8192, G, c);
        EpiIn1 E{(bf16*)(ws + WS_Q), (bf16*)(ws + WS_K), (bf16*)(ws + WS_VV), (bf16*)(dob + DO_G), (const float*)(ws + WS_ST1)};
        pg8::gemm_phase<EpiIn1, pg8::StaticOrder, true, true>(lds, g, S, E);
    }
    xcd_barrier(bar);
    if (PH(7)) { PT p; TLW; phase_attn(p, lds, tid, lane, wave); }
    xcd_barrier(bar);
    if (PH(8)) {
        PT p; GRIDV; unsigned char* ws = p.ws;
        pg8::Gemm g{(const pg8::bf16_t*)(ws + WS_O), (const pg8::bf16_t*)(ws + WS_W1OUT), M, 2048, 2048}; pg8::StaticOrder S; S.init(M, 2048, G, c);
        EpiRes E{(const float*)(ws + WS_X1), p.out, nullptr, (float*)(ws + WS_ST2)};
        pg8::gemm_phase<EpiRes, pg8::StaticOrder, true, true>(lds, g, S, E);
    }
    xcd_barrier(bar);
    if (PH(9)) { PT p; TLW; phase_final(p, lane, wave); }
}

extern "C" void kernel_launch(void* const* d_in, const int* in_sizes, int n_in, void* d_out, int out_size, void* d_ws, size_t ws_size, hipStream_t stream) {
    static int grid = 0;
    if (grid == 0) {
        if (n_in != 23 || out_size != M * DM || ws_size < WS_END) { fprintf(stderr, "kernel_launch: unexpected shapes (n_in %d out %d ws %zu)\n", n_in, out_size, ws_size); grid = -1; return; }
        int dev = 0, cus = 0, per_cu = 0;
        hipGetDevice(&dev); hipDeviceGetAttribute(&cus, hipDeviceAttributeMultiprocessorCount, dev);
        hipFuncSetAttribute((const void*)fwd_megakernel, hipFuncAttributeMaxDynamicSharedMemorySize, LDS_BYTES);
        hipOccupancyMaxActiveBlocksPerMultiprocessor(&per_cu, (const void*)fwd_megakernel, 512, LDS_BYTES);
        if (per_cu < 1) { fprintf(stderr, "kernel_launch: occupancy query says %d blocks per CU\n", per_cu); per_cu = 1; }
        (void)hipGetLastError();
        grid = cus;
    }
    if (grid < 0) return;
    Params p{};
    for (int i = 0; i < 23; ++i) p.in[i] = (const float*)d_in[i];
    p.out = (float*)d_out; p.ws = (unsigned char*)d_ws;
    if (hipMemsetAsync((char*)d_ws + WS_BAR, 0, XCD_BAR_WORDS * 4, stream) != hipSuccess) { fprintf(stderr, "kernel_launch: memset of the barrier words failed\n"); return; }
    void* args[] = {&p};
    hipError_t e = hipLaunchCooperativeKernel((const void*)fwd_megakernel, dim3(grid), dim3(512), args, LDS_BYTES, stream);
    if (e != hipSuccess) fprintf(stderr, "cooperative launch failed: %s (grid %d)\n", hipGetErrorString(e), grid);
}
```

```cpp
#include <hip/hip_runtime.h>
#include <hip/hip_cooperative_groups.h>
#include <cstdio>
#include <cstdint>
#include <cmath>
namespace cg = cooperative_groups;
namespace pg8 {
#define PG8_LAS __attribute__((address_space(3)))
typedef unsigned short bf16_t;
typedef short bf16x8 __attribute__((ext_vector_type(8)));
typedef float f32x4 __attribute__((ext_vector_type(4)));
typedef unsigned u32x4 __attribute__((ext_vector_type(4)));
constexpr int BM = 256, BK = 64, HALF = 128, HTB = HALF * BK * 2  , STAGE_BYTES = 8 * HTB, NXCD = 8, WGM = 8;

__host__ __device__ __forceinline__ int lds_byte(int r, int c) { const int st = (r >> 4) * 2 + (c >> 5), rr = r & 15, cc = c & 31, ob = rr * 64 + cc * 2; return st * 1024 + (ob ^ (((ob >> 9) & 1) << 5)); }
__host__ __device__ __forceinline__ void stage_rc(int b, int& R, int& C) { const int st = b / 1024, sb = b % 1024, swz = sb ^ (((sb >> 9) & 1) << 5); R = (st >> 1) * 16 + swz / 64; C = (st & 1) * 32 + (swz % 64) / 2; }
__host__ __device__ __forceinline__ int perm32(int rho) { const int n = rho >> 4, i = rho & 15; return 8 * (i >> 2) + 4 * n + (i & 3); }

struct Unit { int pm, pn; };
struct Gemm { const bf16_t* A; const bf16_t* Bt; int M, N, K; };

struct StaticOrder {
    int nM, nN, nwg, G, c;
    __host__ __device__ void init(int M, int N, int G_, int c_) { nM = M / BM; nN = N / BM; nwg = nM * nN; G = G_; c = c_; }
    __host__ __device__ bool next(int i, Unit& u) const {
        const long L = (long)i * G + c; if (L >= nwg) return false;
        int wgid = (int)L; { const int q = nwg / NXCD, r = nwg % NXCD, xcd = wgid % NXCD, off = wgid / NXCD; wgid = (xcd < r ? xcd * (q + 1) : r * (q + 1) + (xcd - r) * q) + off; }
        const int nig = WGM * nN, gid = wgid / nig, fm = gid * WGM, gsz = (nM - fm) < WGM ? (nM - fm) : WGM;
        u.pm = fm + ((wgid % nig) % gsz); u.pn = (wgid % nig) / gsz; return true;
    }
    __device__ __forceinline__ void a_ready(const Unit&) const {}
    __device__ __forceinline__ void done(const Unit&) const {}
};

template <class Epi, class Sched, bool ALIGN_EPI = false, bool SP2 = false>
__device__ __forceinline__ void gemm_phase(PG8_LAS unsigned char* lds, const Gemm g, const Sched& S, const Epi& E) {
    int tid_ = threadIdx.x; asm volatile("" : "+v"(tid_));
    const int tid = tid_, wid = __builtin_amdgcn_readfirstlane(tid >> 6), lane = tid & 63, wr = wid >> 2, wc = wid & 3, fr = lane & 15, fq = lane >> 4;
    const int K = g.K, nt = K / BK;
    unsigned voffA[2], voffB[2];
#pragma unroll
    for (int i = 0; i < 2; ++i) { int R, C; stage_rc(tid * 16 + i * 8192, R, C); const int Rb = Epi::PERM ? ((R & ~31) + perm32(R & 31)) : R;
        voffA[i] = (unsigned)(R * K + C) * 2u; voffB[i] = (unsigned)(Rb * K + C) * 2u; }
    const size_t kstep = (size_t)(BK * 2);
    const size_t hstep = (size_t)HALF * K * 2;
    const size_t tstep = 2 * hstep;
    const unsigned ldsw = (unsigned)wid * 1024u;
    const int aoff = lds_byte(wr * 64 + fr, fq * 8), boff = lds_byte(wc * 32 + fr, fq * 8);
#define PG8_SA(b, h) (((b) * 2 + (h)) * HTB)
#define PG8_SB(b, h) ((4 + (b) * 2 + (h)) * HTB)
#define PG8_STAGE(bufoff, gbase, voff) do { _Pragma("unroll") for (int _i = 0; _i < 2; ++_i) \
        __builtin_amdgcn_global_load_lds((const unsigned*)((const char*)(gbase) + (voff)[_i]), (PG8_LAS unsigned*)(lds + (bufoff) + ldsw + _i * 8192), 16, 0, 0); } while (0)
#define PG8_LDA(dst, b, h) do { _Pragma("unroll") for (int m = 0; m < 4; ++m) _Pragma("unroll") for (int k = 0; k < 2; ++k) dst[m][k] = *(const PG8_LAS bf16x8*)(lds + PG8_SA(b, h) + aoff + m * 2048 + k * 1024); } while (0)
#define PG8_LDB(dst, b, h) do { _Pragma("unroll") for (int n = 0; n < 2; ++n) _Pragma("unroll") for (int k = 0; k < 2; ++k) dst[n][k] = *(const PG8_LAS bf16x8*)(lds + PG8_SB(b, h) + boff + n * 2048 + k * 1024); } while (0)
#define PG8_MMA(ai, bj, At, Bt) do { __builtin_amdgcn_s_setprio(1); _Pragma("unroll") for (int m = 0; m < 4; ++m) _Pragma("unroll") for (int n = 0; n < 2; ++n) _Pragma("unroll") for (int k = 0; k < 2; ++k) \
        acc[ai][bj][m][n] = __builtin_amdgcn_mfma_f32_16x16x32_bf16(Bt[n][k], At[m][k], acc[ai][bj][m][n], 0, 0, 0); __builtin_amdgcn_s_setprio(0); } while (0)
#define PG8_WAIT_V(n) asm volatile("s_waitcnt vmcnt(" #n ")" ::: "memory")
#define PG8_WAIT_L(n) asm volatile("s_waitcnt lgkmcnt(" #n ")" ::: "memory")
#define PG8_BAR __builtin_amdgcn_s_barrier()
#define PG8_SCHED __builtin_amdgcn_sched_barrier(0)
    Unit cur, nxt; int ui = 0;
    if (!S.next(0, cur)) return;
    f32x4 acc[2][2][4][2];
#pragma unroll
    for (int a = 0; a < 2; ++a)
#pragma unroll
        for (int b = 0; b < 2; ++b)
#pragma unroll
            for (int m = 0; m < 4; ++m)
#pragma unroll
                for (int n = 0; n < 2; ++n) acc[a][b][m][n] = (f32x4){0.f, 0.f, 0.f, 0.f};
    bf16x8 At[4][2], B0[2][2], B1[2][2];
    const char* cA = (const char*)g.A + (size_t)cur.pm * tstep; const char* cB = (const char*)g.Bt + (size_t)cur.pn * tstep;
    S.a_ready(cur);
    if constexpr (SP2) {
        PG8_STAGE(PG8_SB(0, 0), cB, voffB); PG8_STAGE(PG8_SB(0, 1), cB + hstep, voffB); PG8_STAGE(PG8_SA(0, 0), cA, voffA); PG8_STAGE(PG8_SA(0, 1), cA + hstep, voffA);
        if (wr == 1) PG8_BAR;
        PG8_WAIT_V(2); PG8_BAR;
        PG8_STAGE(PG8_SB(1, 0), cB + kstep, voffB); PG8_STAGE(PG8_SA(1, 0), cA + kstep, voffA); PG8_STAGE(PG8_SB(1, 1), cB + hstep + kstep, voffB);
        PG8_WAIT_V(6); PG8_BAR;
    } else {
        PG8_STAGE(PG8_SB(0, 0), cB, voffB); PG8_STAGE(PG8_SA(0, 0), cA, voffA); PG8_STAGE(PG8_SB(0, 1), cB + hstep, voffB); PG8_STAGE(PG8_SA(0, 1), cA + hstep, voffA);
        if (wr == 1) PG8_BAR;
        PG8_WAIT_V(4); PG8_BAR;
        PG8_STAGE(PG8_SB(1, 0), cB + kstep, voffB); PG8_STAGE(PG8_SA(1, 0), cA + kstep, voffA); PG8_STAGE(PG8_SB(1, 1), cB + hstep + kstep, voffB);
        PG8_WAIT_V(6); PG8_BAR;
    }
    for (;;) {
        const bool has_next = S.next(ui + 1, nxt);
        const char* nA = has_next ? (const char*)g.A + (size_t)nxt.pm * tstep : cA; const char* nB = has_next ? (const char*)g.Bt + (size_t)nxt.pn * tstep : cB;
        for (int t = 0; t < nt; t += 2) {
            const bool last = (t == nt - 2);
            const char* a1 = cA + (size_t)(t + 1) * kstep;
            const char* a2 = last ? nA : cA + (size_t)(t + 2) * kstep; const char* b2 = last ? nB : cB + (size_t)(t + 2) * kstep;
            const char* a3 = a2 + kstep; const char* b3 = b2 + kstep;
            if (last && has_next) S.a_ready(nxt);
            if constexpr (SP2) {
            PG8_LDB(B0, 0, 0); PG8_LDB(B1, 0, 1); PG8_SCHED; PG8_LDA(At, 0, 0); PG8_STAGE(PG8_SA(1, 1), a1 + hstep, voffA);
            PG8_WAIT_V(8); PG8_WAIT_L(0); PG8_BAR; PG8_MMA(0, 0, At, B0); PG8_MMA(0, 1, At, B1); PG8_BAR; PG8_SCHED;
            PG8_LDA(At, 0, 1); PG8_STAGE(PG8_SB(0, 0), b2, voffB); PG8_STAGE(PG8_SB(0, 1), b2 + hstep, voffB); PG8_STAGE(PG8_SA(0, 0), a2, voffA);
            PG8_WAIT_V(8); PG8_WAIT_L(0); PG8_BAR; PG8_MMA(1, 0, At, B0); PG8_MMA(1, 1, At, B1); PG8_BAR; PG8_SCHED;
            PG8_LDB(B0, 1, 0); PG8_LDB(B1, 1, 1); PG8_SCHED; PG8_LDA(At, 1, 0); PG8_STAGE(PG8_SA(0, 1), a2 + hstep, voffA);
            PG8_WAIT_V(8); PG8_WAIT_L(0); PG8_BAR; PG8_MMA(0, 0, At, B0); PG8_MMA(0, 1, At, B1); PG8_BAR; PG8_SCHED;
            PG8_LDA(At, 1, 1); PG8_STAGE(PG8_SB(1, 0), b3, voffB); PG8_STAGE(PG8_SB(1, 1), b3 + hstep, voffB); PG8_STAGE(PG8_SA(1, 0), a3, voffA);
            PG8_WAIT_V(8); PG8_WAIT_L(0); PG8_BAR; PG8_MMA(1, 0, At, B0); PG8_MMA(1, 1, At, B1); PG8_BAR; PG8_SCHED;
            } else {
            PG8_LDB(B0, 0, 0); PG8_SCHED; PG8_LDA(At, 0, 0); PG8_STAGE(PG8_SA(1, 1), a1 + hstep, voffA);
            PG8_WAIT_L(8); PG8_BAR; PG8_WAIT_L(0); PG8_MMA(0, 0, At, B0); PG8_BAR; PG8_SCHED;
            PG8_LDB(B1, 0, 1); PG8_STAGE(PG8_SB(0, 0), b2, voffB);
            PG8_BAR; PG8_WAIT_L(0); PG8_MMA(0, 1, At, B1); PG8_BAR;
            PG8_LDA(At, 0, 1); PG8_STAGE(PG8_SA(0, 0), a2, voffA);
            PG8_BAR; PG8_WAIT_L(0); PG8_MMA(1, 0, At, B0); PG8_BAR; PG8_SCHED;
            PG8_STAGE(PG8_SB(0, 1), b2 + hstep, voffB);
            PG8_WAIT_V(6); PG8_BAR; PG8_MMA(1, 1, At, B1); PG8_BAR;
            PG8_LDB(B0, 1, 0); PG8_SCHED; PG8_LDA(At, 1, 0); PG8_STAGE(PG8_SA(0, 1), a2 + hstep, voffA);
            PG8_WAIT_L(8); PG8_BAR; PG8_WAIT_L(0); PG8_MMA(0, 0, At, B0); PG8_BAR; PG8_SCHED;
            PG8_LDB(B1, 1, 1); PG8_STAGE(PG8_SB(1, 0), b3, voffB);
            PG8_BAR; PG8_WAIT_L(0); PG8_MMA(0, 1, At, B1); PG8_BAR;
            PG8_LDA(At, 1, 1); PG8_STAGE(PG8_SA(1, 0), a3, voffA);
            PG8_BAR; PG8_WAIT_L(0); PG8_MMA(1, 0, At, B0); PG8_BAR; PG8_SCHED;
            PG8_STAGE(PG8_SB(1, 1), b3 + hstep, voffB);
            PG8_WAIT_V(6); PG8_BAR; PG8_MMA(1, 1, At, B1); PG8_BAR;
            }
        }
        if constexpr (ALIGN_EPI) { if (wr == 0) PG8_BAR; }
        if constexpr (!Epi::AFTER_DRAIN) { E(acc, cur, wr, wc, fr, fq); S.done(cur); }
        if (!has_next) break;
#pragma unroll
        for (int a = 0; a < 2; ++a)
#pragma unroll
            for (int b = 0; b < 2; ++b)
#pragma unroll
                for (int m = 0; m < 4; ++m)
#pragma unroll
                    for (int n = 0; n < 2; ++n) acc[a][b][m][n] = (f32x4){0.f, 0.f, 0.f, 0.f};
        cur = nxt; cA = nA; cB = nB; ++ui;
        if constexpr (ALIGN_EPI) { if (wr == 1) PG8_BAR; }
    }
    PG8_WAIT_V(0);
    if constexpr (!ALIGN_EPI) { if (wr == 0) PG8_BAR; }
    PG8_BAR;
    if constexpr (Epi::AFTER_DRAIN) { E.fused(acc, cur, wr, wc, fr, fq, lds, wid, lane); S.done(cur); }
#undef PG8_SA
#undef PG8_SB
#undef PG8_STAGE
#undef PG8_LDA
#undef PG8_LDB
#undef PG8_MMA
#undef PG8_WAIT_V
#undef PG8_WAIT_L
#undef PG8_BAR
#undef PG8_SCHED
}
}

#define LAS __attribute__((address_space(3)))
typedef unsigned short bf16;
typedef unsigned u32x4 __attribute__((ext_vector_type(4)));
typedef unsigned u32x2 __attribute__((ext_vector_type(2)));
typedef float f32x4 __attribute__((ext_vector_type(4)));
typedef float f32x16 __attribute__((ext_vector_type(16)));
typedef short bf16x8 __attribute__((ext_vector_type(8)));
typedef short v4i16_t __attribute__((ext_vector_type(4)));

constexpr int M = 16384, DM = 2048, SEQ = 2048, NBATCH = 8, NCH = 16;
constexpr int N0P = 11264, N0R = 11296;
constexpr float EPS = 1e-5f;
constexpr float LOG2E = 1.4426950408889634f;
constexpr float QSCALE = 0.125f * LOG2E;
constexpr float LAMBDA_INIT = 0.35550906f;
constexpr size_t MiB = 1u << 20;
constexpr size_t WS_ST0 = 0, WS_ST1 = 128 * 1024, WS_ST2 = 192 * 1024, WS_CD = 256 * 1024, WS_LAM = 300 * 1024;
constexpr size_t WS_DT = 1 * MiB, WS_WSP = 3 * MiB, WS_W0IN = 4 * MiB, WS_W0OUT = 49 * MiB, WS_W1IN = 65 * MiB, WS_W1OUT = 97 * MiB;
constexpr size_t WS_YCAT = 105 * MiB, WS_ZA = 233 * MiB, WS_V = 297 * MiB, WS_H0 = 361 * MiB, WS_XT = 425 * MiB, WS_CN = 489 * MiB, WS_END = 505 * MiB;
constexpr size_t WS_Q = WS_YCAT, WS_K = WS_YCAT + 64 * MiB, WS_X1 = WS_ZA, WS_STATES = WS_V, WS_VT = WS_H0, WS_X1B = WS_H0, WS_O = WS_ZA, WS_VV = WS_XT;
constexpr size_t DO_XBC = 0, DO_BN = 96 * MiB, DO_BT = 112 * MiB, DO_PREV = 0, DO_G = 0;
constexpr int LDS_BYTES = 147456;

__device__ __forceinline__ unsigned pk2(float lo, float hi) {
    typedef float f2 __attribute__((ext_vector_type(2))); typedef __bf16 b2 __attribute__((ext_vector_type(2)));
    f2 v = {lo, hi}; b2 b = __builtin_convertvector(v, b2); return __builtin_bit_cast(unsigned, b);
}
__device__ __forceinline__ float bflo(unsigned u) { return __uint_as_float(u << 16); }
__device__ __forceinline__ float bfhi(unsigned u) { return __uint_as_float(u & 0xffff0000u); }
__device__ __forceinline__ void unpack8(u32x4 r, float* f) { f[0] = bflo(r.x); f[1] = bfhi(r.x); f[2] = bflo(r.y); f[3] = bfhi(r.y); f[4] = bflo(r.z); f[5] = bfhi(r.z); f[6] = bflo(r.w); f[7] = bfhi(r.w); }
__device__ __forceinline__ u32x4 pack8(const float* f) { u32x4 o; o.x = pk2(f[0], f[1]); o.y = pk2(f[2], f[3]); o.z = pk2(f[4], f[5]); o.w = pk2(f[6], f[7]); return o; }
__device__ __forceinline__ float fexp2(float x) { return __builtin_amdgcn_exp2f(x); }
__device__ __forceinline__ float gelu_f(float x) { const float z = 1.5957691216057308f * (x + 0.044715f * x * x * x); return x * __builtin_amdgcn_rcpf(1.0f + __expf(-z)); }
__device__ __forceinline__ float silu_f(float x) { return x * __builtin_amdgcn_rcpf(1.0f + __expf(-x)); }
__device__ __forceinline__ int crow(int r, int h) { return (r & 3) + 8 * (r >> 2) + 4 * h; }
__device__ __forceinline__ f32x16 mfma32(bf16x8 a, bf16x8 b, f32x16 c) { return __builtin_amdgcn_mfma_f32_32x32x16_bf16(a, b, c, 0, 0, 0); }
__device__ __forceinline__ bf16x8 ld_frag16(const bf16* p) { return __builtin_bit_cast(bf16x8, *(const u32x4*)p); }
__device__ __forceinline__ bf16x8 ld_frag8x2(const bf16* p) { const u32x2 lo = *(const u32x2*)p, hi = *(const u32x2*)(p + 8); u32x4 v; v.x = lo.x; v.y = lo.y; v.z = hi.x; v.w = hi.y; return __builtin_bit_cast(bf16x8, v); }
__device__ __forceinline__ bf16x8 pack_frag(const f32x16& x, int s) {
    u32x4 v; v.x = pk2(x[8 * s], x[8 * s + 1]); v.y = pk2(x[8 * s + 2], x[8 * s + 3]); v.z = pk2(x[8 * s + 4], x[8 * s + 5]); v.w = pk2(x[8 * s + 6], x[8 * s + 7]); return __builtin_bit_cast(bf16x8, v);
}
__device__ __forceinline__ float wave_sum(float v) {
#pragma unroll
    for (int o = 1; o < 64; o <<= 1) v += __shfl_xor(v, o);
    return v;
}
#define LDS_WAIT() asm volatile("s_waitcnt lgkmcnt(0)" ::: "memory")
__device__ __forceinline__ void atomic_addf(float* p, float v) { __hip_atomic_fetch_add(p, v, __ATOMIC_RELAXED, __HIP_MEMORY_SCOPE_AGENT); }

struct Params { const float* in[23]; float* out; unsigned char* ws; };
constexpr int PTAB_OFF = LDS_BYTES - 512;
__device__ __forceinline__ unsigned long long ptab_get(int i) {
    const unsigned long long v = ((const LAS unsigned long long*)(PTAB_OFF))[i];
    const unsigned lo = __builtin_amdgcn_readfirstlane((unsigned)v), hi = __builtin_amdgcn_readfirstlane((unsigned)(v >> 32));
    return ((unsigned long long)hi << 32) | lo;
}
struct PT {
    struct InTab { __device__ __forceinline__ const float* operator[](int i) const { return (const float*)(const __attribute__((address_space(1))) float*)ptab_get(i); } } in;
    float* out; unsigned char* ws;
    __device__ __forceinline__ PT() { out = (float*)(__attribute__((address_space(1))) float*)ptab_get(23); ws = (unsigned char*)(__attribute__((address_space(1))) unsigned char*)ptab_get(24); }
};

template <int ACT>
__device__ __forceinline__ void epi_tile_bf16(const f32x4 (&acc)[2][2][4][2], bf16* base, int pitch, int col0, int row0, float sc) {
#pragma unroll
    for (int ai = 0; ai < 2; ++ai)
#pragma unroll
        for (int m = 0; m < 4; ++m) {
            bf16* rowp = base + (size_t)(row0 + ai * 128 + m * 16) * pitch + col0;
#pragma unroll
            for (int bj = 0; bj < 2; ++bj) {
                float v[8];
#pragma unroll
                for (int j = 0; j < 4; ++j) { v[j] = acc[ai][bj][m][0][j]; v[4 + j] = acc[ai][bj][m][1][j]; }
#pragma unroll
                for (int j = 0; j < 8; ++j) { if (ACT == 1) v[j] = gelu_f(v[j]); else if (ACT == 2) v[j] = silu_f(v[j]); else if (ACT == 3) v[j] *= sc; }
                *(u32x4*)(rowp + bj * 128) = pack8(v);
            }
        }
}

struct EpiIn0 {
    static constexpr bool PERM = true, AFTER_DRAIN = false;
    bf16 *ycat, *vbuf, *za, *xbc; float* stats0;
    __device__ __forceinline__ void operator()(const f32x4 (&acc)[2][2][4][2], const pg8::Unit& u, int wr, int wc, int fr, int fq) const {
        const int pn = u.pn, row0 = u.pm * 256 + wr * 64 + fr, cl = wc * 32 + 8 * fq;
        if (pn < 8) { epi_tile_bf16<1>(acc, ycat, 4096, pn * 256 + cl, row0, 1.f); }
        else if (pn < 16) {
#pragma unroll
            for (int ai = 0; ai < 2; ++ai)
#pragma unroll
                for (int m = 0; m < 4; ++m) {
                    const int row = row0 + ai * 128 + m * 16;
                    bf16* rowp = vbuf + (size_t)row * 2048 + (pn - 8) * 256 + cl;
                    float s = 0.f, ss = 0.f;
#pragma unroll
                    for (int bj = 0; bj < 2; ++bj) {
                        float v[8];
#pragma unroll
                        for (int j = 0; j < 4; ++j) { v[j] = gelu_f(acc[ai][bj][m][0][j]); v[4 + j] = gelu_f(acc[ai][bj][m][1][j]); }
#pragma unroll
                        for (int j = 0; j < 8; ++j) { s += v[j]; ss += v[j] * v[j]; }
                        *(u32x4*)(rowp + bj * 128) = pack8(v);
                    }
                    s += __shfl_xor(s, 16); s += __shfl_xor(s, 32); ss += __shfl_xor(ss, 16); ss += __shfl_xor(ss, 32);
                    if (fq == 0) { atomic_addf(stats0 + 2 * row, s); atomic_addf(stats0 + 2 * row + 1, ss); }
                }
        }
        else if (pn < 24) { epi_tile_bf16<2>(acc, za, 2048, (pn - 16) * 256 + cl, row0, 1.f); }
        else if (pn < 32) { epi_tile_bf16<2>(acc, ycat, 4096, 2048 + (pn - 24) * 256 + cl, row0, 1.f); }
        else { epi_tile_bf16<0>(acc, xbc, 3072, (pn - 32) * 256 + cl, row0, 1.f); }
    }
};

__device__ __forceinline__ void dt_tasks(const PT& p, int lane, int wave) {
    if (wave >= 2) return;
    unsigned char* ws = p.ws; const bf16* H0 = (const bf16*)(ws + WS_H0); const bf16* Wdt = (const bf16*)(ws + WS_W0IN) + (size_t)11264 * 2048; float* DT = (float*)(ws + WS_DT);
    const int r32 = lane & 31, h = lane >> 5;
    for (int task = wave * gridDim.x + blockIdx.x; task < 512; task += 2 * gridDim.x) {
        const bf16* ap = Wdt + (size_t)r32 * 2048 + 8 * h; const bf16* bp = H0 + (size_t)(task * 32 + r32) * 2048 + 8 * h;
        f32x16 acc;
#pragma unroll
        for (int i = 0; i < 16; ++i) acc[i] = 0.f;
#pragma unroll 8
        for (int st = 0; st < 128; ++st) acc = mfma32(ld_frag16(ap + 16 * st), ld_frag16(bp + 16 * st), acc);
#pragma unroll
        for (int qd = 0; qd < 4; ++qd) {
            const int j0 = 8 * qd + 4 * h; const f32x4 bb = *(const f32x4*)(p.in[9] + j0); f32x4 v;
#pragma unroll
            for (int j = 0; j < 4; ++j) { const float x = acc[4 * qd + j] + bb[j]; v[j] = x > 20.f ? x : log1pf(__expf(x)); }
            *(f32x4*)(DT + (size_t)(task * 32 + r32) * 32 + j0) = v;
        }
    }
}
template <bool RB16> struct EpiResT {
    static constexpr bool PERM = true, AFTER_DRAIN = false;
    const void* resid; float* outf; bf16* outb; float* stats;
    __device__ __forceinline__ void operator()(const f32x4 (&acc)[2][2][4][2], const pg8::Unit& u, int wr, int wc, int fr, int fq) const {
        const int row0 = u.pm * 256 + wr * 64 + fr, col0 = u.pn * 256 + wc * 32 + 8 * fq;
#pragma unroll
        for (int ai = 0; ai < 2; ++ai)
#pragma unroll
            for (int m = 0; m < 4; ++m) {
                const int row = row0 + ai * 128 + m * 16; const size_t off = (size_t)row * 2048 + col0;
                float ss = 0.f;
#pragma unroll
                for (int bj = 0; bj < 2; ++bj) {
                    f32x4 r0, r1;
                    if (RB16) { float f[8]; unpack8(*(const u32x4*)((const bf16*)resid + off + bj * 128), f); r0 = (f32x4){f[0], f[1], f[2], f[3]}; r1 = (f32x4){f[4], f[5], f[6], f[7]}; }
                    else { r0 = *(const f32x4*)((const float*)resid + off + bj * 128); r1 = *(const f32x4*)((const float*)resid + off + bj * 128 + 4); }
                    r0 = r0 + acc[ai][bj][m][0]; r1 = r1 + acc[ai][bj][m][1];
                    if (outf) { *(f32x4*)(outf + off + bj * 128) = r0; *(f32x4*)(outf + off + bj * 128 + 4) = r1; }
                    ss += (r0[0] * r0[0] + r0[1] * r0[1]) + (r0[2] * r0[2] + r0[3] * r0[3]) + (r1[0] * r1[0] + r1[1] * r1[1]) + (r1[2] * r1[2] + r1[3] * r1[3]);
                    if (outb) { u32x4 w; w.x = pk2(r0[0], r0[1]); w.y = pk2(r0[2], r0[3]); w.z = pk2(r1[0], r1[1]); w.w = pk2(r1[2], r1[3]); *(u32x4*)(outb + off + bj * 128) = w; }
                }
                ss += __shfl_xor(ss, 16); ss += __shfl_xor(ss, 32);
                if (fq == 0) atomic_addf(stats + row, ss);
            }
    }
};

struct EpiIn1 {
    static constexpr bool PERM = true, AFTER_DRAIN = false;
    bf16 *q, *k, *v, *g; const float* stats1;
    __device__ __forceinline__ void operator()(const f32x4 (&acc)[2][2][4][2], const pg8::Unit& u, int wr, int wc, int fr, int fq) const {
        const int seg = u.pn >> 3, row0 = u.pm * 256 + wr * 64 + fr, col0 = (u.pn & 7) * 256 + wc * 32 + 8 * fq;
        bf16* base = seg == 0 ? q : (seg == 1 ? k : (seg == 2 ? v : g));
        const float sc = seg == 0 ? QSCALE : 1.f;
#pragma unroll
        for (int ai = 0; ai < 2; ++ai)
#pragma unroll
            for (int m = 0; m < 4; ++m) {
                const int row = row0 + ai * 128 + m * 16;
                const float rs = rsqrtf(stats1[row] * (1.f / 2048.f) + EPS) * sc;
                bf16* rowp = base + (size_t)row * 2048 + col0;
#pragma unroll
                for (int bj = 0; bj < 2; ++bj) {
                    float v8[8];
#pragma unroll
                    for (int j = 0; j < 4; ++j) { v8[j] = acc[ai][bj][m][0][j] * rs; v8[4 + j] = acc[ai][bj][m][1][j] * rs; }
                    if (seg == 3) {
#pragma unroll
                        for (int j = 0; j < 8; ++j) v8[j] = silu_f(v8[j]);
                    }
                    *(u32x4*)(rowp + bj * 128) = pack8(v8);
                }
            }
    }
};

__device__ __forceinline__ void transpose_item(const float* W, int K, int N, bf16* WT, int item, int lane, const float* kscale) {
    const int nblk = N / 32, kb = item / nblk, nb = item % nblk, kq = lane & 7, c4 = lane >> 3;
    const int k0 = 64 * kb + 8 * kq, n0 = 32 * nb + 4 * c4;
    f32x4 v[8];
#pragma unroll
    for (int i = 0; i < 8; ++i) v[i] = *(const f32x4*)(W + (size_t)(k0 + i) * N + n0);
    if (kscale) {
        const f32x4 g0 = *(const f32x4*)(kscale + k0), g1 = *(const f32x4*)(kscale + k0 + 4);
#pragma unroll
        for (int i = 0; i < 4; ++i) { v[i] = v[i] * g0[i]; v[4 + i] = v[4 + i] * g1[i]; }
    }
#pragma unroll
    for (int j = 0; j < 4; ++j) {
        u32x4 o; o.x = pk2(v[0][j], v[1][j]); o.y = pk2(v[2][j], v[3][j]); o.z = pk2(v[4][j], v[5][j]); o.w = pk2(v[6][j], v[7][j]);
        *(u32x4*)(WT + (size_t)(n0 + j) * K + k0) = o;
    }
}

__device__ __forceinline__ void phase0(const PT& p, LAS unsigned char* lds, int tid, int lane, int wave) {
    unsigned char* ws = p.ws;
    const int gw = blockIdx.x * 8 + wave, NGW = gridDim.x * 8;
    const int gt = blockIdx.x * 512 + tid, NGT = gridDim.x * 512;
    for (int i = gt; i < 65536; i += NGT) ((float*)(ws + WS_ST0))[i] = 0.f;
    constexpr int I0 = 32 * (N0R / 32), I1 = 64 * 64, I2 = 32 * 256, I3 = 32 * 64;
    for (int it = gw; it < I0 + I1 + I2 + I3; it += NGW) {
        int r = it;
        if (r < I0) { transpose_item(p.in[2], 2048, N0R, (bf16*)(ws + WS_W0IN), r, lane, nullptr); continue; } r -= I0;
        if (r < I1) { transpose_item(p.in[13], 4096, 2048, (bf16*)(ws + WS_W0OUT), r, lane, nullptr); continue; } r -= I1;
        if (r < I2) { transpose_item(p.in[15], 2048, 8192, (bf16*)(ws + WS_W1IN), r, lane, p.in[14]); continue; } r -= I2;
        transpose_item(p.in[21], 2048, 2048, (bf16*)(ws + WS_W1OUT), r, lane, nullptr);
    }
    for (int i = gt; i < 16 * 128 * 128 / 8; i += NGT) {
        const int e = i * 8, t = (e >> 7) & 127, s0 = e & 127; const float* src = p.in[5] + e; float v[8];
#pragma unroll
        for (int j = 0; j < 8; ++j) v[j] = (s0 + j <= t) ? src[j] : 0.f;
        ((u32x4*)(ws + WS_WSP))[i] = pack8(v);
    }
    const float* g0 = p.in[1]; bf16* H0 = (bf16*)(ws + WS_H0);
    for (int m = gw; m < M; m += NGW) {
        const f32x4* xr = (const f32x4*)(p.in[0] + (size_t)m * 2048) + lane; f32x4 v[8]; float s = 0.f;
#pragma unroll
        for (int j = 0; j < 8; ++j) { v[j] = xr[64 * j]; s += (v[j].x * v[j].x + v[j].y * v[j].y) + (v[j].z * v[j].z + v[j].w * v[j].w); }
        const float rs = rsqrtf(wave_sum(s) * (1.f / 2048.f) + EPS);
        u32x2* o = (u32x2*)(H0 + (size_t)m * 2048) + lane;
#pragma unroll
        for (int j = 0; j < 8; ++j) { const f32x4 g = ((const f32x4*)g0)[lane + 64 * j]; u32x2 w; w.x = pk2(v[j].x * rs * g.x, v[j].y * rs * g.y); w.y = pk2(v[j].z * rs * g.z, v[j].w * rs * g.w); o[64 * j] = w; }
    }
}

__device__ __forceinline__ void phase_layout(const PT& p, int tid) {
    unsigned char* ws = p.ws; unsigned char* dob = (unsigned char*)p.out;
    const bf16* Vb = (const bf16*)(ws + WS_V); const float* st0 = (const float*)(ws + WS_ST0);
    const bf16* XBC = (const bf16*)(dob + DO_XBC);
    bf16 *vT = (bf16*)(ws + WS_VT), *xT = (bf16*)(ws + WS_XT), *Bn = (bf16*)(dob + DO_BN), *BT = (bf16*)(dob + DO_BT), *Cn = (bf16*)(ws + WS_CN);
    const int t = tid & 255, so = t >> 4, co = t & 15;
    for (int pi = blockIdx.x * 2 + (tid >> 8); pi < 128 * 24; pi += gridDim.x * 2) {
        const int bc = pi / 24, k = 16 + pi % 24; const int tok0 = bc * 128 + so * 8;
        float o[8][8];
        if (k < 16) {
            const int ch0 = k * 128 + co * 8;
            float g[8], bb[8];
#pragma unroll
            for (int j = 0; j < 8; ++j) { g[j] = p.in[3][ch0 + j]; bb[j] = p.in[4][ch0 + j]; }
#pragma unroll
            for (int i = 0; i < 8; ++i) {
                const int row = tok0 + i; float f[8]; unpack8(*(const u32x4*)(Vb + (size_t)row * 2048 + ch0), f);
                const float mu = st0[2 * row] * (1.f / 2048.f), var = st0[2 * row + 1] * (1.f / 2048.f) - mu * mu, rs = rsqrtf(fmaxf(var, 0.f) + EPS);
#pragma unroll
                for (int j = 0; j < 8; ++j) o[i][j] = (f[j] - mu) * rs * g[j] + bb[j];
            }
#pragma unroll
            for (int j = 0; j < 8; ++j) { float c8[8];
#pragma unroll
                for (int i = 0; i < 8; ++i) c8[i] = o[i][j];
                *(u32x4*)(vT + ((size_t)bc * 2048 + ch0 + j) * 128 + so * 8) = pack8(c8); }
        } else {
            const int sc0 = (k - 16) * 128 + co * 8;
            float cw[4][8], cb[8];
#pragma unroll
            for (int j = 0; j < 8; ++j) { cb[j] = p.in[8][sc0 + j];
#pragma unroll
                for (int kk = 0; kk < 4; ++kk) cw[kk][j] = p.in[7][kk * 3072 + sc0 + j]; }
            const int pos0 = (bc & 15) * 128 + so * 8;
            float xw[11][8];
#pragma unroll
            for (int ii = 0; ii < 11; ++ii) {
                if (pos0 - 3 + ii >= 0) unpack8(*(const u32x4*)(XBC + (size_t)(tok0 - 3 + ii) * 3072 + sc0), xw[ii]);
                else {
#pragma unroll
                    for (int j = 0; j < 8; ++j) xw[ii][j] = 0.f;
                }
            }
#pragma unroll
            for (int i = 0; i < 8; ++i)
#pragma unroll
                for (int j = 0; j < 8; ++j) { float a = cb[j];
#pragma unroll
                    for (int kk = 0; kk < 4; ++kk) a += cw[kk][j] * xw[i + kk][j];
                    o[i][j] = silu_f(a); }
            if (k < 32) {
#pragma unroll
                for (int j = 0; j < 8; ++j) { float c8[8];
#pragma unroll
                    for (int i = 0; i < 8; ++i) c8[i] = o[i][j];
                    *(u32x4*)(xT + ((size_t)bc * 2048 + sc0 + j) * 128 + so * 8) = pack8(c8); }
            } else if (k < 36) {
                const int n0 = sc0 - 2048;
#pragma unroll
                for (int i = 0; i < 8; ++i) *(u32x4*)(Bn + (size_t)(tok0 + i) * 512 + n0) = pack8(o[i]);
#pragma unroll
                for (int j = 0; j < 8; ++j) { float c8[8];
#pragma unroll
                    for (int i = 0; i < 8; ++i) c8[i] = o[i][j];
                    *(u32x4*)(BT + ((size_t)bc * 512 + n0 + j) * 128 + so * 8) = pack8(c8); }
            } else {
                const int n0 = sc0 - 2560;
#pragma unroll
                for (int i = 0; i < 8; ++i) *(u32x4*)(Cn + (size_t)(tok0 + i) * 512 + n0) = pack8(o[i]);
            }
        }
    }
}

__device__ __forceinline__ void chunk_cumsum(const float* DT, const float* a_log, int tok0, int hh, int lane, float& d0, float& d1, float& c0, float& c1, float& tot) {
    d0 = DT[(size_t)(tok0 + 2 * lane) * 32 + hh]; d1 = DT[(size_t)(tok0 + 2 * lane + 1) * 32 + hh];
    const float A = -__expf(a_log[hh]); const float x0 = d0 * A, x1 = d1 * A; float ps = x0 + x1;
#pragma unroll
    for (int o = 1; o < 64; o <<= 1) { const float t = __shfl_up(ps, o); if (lane >= o) ps += t; }
    c1 = ps; c0 = ps - x1; tot = __shfl(ps, 63);
}

__device__ __forceinline__ void phase_mix(const PT& p, LAS unsigned char* lds, int tid, int lane, int wave) {
    unsigned char* ws = p.ws; unsigned char* dob = (unsigned char*)p.out;
    const int r32 = lane & 31, h = lane >> 5;
    bf16* Ycat = (bf16*)(ws + WS_YCAT); const bf16* ZA = (const bf16*)(ws + WS_ZA); const bf16* Vb = (const bf16*)(ws + WS_V); const float* st0 = (const float*)(ws + WS_ST0); const bf16* Wsp = (const bf16*)(ws + WS_WSP);
    const bf16* xT = (const bf16*)(ws + WS_XT); const bf16* BT = (const bf16*)(dob + DO_BT); const float* DT = (const float*)(ws + WS_DT);
    bf16* ST = (bf16*)(ws + WS_STATES); float* CD = (float*)(ws + WS_CD);
    LAS float* wtab = (LAS float*)lds;
    constexpr int NG = 128 * 16, NS = NBATCH * 15 * 4;
    for (int it = blockIdx.x; it < NG + NS; it += gridDim.x) {
        if (it < NG) {
            const int bc = it >> 4, g = it & 15, cb = wave & 3, th = wave >> 2;
            const int ch0 = g * 128 + cb * 32;
            __syncthreads();
            {
                const int c16 = tid & 15; float lg[8], lb[8];
#pragma unroll
                for (int j = 0; j < 8; ++j) { lg[j] = p.in[3][g * 128 + 8 * c16 + j]; lb[j] = p.in[4][g * 128 + 8 * c16 + j]; }
#pragma unroll
                for (int i = 0; i < 4; ++i) {
                    const int row = (tid >> 4) + 32 * i; const size_t tokr = (size_t)bc * 128 + row;
                    float f[8]; unpack8(*(const u32x4*)(Vb + tokr * 2048 + g * 128 + 8 * c16), f);
                    const float mu = st0[2 * tokr] * (1.f / 2048.f), var = st0[2 * tokr + 1] * (1.f / 2048.f) - mu * mu, rs = rsqrtf(fmaxf(var, 0.f) + EPS);
#pragma unroll
                    for (int j = 0; j < 8; ++j) f[j] = (f[j] - mu) * rs * lg[j] + lb[j];
                    *(LAS u32x4*)(lds + row * 272 + 16 * c16) = pack8(f);
                }
            }
            __syncthreads();
            const LAS unsigned char* ap = lds + (8 * h + ((lane & 15) >> 2)) * 272 + (cb * 32 + 16 * ((lane >> 4) & 1)) * 2 + (lane & 3) * 8;
            f32x16 acc[2];
#pragma unroll
            for (int i = 0; i < 16; ++i) { acc[0][i] = 0.f; acc[1][i] = 0.f; }
#pragma unroll
            for (int st = 0; st < 8; ++st) {
                const v4i16_t lo = __builtin_amdgcn_ds_read_tr16_b64_v4i16((LAS v4i16_t*)(ap + 16 * st * 272)), hi = __builtin_amdgcn_ds_read_tr16_b64_v4i16((LAS v4i16_t*)(ap + (16 * st + 4) * 272));
                const bf16x8 a = {lo[0], lo[1], lo[2], lo[3], hi[0], hi[1], hi[2], hi[3]};
#pragma unroll
                for (int t2 = 0; t2 < 2; ++t2) { const int tb = 2 * th + t2;
                    if (st < 2 * (tb + 1)) { const bf16x8 b = ld_frag16(Wsp + ((size_t)g * 128 + tb * 32 + r32) * 128 + 16 * st + 8 * h); acc[t2] = mfma32(a, b, acc[t2]); } }
            }
#pragma unroll
            for (int t2 = 0; t2 < 2; ++t2) {
                const int t = (2 * th + t2) * 32 + r32; const size_t tok = (size_t)bc * 128 + t; const float sb = p.in[6][g * 128 + t];
#pragma unroll
                for (int qd = 0; qd < 4; ++qd) {
                    const int ch = ch0 + 8 * qd + 4 * h;
                    u32x2* up = (u32x2*)(Ycat + tok * 4096 + ch); const u32x2 uu = *up, zz = *(const u32x2*)(ZA + tok * 2048 + ch);
                    const float y0 = bflo(uu.x) * (acc[t2][4 * qd] + sb) * bflo(zz.x), y1 = bfhi(uu.x) * (acc[t2][4 * qd + 1] + sb) * bfhi(zz.x);
                    const float y2 = bflo(uu.y) * (acc[t2][4 * qd + 2] + sb) * bflo(zz.y), y3 = bfhi(uu.y) * (acc[t2][4 * qd + 3] + sb) * bfhi(zz.y);
                    u32x2 w; w.x = pk2(y0, y1); w.y = pk2(y2, y3); *up = w;
                }
            }
        } else {
            const int id = it - NG, b = id / 60, c = (id / 4) % 15, grp = id & 3; const int bc = b * 16 + c, tok0 = bc * 128;
            __syncthreads();
            { const int hh = grp * 8 + wave; float d0, d1, c0, c1, tot; chunk_cumsum(DT, p.in[10], tok0, hh, lane, d0, d1, c0, c1, tot);
              wtab[wave * 128 + 2 * lane] = d0 * __expf(tot - c0); wtab[wave * 128 + 2 * lane + 1] = d1 * __expf(tot - c1);
              if (lane == 0) CD[bc * 32 + hh] = __expf(tot); }
            __syncthreads();
#pragma unroll 1
            for (int tk = 0; tk < 2; ++tk) {
                const int r = (wave >> 1) + 4 * tk, pb = wave & 1, hh = grp * 8 + r;
                const bf16* ap = xT + ((size_t)bc * 2048 + hh * 64 + pb * 32 + r32) * 128 + 8 * h;
                const bf16* bp = BT + ((size_t)bc * 512 + grp * 128 + r32) * 128 + 8 * h;
                f32x16 acc[4];
#pragma unroll
                for (int nb = 0; nb < 4; ++nb)
#pragma unroll
                    for (int i = 0; i < 16; ++i) acc[nb][i] = 0.f;
#pragma unroll
                for (int st = 0; st < 8; ++st) {
                    float f[8]; unpack8(*(const u32x4*)(ap + 16 * st), f);
                    const f32x4 w0 = *(const LAS f32x4*)(wtab + r * 128 + 16 * st + 8 * h), w1 = *(const LAS f32x4*)(wtab + r * 128 + 16 * st + 8 * h + 4);
                    f[0] *= w0.x; f[1] *= w0.y; f[2] *= w0.z; f[3] *= w0.w; f[4] *= w1.x; f[5] *= w1.y; f[6] *= w1.z; f[7] *= w1.w;
                    const bf16x8 a = __builtin_bit_cast(bf16x8, pack8(f));
#pragma unroll
                    for (int nb = 0; nb < 4; ++nb) { const bf16x8 bfr = ld_frag16(bp + (size_t)nb * 32 * 128 + 16 * st); acc[nb] = mfma32(a, bfr, acc[nb]); }
                }
                bf16* sp = ST + ((size_t)(bc * 32 + hh) * 64 + pb * 32) * 128;
#pragma unroll
                for (int nb = 0; nb < 4; ++nb)
#pragma unroll
                    for (int i = 0; i < 16; ++i) sp[(size_t)crow(i, h) * 128 + nb * 32 + r32] = (bf16)(pk2(acc[nb][i], 0.f) & 0xffffu);
            }
        }
    }
}

__device__ __forceinline__ void phase_scan(const PT& p, int tid) {
    unsigned char* ws = p.ws; const bf16* ST = (const bf16*)(ws + WS_STATES); const float* CD = (const float*)(ws + WS_CD); bf16* PV = (bf16*)((unsigned char*)p.out + DO_PREV);
    for (int id = blockIdx.x * 512 + tid; id < NBATCH * 32 * 64 * 16; id += gridDim.x * 512) {
        const int b = id >> 15, rem = id & 32767, hh = rem >> 10;
        float run[8];
#pragma unroll
        for (int j = 0; j < 8; ++j) run[j] = 0.f;
#pragma unroll
        for (int c = 0; c < 16; ++c) {
            const size_t off = ((size_t)(b * 16 + c) * 32 * 64 * 16 + rem) * 8;
            *(u32x4*)(PV + off) = pack8(run);
            if (c < 15) { float s[8]; unpack8(*(const u32x4*)(ST + off), s); const float cd = CD[(b * 16 + c) * 32 + hh];
#pragma unroll
                for (int j = 0; j < 8; ++j) run[j] = run[j] * cd + s[j]; }
        }
    }
}

__device__ __forceinline__ void phase_ssd_y(const PT& p, LAS unsigned char* lds, int tid, int lane, int wave) {
    unsigned char* ws = p.ws; unsigned char* dob = (unsigned char*)p.out;
    const int r32 = lane & 31, h = lane >> 5;
    bf16* Ycat = (bf16*)(ws + WS_YCAT); const bf16* xT = (const bf16*)(ws + WS_XT); const bf16* Bn = (const bf16*)(dob + DO_BN); const bf16* Cn = (const bf16*)(ws + WS_CN);
    const bf16* PV = (const bf16*)(dob + DO_PREV); const float* DT = (const float*)(ws + WS_DT);
    LAS float* acum = (LAS float*)lds; LAS float* dtt = acum + 1024; LAS float* ssqp = dtt + 1024;
    for (int it = blockIdx.x; it < 128 * 4; it += gridDim.x) {
        const int bc = it >> 2, grp = it & 3, tok0 = bc * 128;
        __syncthreads();
        { const int hh = grp * 8 + wave; float d0, d1, c0, c1, tot; chunk_cumsum(DT, p.in[10], tok0, hh, lane, d0, d1, c0, c1, tot);
          acum[wave * 128 + 2 * lane] = c0; acum[wave * 128 + 2 * lane + 1] = c1; dtt[wave * 128 + 2 * lane] = d0; dtt[wave * 128 + 2 * lane + 1] = d1; }
        __syncthreads();
        const int pb = wave >> 2, lb = wave & 3, l = lb * 32 + r32; const size_t tok = (size_t)tok0 + l;
        bf16x8 cf[8];
#pragma unroll
        for (int st = 0; st < 8; ++st) cf[st] = ld_frag16(Cn + tok * 512 + grp * 128 + 16 * st + 8 * h);
        f32x16 X[4];
#pragma unroll
        for (int sb = 0; sb < 4; ++sb) {
#pragma unroll
            for (int i = 0; i < 16; ++i) X[sb][i] = 0.f;
            if (sb <= lb) {
#pragma unroll
                for (int st = 0; st < 8; ++st) X[sb] = mfma32(ld_frag16(Bn + ((size_t)tok0 + sb * 32 + r32) * 512 + grp * 128 + 16 * st + 8 * h), cf[st], X[sb]);
            }
        }
        float ssq = 0.f;
#pragma unroll 2
        for (int r = 0; r < 8; ++r) {
            const int hh = grp * 8 + r;
            f32x16 acc;
#pragma unroll
            for (int i = 0; i < 16; ++i) acc[i] = 0.f;
            const bf16* pp = PV + ((size_t)(bc * 32 + hh) * 64 + pb * 32 + r32) * 128 + 8 * h;
#pragma unroll
            for (int st = 0; st < 8; ++st) acc = mfma32(ld_frag16(pp + 16 * st), cf[st], acc);
            const float al = acum[r * 128 + l]; const float el = __expf(al); const float dsk = p.in[11][hh];
#pragma unroll
            for (int i = 0; i < 16; ++i) acc[i] *= el;
            const bf16* xrow = xT + ((size_t)bc * 2048 + hh * 64 + pb * 32 + r32) * 128 + 4 * h;
#pragma unroll
            for (int sb = 0; sb < 4; ++sb) {
                if (sb <= lb) {
                    f32x16 mm;
#pragma unroll
                    for (int qd = 0; qd < 4; ++qd) {
                        const int s0 = sb * 32 + 8 * qd + 4 * h;
                        const f32x4 as = *(const LAS f32x4*)(acum + r * 128 + s0), ds = *(const LAS f32x4*)(dtt + r * 128 + s0);
#pragma unroll
                        for (int j = 0; j < 4; ++j) { const float v = X[sb][4 * qd + j] * __expf(al - as[j]) * ds[j]; mm[4 * qd + j] = (s0 + j < l) ? v : ((s0 + j == l) ? v + dsk : 0.f); }
                    }
#pragma unroll
                    for (int s2 = 0; s2 < 2; ++s2) acc = mfma32(ld_frag8x2(xrow + sb * 32 + 16 * s2), pack_frag(mm, s2), acc);
                }
            }
#pragma unroll
            for (int qd = 0; qd < 4; ++qd) {
                const int ch = hh * 64 + pb * 32 + 8 * qd + 4 * h;
                u32x2* yp = (u32x2*)(Ycat + tok * 4096 + 2048 + ch); const u32x2 zz = *yp;
                const float y0 = acc[4 * qd] * bflo(zz.x), y1 = acc[4 * qd + 1] * bfhi(zz.x);
                const float y2 = acc[4 * qd + 2] * bflo(zz.y), y3 = acc[4 * qd + 3] * bfhi(zz.y);
                ssq += (y0 * y0 + y1 * y1) + (y2 * y2 + y3 * y3);
                u32x2 w; w.x = pk2(y0, y1); w.y = pk2(y2, y3); *yp = w;
            }
        }
        ssq += __shfl_xor(ssq, 32);
        if (h == 0) ssqp[pb * 128 + l] = ssq;
        __syncthreads();
        const float rs = rsqrtf((ssqp[l] + ssqp[128 + l]) * (1.f / 512.f) + EPS);
#pragma unroll 1
        for (int r = 0; r < 8; ++r) {
#pragma unroll
            for (int qd = 0; qd < 4; ++qd) {
                const int ch = (grp * 8 + r) * 64 + pb * 32 + 8 * qd + 4 * h;
                u32x2* yp = (u32x2*)(Ycat + tok * 4096 + 2048 + ch); const u32x2 yy = *yp; const f32x4 g = *(const f32x4*)(p.in[12] + ch);
                u32x2 w; w.x = pk2(bflo(yy.x) * rs * g.x, bfhi(yy.x) * rs * g.y); w.y = pk2(bflo(yy.y) * rs * g.z, bfhi(yy.y) * rs * g.w); *yp = w;
            }
        }
    }
}

constexpr int AK_PITCH = 272, AV_PITCH = 272, A_KOFF = 0, A_VOFF = 128 * AK_PITCH, A_STAGE = A_VOFF + 128 * AV_PITCH;
static_assert(2 * A_STAGE <= PTAB_OFF && 4 * 16384 <= A_STAGE, "attention LDS map");
__device__ __forceinline__ float max3f(float a, float b, float c) { return fmaxf(fmaxf(a, b), c); }
__device__ __forceinline__ void attn_unit(const PT& p, LAS unsigned char* lds, int tid, int lane, int wave, int b, int hd, int qb, float lam) {
    unsigned char* ws = p.ws;
    const bf16* Qb = (const bf16*)(ws + WS_Q); const bf16* Kb = (const bf16*)(ws + WS_K); const bf16* Vb = (const bf16*)(ws + WS_VV); const bf16* Gb = (const bf16*)((unsigned char*)p.out + DO_G);
    bf16* Ob = (bf16*)(ws + WS_O);
    const int r32 = lane & 31, h = lane >> 5, mp = wave >> 2, wq = wave & 3;
    const int qw0 = qb * 128 + 32 * wq, q = qw0 + r32; const unsigned tokq = (unsigned)(b * SEQ + q), tokb = (unsigned)(b * SEQ);
    const float slope2 = fexp2(-0.5f * (float)(hd + 1)) * LOG2E;
    bf16x8 qf[4];
#pragma unroll
    for (int ds = 0; ds < 4; ++ds) qf[ds] = ld_frag16(Qb + (tokq * 2048u + (unsigned)(hd * 128 + mp * 64 + 16 * ds + 8 * h)));
    float mrun = -INFINITY, lsum = 0.f;
    f32x16 oT[4];
#pragma unroll
    for (int db = 0; db < 4; ++db)
#pragma unroll
        for (int i = 0; i < 16; ++i) oT[db][i] = 0.f;
    const int ntiles = qb + 1;
    u32x4 preV[4], preK[4];
#define PREFETCH(t) do { \
        _Pragma("unroll") for (int i_ = 0; i_ < 4; ++i_) { const int pid_ = tid + 512 * i_, row_ = pid_ >> 4, c16_ = pid_ & 15; const unsigned go_ = (tokb + (unsigned)((t) * 128 + row_)) * 2048u + (unsigned)(hd * 128 + 8 * c16_); \
            preK[i_] = *(const u32x4*)(Kb + go_); preV[i_] = *(const u32x4*)(Vb + go_); } \
    } while (0)
    PREFETCH(0);
    const LAS unsigned char* kbase0 = lds + A_KOFF + r32 * AK_PITCH + (mp * 64 + 8 * h) * 2;
    const LAS unsigned char* vbase0 = lds + A_VOFF + (4 * h + ((lane & 15) >> 2)) * AV_PITCH + ((lane >> 4) & 1) * 32 + (lane & 3) * 8;
#define STAGE_WRITE(stg) do { \
        _Pragma("unroll") for (int i_ = 0; i_ < 4; ++i_) { const int pid_ = tid + 512 * i_, row_ = pid_ >> 4, c16_ = pid_ & 15; \
            *(LAS u32x4*)(lds + (stg) * A_STAGE + A_KOFF + row_ * AK_PITCH + 16 * c16_) = preK[i_]; *(LAS u32x4*)(lds + (stg) * A_STAGE + A_VOFF + row_ * AV_PITCH + 16 * c16_) = preV[i_]; } \
    } while (0)
    __syncthreads();
    STAGE_WRITE(0);
    asm volatile("" : "+v"(qf[0]), "+v"(qf[1]), "+v"(qf[2]), "+v"(qf[3]));
    __syncthreads();
#pragma unroll 1
    for (int t = 0; t < ntiles; ++t) {
        const int stg = t & 1;
        if (t + 1 < ntiles) PREFETCH(t + 1);
        const LAS unsigned char* kbase = kbase0 + stg * A_STAGE; const LAS unsigned char* vbase = vbase0 + stg * A_STAGE;
        const bool diag = (t == qb);
#pragma unroll 1
        for (int sub = 0; sub < 2; ++sub) {
            const int nact = diag ? min(2, max(0, wq + 1 - 2 * sub)) : 2;
            if (nact > 0) {
                float sl = slope2; asm volatile("" : "+v"(sl));
                const float bq = sl * (float)(t * 128 + sub * 64 + 4 * h - q);
                const LAS unsigned char* kb0 = kbase + sub * 64 * AK_PITCH; const LAS unsigned char* vb0 = vbase + sub * 64 * AV_PITCH;
                f32x16 s[2];
#pragma unroll
                for (int kb = 0; kb < 2; ++kb) {
                    if (kb < nact) {
                        const float bk = bq + sl * (float)(32 * kb);
#pragma unroll
                        for (int i = 0; i < 16; ++i) s[kb][i] = __builtin_fmaf(sl, (float)((i & 3) + 8 * (i >> 2)), bk);
#pragma unroll
                        for (int ds = 0; ds < 4; ++ds) s[kb] = mfma32(__builtin_bit_cast(bf16x8, *(const LAS u32x4*)(kb0 + kb * 32 * AK_PITCH + ds * 32)), qf[ds], s[kb]);
                    } else {
#pragma unroll
                        for (int i = 0; i < 16; ++i) s[kb][i] = -INFINITY;
                    }
                }
                if (diag) {
#pragma unroll
                    for (int kb = 0; kb < 2; ++kb) if (2 * sub + kb == wq) {
#pragma unroll
                        for (int i = 0; i < 16; ++i) if (crow(i, h) > r32) s[kb][i] = -INFINITY; }
                }
                float mx = -INFINITY;
#pragma unroll
                for (int kb = 0; kb < 2; ++kb)
#pragma unroll
                    for (int i = 0; i < 16; i += 2) mx = max3f(mx, s[kb][i], s[kb][i + 1]);
                mx = fmaxf(mx, __shfl_xor(mx, 32));
                const float mnew = fmaxf(mrun, mx), alpha = fexp2(mrun - mnew); mrun = mnew;
                float rs = 0.f;
#pragma unroll
                for (int kb = 0; kb < 2; ++kb)
#pragma unroll
                    for (int i = 0; i < 16; ++i) { s[kb][i] = fexp2(s[kb][i] - mnew); rs += s[kb][i]; }
                lsum = lsum * alpha + rs;
                if (__builtin_amdgcn_ballot_w64(alpha != 1.0f) != 0ull) {
#pragma unroll
                    for (int db = 0; db < 4; ++db)
#pragma unroll
                        for (int i = 0; i < 16; ++i) oT[db][i] *= alpha;
                }
#pragma unroll
                for (int kb = 0; kb < 2; ++kb) if (kb < nact) {
#pragma unroll
                    for (int s2 = 0; s2 < 2; ++s2) {
                        const bf16x8 pf = pack_frag(s[kb], s2);
#pragma unroll
                        for (int db = 0; db < 4; ++db) {
                            const LAS unsigned char* vp = vb0 + (kb * 32 + 16 * s2) * AV_PITCH + db * 64;
                            const v4i16_t lo = __builtin_amdgcn_ds_read_tr16_b64_v4i16((LAS v4i16_t*)vp), hi = __builtin_amdgcn_ds_read_tr16_b64_v4i16((LAS v4i16_t*)(vp + 8 * AV_PITCH));
                            const bf16x8 vf = {lo[0], lo[1], lo[2], lo[3], hi[0], hi[1], hi[2], hi[3]};
                            oT[db] = mfma32(vf, pf, oT[db]);
                        }
                    }
                }
            }
        }
        if (t + 1 < ntiles) STAGE_WRITE(stg ^ 1);
        __syncthreads();
    }
#undef PREFETCH
#undef STAGE_WRITE
    const float lt = lsum + __shfl_xor(lsum, 32);
    LAS float* xch = (LAS float*)(lds + (ntiles & 1) * A_STAGE + wq * 16384);
    if (mp == 1) { const float sc = lam / lt;
#pragma unroll
        for (int db = 0; db < 4; ++db)
#pragma unroll
            for (int i = 0; i < 16; ++i) xch[(db * 16 + i) * 64 + lane] = oT[db][i] * sc; }
    __syncthreads();
    if (mp == 0) {
        const float i1 = 1.f / lt; float ss = 0.f;
#pragma unroll
        for (int db = 0; db < 4; ++db)
#pragma unroll
            for (int i = 0; i < 16; ++i) { const float o = oT[db][i] * i1 - xch[(db * 16 + i) * 64 + lane]; oT[db][i] = o; ss += o * o; }
        ss += __shfl_xor(ss, 32);
        const float rn = rsqrtf(ss * (1.f / 128.f) + EPS) * (1.f - LAMBDA_INIT);
#pragma unroll
        for (int db = 0; db < 4; ++db)
#pragma unroll
            for (int qd = 0; qd < 4; ++qd) {
                const int d = db * 32 + 8 * qd + 4 * h; const unsigned off = tokq * 2048u + (unsigned)(hd * 128 + d);
                const u32x2 gg = *(const u32x2*)(Gb + off); const f32x4 sg = *(const f32x4*)(p.in[20] + d);
                u32x2 w; w.x = pk2(oT[db][4 * qd] * rn * sg.x * bflo(gg.x), oT[db][4 * qd + 1] * rn * sg.y * bfhi(gg.x));
                w.y = pk2(oT[db][4 * qd + 2] * rn * sg.z * bflo(gg.y), oT[db][4 * qd + 3] * rn * sg.w * bfhi(gg.y));
                *(u32x2*)(Ob + off) = w;
            }
    }
}

__device__ __forceinline__ void phase_attn(const PT& p, LAS unsigned char* lds, int tid, int lane, int wave) {
    const float s1 = wave_sum(p.in[16][lane] * p.in[17][lane]), s2 = wave_sum(p.in[18][lane] * p.in[19][lane]);
    const float lam = __expf(s1) - __expf(s2) + LAMBDA_INIT;
#pragma unroll 1
    for (int u = blockIdx.x; u < NBATCH * 16 * 8; u += gridDim.x) {
        const int j = u & 7, hd = (u >> 3) & 15, b = u >> 7;
#pragma unroll 1
        for (int k = 0; k < 2; ++k) attn_unit(p, lds, tid, lane, wave, b, hd, k == 0 ? 15 - j : j, lam);
    }
}

__device__ __forceinline__ void phase_final(const PT& p, int lane, int wave) {
    const float* st2 = (const float*)(p.ws + WS_ST2); const float* g = p.in[22];
    for (int m = blockIdx.x * 8 + wave; m < M; m += gridDim.x * 8) {
        const float rs = rsqrtf(st2[m] * (1.f / 2048.f) + EPS);
        f32x4* xr = (f32x4*)(p.out + (size_t)m * 2048) + lane;
#pragma unroll
        for (int j = 0; j < 8; ++j) { const f32x4 gg = ((const f32x4*)g)[lane + 64 * j]; f32x4 v = xr[64 * j]; v.x *= rs * gg.x; v.y *= rs * gg.y; v.z *= rs * gg.z; v.w *= rs * gg.w; xr[64 * j] = v; }
    }
}

constexpr size_t WS_BAR = 384 * 1024;
constexpr int XBST_OFF = PTAB_OFF + 256;
typedef __attribute__((address_space(1))) unsigned gu32;
#define XB_TMO      128
#define XB_XCNT(j)  (256  + 64 * (j))
#define XB_XSUB(j)  (1280 + 64 * (j))
#define XB_XGEN(j)  (2304 + 64 * (j))
#define XB_TOP      3328
#define XB_TOPGEN   3392
#define XCD_BAR_WORDS 3456
#define XB_SPIN_CAP (1u << 18)

__device__ __forceinline__ unsigned xb_ld(unsigned* p)              { return __hip_atomic_load(p, __ATOMIC_RELAXED, __HIP_MEMORY_SCOPE_AGENT); }
__device__ __forceinline__ unsigned xb_add(unsigned* p, unsigned v) { return __hip_atomic_fetch_add(p, v, __ATOMIC_RELAXED, __HIP_MEMORY_SCOPE_AGENT); }
__device__ __forceinline__ unsigned xb_xcc_id() { return (unsigned)__builtin_amdgcn_s_getreg((3 << 11) | 20) & 0xFu; }
#define XB_SPIN(cond, bar) do { unsigned _sp = 0; while (cond) { __builtin_amdgcn_s_sleep(1); \
    if ((++_sp & 255u) == 0u) { if (xb_ld(&(bar)[XB_TMO])) break; if (_sp > XB_SPIN_CAP) { atomicAdd(&(bar)[XB_TMO], 1u); break; } } } } while (0)

struct XcdBarrier {
    unsigned* bar; unsigned x;
    volatile LAS unsigned* st;
};

__device__ __forceinline__ XcdBarrier xcd_barrier_post(unsigned* bar, volatile LAS unsigned* st) {
    XcdBarrier b; b.bar = bar; b.x = xb_xcc_id(); b.st = st;
    if (threadIdx.x == 0) (void)xb_add(&bar[XB_XCNT(b.x)], 1u);
    return b;
}
__device__ __forceinline__ void xcd_barrier_complete(unsigned* bar, unsigned x, unsigned& nloc, unsigned& nx) {
    const unsigned G = gridDim.x * gridDim.y * gridDim.z;
    unsigned sum, cnt, mine, sp = 0u;
    for (;;) {
        sum = 0u; cnt = 0u; mine = 0u;
#pragma unroll
        for (unsigned j = 0; j < 16; ++j) { const unsigned c = xb_ld(&bar[XB_XCNT(j)]); sum += c; cnt += (c > 0u) ? 1u : 0u; mine = (j == x) ? c : mine; }
        if (sum == G) break;
        __builtin_amdgcn_s_sleep(1);
        if ((++sp & 255u) == 0u) { if (xb_ld(&bar[XB_TMO])) break; if (sp > XB_SPIN_CAP) { atomicAdd(&bar[XB_TMO], 1u); break; } }
    }
    nloc = mine > 0u ? mine : 1u; nx = cnt > 0u ? cnt : 1u;
}

__device__ __forceinline__ void xcd_barrier(const XcdBarrier& b) {
    asm volatile("s_waitcnt vmcnt(0)" ::: "memory");
    __syncthreads();
    if (threadIdx.x == 0) {
        unsigned* bar = b.bar;
        __builtin_amdgcn_s_waitcnt(0);
        unsigned nloc = b.st[0], nx = b.st[1];
        if (nloc == 0u) { xcd_barrier_complete(bar, b.x, nloc, nx); b.st[0] = nloc; b.st[1] = nx; }
        const unsigned old = xb_add(&bar[XB_XSUB(b.x)], 1u);
        const unsigned gen = old / nloc;
        if (old + 1u == (gen + 1u) * nloc) {
            __builtin_amdgcn_fence(__ATOMIC_RELEASE, "agent");
            asm volatile("s_waitcnt vmcnt(0)" ::: "memory");
            const unsigned og = xb_add(&bar[XB_TOP], 1u);
            const unsigned tg = og / nx;
            if (og + 1u == (tg + 1u) * nx) xb_add(&bar[XB_TOPGEN], 1u);
            else XB_SPIN(xb_ld(&bar[XB_TOPGEN]) == tg, bar);
            __builtin_amdgcn_fence(__ATOMIC_ACQUIRE, "agent");
            xb_add(&bar[XB_XGEN(b.x)], 1u);
            asm volatile("s_waitcnt vmcnt(0)" ::: "memory");
        } else {
            XB_SPIN(xb_ld(&bar[XB_XGEN(b.x)]) == gen, bar);
            __builtin_amdgcn_fence(__ATOMIC_ACQUIRE, "agent");
            asm volatile("s_waitcnt vmcnt(0)" ::: "memory");
        }
    }
    __syncthreads();
}

__global__ void __launch_bounds__(512) fwd_megakernel(Params pa) {
    extern __shared__ __attribute__((aligned(16))) unsigned char lds_raw[];
    cg::grid_group grid = cg::this_grid();
    LAS unsigned char* lds = (LAS unsigned char*)lds_raw;
    if (threadIdx.x < 25) {
        unsigned long long v = 0;
#pragma unroll
        for (int i = 0; i < 23; ++i) if ((int)threadIdx.x == i) v = (unsigned long long)pa.in[i];
        if (threadIdx.x == 23) v = (unsigned long long)pa.out;
        if (threadIdx.x == 24) v = (unsigned long long)pa.ws;
        ((LAS unsigned long long*)(lds + PTAB_OFF))[threadIdx.x] = v;
    }
    if (threadIdx.x < 2) ((LAS unsigned*)(lds + XBST_OFF))[threadIdx.x] = 0u;
    __syncthreads();
    const XcdBarrier bar = xcd_barrier_post((unsigned*)(pa.ws + WS_BAR), (volatile LAS unsigned*)(lds + XBST_OFF));
#ifndef PHMASK
#define PHMASK 0x3ff
#endif
#define PH(n) (((PHMASK) >> (n)) & 1)
#define TLW int tid_ = threadIdx.x; asm volatile("" : "+v"(tid_)); const int tid = tid_, lane = tid & 63, wave = __builtin_amdgcn_readfirstlane(tid >> 6); (void)tid; (void)lane; (void)wave
#define GRIDV const int G = gridDim.x, c = blockIdx.x
    if (PH(0)) { PT p; TLW; phase0(p, lds, tid, lane, wave); }
    grid.sync();
    if (PH(1)) {
        PT p; GRIDV; unsigned char* ws = p.ws; unsigned char* dob = (unsigned char*)p.out;
        pg8::Gemm g{(const pg8::bf16_t*)(ws + WS_H0), (const pg8::bf16_t*)(ws + WS_W0IN), M, N0P, 2048}; pg8::StaticOrder S; S.init(M, N0P, G, c);
        EpiIn0 E{(bf16*)(ws + WS_YCAT), (bf16*)(ws + WS_V), (bf16*)(ws + WS_ZA), (bf16*)(dob + DO_XBC), (float*)(ws + WS_ST0)};
        pg8::gemm_phase<EpiIn0, pg8::StaticOrder, true, true>(lds, g, S, E);
        { TLW; dt_tasks(p, lane, wave); }
    }
    xcd_barrier(bar);
    if (PH(2)) { PT p; TLW; phase_layout(p, tid); }
    xcd_barrier(bar);
    if (PH(3)) { PT p; TLW; phase_mix(p, lds, tid, lane, wave); }
    xcd_barrier(bar);
    if (PH(4)) { PT p; TLW; phase_scan(p, tid); }
    xcd_barrier(bar);
    if (PH(5)) { PT p; TLW; phase_ssd_y(p, lds, tid, lane, wave); }
    xcd_barrier(bar);
    if (PH(6)) {
        PT p; GRIDV; unsigned char* ws = p.ws;
        pg8::Gemm g{(const pg8::bf16_t*)(ws + WS_YCAT), (const pg8::bf16_t*)(ws + WS_W0OUT), M, 2048, 4096}; pg8::StaticOrder S; S.init(M, 2048, G, c);
        EpiResT<false> E{p.in[0], nullptr, (bf16*)(ws + WS_X1B), (float*)(ws + WS_ST1)};
        pg8::gemm_phase<EpiResT<false>, pg8::StaticOrder, true, true>(lds, g, S, E);
    }
    xcd_barrier(bar);
    if (PH(6)) {
        PT p; GRIDV; unsigned char* ws = p.ws; unsigned char* dob = (unsigned char*)p.out;
        pg8::Gemm g{(const pg8::bf16_t*)(ws + WS_X1B), (const pg8::bf16_t*)(ws + WS_W1IN), M, 8192, 2048}; pg8::StaticOrder S; S.init(M, 8192, G, c);
        EpiIn1 E{(bf16*)(ws + WS_Q), (bf16*)(ws + WS_K), (bf16*)(ws + WS_VV), (bf16*)(dob + DO_G), (const float*)(ws + WS_ST1)};
        pg8::gemm_phase<EpiIn1, pg8::StaticOrder, true, true>(lds, g, S, E);
    }
    xcd_barrier(bar);
    if (PH(7)) { PT p; TLW; phase_attn(p, lds, tid, lane, wave); }
    xcd_barrier(bar);
    if (PH(8)) {
        PT p; GRIDV; unsigned char* ws = p.ws;
        pg8::Gemm g{(const pg8::bf16_t*)(ws + WS_O), (const pg8::bf16_t*)(ws + WS_W1OUT), M, 2048, 2048}; pg8::StaticOrder S; S.init(M, 2048, G, c);
        EpiResT<true> E{(const void*)(ws + WS_X1B), p.out, nullptr, (float*)(ws + WS_ST2)};
        pg8::gemm_phase<EpiResT<true>, pg8::StaticOrder, true, true>(lds, g, S, E);
    }
    xcd_barrier(bar);
    if (PH(9)) { PT p; TLW; phase_final(p, lane, wave); }
}

extern "C" void kernel_launch(void* const* d_in, const int* in_sizes, int n_in, void* d_out, int out_size, void* d_ws, size_t ws_size, hipStream_t stream) {
    static int grid = 0;
    if (grid == 0) {
        if (n_in != 23 || out_size != M * DM || ws_size < WS_END) { fprintf(stderr, "kernel_launch: unexpected shapes (n_in %d out %d ws %zu)\n", n_in, out_size, ws_size); grid = -1; return; }
        int dev = 0, cus = 0, per_cu = 0;
        hipGetDevice(&dev); hipDeviceGetAttribute(&cus, hipDeviceAttributeMultiprocessorCount, dev);
        hipFuncSetAttribute((const void*)fwd_megakernel, hipFuncAttributeMaxDynamicSharedMemorySize, LDS_BYTES);
        hipOccupancyMaxActiveBlocksPerMultiprocessor(&per_cu, (const void*)fwd_megakernel, 512, LDS_BYTES);
        if (per_cu < 1) { fprintf(stderr, "kernel_launch: occupancy query says %d blocks per CU\n", per_cu); per_cu = 1; }
        (void)hipGetLastError();
        grid = cus;
    }
    if (grid < 0) return;
    Params p{};
    for (int i = 0; i < 23; ++i) p.in[i] = (const float*)d_in[i];
    p.out = (float*)d_out; p.ws = (unsigned char*)d_ws;
    if (hipMemsetAsync((char*)d_ws + WS_BAR, 0, XCD_BAR_WORDS * 4, stream) != hipSuccess) { fprintf(stderr, "kernel_launch: memset of the barrier words failed\n"); return; }
    void* args[] = {&p};
    hipError_t e = hipLaunchCooperativeKernel((const void*)fwd_megakernel, dim3(grid), dim3(512), args, LDS_BYTES, stream);
    if (e != hipSuccess) fprintf(stderr, "cooperative launch failed: %s (grid %d)\n", hipGetErrorString(e), grid);
}
```

```cpp
#include <hip/hip_runtime.h>
#include <hip/hip_cooperative_groups.h>
#include <cstdio>
#include <cstdint>
#include <cmath>
namespace cg = cooperative_groups;
namespace pg8 {
#define PG8_LAS __attribute__((address_space(3)))
typedef unsigned short bf16_t;
typedef short bf16x8 __attribute__((ext_vector_type(8)));
typedef float f32x4 __attribute__((ext_vector_type(4)));
typedef unsigned u32x4 __attribute__((ext_vector_type(4)));
constexpr int BM = 256, BK = 64, HALF = 128, HTB = HALF * BK * 2  , STAGE_BYTES = 8 * HTB, NXCD = 8, WGM = 8;

__host__ __device__ __forceinline__ int lds_byte(int r, int c) { const int st = (r >> 4) * 2 + (c >> 5), rr = r & 15, cc = c & 31, ob = rr * 64 + cc * 2; return st * 1024 + (ob ^ (((ob >> 9) & 1) << 5)); }
__host__ __device__ __forceinline__ void stage_rc(int b, int& R, int& C) { const int st = b / 1024, sb = b % 1024, swz = sb ^ (((sb >> 9) & 1) << 5); R = (st >> 1) * 16 + swz / 64; C = (st & 1) * 32 + (swz % 64) / 2; }
__host__ __device__ __forceinline__ int perm32(int rho) { const int n = rho >> 4, i = rho & 15; return 8 * (i >> 2) + 4 * n + (i & 3); }

struct Unit { int pm, pn; };
struct Gemm { const bf16_t* A; const bf16_t* Bt; int M, N, K; };

struct StaticOrder {
    int nM, nN, nwg, G, c;
    __host__ __device__ void init(int M, int N, int G_, int c_) { nM = M / BM; nN = N / BM; nwg = nM * nN; G = G_; c = c_; }
    __host__ __device__ bool next(int i, Unit& u) const {
        const long L = (long)i * G + c; if (L >= nwg) return false;
        int wgid = (int)L; { const int q = nwg / NXCD, r = nwg % NXCD, xcd = wgid % NXCD, off = wgid / NXCD; wgid = (xcd < r ? xcd * (q + 1) : r * (q + 1) + (xcd - r) * q) + off; }
        const int nig = WGM * nN, gid = wgid / nig, fm = gid * WGM, gsz = (nM - fm) < WGM ? (nM - fm) : WGM;
        u.pm = fm + ((wgid % nig) % gsz); u.pn = (wgid % nig) / gsz; return true;
    }
    __device__ __forceinline__ void a_ready(const Unit&) const {}
    __device__ __forceinline__ void done(const Unit&) const {}
};

template <class Epi, class Sched, bool ALIGN_EPI = false, bool SP2 = false>
__device__ __forceinline__ void gemm_phase(PG8_LAS unsigned char* lds, const Gemm g, const Sched& S, const Epi& E) {
    int tid_ = threadIdx.x; asm volatile("" : "+v"(tid_));
    const int tid = tid_, wid = __builtin_amdgcn_readfirstlane(tid >> 6), lane = tid & 63, wr = wid >> 2, wc = wid & 3, fr = lane & 15, fq = lane >> 4;
    const int K = g.K, nt = K / BK;
    unsigned voffA[2], voffB[2];
#pragma unroll
    for (int i = 0; i < 2; ++i) { int R, C; stage_rc(tid * 16 + i * 8192, R, C); const int Rb = Epi::PERM ? ((R & ~31) + perm32(R & 31)) : R;
        voffA[i] = (unsigned)(R * K + C) * 2u; voffB[i] = (unsigned)(Rb * K + C) * 2u; }
    const size_t kstep = (size_t)(BK * 2);
    const size_t hstep = (size_t)HALF * K * 2;
    const size_t tstep = 2 * hstep;
    const unsigned ldsw = (unsigned)wid * 1024u;
    const int aoff = lds_byte(wr * 64 + fr, fq * 8), boff = lds_byte(wc * 32 + fr, fq * 8);
#define PG8_SA(b, h) (((b) * 2 + (h)) * HTB)
#define PG8_SB(b, h) ((4 + (b) * 2 + (h)) * HTB)
#define PG8_STAGE(bufoff, gbase, voff) do { _Pragma("unroll") for (int _i = 0; _i < 2; ++_i) \
        __builtin_amdgcn_global_load_lds((const unsigned*)((const char*)(gbase) + (voff)[_i]), (PG8_LAS unsigned*)(lds + (bufoff) + ldsw + _i * 8192), 16, 0, 0); } while (0)
#define PG8_LDA(dst, b, h) do { _Pragma("unroll") for (int m = 0; m < 4; ++m) _Pragma("unroll") for (int k = 0; k < 2; ++k) dst[m][k] = *(const PG8_LAS bf16x8*)(lds + PG8_SA(b, h) + aoff + m * 2048 + k * 1024); } while (0)
#define PG8_LDB(dst, b, h) do { _Pragma("unroll") for (int n = 0; n < 2; ++n) _Pragma("unroll") for (int k = 0; k < 2; ++k) dst[n][k] = *(const PG8_LAS bf16x8*)(lds + PG8_SB(b, h) + boff + n * 2048 + k * 1024); } while (0)
#define PG8_MMA(ai, bj, At, Bt) do { __builtin_amdgcn_s_setprio(1); _Pragma("unroll") for (int m = 0; m < 4; ++m) _Pragma("unroll") for (int n = 0; n < 2; ++n) _Pragma("unroll") for (int k = 0; k < 2; ++k) \
        acc[ai][bj][m][n] = __builtin_amdgcn_mfma_f32_16x16x32_bf16(Bt[n][k], At[m][k], acc[ai][bj][m][n], 0, 0, 0); __builtin_amdgcn_s_setprio(0); } while (0)
#define PG8_WAIT_V(n) asm volatile("s_waitcnt vmcnt(" #n ")" ::: "memory")
#define PG8_WAIT_L(n) asm volatile("s_waitcnt lgkmcnt(" #n ")" ::: "memory")
#define PG8_BAR __builtin_amdgcn_s_barrier()
#define PG8_SCHED __builtin_amdgcn_sched_barrier(0)
    Unit cur, nxt; int ui = 0;
    if (!S.next(0, cur)) return;
    f32x4 acc[2][2][4][2];
#pragma unroll
    for (int a = 0; a < 2; ++a)
#pragma unroll
        for (int b = 0; b < 2; ++b)
#pragma unroll
            for (int m = 0; m < 4; ++m)
#pragma unroll
                for (int n = 0; n < 2; ++n) acc[a][b][m][n] = (f32x4){0.f, 0.f, 0.f, 0.f};
    bf16x8 At[4][2], B0[2][2], B1[2][2];
    const char* cA = (const char*)g.A + (size_t)cur.pm * tstep; const char* cB = (const char*)g.Bt + (size_t)cur.pn * tstep;
    S.a_ready(cur);
    if constexpr (SP2) {
        PG8_STAGE(PG8_SB(0, 0), cB, voffB); PG8_STAGE(PG8_SB(0, 1), cB + hstep, voffB); PG8_STAGE(PG8_SA(0, 0), cA, voffA); PG8_STAGE(PG8_SA(0, 1), cA + hstep, voffA);
        if (wr == 1) PG8_BAR;
        PG8_WAIT_V(2); PG8_BAR;
        PG8_STAGE(PG8_SB(1, 0), cB + kstep, voffB); PG8_STAGE(PG8_SA(1, 0), cA + kstep, voffA); PG8_STAGE(PG8_SB(1, 1), cB + hstep + kstep, voffB);
        PG8_WAIT_V(6); PG8_BAR;
    } else {
        PG8_STAGE(PG8_SB(0, 0), cB, voffB); PG8_STAGE(PG8_SA(0, 0), cA, voffA); PG8_STAGE(PG8_SB(0, 1), cB + hstep, voffB); PG8_STAGE(PG8_SA(0, 1), cA + hstep, voffA);
        if (wr == 1) PG8_BAR;
        PG8_WAIT_V(4); PG8_BAR;
        PG8_STAGE(PG8_SB(1, 0), cB + kstep, voffB); PG8_STAGE(PG8_SA(1, 0), cA + kstep, voffA); PG8_STAGE(PG8_SB(1, 1), cB + hstep + kstep, voffB);
        PG8_WAIT_V(6); PG8_BAR;
    }
    for (;;) {
        const bool has_next = S.next(ui + 1, nxt);
        const char* nA = has_next ? (const char*)g.A + (size_t)nxt.pm * tstep : cA; const char* nB = has_next ? (const char*)g.Bt + (size_t)nxt.pn * tstep : cB;
        for (int t = 0; t < nt; t += 2) {
            const bool last = (t == nt - 2);
            const char* a1 = cA + (size_t)(t + 1) * kstep;
            const char* a2 = last ? nA : cA + (size_t)(t + 2) * kstep; const char* b2 = last ? nB : cB + (size_t)(t + 2) * kstep;
            const char* a3 = a2 + kstep; const char* b3 = b2 + kstep;
            if (last && has_next) S.a_ready(nxt);
            if constexpr (SP2) {
            PG8_LDB(B0, 0, 0); PG8_LDB(B1, 0, 1); PG8_SCHED; PG8_LDA(At, 0, 0); PG8_STAGE(PG8_SA(1, 1), a1 + hstep, voffA);
            PG8_WAIT_V(8); PG8_WAIT_L(0); PG8_BAR; PG8_MMA(0, 0, At, B0); PG8_MMA(0, 1, At, B1); PG8_BAR; PG8_SCHED;
            PG8_LDA(At, 0, 1); PG8_STAGE(PG8_SB(0, 0), b2, voffB); PG8_STAGE(PG8_SB(0, 1), b2 + hstep, voffB); PG8_STAGE(PG8_SA(0, 0), a2, voffA);
            PG8_WAIT_V(8); PG8_WAIT_L(0); PG8_BAR; PG8_MMA(1, 0, At, B0); PG8_MMA(1, 1, At, B1); PG8_BAR; PG8_SCHED;
            PG8_LDB(B0, 1, 0); PG8_LDB(B1, 1, 1); PG8_SCHED; PG8_LDA(At, 1, 0); PG8_STAGE(PG8_SA(0, 1), a2 + hstep, voffA);
            PG8_WAIT_V(8); PG8_WAIT_L(0); PG8_BAR; PG8_MMA(0, 0, At, B0); PG8_MMA(0, 1, At, B1); PG8_BAR; PG8_SCHED;
            PG8_LDA(At, 1, 1); PG8_STAGE(PG8_SB(1, 0), b3, voffB); PG8_STAGE(PG8_SB(1, 1), b3 + hstep, voffB); PG8_STAGE(PG8_SA(1, 0), a3, voffA);
            PG8_WAIT_V(8); PG8_WAIT_L(0); PG8_BAR; PG8_MMA(1, 0, At, B0); PG8_MMA(1, 1, At, B1); PG8_BAR; PG8_SCHED;
            } else {
            PG8_LDB(B0, 0, 0); PG8_SCHED; PG8_LDA(At, 0, 0); PG8_STAGE(PG8_SA(1, 1), a1 + hstep, voffA);
            PG8_WAIT_L(8); PG8_BAR; PG8_WAIT_L(0); PG8_MMA(0, 0, At, B0); PG8_BAR; PG8_SCHED;
            PG8_LDB(B1, 0, 1); PG8_STAGE(PG8_SB(0, 0), b2, voffB);
            PG8_BAR; PG8_WAIT_L(0); PG8_MMA(0, 1, At, B1); PG8_BAR;
            PG8_LDA(At, 0, 1); PG8_STAGE(PG8_SA(0, 0), a2, voffA);
            PG8_BAR; PG8_WAIT_L(0); PG8_MMA(1, 0, At, B0); PG8_BAR; PG8_SCHED;
            PG8_STAGE(PG8_SB(0, 1), b2 + hstep, voffB);
            PG8_WAIT_V(6); PG8_BAR; PG8_MMA(1, 1, At, B1); PG8_BAR;
            PG8_LDB(B0, 1, 0); PG8_SCHED; PG8_LDA(At, 1, 0); PG8_STAGE(PG8_SA(0, 1), a2 + hstep, voffA);
            PG8_WAIT_L(8); PG8_BAR; PG8_WAIT_L(0); PG8_MMA(0, 0, At, B0); PG8_BAR; PG8_SCHED;
            PG8_LDB(B1, 1, 1); PG8_STAGE(PG8_SB(1, 0), b3, voffB);
            PG8_BAR; PG8_WAIT_L(0); PG8_MMA(0, 1, At, B1); PG8_BAR;
            PG8_LDA(At, 1, 1); PG8_STAGE(PG8_SA(1, 0), a3, voffA);
            PG8_BAR; PG8_WAIT_L(0); PG8_MMA(1, 0, At, B0); PG8_BAR; PG8_SCHED;
            PG8_STAGE(PG8_SB(1, 1), b3 + hstep, voffB);
            PG8_WAIT_V(6); PG8_BAR; PG8_MMA(1, 1, At, B1); PG8_BAR;
            }
        }
        if constexpr (ALIGN_EPI) { if (wr == 0) PG8_BAR; }
        if constexpr (!Epi::AFTER_DRAIN) { E(acc, cur, wr, wc, fr, fq); S.done(cur); }
        if (!has_next) break;
#pragma unroll
        for (int a = 0; a < 2; ++a)
#pragma unroll
            for (int b = 0; b < 2; ++b)
#pragma unroll
                for (int m = 0; m < 4; ++m)
#pragma unroll
                    for (int n = 0; n < 2; ++n) acc[a][b][m][n] = (f32x4){0.f, 0.f, 0.f, 0.f};
        cur = nxt; cA = nA; cB = nB; ++ui;
        if constexpr (ALIGN_EPI) { if (wr == 1) PG8_BAR; }
    }
    PG8_WAIT_V(0);
    if constexpr (!ALIGN_EPI) { if (wr == 0) PG8_BAR; }
    PG8_BAR;
    if constexpr (Epi::AFTER_DRAIN) { E.fused(acc, cur, wr, wc, fr, fq, lds, wid, lane); S.done(cur); }
#undef PG8_SA
#undef PG8_SB
#undef PG8_STAGE
#undef PG8_LDA
#undef PG8_LDB
#undef PG8_MMA
#undef PG8_WAIT_V
#undef PG8_WAIT_L
#undef PG8_BAR
#undef PG8_SCHED
}
}

#define LAS __attribute__((address_space(3)))
typedef unsigned short bf16;
typedef unsigned u32x4 __attribute__((ext_vector_type(4)));
typedef unsigned u32x2 __attribute__((ext_vector_type(2)));
typedef float f32x4 __attribute__((ext_vector_type(4)));
typedef float f32x16 __attribute__((ext_vector_type(16)));
typedef short bf16x8 __attribute__((ext_vector_type(8)));
typedef short v4i16_t __attribute__((ext_vector_type(4)));

constexpr int M = 16384, DM = 2048, SEQ = 2048, NBATCH = 8, NCH = 16;
constexpr int N0P = 11264, N0R = 11296;
constexpr float EPS = 1e-5f;
constexpr float LOG2E = 1.4426950408889634f;
constexpr float QSCALE = 0.125f * LOG2E;
constexpr float LAMBDA_INIT = 0.35550906f;
constexpr size_t MiB = 1u << 20;
constexpr size_t WS_ST0 = 0, WS_ST1 = 128 * 1024, WS_ST2 = 192 * 1024, WS_CD = 256 * 1024, WS_LAM = 300 * 1024;
constexpr size_t WS_DT = 1 * MiB, WS_WSP = 3 * MiB, WS_W0IN = 4 * MiB, WS_W0OUT = 49 * MiB, WS_W1IN = 65 * MiB, WS_W1OUT = 97 * MiB;
constexpr size_t WS_YCAT = 105 * MiB, WS_ZA = 233 * MiB, WS_V = 297 * MiB, WS_H0 = 361 * MiB, WS_XT = 425 * MiB, WS_CN = 489 * MiB, WS_END = 505 * MiB;
constexpr size_t WS_Q = WS_YCAT, WS_K = WS_YCAT + 64 * MiB, WS_X1 = WS_ZA, WS_STATES = WS_V, WS_VT = WS_H0, WS_X1B = WS_H0, WS_O = WS_ZA, WS_VV = WS_XT;
constexpr size_t DO_XBC = 0, DO_BN = 96 * MiB, DO_BT = 112 * MiB, DO_PREV = 0, DO_G = 0;
constexpr int LDS_BYTES = 147456;
constexpr int GM_UOFF = 128 * 272, GM_ZOFF = 2 * 128 * 272;

__device__ __forceinline__ unsigned pk2(float lo, float hi) {
    typedef float f2 __attribute__((ext_vector_type(2))); typedef __bf16 b2 __attribute__((ext_vector_type(2)));
    f2 v = {lo, hi}; b2 b = __builtin_convertvector(v, b2); return __builtin_bit_cast(unsigned, b);
}
__device__ __forceinline__ float bflo(unsigned u) { return __uint_as_float(u << 16); }
__device__ __forceinline__ float bfhi(unsigned u) { return __uint_as_float(u & 0xffff0000u); }
__device__ __forceinline__ void unpack8(u32x4 r, float* f) { f[0] = bflo(r.x); f[1] = bfhi(r.x); f[2] = bflo(r.y); f[3] = bfhi(r.y); f[4] = bflo(r.z); f[5] = bfhi(r.z); f[6] = bflo(r.w); f[7] = bfhi(r.w); }
__device__ __forceinline__ u32x4 pack8(const float* f) { u32x4 o; o.x = pk2(f[0], f[1]); o.y = pk2(f[2], f[3]); o.z = pk2(f[4], f[5]); o.w = pk2(f[6], f[7]); return o; }
__device__ __forceinline__ float fexp2(float x) { return __builtin_amdgcn_exp2f(x); }
__device__ __forceinline__ float gelu_f(float x) { const float z = 1.5957691216057308f * (x + 0.044715f * x * x * x); return x * __builtin_amdgcn_rcpf(1.0f + __expf(-z)); }
__device__ __forceinline__ float silu_f(float x) { return x * __builtin_amdgcn_rcpf(1.0f + __expf(-x)); }
__device__ __forceinline__ int crow(int r, int h) { return (r & 3) + 8 * (r >> 2) + 4 * h; }
__device__ __forceinline__ f32x16 mfma32(bf16x8 a, bf16x8 b, f32x16 c) { return __builtin_amdgcn_mfma_f32_32x32x16_bf16(a, b, c, 0, 0, 0); }
__device__ __forceinline__ bf16x8 ld_frag16(const bf16* p) { return __builtin_bit_cast(bf16x8, *(const u32x4*)p); }
__device__ __forceinline__ bf16x8 ld_frag8x2(const bf16* p) { const u32x2 lo = *(const u32x2*)p, hi = *(const u32x2*)(p + 8); u32x4 v; v.x = lo.x; v.y = lo.y; v.z = hi.x; v.w = hi.y; return __builtin_bit_cast(bf16x8, v); }
__device__ __forceinline__ bf16x8 pack_frag(const f32x16& x, int s) {
    u32x4 v; v.x = pk2(x[8 * s], x[8 * s + 1]); v.y = pk2(x[8 * s + 2], x[8 * s + 3]); v.z = pk2(x[8 * s + 4], x[8 * s + 5]); v.w = pk2(x[8 * s + 6], x[8 * s + 7]); return __builtin_bit_cast(bf16x8, v);
}
__device__ __forceinline__ float wave_sum(float v) {
#pragma unroll
    for (int o = 1; o < 64; o <<= 1) v += __shfl_xor(v, o);
    return v;
}
#define LDS_WAIT() asm volatile("s_waitcnt lgkmcnt(0)" ::: "memory")
__device__ __forceinline__ void atomic_addf(float* p, float v) { __hip_atomic_fetch_add(p, v, __ATOMIC_RELAXED, __HIP_MEMORY_SCOPE_AGENT); }

struct Params { const float* in[23]; float* out; unsigned char* ws; };
constexpr int PTAB_OFF = LDS_BYTES - 512;
__device__ __forceinline__ unsigned long long ptab_get(int i) {
    const unsigned long long v = ((const LAS unsigned long long*)(PTAB_OFF))[i];
    const unsigned lo = __builtin_amdgcn_readfirstlane((unsigned)v), hi = __builtin_amdgcn_readfirstlane((unsigned)(v >> 32));
    return ((unsigned long long)hi << 32) | lo;
}
struct PT {
    struct InTab { __device__ __forceinline__ const float* operator[](int i) const { return (const float*)(const __attribute__((address_space(1))) float*)ptab_get(i); } } in;
    float* out; unsigned char* ws;
    __device__ __forceinline__ PT() { out = (float*)(__attribute__((address_space(1))) float*)ptab_get(23); ws = (unsigned char*)(__attribute__((address_space(1))) unsigned char*)ptab_get(24); }
};

template <int ACT>
__device__ __forceinline__ void epi_tile_bf16(const f32x4 (&acc)[2][2][4][2], bf16* base, int pitch, int col0, int row0, float sc) {
#pragma unroll
    for (int ai = 0; ai < 2; ++ai)
#pragma unroll
        for (int m = 0; m < 4; ++m) {
            bf16* rowp = base + (size_t)(row0 + ai * 128 + m * 16) * pitch + col0;
#pragma unroll
            for (int bj = 0; bj < 2; ++bj) {
                float v[8];
#pragma unroll
                for (int j = 0; j < 4; ++j) { v[j] = acc[ai][bj][m][0][j]; v[4 + j] = acc[ai][bj][m][1][j]; }
#pragma unroll
                for (int j = 0; j < 8; ++j) { if (ACT == 1) v[j] = gelu_f(v[j]); else if (ACT == 2) v[j] = silu_f(v[j]); else if (ACT == 3) v[j] *= sc; }
                *(u32x4*)(rowp + bj * 128) = pack8(v);
            }
        }
}

struct EpiIn0 {
    static constexpr bool PERM = true, AFTER_DRAIN = false;
    bf16 *ycat, *vbuf, *za, *xbc; float* stats0;
    __device__ __forceinline__ void operator()(const f32x4 (&acc)[2][2][4][2], const pg8::Unit& u, int wr, int wc, int fr, int fq) const {
        const int pn = u.pn, row0 = u.pm * 256 + wr * 64 + fr, cl = wc * 32 + 8 * fq;
        if (pn < 8) { epi_tile_bf16<1>(acc, ycat, 4096, pn * 256 + cl, row0, 1.f); }
        else if (pn < 16) {
#pragma unroll
            for (int ai = 0; ai < 2; ++ai)
#pragma unroll
                for (int m = 0; m < 4; ++m) {
                    const int row = row0 + ai * 128 + m * 16;
                    bf16* rowp = vbuf + (size_t)row * 2048 + (pn - 8) * 256 + cl;
                    float s = 0.f, ss = 0.f;
#pragma unroll
                    for (int bj = 0; bj < 2; ++bj) {
                        float v[8];
#pragma unroll
                        for (int j = 0; j < 4; ++j) { v[j] = gelu_f(acc[ai][bj][m][0][j]); v[4 + j] = gelu_f(acc[ai][bj][m][1][j]); }
#pragma unroll
                        for (int j = 0; j < 8; ++j) { s += v[j]; ss += v[j] * v[j]; }
                        *(u32x4*)(rowp + bj * 128) = pack8(v);
                    }
                    s += __shfl_xor(s, 16); s += __shfl_xor(s, 32); ss += __shfl_xor(ss, 16); ss += __shfl_xor(ss, 32);
                    if (fq == 0) { atomic_addf(stats0 + 2 * row, s); atomic_addf(stats0 + 2 * row + 1, ss); }
                }
        }
        else if (pn < 24) { epi_tile_bf16<2>(acc, za, 2048, (pn - 16) * 256 + cl, row0, 1.f); }
        else if (pn < 32) { epi_tile_bf16<2>(acc, ycat, 4096, 2048 + (pn - 24) * 256 + cl, row0, 1.f); }
        else { epi_tile_bf16<0>(acc, xbc, 3072, (pn - 32) * 256 + cl, row0, 1.f); }
    }
};

__device__ __forceinline__ void dt_tasks(const PT& p, int lane, int wave) {
    if (wave >= 2) return;
    unsigned char* ws = p.ws; const bf16* H0 = (const bf16*)(ws + WS_H0); const bf16* Wdt = (const bf16*)(ws + WS_W0IN) + (size_t)11264 * 2048; float* DT = (float*)(ws + WS_DT);
    const int r32 = lane & 31, h = lane >> 5;
    for (int task = wave * gridDim.x + blockIdx.x; task < 512; task += 2 * gridDim.x) {
        const bf16* ap = Wdt + (size_t)r32 * 2048 + 8 * h; const bf16* bp = H0 + (size_t)(task * 32 + r32) * 2048 + 8 * h;
        f32x16 acc;
#pragma unroll
        for (int i = 0; i < 16; ++i) acc[i] = 0.f;
#pragma unroll 8
        for (int st = 0; st < 128; ++st) acc = mfma32(ld_frag16(ap + 16 * st), ld_frag16(bp + 16 * st), acc);
#pragma unroll
        for (int qd = 0; qd < 4; ++qd) {
            const int j0 = 8 * qd + 4 * h; const f32x4 bb = *(const f32x4*)(p.in[9] + j0); f32x4 v;
#pragma unroll
            for (int j = 0; j < 4; ++j) { const float x = acc[4 * qd + j] + bb[j]; v[j] = x > 20.f ? x : log1pf(__expf(x)); }
            *(f32x4*)(DT + (size_t)(task * 32 + r32) * 32 + j0) = v;
        }
    }
}
template <bool RB16> struct EpiResT {
    static constexpr bool PERM = true, AFTER_DRAIN = false;
    const void* resid; float* outf; bf16* outb; float* stats;
    __device__ __forceinline__ void operator()(const f32x4 (&acc)[2][2][4][2], const pg8::Unit& u, int wr, int wc, int fr, int fq) const {
        const int row0 = u.pm * 256 + wr * 64 + fr, col0 = u.pn * 256 + wc * 32 + 8 * fq;
#pragma unroll
        for (int ai = 0; ai < 2; ++ai)
#pragma unroll
            for (int m = 0; m < 4; ++m) {
                const int row = row0 + ai * 128 + m * 16; const size_t off = (size_t)row * 2048 + col0;
                float ss = 0.f;
#pragma unroll
                for (int bj = 0; bj < 2; ++bj) {
                    f32x4 r0, r1;
                    if (RB16) { float f[8]; unpack8(*(const u32x4*)((const bf16*)resid + off + bj * 128), f); r0 = (f32x4){f[0], f[1], f[2], f[3]}; r1 = (f32x4){f[4], f[5], f[6], f[7]}; }
                    else { r0 = *(const f32x4*)((const float*)resid + off + bj * 128); r1 = *(const f32x4*)((const float*)resid + off + bj * 128 + 4); }
                    r0 = r0 + acc[ai][bj][m][0]; r1 = r1 + acc[ai][bj][m][1];
                    if (outf) { *(f32x4*)(outf + off + bj * 128) = r0; *(f32x4*)(outf + off + bj * 128 + 4) = r1; }
                    ss += (r0[0] * r0[0] + r0[1] * r0[1]) + (r0[2] * r0[2] + r0[3] * r0[3]) + (r1[0] * r1[0] + r1[1] * r1[1]) + (r1[2] * r1[2] + r1[3] * r1[3]);
                    if (outb) { u32x4 w; w.x = pk2(r0[0], r0[1]); w.y = pk2(r0[2], r0[3]); w.z = pk2(r1[0], r1[1]); w.w = pk2(r1[2], r1[3]); *(u32x4*)(outb + off + bj * 128) = w; }
                }
                ss += __shfl_xor(ss, 16); ss += __shfl_xor(ss, 32);
                if (fq == 0) atomic_addf(stats + row, ss);
            }
    }
};

struct EpiIn1 {
    static constexpr bool PERM = true, AFTER_DRAIN = false;
    bf16 *q, *k, *v, *g; const float* stats1;
    __device__ __forceinline__ void operator()(const f32x4 (&acc)[2][2][4][2], const pg8::Unit& u, int wr, int wc, int fr, int fq) const {
        const int seg = u.pn >> 3, row0 = u.pm * 256 + wr * 64 + fr, col0 = (u.pn & 7) * 256 + wc * 32 + 8 * fq;
        bf16* base = seg == 0 ? q : (seg == 1 ? k : (seg == 2 ? v : g));
        const float sc = seg == 0 ? QSCALE : 1.f;
#pragma unroll
        for (int ai = 0; ai < 2; ++ai)
#pragma unroll
            for (int m = 0; m < 4; ++m) {
                const int row = row0 + ai * 128 + m * 16;
                const float rs = rsqrtf(stats1[row] * (1.f / 2048.f) + EPS) * sc;
                bf16* rowp = base + (size_t)row * 2048 + col0;
#pragma unroll
                for (int bj = 0; bj < 2; ++bj) {
                    float v8[8];
#pragma unroll
                    for (int j = 0; j < 4; ++j) { v8[j] = acc[ai][bj][m][0][j] * rs; v8[4 + j] = acc[ai][bj][m][1][j] * rs; }
                    if (seg == 3) {
#pragma unroll
                        for (int j = 0; j < 8; ++j) v8[j] = silu_f(v8[j]);
                    }
                    *(u32x4*)(rowp + bj * 128) = pack8(v8);
                }
            }
    }
};

__device__ __forceinline__ void transpose_item(const float* W, int K, int N, bf16* WT, int item, int lane, const float* kscale) {
    const int nblk = N / 32, kb = item / nblk, nb = item % nblk, kq = lane & 7, c4 = lane >> 3;
    const int k0 = 64 * kb + 8 * kq, n0 = 32 * nb + 4 * c4;
    f32x4 v[8];
#pragma unroll
    for (int i = 0; i < 8; ++i) v[i] = *(const f32x4*)(W + (size_t)(k0 + i) * N + n0);
    if (kscale) {
        const f32x4 g0 = *(const f32x4*)(kscale + k0), g1 = *(const f32x4*)(kscale + k0 + 4);
#pragma unroll
        for (int i = 0; i < 4; ++i) { v[i] = v[i] * g0[i]; v[4 + i] = v[4 + i] * g1[i]; }
    }
#pragma unroll
    for (int j = 0; j < 4; ++j) {
        u32x4 o; o.x = pk2(v[0][j], v[1][j]); o.y = pk2(v[2][j], v[3][j]); o.z = pk2(v[4][j], v[5][j]); o.w = pk2(v[6][j], v[7][j]);
        *(u32x4*)(WT + (size_t)(n0 + j) * K + k0) = o;
    }
}

__device__ __forceinline__ void phase0(const PT& p, LAS unsigned char* lds, int tid, int lane, int wave) {
    unsigned char* ws = p.ws;
    const int gw = blockIdx.x * 8 + wave, NGW = gridDim.x * 8;
    const int gt = blockIdx.x * 512 + tid, NGT = gridDim.x * 512;
    for (int i = gt; i < 65536; i += NGT) ((float*)(ws + WS_ST0))[i] = 0.f;
    constexpr int I0 = 32 * (N0R / 32), I1 = 64 * 64, I2 = 32 * 256, I3 = 32 * 64;
    for (int it = gw; it < I0 + I1 + I2 + I3; it += NGW) {
        int r = it;
        if (r < I0) { transpose_item(p.in[2], 2048, N0R, (bf16*)(ws + WS_W0IN), r, lane, nullptr); continue; } r -= I0;
        if (r < I1) { transpose_item(p.in[13], 4096, 2048, (bf16*)(ws + WS_W0OUT), r, lane, nullptr); continue; } r -= I1;
        if (r < I2) { transpose_item(p.in[15], 2048, 8192, (bf16*)(ws + WS_W1IN), r, lane, p.in[14]); continue; } r -= I2;
        transpose_item(p.in[21], 2048, 2048, (bf16*)(ws + WS_W1OUT), r, lane, nullptr);
    }
    for (int i = gt; i < 16 * 128 * 128 / 8; i += NGT) {
        const int e = i * 8, t = (e >> 7) & 127, s0 = e & 127; const float* src = p.in[5] + e; float v[8];
#pragma unroll
        for (int j = 0; j < 8; ++j) v[j] = (s0 + j <= t) ? src[j] : 0.f;
        ((u32x4*)(ws + WS_WSP))[i] = pack8(v);
    }
    const float* g0 = p.in[1]; bf16* H0 = (bf16*)(ws + WS_H0);
    for (int m = gw; m < M; m += NGW) {
        const f32x4* xr = (const f32x4*)(p.in[0] + (size_t)m * 2048) + lane; f32x4 v[8]; float s = 0.f;
#pragma unroll
        for (int j = 0; j < 8; ++j) { v[j] = xr[64 * j]; s += (v[j].x * v[j].x + v[j].y * v[j].y) + (v[j].z * v[j].z + v[j].w * v[j].w); }
        const float rs = rsqrtf(wave_sum(s) * (1.f / 2048.f) + EPS);
        u32x2* o = (u32x2*)(H0 + (size_t)m * 2048) + lane;
#pragma unroll
        for (int j = 0; j < 8; ++j) { const f32x4 g = ((const f32x4*)g0)[lane + 64 * j]; u32x2 w; w.x = pk2(v[j].x * rs * g.x, v[j].y * rs * g.y); w.y = pk2(v[j].z * rs * g.z, v[j].w * rs * g.w); o[64 * j] = w; }
    }
}

__device__ __forceinline__ void phase_layout(const PT& p, int tid) {
    unsigned char* ws = p.ws; unsigned char* dob = (unsigned char*)p.out;
    const bf16* Vb = (const bf16*)(ws + WS_V); const float* st0 = (const float*)(ws + WS_ST0);
    const bf16* XBC = (const bf16*)(dob + DO_XBC);
    bf16 *vT = (bf16*)(ws + WS_VT), *xT = (bf16*)(ws + WS_XT), *Bn = (bf16*)(dob + DO_BN), *BT = (bf16*)(dob + DO_BT), *Cn = (bf16*)(ws + WS_CN);
    const int t = tid & 255, so = t >> 4, co = t & 15;
    for (int pi = blockIdx.x * 2 + (tid >> 8); pi < 128 * 24; pi += gridDim.x * 2) {
        const int bc = pi / 24, k = 16 + pi % 24; const int tok0 = bc * 128 + so * 8;
        float o[8][8];
        if (k < 16) {
            const int ch0 = k * 128 + co * 8;
            float g[8], bb[8];
#pragma unroll
            for (int j = 0; j < 8; ++j) { g[j] = p.in[3][ch0 + j]; bb[j] = p.in[4][ch0 + j]; }
#pragma unroll
            for (int i = 0; i < 8; ++i) {
                const int row = tok0 + i; float f[8]; unpack8(*(const u32x4*)(Vb + (size_t)row * 2048 + ch0), f);
                const float mu = st0[2 * row] * (1.f / 2048.f), var = st0[2 * row + 1] * (1.f / 2048.f) - mu * mu, rs = rsqrtf(fmaxf(var, 0.f) + EPS);
#pragma unroll
                for (int j = 0; j < 8; ++j) o[i][j] = (f[j] - mu) * rs * g[j] + bb[j];
            }
#pragma unroll
            for (int j = 0; j < 8; ++j) { float c8[8];
#pragma unroll
                for (int i = 0; i < 8; ++i) c8[i] = o[i][j];
                *(u32x4*)(vT + ((size_t)bc * 2048 + ch0 + j) * 128 + so * 8) = pack8(c8); }
        } else {
            const int sc0 = (k - 16) * 128 + co * 8;
            float cw[4][8], cb[8];
#pragma unroll
            for (int j = 0; j < 8; ++j) { cb[j] = p.in[8][sc0 + j];
#pragma unroll
                for (int kk = 0; kk < 4; ++kk) cw[kk][j] = p.in[7][kk * 3072 + sc0 + j]; }
            const int pos0 = (bc & 15) * 128 + so * 8;
            float xw[11][8];
#pragma unroll
            for (int ii = 0; ii < 11; ++ii) {
                if (pos0 - 3 + ii >= 0) unpack8(*(const u32x4*)(XBC + (size_t)(tok0 - 3 + ii) * 3072 + sc0), xw[ii]);
                else {
#pragma unroll
                    for (int j = 0; j < 8; ++j) xw[ii][j] = 0.f;
                }
            }
#pragma unroll
            for (int i = 0; i < 8; ++i)
#pragma unroll
                for (int j = 0; j < 8; ++j) { float a = cb[j];
#pragma unroll
                    for (int kk = 0; kk < 4; ++kk) a += cw[kk][j] * xw[i + kk][j];
                    o[i][j] = silu_f(a); }
            if (k < 32) {
#pragma unroll
                for (int j = 0; j < 8; ++j) { float c8[8];
#pragma unroll
                    for (int i = 0; i < 8; ++i) c8[i] = o[i][j];
                    *(u32x4*)(xT + ((size_t)bc * 2048 + sc0 + j) * 128 + so * 8) = pack8(c8); }
            } else if (k < 36) {
                const int n0 = sc0 - 2048;
#pragma unroll
                for (int i = 0; i < 8; ++i) *(u32x4*)(Bn + (size_t)(tok0 + i) * 512 + n0) = pack8(o[i]);
#pragma unroll
                for (int j = 0; j < 8; ++j) { float c8[8];
#pragma unroll
                    for (int i = 0; i < 8; ++i) c8[i] = o[i][j];
                    *(u32x4*)(BT + ((size_t)bc * 512 + n0 + j) * 128 + so * 8) = pack8(c8); }
            } else {
                const int n0 = sc0 - 2560;
#pragma unroll
                for (int i = 0; i < 8; ++i) *(u32x4*)(Cn + (size_t)(tok0 + i) * 512 + n0) = pack8(o[i]);
            }
        }
    }
}

__device__ __forceinline__ void chunk_cumsum(const float* DT, const float* a_log, int tok0, int hh, int lane, float& d0, float& d1, float& c0, float& c1, float& tot) {
    d0 = DT[(size_t)(tok0 + 2 * lane) * 32 + hh]; d1 = DT[(size_t)(tok0 + 2 * lane + 1) * 32 + hh];
    const float A = -__expf(a_log[hh]); const float x0 = d0 * A, x1 = d1 * A; float ps = x0 + x1;
#pragma unroll
    for (int o = 1; o < 64; o <<= 1) { const float t = __shfl_up(ps, o); if (lane >= o) ps += t; }
    c1 = ps; c0 = ps - x1; tot = __shfl(ps, 63);
}

__device__ __forceinline__ void phase_mix(const PT& p, LAS unsigned char* lds, int tid, int lane, int wave) {
    unsigned char* ws = p.ws; unsigned char* dob = (unsigned char*)p.out;
    const int r32 = lane & 31, h = lane >> 5;
    bf16* Ycat = (bf16*)(ws + WS_YCAT); const bf16* ZA = (const bf16*)(ws + WS_ZA); const bf16* Vb = (const bf16*)(ws + WS_V); const float* st0 = (const float*)(ws + WS_ST0); const bf16* Wsp = (const bf16*)(ws + WS_WSP);
    const bf16* xT = (const bf16*)(ws + WS_XT); const bf16* BT = (const bf16*)(dob + DO_BT); const float* DT = (const float*)(ws + WS_DT);
    bf16* ST = (bf16*)(ws + WS_STATES); float* CD = (float*)(ws + WS_CD);
    LAS float* wtab = (LAS float*)lds;
    constexpr int NG = 128 * 16, NS = NBATCH * 15 * 4;
    for (int it = blockIdx.x; it < NG + NS; it += gridDim.x) {
        if (it < NG) {
            const int bc = it >> 4, g = it & 15, cb = wave & 3, th = wave >> 2;
            const int ch0 = g * 128 + cb * 32;
            __syncthreads();
            {
                const int c16 = tid & 15; float lg[8], lb[8];
#pragma unroll
                for (int j = 0; j < 8; ++j) { lg[j] = p.in[3][g * 128 + 8 * c16 + j]; lb[j] = p.in[4][g * 128 + 8 * c16 + j]; }
#pragma unroll
                for (int i = 0; i < 4; ++i) {
                    const int row = (tid >> 4) + 32 * i; const size_t tokr = (size_t)bc * 128 + row;
                    float f[8]; unpack8(*(const u32x4*)(Vb + tokr * 2048 + g * 128 + 8 * c16), f);
                    const float mu = st0[2 * tokr] * (1.f / 2048.f), var = st0[2 * tokr + 1] * (1.f / 2048.f) - mu * mu, rs = rsqrtf(fmaxf(var, 0.f) + EPS);
#pragma unroll
                    for (int j = 0; j < 8; ++j) f[j] = (f[j] - mu) * rs * lg[j] + lb[j];
                    *(LAS u32x4*)(lds + row * 272 + 16 * c16) = pack8(f);
                    *(LAS u32x4*)(lds + GM_UOFF + row * 272 + 16 * c16) = *(const u32x4*)(Ycat + tokr * 4096 + g * 128 + 8 * c16);
                    *(LAS u32x4*)(lds + GM_ZOFF + row * 272 + 16 * c16) = *(const u32x4*)(ZA + tokr * 2048 + g * 128 + 8 * c16);
                }
            }
            __syncthreads();
            const LAS unsigned char* ap = lds + (8 * h + ((lane & 15) >> 2)) * 272 + (cb * 32 + 16 * ((lane >> 4) & 1)) * 2 + (lane & 3) * 8;
            f32x16 acc[2];
#pragma unroll
            for (int i = 0; i < 16; ++i) { acc[0][i] = 0.f; acc[1][i] = 0.f; }
#pragma unroll
            for (int st = 0; st < 8; ++st) {
                const v4i16_t lo = __builtin_amdgcn_ds_read_tr16_b64_v4i16((LAS v4i16_t*)(ap + 16 * st * 272)), hi = __builtin_amdgcn_ds_read_tr16_b64_v4i16((LAS v4i16_t*)(ap + (16 * st + 4) * 272));
                const bf16x8 a = {lo[0], lo[1], lo[2], lo[3], hi[0], hi[1], hi[2], hi[3]};
#pragma unroll
                for (int t2 = 0; t2 < 2; ++t2) { const int tb = 2 * th + t2;
                    if (st < 2 * (tb + 1)) { const bf16x8 b = ld_frag16(Wsp + ((size_t)g * 128 + tb * 32 + r32) * 128 + 16 * st + 8 * h); acc[t2] = mfma32(a, b, acc[t2]); } }
            }
#pragma unroll
            for (int t2 = 0; t2 < 2; ++t2) {
                const int t = (2 * th + t2) * 32 + r32; const float sb = p.in[6][g * 128 + t];
#pragma unroll
                for (int qd = 0; qd < 4; ++qd) {
                    const int cl = cb * 32 + 8 * qd + 4 * h;
                    LAS u32x2* up = (LAS u32x2*)(lds + GM_UOFF + t * 272 + cl * 2); const u32x2 uu = *up, zz = *(const LAS u32x2*)(lds + GM_ZOFF + t * 272 + cl * 2);
                    const float y0 = bflo(uu.x) * (acc[t2][4 * qd] + sb) * bflo(zz.x), y1 = bfhi(uu.x) * (acc[t2][4 * qd + 1] + sb) * bfhi(zz.x);
                    const float y2 = bflo(uu.y) * (acc[t2][4 * qd + 2] + sb) * bflo(zz.y), y3 = bfhi(uu.y) * (acc[t2][4 * qd + 3] + sb) * bfhi(zz.y);
                    u32x2 w; w.x = pk2(y0, y1); w.y = pk2(y2, y3); *up = w;
                }
            }
            __syncthreads();
            { const int c16 = tid & 15;
#pragma unroll
              for (int i = 0; i < 4; ++i) { const int row = (tid >> 4) + 32 * i; *(u32x4*)(Ycat + ((size_t)bc * 128 + row) * 4096 + g * 128 + 8 * c16) = *(const LAS u32x4*)(lds + GM_UOFF + row * 272 + 16 * c16); } }
        } else {
            const int id = it - NG, b = id / 60, c = (id / 4) % 15, grp = id & 3; const int bc = b * 16 + c, tok0 = bc * 128;
            __syncthreads();
            { const int hh = grp * 8 + wave; float d0, d1, c0, c1, tot; chunk_cumsum(DT, p.in[10], tok0, hh, lane, d0, d1, c0, c1, tot);
              wtab[wave * 128 + 2 * lane] = d0 * __expf(tot - c0); wtab[wave * 128 + 2 * lane + 1] = d1 * __expf(tot - c1);
              if (lane == 0) CD[bc * 32 + hh] = __expf(tot); }
            __syncthreads();
#pragma unroll 1
            for (int tk = 0; tk < 2; ++tk) {
                const int r = (wave >> 1) + 4 * tk, pb = wave & 1, hh = grp * 8 + r;
                const bf16* ap = xT + ((size_t)bc * 2048 + hh * 64 + pb * 32 + r32) * 128 + 8 * h;
                const bf16* bp = BT + ((size_t)bc * 512 + grp * 128 + r32) * 128 + 8 * h;
                f32x16 acc[4];
#pragma unroll
                for (int nb = 0; nb < 4; ++nb)
#pragma unroll
                    for (int i = 0; i < 16; ++i) acc[nb][i] = 0.f;
#pragma unroll
                for (int st = 0; st < 8; ++st) {
                    float f[8]; unpack8(*(const u32x4*)(ap + 16 * st), f);
                    const f32x4 w0 = *(const LAS f32x4*)(wtab + r * 128 + 16 * st + 8 * h), w1 = *(const LAS f32x4*)(wtab + r * 128 + 16 * st + 8 * h + 4);
                    f[0] *= w0.x; f[1] *= w0.y; f[2] *= w0.z; f[3] *= w0.w; f[4] *= w1.x; f[5] *= w1.y; f[6] *= w1.z; f[7] *= w1.w;
                    const bf16x8 a = __builtin_bit_cast(bf16x8, pack8(f));
#pragma unroll
                    for (int nb = 0; nb < 4; ++nb) { const bf16x8 bfr = ld_frag16(bp + (size_t)nb * 32 * 128 + 16 * st); acc[nb] = mfma32(a, bfr, acc[nb]); }
                }
                bf16* sp = ST + ((size_t)(bc * 32 + hh) * 64 + pb * 32) * 128;
#pragma unroll
                for (int nb = 0; nb < 4; ++nb)
#pragma unroll
                    for (int i = 0; i < 16; ++i) sp[(size_t)crow(i, h) * 128 + nb * 32 + r32] = (bf16)(pk2(acc[nb][i], 0.f) & 0xffffu);
            }
        }
    }
}

__device__ __forceinline__ void phase_scan(const PT& p, int tid) {
    unsigned char* ws = p.ws; const bf16* ST = (const bf16*)(ws + WS_STATES); const float* CD = (const float*)(ws + WS_CD); bf16* PV = (bf16*)((unsigned char*)p.out + DO_PREV);
    for (int id = blockIdx.x * 512 + tid; id < NBATCH * 32 * 64 * 16; id += gridDim.x * 512) {
        const int b = id >> 15, rem = id & 32767, hh = rem >> 10;
        float run[8];
#pragma unroll
        for (int j = 0; j < 8; ++j) run[j] = 0.f;
#pragma unroll
        for (int c = 0; c < 16; ++c) {
            const size_t off = ((size_t)(b * 16 + c) * 32 * 64 * 16 + rem) * 8;
            *(u32x4*)(PV + off) = pack8(run);
            if (c < 15) { float s[8]; unpack8(*(const u32x4*)(ST + off), s); const float cd = CD[(b * 16 + c) * 32 + hh];
#pragma unroll
                for (int j = 0; j < 8; ++j) run[j] = run[j] * cd + s[j]; }
        }
    }
}

__device__ __forceinline__ void phase_ssd_y(const PT& p, LAS unsigned char* lds, int tid, int lane, int wave) {
    unsigned char* ws = p.ws; unsigned char* dob = (unsigned char*)p.out;
    const int r32 = lane & 31, h = lane >> 5, half = wave >> 2, lb = wave & 3;
    bf16* Ycat = (bf16*)(ws + WS_YCAT); const bf16* xT = (const bf16*)(ws + WS_XT); const bf16* Bn = (const bf16*)(dob + DO_BN); const bf16* Cn = (const bf16*)(ws + WS_CN);
    const bf16* PV = (const bf16*)(dob + DO_PREV); const float* DT = (const float*)(ws + WS_DT);
    LAS float* acum = (LAS float*)lds + half * 2048; LAS float* dtt = acum + 1024;
    for (int base = blockIdx.x * 2; base < 128 * 4; base += gridDim.x * 2) {
        const int it = base + half, bc = it >> 2, grp = it & 3, tok0 = bc * 128;
        __syncthreads();
#pragma unroll 1
        for (int k = 0; k < 2; ++k) { const int r = lb + 4 * k, hh = grp * 8 + r; float d0, d1, c0, c1, tot; chunk_cumsum(DT, p.in[10], tok0, hh, lane, d0, d1, c0, c1, tot);
          acum[r * 128 + 2 * lane] = c0; acum[r * 128 + 2 * lane + 1] = c1; dtt[r * 128 + 2 * lane] = d0; dtt[r * 128 + 2 * lane + 1] = d1; }
        __syncthreads();
        const int l = lb * 32 + r32; const size_t tok = (size_t)tok0 + l;
        bf16x8 cf[8];
#pragma unroll
        for (int st = 0; st < 8; ++st) cf[st] = ld_frag16(Cn + tok * 512 + grp * 128 + 16 * st + 8 * h);
        f32x16 X[4];
#pragma unroll
        for (int sb = 0; sb < 4; ++sb) {
#pragma unroll
            for (int i = 0; i < 16; ++i) X[sb][i] = 0.f;
            if (sb <= lb) {
#pragma unroll
                for (int st = 0; st < 8; ++st) X[sb] = mfma32(ld_frag16(Bn + ((size_t)tok0 + sb * 32 + r32) * 512 + grp * 128 + 16 * st + 8 * h), cf[st], X[sb]);
            }
        }
        float ssq = 0.f;
#pragma unroll 1
        for (int r = 0; r < 8; ++r) {
            const int hh = grp * 8 + r;
            f32x16 acc[2];
#pragma unroll
            for (int pb = 0; pb < 2; ++pb) {
#pragma unroll
                for (int i = 0; i < 16; ++i) acc[pb][i] = 0.f;
                const bf16* pp = PV + ((size_t)(bc * 32 + hh) * 64 + pb * 32 + r32) * 128 + 8 * h;
#pragma unroll
                for (int st = 0; st < 8; ++st) acc[pb] = mfma32(ld_frag16(pp + 16 * st), cf[st], acc[pb]);
            }
            const float al = acum[r * 128 + l]; const float el = __expf(al); const float dsk = p.in[11][hh];
#pragma unroll
            for (int pb = 0; pb < 2; ++pb)
#pragma unroll
                for (int i = 0; i < 16; ++i) acc[pb][i] *= el;
            const bf16* xrow = xT + ((size_t)bc * 2048 + hh * 64 + r32) * 128 + 4 * h;
#pragma unroll
            for (int sb = 0; sb < 4; ++sb) {
                if (sb <= lb) {
                    f32x16 mm;
#pragma unroll
                    for (int qd = 0; qd < 4; ++qd) {
                        const int s0 = sb * 32 + 8 * qd + 4 * h;
                        const f32x4 as = *(const LAS f32x4*)(acum + r * 128 + s0), ds = *(const LAS f32x4*)(dtt + r * 128 + s0);
#pragma unroll
                        for (int j = 0; j < 4; ++j) { const float v = X[sb][4 * qd + j] * __expf(al - as[j]) * ds[j]; mm[4 * qd + j] = (s0 + j < l) ? v : ((s0 + j == l) ? v + dsk : 0.f); }
                    }
#pragma unroll
                    for (int s2 = 0; s2 < 2; ++s2) { const bf16x8 bfr = pack_frag(mm, s2);
#pragma unroll
                        for (int pb = 0; pb < 2; ++pb) acc[pb] = mfma32(ld_frag8x2(xrow + (size_t)pb * 32 * 128 + sb * 32 + 16 * s2), bfr, acc[pb]); }
                }
            }
#pragma unroll
            for (int pb = 0; pb < 2; ++pb)
#pragma unroll
                for (int qd = 0; qd < 4; ++qd) {
                    const int ch = hh * 64 + pb * 32 + 8 * qd + 4 * h;
                    u32x2* yp = (u32x2*)(Ycat + tok * 4096 + 2048 + ch); const u32x2 zz = *yp;
                    const float y0 = acc[pb][4 * qd] * bflo(zz.x), y1 = acc[pb][4 * qd + 1] * bfhi(zz.x);
                    const float y2 = acc[pb][4 * qd + 2] * bflo(zz.y), y3 = acc[pb][4 * qd + 3] * bfhi(zz.y);
                    ssq += (y0 * y0 + y1 * y1) + (y2 * y2 + y3 * y3);
                    u32x2 w; w.x = pk2(y0, y1); w.y = pk2(y2, y3); *yp = w;
                }
        }
        ssq += __shfl_xor(ssq, 32);
        const float rs = rsqrtf(ssq * (1.f / 512.f) + EPS);
#pragma unroll 1
        for (int r = 0; r < 8; ++r) {
#pragma unroll
            for (int pq = 0; pq < 8; ++pq) {
                const int ch = (grp * 8 + r) * 64 + (pq >> 2) * 32 + 8 * (pq & 3) + 4 * h;
                u32x2* yp = (u32x2*)(Ycat + tok * 4096 + 2048 + ch); const u32x2 yy = *yp; const f32x4 g = *(const f32x4*)(p.in[12] + ch);
                u32x2 w; w.x = pk2(bflo(yy.x) * rs * g.x, bfhi(yy.x) * rs * g.y); w.y = pk2(bflo(yy.y) * rs * g.z, bfhi(yy.y) * rs * g.w); *yp = w;
            }
        }
    }
}

constexpr int AK_PITCH = 272, AV_PITCH = 272, A_KOFF = 0, A_VOFF = 128 * AK_PITCH, A_STAGE = A_VOFF + 128 * AV_PITCH;
static_assert(2 * A_STAGE <= PTAB_OFF && 4 * 16384 <= A_STAGE, "attention LDS map");
__device__ __forceinline__ float max3f(float a, float b, float c) { return fmaxf(fmaxf(a, b), c); }
__device__ __forceinline__ void attn_unit(const PT& p, LAS unsigned char* lds, int tid, int lane, int wave, int b, int hd, int qb, float lam) {
    unsigned char* ws = p.ws;
    const bf16* Qb = (const bf16*)(ws + WS_Q); const bf16* Kb = (const bf16*)(ws + WS_K); const bf16* Vb = (const bf16*)(ws + WS_VV); const bf16* Gb = (const bf16*)((unsigned char*)p.out + DO_G);
    bf16* Ob = (bf16*)(ws + WS_O);
    const int r32 = lane & 31, h = lane >> 5, mp = wave >> 2, wq = wave & 3;
    const int qw0 = qb * 128 + 32 * wq, q = qw0 + r32; const unsigned tokq = (unsigned)(b * SEQ + q), tokb = (unsigned)(b * SEQ);
    const float slope2 = fexp2(-0.5f * (float)(hd + 1)) * LOG2E;
    bf16x8 qf[4];
#pragma unroll
    for (int ds = 0; ds < 4; ++ds) qf[ds] = ld_frag16(Qb + (tokq * 2048u + (unsigned)(hd * 128 + mp * 64 + 16 * ds + 8 * h)));
    float mrun = -INFINITY, lsum = 0.f;
    f32x16 oT[4];
#pragma unroll
    for (int db = 0; db < 4; ++db)
#pragma unroll
        for (int i = 0; i < 16; ++i) oT[db][i] = 0.f;
    const int ntiles = qb + 1;
    u32x4 preV[4], preK[4];
#define PREFETCH(t) do { \
        _Pragma("unroll") for (int i_ = 0; i_ < 4; ++i_) { const int pid_ = tid + 512 * i_, row_ = pid_ >> 4, c16_ = pid_ & 15; const unsigned go_ = (tokb + (unsigned)((t) * 128 + row_)) * 2048u + (unsigned)(hd * 128 + 8 * c16_); \
            preK[i_] = *(const u32x4*)(Kb + go_); preV[i_] = *(const u32x4*)(Vb + go_); } \
    } while (0)
    PREFETCH(0);
    const LAS unsigned char* kbase0 = lds + A_KOFF + r32 * AK_PITCH + (mp * 64 + 8 * h) * 2;
    const LAS unsigned char* vbase0 = lds + A_VOFF + (4 * h + ((lane & 15) >> 2)) * AV_PITCH + ((lane >> 4) & 1) * 32 + (lane & 3) * 8;
#define STAGE_WRITE(stg) do { \
        _Pragma("unroll") for (int i_ = 0; i_ < 4; ++i_) { const int pid_ = tid + 512 * i_, row_ = pid_ >> 4, c16_ = pid_ & 15; \
            *(LAS u32x4*)(lds + (stg) * A_STAGE + A_KOFF + row_ * AK_PITCH + 16 * c16_) = preK[i_]; *(LAS u32x4*)(lds + (stg) * A_STAGE + A_VOFF + row_ * AV_PITCH + 16 * c16_) = preV[i_]; } \
    } while (0)
    __syncthreads();
    STAGE_WRITE(0);
    asm volatile("" : "+v"(qf[0]), "+v"(qf[1]), "+v"(qf[2]), "+v"(qf[3]));
    __syncthreads();
#pragma unroll 1
    for (int t = 0; t < ntiles; ++t) {
        const int stg = t & 1;
        if (t + 1 < ntiles) PREFETCH(t + 1);
        const LAS unsigned char* kbase = kbase0 + stg * A_STAGE; const LAS unsigned char* vbase = vbase0 + stg * A_STAGE;
        const bool diag = (t == qb);
#pragma unroll 1
        for (int sub = 0; sub < 2; ++sub) {
            const int nact = diag ? min(2, max(0, wq + 1 - 2 * sub)) : 2;
            if (nact > 0) {
                float sl = slope2; asm volatile("" : "+v"(sl));
                const float bq = sl * (float)(t * 128 + sub * 64 + 4 * h - q);
                const LAS unsigned char* kb0 = kbase + sub * 64 * AK_PITCH; const LAS unsigned char* vb0 = vbase + sub * 64 * AV_PITCH;
                f32x16 s[2];
#pragma unroll
                for (int kb = 0; kb < 2; ++kb) {
                    if (kb < nact) {
                        const float bk = bq + sl * (float)(32 * kb);
#pragma unroll
                        for (int i = 0; i < 16; ++i) s[kb][i] = __builtin_fmaf(sl, (float)((i & 3) + 8 * (i >> 2)), bk);
#pragma unroll
                        for (int ds = 0; ds < 4; ++ds) s[kb] = mfma32(__builtin_bit_cast(bf16x8, *(const LAS u32x4*)(kb0 + kb * 32 * AK_PITCH + ds * 32)), qf[ds], s[kb]);
                    } else {
#pragma unroll
                        for (int i = 0; i < 16; ++i) s[kb][i] = -INFINITY;
                    }
                }
                if (diag) {
#pragma unroll
                    for (int kb = 0; kb < 2; ++kb) if (2 * sub + kb == wq) {
#pragma unroll
                        for (int i = 0; i < 16; ++i) if (crow(i, h) > r32) s[kb][i] = -INFINITY; }
                }
                float mx = -INFINITY;
#pragma unroll
                for (int kb = 0; kb < 2; ++kb)
#pragma unroll
                    for (int i = 0; i < 16; i += 2) mx = max3f(mx, s[kb][i], s[kb][i + 1]);
                mx = fmaxf(mx, __shfl_xor(mx, 32));
                const float mnew = fmaxf(mrun, mx), alpha = fexp2(mrun - mnew); mrun = mnew;
                float rs = 0.f;
#pragma unroll
                for (int kb = 0; kb < 2; ++kb)
#pragma unroll
                    for (int i = 0; i < 16; ++i) { s[kb][i] = fexp2(s[kb][i] - mnew); rs += s[kb][i]; }
                lsum = lsum * alpha + rs;
                if (__builtin_amdgcn_ballot_w64(alpha != 1.0f) != 0ull) {
#pragma unroll
                    for (int db = 0; db < 4; ++db)
#pragma unroll
                        for (int i = 0; i < 16; ++i) oT[db][i] *= alpha;
                }
#pragma unroll
                for (int kb = 0; kb < 2; ++kb) if (kb < nact) {
#pragma unroll
                    for (int s2 = 0; s2 < 2; ++s2) {
                        const bf16x8 pf = pack_frag(s[kb], s2);
#pragma unroll
                        for (int db = 0; db < 4; ++db) {
                            const LAS unsigned char* vp = vb0 + (kb * 32 + 16 * s2) * AV_PITCH + db * 64;
                            const v4i16_t lo = __builtin_amdgcn_ds_read_tr16_b64_v4i16((LAS v4i16_t*)vp), hi = __builtin_amdgcn_ds_read_tr16_b64_v4i16((LAS v4i16_t*)(vp + 8 * AV_PITCH));
                            const bf16x8 vf = {lo[0], lo[1], lo[2], lo[3], hi[0], hi[1], hi[2], hi[3]};
                            oT[db] = mfma32(vf, pf, oT[db]);
                        }
                    }
                }
            }
        }
        if (t + 1 < ntiles) STAGE_WRITE(stg ^ 1);
        __syncthreads();
    }
#undef PREFETCH
#undef STAGE_WRITE
    const float lt = lsum + __shfl_xor(lsum, 32);
    LAS float* xch = (LAS float*)(lds + (ntiles & 1) * A_STAGE + wq * 16384);
    if (mp == 1) { const float sc = lam / lt;
#pragma unroll
        for (int db = 0; db < 4; ++db)
#pragma unroll
            for (int i = 0; i < 16; ++i) xch[(db * 16 + i) * 64 + lane] = oT[db][i] * sc; }
    __syncthreads();
    if (mp == 0) {
        const float i1 = 1.f / lt; float ss = 0.f;
#pragma unroll
        for (int db = 0; db < 4; ++db)
#pragma unroll
            for (int i = 0; i < 16; ++i) { const float o = oT[db][i] * i1 - xch[(db * 16 + i) * 64 + lane]; oT[db][i] = o; ss += o * o; }
        ss += __shfl_xor(ss, 32);
        const float rn = rsqrtf(ss * (1.f / 128.f) + EPS) * (1.f - LAMBDA_INIT);
#pragma unroll
        for (int db = 0; db < 4; ++db)
#pragma unroll
            for (int qd = 0; qd < 4; ++qd) {
                const int d = db * 32 + 8 * qd + 4 * h; const unsigned off = tokq * 2048u + (unsigned)(hd * 128 + d);
                const u32x2 gg = *(const u32x2*)(Gb + off); const f32x4 sg = *(const f32x4*)(p.in[20] + d);
                u32x2 w; w.x = pk2(oT[db][4 * qd] * rn * sg.x * bflo(gg.x), oT[db][4 * qd + 1] * rn * sg.y * bfhi(gg.x));
                w.y = pk2(oT[db][4 * qd + 2] * rn * sg.z * bflo(gg.y), oT[db][4 * qd + 3] * rn * sg.w * bfhi(gg.y));
                *(u32x2*)(Ob + off) = w;
            }
    }
}

__device__ __forceinline__ void phase_attn(const PT& p, LAS unsigned char* lds, int tid, int lane, int wave) {
    const float s1 = wave_sum(p.in[16][lane] * p.in[17][lane]), s2 = wave_sum(p.in[18][lane] * p.in[19][lane]);
    const float lam = __expf(s1) - __expf(s2) + LAMBDA_INIT;
#pragma unroll 1
    for (int u = blockIdx.x; u < NBATCH * 16 * 8; u += gridDim.x) {
        const int j = u & 7, hd = (u >> 3) & 15, b = u >> 7;
#pragma unroll 1
        for (int k = 0; k < 2; ++k) attn_unit(p, lds, tid, lane, wave, b, hd, k == 0 ? 15 - j : j, lam);
    }
}

__device__ __forceinline__ void phase_final(const PT& p, int lane, int wave) {
    const float* st2 = (const float*)(p.ws + WS_ST2); const float* g = p.in[22];
    for (int m = blockIdx.x * 8 + wave; m < M; m += gridDim.x * 8) {
        const float rs = rsqrtf(st2[m] * (1.f / 2048.f) + EPS);
        f32x4* xr = (f32x4*)(p.out + (size_t)m * 2048) + lane;
#pragma unroll
        for (int j = 0; j < 8; ++j) { const f32x4 gg = ((const f32x4*)g)[lane + 64 * j]; f32x4 v = xr[64 * j]; v.x *= rs * gg.x; v.y *= rs * gg.y; v.z *= rs * gg.z; v.w *= rs * gg.w; xr[64 * j] = v; }
    }
}

constexpr size_t WS_BAR = 384 * 1024;
constexpr int XBST_OFF = PTAB_OFF + 256;
typedef __attribute__((address_space(1))) unsigned gu32;
#define XB_TMO      128
#define XB_XCNT(j)  (256  + 64 * (j))
#define XB_XSUB(j)  (1280 + 64 * (j))
#define XB_XGEN(j)  (2304 + 64 * (j))
#define XB_TOP      3328
#define XB_TOPGEN   3392
#define XCD_BAR_WORDS 3456
#define XB_SPIN_CAP (1u << 18)

__device__ __forceinline__ unsigned xb_ld(unsigned* p)              { return __hip_atomic_load(p, __ATOMIC_RELAXED, __HIP_MEMORY_SCOPE_AGENT); }
__device__ __forceinline__ unsigned xb_add(unsigned* p, unsigned v) { return __hip_atomic_fetch_add(p, v, __ATOMIC_RELAXED, __HIP_MEMORY_SCOPE_AGENT); }
__device__ __forceinline__ unsigned xb_xcc_id() { return (unsigned)__builtin_amdgcn_s_getreg((3 << 11) | 20) & 0xFu; }
#define XB_SPIN(cond, bar) do { unsigned _sp = 0; while (cond) { __builtin_amdgcn_s_sleep(1); \
    if ((++_sp & 255u) == 0u) { if (xb_ld(&(bar)[XB_TMO])) break; if (_sp > XB_SPIN_CAP) { atomicAdd(&(bar)[XB_TMO], 1u); break; } } } } while (0)

struct XcdBarrier {
    unsigned* bar; unsigned x;
    volatile LAS unsigned* st;
};

__device__ __forceinline__ XcdBarrier xcd_barrier_post(unsigned* bar, volatile LAS unsigned* st) {
    XcdBarrier b; b.bar = bar; b.x = xb_xcc_id(); b.st = st;
    if (threadIdx.x == 0) (void)xb_add(&bar[XB_XCNT(b.x)], 1u);
    return b;
}
__device__ __forceinline__ void xcd_barrier_complete(unsigned* bar, unsigned x, unsigned& nloc, unsigned& nx) {
    const unsigned G = gridDim.x * gridDim.y * gridDim.z;
    unsigned sum, cnt, mine, sp = 0u;
    for (;;) {
        sum = 0u; cnt = 0u; mine = 0u;
#pragma unroll
        for (unsigned j = 0; j < 16; ++j) { const unsigned c = xb_ld(&bar[XB_XCNT(j)]); sum += c; cnt += (c > 0u) ? 1u : 0u; mine = (j == x) ? c : mine; }
        if (sum == G) break;
        __builtin_amdgcn_s_sleep(1);
        if ((++sp & 255u) == 0u) { if (xb_ld(&bar[XB_TMO])) break; if (sp > XB_SPIN_CAP) { atomicAdd(&bar[XB_TMO], 1u); break; } }
    }
    nloc = mine > 0u ? mine : 1u; nx = cnt > 0u ? cnt : 1u;
}

__device__ __forceinline__ void xcd_barrier(const XcdBarrier& b) {
    asm volatile("s_waitcnt vmcnt(0)" ::: "memory");
    __syncthreads();
    if (threadIdx.x == 0) {
        unsigned* bar = b.bar;
        __builtin_amdgcn_s_waitcnt(0);
        unsigned nloc = b.st[0], nx = b.st[1];
        if (nloc == 0u) { xcd_barrier_complete(bar, b.x, nloc, nx); b.st[0] = nloc; b.st[1] = nx; }
        const unsigned old = xb_add(&bar[XB_XSUB(b.x)], 1u);
        const unsigned gen = old / nloc;
        if (old + 1u == (gen + 1u) * nloc) {
            __builtin_amdgcn_fence(__ATOMIC_RELEASE, "agent");
            asm volatile("s_waitcnt vmcnt(0)" ::: "memory");
            const unsigned og = xb_add(&bar[XB_TOP], 1u);
            const unsigned tg = og / nx;
            if (og + 1u == (tg + 1u) * nx) xb_add(&bar[XB_TOPGEN], 1u);
            else XB_SPIN(xb_ld(&bar[XB_TOPGEN]) == tg, bar);
            __builtin_amdgcn_fence(__ATOMIC_ACQUIRE, "agent");
            xb_add(&bar[XB_XGEN(b.x)], 1u);
            asm volatile("s_waitcnt vmcnt(0)" ::: "memory");
        } else {
            XB_SPIN(xb_ld(&bar[XB_XGEN(b.x)]) == gen, bar);
            __builtin_amdgcn_fence(__ATOMIC_ACQUIRE, "agent");
            asm volatile("s_waitcnt vmcnt(0)" ::: "memory");
        }
    }
    __syncthreads();
}

__global__ void __launch_bounds__(512) fwd_megakernel(Params pa) {
    extern __shared__ __attribute__((aligned(16))) unsigned char lds_raw[];
    cg::grid_group grid = cg::this_grid();
    LAS unsigned char* lds = (LAS unsigned char*)lds_raw;
    if (threadIdx.x < 25) {
        unsigned long long v = 0;
#pragma unroll
        for (int i = 0; i < 23; ++i) if ((int)threadIdx.x == i) v = (unsigned long long)pa.in[i];
        if (threadIdx.x == 23) v = (unsigned long long)pa.out;
        if (threadIdx.x == 24) v = (unsigned long long)pa.ws;
        ((LAS unsigned long long*)(lds + PTAB_OFF))[threadIdx.x] = v;
    }
    if (threadIdx.x < 2) ((LAS unsigned*)(lds + XBST_OFF))[threadIdx.x] = 0u;
    __syncthreads();
    const XcdBarrier bar = xcd_barrier_post((unsigned*)(pa.ws + WS_BAR), (volatile LAS unsigned*)(lds + XBST_OFF));
#ifndef PHMASK
#define PHMASK 0x3ff
#endif
#define PH(n) (((PHMASK) >> (n)) & 1)
#define TLW int tid_ = threadIdx.x; asm volatile("" : "+v"(tid_)); const int tid = tid_, lane = tid & 63, wave = __builtin_amdgcn_readfirstlane(tid >> 6); (void)tid; (void)lane; (void)wave
#define GRIDV const int G = gridDim.x, c = blockIdx.x
    if (PH(0)) { PT p; TLW; phase0(p, lds, tid, lane, wave); }
    grid.sync();
    if (PH(1)) {
        PT p; GRIDV; unsigned char* ws = p.ws; unsigned char* dob = (unsigned char*)p.out;
        pg8::Gemm g{(const pg8::bf16_t*)(ws + WS_H0), (const pg8::bf16_t*)(ws + WS_W0IN), M, N0P, 2048}; pg8::StaticOrder S; S.init(M, N0P, G, c);
        EpiIn0 E{(bf16*)(ws + WS_YCAT), (bf16*)(ws + WS_V), (bf16*)(ws + WS_ZA), (bf16*)(dob + DO_XBC), (float*)(ws + WS_ST0)};
        pg8::gemm_phase<EpiIn0, pg8::StaticOrder, true, true>(lds, g, S, E);
        { TLW; dt_tasks(p, lane, wave); }
    }
    xcd_barrier(bar);
    if (PH(2)) { PT p; TLW; phase_layout(p, tid); }
    xcd_barrier(bar);
    if (PH(3)) { PT p; TLW; phase_mix(p, lds, tid, lane, wave); }
    xcd_barrier(bar);
    if (PH(4)) { PT p; TLW; phase_scan(p, tid); }
    xcd_barrier(bar);
    if (PH(5)) { PT p; TLW; phase_ssd_y(p, lds, tid, lane, wave); }
    xcd_barrier(bar);
    if (PH(6)) {
        PT p; GRIDV; unsigned char* ws = p.ws;
        pg8::Gemm g{(const pg8::bf16_t*)(ws + WS_YCAT), (const pg8::bf16_t*)(ws + WS_W0OUT), M, 2048, 4096}; pg8::StaticOrder S; S.init(M, 2048, G, c);
        EpiResT<false> E{p.in[0], nullptr, (bf16*)(ws + WS_X1B), (float*)(ws + WS_ST1)};
        pg8::gemm_phase<EpiResT<false>, pg8::StaticOrder, true, true>(lds, g, S, E);
    }
    xcd_barrier(bar);
    if (PH(6)) {
        PT p; GRIDV; unsigned char* ws = p.ws; unsigned char* dob = (unsigned char*)p.out;
        pg8::Gemm g{(const pg8::bf16_t*)(ws + WS_X1B), (const pg8::bf16_t*)(ws + WS_W1IN), M, 8192, 2048}; pg8::StaticOrder S; S.init(M, 8192, G, c);
        EpiIn1 E{(bf16*)(ws + WS_Q), (bf16*)(ws + WS_K), (bf16*)(ws + WS_VV), (bf16*)(dob + DO_G), (const float*)(ws + WS_ST1)};
        pg8::gemm_phase<EpiIn1, pg8::StaticOrder, true, true>(lds, g, S, E);
    }
    xcd_barrier(bar);
    if (PH(7)) { PT p; TLW; phase_attn(p, lds, tid, lane, wave); }
    xcd_barrier(bar);
    if (PH(8)) {
        PT p; GRIDV; unsigned char* ws = p.ws;
        pg8::Gemm g{(const pg8::bf16_t*)(ws + WS_O), (const pg8::bf16_t*)(ws + WS_W1OUT), M, 2048, 2048}; pg8::StaticOrder S; S.init(M, 2048, G, c);
        EpiResT<true> E{(const void*)(ws + WS_X1B), p.out, nullptr, (float*)(ws + WS_ST2)};
        pg8::gemm_phase<EpiResT<true>, pg8::StaticOrder, true, true>(lds, g, S, E);
    }
    xcd_barrier(bar);
    if (PH(9)) { PT p; TLW; phase_final(p, lane, wave); }
}

extern "C" void kernel_launch(void* const* d_in, const int* in_sizes, int n_in, void* d_out, int out_size, void* d_ws, size_t ws_size, hipStream_t stream) {
    static int grid = 0;
    if (grid == 0) {
        if (n_in != 23 || out_size != M * DM || ws_size < WS_END) { fprintf(stderr, "kernel_launch: unexpected shapes (n_in %d out %d ws %zu)\n", n_in, out_size, ws_size); grid = -1; return; }
        int dev = 0, cus = 0, per_cu = 0;
        hipGetDevice(&dev); hipDeviceGetAttribute(&cus, hipDeviceAttributeMultiprocessorCount, dev);
        hipFuncSetAttribute((const void*)fwd_megakernel, hipFuncAttributeMaxDynamicSharedMemorySize, LDS_BYTES);
        hipOccupancyMaxActiveBlocksPerMultiprocessor(&per_cu, (const void*)fwd_megakernel, 512, LDS_BYTES);
        if (per_cu < 1) { fprintf(stderr, "kernel_launch: occupancy query says %d blocks per CU\n", per_cu); per_cu = 1; }
        (void)hipGetLastError();
        grid = cus;
    }
    if (grid < 0) return;
    Params p{};
    for (int i = 0; i < 23; ++i) p.in[i] = (const float*)d_in[i];
    p.out = (float*)d_out; p.ws = (unsigned char*)d_ws;
    if (hipMemsetAsync((char*)d_ws + WS_BAR, 0, XCD_BAR_WORDS * 4, stream) != hipSuccess) { fprintf(stderr, "kernel_launch: memset of the barrier words failed\n"); return; }
    void* args[] = {&p};
    hipError_t e = hipLaunchCooperativeKernel((const void*)fwd_megakernel, dim3(grid), dim3(512), args, LDS_BYTES, stream);
    if (e != hipSuccess) fprintf(stderr, "cooperative launch failed: %s (grid %d)\n", hipGetErrorString(e), grid);
}
```

```cpp
#include <hip/hip_runtime.h>
#include <hip/hip_cooperative_groups.h>
#include <cstdio>
#include <cstdint>
#include <cmath>
namespace cg = cooperative_groups;
namespace pg8 {
#define PG8_LAS __attribute__((address_space(3)))
typedef unsigned short bf16_t;
typedef short bf16x8 __attribute__((ext_vector_type(8)));
typedef float f32x4 __attribute__((ext_vector_type(4)));
typedef unsigned u32x4 __attribute__((ext_vector_type(4)));
constexpr int BM = 256, BK = 64, HALF = 128, HTB = HALF * BK * 2  , STAGE_BYTES = 8 * HTB, NXCD = 8, WGM = 8;

__host__ __device__ __forceinline__ int lds_byte(int r, int c) { const int st = (r >> 4) * 2 + (c >> 5), rr = r & 15, cc = c & 31, ob = rr * 64 + cc * 2; return st * 1024 + (ob ^ (((ob >> 9) & 1) << 5)); }
__host__ __device__ __forceinline__ void stage_rc(int b, int& R, int& C) { const int st = b / 1024, sb = b % 1024, swz = sb ^ (((sb >> 9) & 1) << 5); R = (st >> 1) * 16 + swz / 64; C = (st & 1) * 32 + (swz % 64) / 2; }
__host__ __device__ __forceinline__ int perm32(int rho) { const int n = rho >> 4, i = rho & 15; return 8 * (i >> 2) + 4 * n + (i & 3); }

struct Unit { int pm, pn; };
struct Gemm { const bf16_t* A; const bf16_t* Bt; int M, N, K; };

struct StaticOrder {
    int nM, nN, nwg, G, c;
    __host__ __device__ void init(int M, int N, int G_, int c_) { nM = M / BM; nN = N / BM; nwg = nM * nN; G = G_; c = c_; }
    __host__ __device__ bool next(int i, Unit& u) const {
        const long L = (long)i * G + c; if (L >= nwg) return false;
        int wgid = (int)L; { const int q = nwg / NXCD, r = nwg % NXCD, xcd = wgid % NXCD, off = wgid / NXCD; wgid = (xcd < r ? xcd * (q + 1) : r * (q + 1) + (xcd - r) * q) + off; }
        const int nig = WGM * nN, gid = wgid / nig, fm = gid * WGM, gsz = (nM - fm) < WGM ? (nM - fm) : WGM;
        u.pm = fm + ((wgid % nig) % gsz); u.pn = (wgid % nig) / gsz; return true;
    }
    __device__ __forceinline__ void a_ready(const Unit&) const {}
    __device__ __forceinline__ void done(const Unit&) const {}
};

template <class Epi, class Sched, bool ALIGN_EPI = false, bool SP2 = false>
__device__ __forceinline__ void gemm_phase(PG8_LAS unsigned char* lds, const Gemm g, const Sched& S, const Epi& E) {
    int tid_ = threadIdx.x; asm volatile("" : "+v"(tid_));
    const int tid = tid_, wid = __builtin_amdgcn_readfirstlane(tid >> 6), lane = tid & 63, wr = wid >> 2, wc = wid & 3, fr = lane & 15, fq = lane >> 4;
    const int K = g.K, nt = K / BK;
    unsigned voffA[2], voffB[2];
#pragma unroll
    for (int i = 0; i < 2; ++i) { int R, C; stage_rc(tid * 16 + i * 8192, R, C); const int Rb = Epi::PERM ? ((R & ~31) + perm32(R & 31)) : R;
        voffA[i] = (unsigned)(R * K + C) * 2u; voffB[i] = (unsigned)(Rb * K + C) * 2u; }
    const size_t kstep = (size_t)(BK * 2);
    const size_t hstep = (size_t)HALF * K * 2;
    const size_t tstep = 2 * hstep;
    const unsigned ldsw = (unsigned)wid * 1024u;
    const int aoff = lds_byte(wr * 64 + fr, fq * 8), boff = lds_byte(wc * 32 + fr, fq * 8);
#define PG8_SA(b, h) (((b) * 2 + (h)) * HTB)
#define PG8_SB(b, h) ((4 + (b) * 2 + (h)) * HTB)
#define PG8_STAGE(bufoff, gbase, voff) do { _Pragma("unroll") for (int _i = 0; _i < 2; ++_i) \
        __builtin_amdgcn_global_load_lds((const unsigned*)((const char*)(gbase) + (voff)[_i]), (PG8_LAS unsigned*)(lds + (bufoff) + ldsw + _i * 8192), 16, 0, 0); } while (0)
#define PG8_LDA(dst, b, h) do { _Pragma("unroll") for (int m = 0; m < 4; ++m) _Pragma("unroll") for (int k = 0; k < 2; ++k) dst[m][k] = *(const PG8_LAS bf16x8*)(lds + PG8_SA(b, h) + aoff + m * 2048 + k * 1024); } while (0)
#define PG8_LDB(dst, b, h) do { _Pragma("unroll") for (int n = 0; n < 2; ++n) _Pragma("unroll") for (int k = 0; k < 2; ++k) dst[n][k] = *(const PG8_LAS bf16x8*)(lds + PG8_SB(b, h) + boff + n * 2048 + k * 1024); } while (0)
#define PG8_MMA(ai, bj, At, Bt) do { __builtin_amdgcn_s_setprio(1); _Pragma("unroll") for (int m = 0; m < 4; ++m) _Pragma("unroll") for (int n = 0; n < 2; ++n) _Pragma("unroll") for (int k = 0; k < 2; ++k) \
        acc[ai][bj][m][n] = __builtin_amdgcn_mfma_f32_16x16x32_bf16(Bt[n][k], At[m][k], acc[ai][bj][m][n], 0, 0, 0); __builtin_amdgcn_s_setprio(0); } while (0)
#define PG8_WAIT_V(n) asm volatile("s_waitcnt vmcnt(" #n ")" ::: "memory")
#define PG8_WAIT_L(n) asm volatile("s_waitcnt lgkmcnt(" #n ")" ::: "memory")
#define PG8_BAR __builtin_amdgcn_s_barrier()
#define PG8_SCHED __builtin_amdgcn_sched_barrier(0)
    Unit cur, nxt; int ui = 0;
    if (!S.next(0, cur)) return;
    f32x4 acc[2][2][4][2];
#pragma unroll
    for (int a = 0; a < 2; ++a)
#pragma unroll
        for (int b = 0; b < 2; ++b)
#pragma unroll
            for (int m = 0; m < 4; ++m)
#pragma unroll
                for (int n = 0; n < 2; ++n) acc[a][b][m][n] = (f32x4){0.f, 0.f, 0.f, 0.f};
    bf16x8 At[4][2], B0[2][2], B1[2][2];
    const char* cA = (const char*)g.A + (size_t)cur.pm * tstep; const char* cB = (const char*)g.Bt + (size_t)cur.pn * tstep;
    S.a_ready(cur);
    if constexpr (SP2) {
        PG8_STAGE(PG8_SB(0, 0), cB, voffB); PG8_STAGE(PG8_SB(0, 1), cB + hstep, voffB); PG8_STAGE(PG8_SA(0, 0), cA, voffA); PG8_STAGE(PG8_SA(0, 1), cA + hstep, voffA);
        if (wr == 1) PG8_BAR;
        PG8_WAIT_V(2); PG8_BAR;
        PG8_STAGE(PG8_SB(1, 0), cB + kstep, voffB); PG8_STAGE(PG8_SA(1, 0), cA + kstep, voffA); PG8_STAGE(PG8_SB(1, 1), cB + hstep + kstep, voffB);
        PG8_WAIT_V(6); PG8_BAR;
    } else {
        PG8_STAGE(PG8_SB(0, 0), cB, voffB); PG8_STAGE(PG8_SA(0, 0), cA, voffA); PG8_STAGE(PG8_SB(0, 1), cB + hstep, voffB); PG8_STAGE(PG8_SA(0, 1), cA + hstep, voffA);
        if (wr == 1) PG8_BAR;
        PG8_WAIT_V(4); PG8_BAR;
        PG8_STAGE(PG8_SB(1, 0), cB + kstep, voffB); PG8_STAGE(PG8_SA(1, 0), cA + kstep, voffA); PG8_STAGE(PG8_SB(1, 1), cB + hstep + kstep, voffB);
        PG8_WAIT_V(6); PG8_BAR;
    }
    for (;;) {
        const bool has_next = S.next(ui + 1, nxt);
        const char* nA = has_next ? (const char*)g.A + (size_t)nxt.pm * tstep : cA; const char* nB = has_next ? (const char*)g.Bt + (size_t)nxt.pn * tstep : cB;
        for (int t = 0; t < nt; t += 2) {
            const bool last = (t == nt - 2);
            const char* a1 = cA + (size_t)(t + 1) * kstep;
            const char* a2 = last ? nA : cA + (size_t)(t + 2) * kstep; const char* b2 = last ? nB : cB + (size_t)(t + 2) * kstep;
            const char* a3 = a2 + kstep; const char* b3 = b2 + kstep;
            if (last && has_next) S.a_ready(nxt);
            if constexpr (SP2) {
            PG8_LDB(B0, 0, 0); PG8_LDB(B1, 0, 1); PG8_SCHED; PG8_LDA(At, 0, 0); PG8_STAGE(PG8_SA(1, 1), a1 + hstep, voffA);
            PG8_WAIT_V(8); PG8_WAIT_L(0); PG8_BAR; PG8_MMA(0, 0, At, B0); PG8_MMA(0, 1, At, B1); PG8_BAR; PG8_SCHED;
            PG8_LDA(At, 0, 1); PG8_STAGE(PG8_SB(0, 0), b2, voffB); PG8_STAGE(PG8_SB(0, 1), b2 + hstep, voffB); PG8_STAGE(PG8_SA(0, 0), a2, voffA);
            PG8_WAIT_V(8); PG8_WAIT_L(0); PG8_BAR; PG8_MMA(1, 0, At, B0); PG8_MMA(1, 1, At, B1); PG8_BAR; PG8_SCHED;
            PG8_LDB(B0, 1, 0); PG8_LDB(B1, 1, 1); PG8_SCHED; PG8_LDA(At, 1, 0); PG8_STAGE(PG8_SA(0, 1), a2 + hstep, voffA);
            PG8_WAIT_V(8); PG8_WAIT_L(0); PG8_BAR; PG8_MMA(0, 0, At, B0); PG8_MMA(0, 1, At, B1); PG8_BAR; PG8_SCHED;
            PG8_LDA(At, 1, 1); PG8_STAGE(PG8_SB(1, 0), b3, voffB); PG8_STAGE(PG8_SB(1, 1), b3 + hstep, voffB); PG8_STAGE(PG8_SA(1, 0), a3, voffA);
            PG8_WAIT_V(8); PG8_WAIT_L(0); PG8_BAR; PG8_MMA(1, 0, At, B0); PG8_MMA(1, 1, At, B1); PG8_BAR; PG8_SCHED;
            } else {
            PG8_LDB(B0, 0, 0); PG8_SCHED; PG8_LDA(At, 0, 0); PG8_STAGE(PG8_SA(1, 1), a1 + hstep, voffA);
            PG8_WAIT_L(8); PG8_BAR; PG8_WAIT_L(0); PG8_MMA(0, 0, At, B0); PG8_BAR; PG8_SCHED;
            PG8_LDB(B1, 0, 1); PG8_STAGE(PG8_SB(0, 0), b2, voffB);
            PG8_BAR; PG8_WAIT_L(0); PG8_MMA(0, 1, At, B1); PG8_BAR;
            PG8_LDA(At, 0, 1); PG8_STAGE(PG8_SA(0, 0), a2, voffA);
            PG8_BAR; PG8_WAIT_L(0); PG8_MMA(1, 0, At, B0); PG8_BAR; PG8_SCHED;
            PG8_STAGE(PG8_SB(0, 1), b2 + hstep, voffB);
            PG8_WAIT_V(6); PG8_BAR; PG8_MMA(1, 1, At, B1); PG8_BAR;
            PG8_LDB(B0, 1, 0); PG8_SCHED; PG8_LDA(At, 1, 0); PG8_STAGE(PG8_SA(0, 1), a2 + hstep, voffA);
            PG8_WAIT_L(8); PG8_BAR; PG8_WAIT_L(0); PG8_MMA(0, 0, At, B0); PG8_BAR; PG8_SCHED;
            PG8_LDB(B1, 1, 1); PG8_STAGE(PG8_SB(1, 0), b3, voffB);
            PG8_BAR; PG8_WAIT_L(0); PG8_MMA(0, 1, At, B1); PG8_BAR;
            PG8_LDA(At, 1, 1); PG8_STAGE(PG8_SA(1, 0), a3, voffA);
            PG8_BAR; PG8_WAIT_L(0); PG8_MMA(1, 0, At, B0); PG8_BAR; PG8_SCHED;
            PG8_STAGE(PG8_SB(1, 1), b3 + hstep, voffB);
            PG8_WAIT_V(6); PG8_BAR; PG8_MMA(1, 1, At, B1); PG8_BAR;
            }
        }
        if constexpr (ALIGN_EPI) { if (wr == 0) PG8_BAR; }
        if constexpr (!Epi::AFTER_DRAIN) { E(acc, cur, wr, wc, fr, fq); S.done(cur); }
        if (!has_next) break;
#pragma unroll
        for (int a = 0; a < 2; ++a)
#pragma unroll
            for (int b = 0; b < 2; ++b)
#pragma unroll
                for (int m = 0; m < 4; ++m)
#pragma unroll
                    for (int n = 0; n < 2; ++n) acc[a][b][m][n] = (f32x4){0.f, 0.f, 0.f, 0.f};
        cur = nxt; cA = nA; cB = nB; ++ui;
        if constexpr (ALIGN_EPI) { if (wr == 1) PG8_BAR; }
    }
    PG8_WAIT_V(0);
    if constexpr (!ALIGN_EPI) { if (wr == 0) PG8_BAR; }
    PG8_BAR;
    if constexpr (Epi::AFTER_DRAIN) { E.fused(acc, cur, wr, wc, fr, fq, lds, wid, lane); S.done(cur); }
#undef PG8_SA
#undef PG8_SB
#undef PG8_STAGE
#undef PG8_LDA
#undef PG8_LDB
#undef PG8_MMA
#undef PG8_WAIT_V
#undef PG8_WAIT_L
#undef PG8_BAR
#undef PG8_SCHED
}
}

#define LAS __attribute__((address_space(3)))
typedef unsigned short bf16;
typedef unsigned u32x4 __attribute__((ext_vector_type(4)));
typedef unsigned u32x2 __attribute__((ext_vector_type(2)));
typedef float f32x4 __attribute__((ext_vector_type(4)));
typedef float f32x16 __attribute__((ext_vector_type(16)));
typedef short bf16x8 __attribute__((ext_vector_type(8)));
typedef short v4i16_t __attribute__((ext_vector_type(4)));

constexpr int M = 16384, DM = 2048, SEQ = 2048, NBATCH = 8, NCH = 16;
constexpr int N0P = 11264, N0R = 11296;
constexpr float EPS = 1e-5f;
constexpr float LOG2E = 1.4426950408889634f;
constexpr float QSCALE = 0.125f * LOG2E;
constexpr float LAMBDA_INIT = 0.35550906f;
constexpr size_t MiB = 1u << 20;
constexpr size_t WS_ST0 = 0, WS_ST1 = 128 * 1024, WS_ST2 = 192 * 1024, WS_CD = 256 * 1024, WS_LAM = 300 * 1024;
constexpr size_t WS_DT = 1 * MiB, WS_WSP = 3 * MiB, WS_W0IN = 4 * MiB, WS_W0OUT = 49 * MiB, WS_W1IN = 65 * MiB, WS_W1OUT = 97 * MiB;
constexpr size_t WS_YCAT = 105 * MiB, WS_ZA = 233 * MiB, WS_V = 297 * MiB, WS_H0 = 361 * MiB, WS_XT = 425 * MiB, WS_CN = 489 * MiB, WS_END = 505 * MiB;
constexpr size_t WS_Q = WS_YCAT, WS_K = WS_YCAT + 64 * MiB, WS_X1 = WS_ZA, WS_STATES = WS_V, WS_VT = WS_H0, WS_X1B = WS_H0, WS_O = WS_ZA, WS_VV = WS_XT, WS_X2B = WS_YCAT;
constexpr size_t DO_XBC = 0, DO_BN = 96 * MiB, DO_BT = 112 * MiB, DO_PREV = 0, DO_G = 0;
constexpr int LDS_BYTES = 147456;
constexpr int GM_UOFF = 128 * 272, GM_ZOFF = 2 * 128 * 272;

__device__ __forceinline__ unsigned pk2(float lo, float hi) {
    typedef float f2 __attribute__((ext_vector_type(2))); typedef __bf16 b2 __attribute__((ext_vector_type(2)));
    f2 v = {lo, hi}; b2 b = __builtin_convertvector(v, b2); return __builtin_bit_cast(unsigned, b);
}
__device__ __forceinline__ float bflo(unsigned u) { return __uint_as_float(u << 16); }
__device__ __forceinline__ float bfhi(unsigned u) { return __uint_as_float(u & 0xffff0000u); }
__device__ __forceinline__ void unpack8(u32x4 r, float* f) { f[0] = bflo(r.x); f[1] = bfhi(r.x); f[2] = bflo(r.y); f[3] = bfhi(r.y); f[4] = bflo(r.z); f[5] = bfhi(r.z); f[6] = bflo(r.w); f[7] = bfhi(r.w); }
__device__ __forceinline__ u32x4 pack8(const float* f) { u32x4 o; o.x = pk2(f[0], f[1]); o.y = pk2(f[2], f[3]); o.z = pk2(f[4], f[5]); o.w = pk2(f[6], f[7]); return o; }
__device__ __forceinline__ float fexp2(float x) { return __builtin_amdgcn_exp2f(x); }
__device__ __forceinline__ float gelu_f(float x) { const float z = 1.5957691216057308f * (x + 0.044715f * x * x * x); return x * __builtin_amdgcn_rcpf(1.0f + __expf(-z)); }
__device__ __forceinline__ float silu_f(float x) { return x * __builtin_amdgcn_rcpf(1.0f + __expf(-x)); }
__device__ __forceinline__ int crow(int r, int h) { return (r & 3) + 8 * (r >> 2) + 4 * h; }
__device__ __forceinline__ f32x16 mfma32(bf16x8 a, bf16x8 b, f32x16 c) { return __builtin_amdgcn_mfma_f32_32x32x16_bf16(a, b, c, 0, 0, 0); }
__device__ __forceinline__ bf16x8 ld_frag16(const bf16* p) { return __builtin_bit_cast(bf16x8, *(const u32x4*)p); }
__device__ __forceinline__ bf16x8 ld_frag8x2(const bf16* p) { const u32x2 lo = *(const u32x2*)p, hi = *(const u32x2*)(p + 8); u32x4 v; v.x = lo.x; v.y = lo.y; v.z = hi.x; v.w = hi.y; return __builtin_bit_cast(bf16x8, v); }
__device__ __forceinline__ bf16x8 pack_frag(const f32x16& x, int s) {
    u32x4 v; v.x = pk2(x[8 * s], x[8 * s + 1]); v.y = pk2(x[8 * s + 2], x[8 * s + 3]); v.z = pk2(x[8 * s + 4], x[8 * s + 5]); v.w = pk2(x[8 * s + 6], x[8 * s + 7]); return __builtin_bit_cast(bf16x8, v);
}
__device__ __forceinline__ float wave_sum(float v) {
#pragma unroll
    for (int o = 1; o < 64; o <<= 1) v += __shfl_xor(v, o);
    return v;
}
#define LDS_WAIT() asm volatile("s_waitcnt lgkmcnt(0)" ::: "memory")
__device__ __forceinline__ void atomic_addf(float* p, float v) { __hip_atomic_fetch_add(p, v, __ATOMIC_RELAXED, __HIP_MEMORY_SCOPE_AGENT); }

struct Params { const float* in[23]; float* out; unsigned char* ws; };
constexpr int PTAB_OFF = LDS_BYTES - 512;
__device__ __forceinline__ unsigned long long ptab_get(int i) {
    const unsigned long long v = ((const LAS unsigned long long*)(PTAB_OFF))[i];
    const unsigned lo = __builtin_amdgcn_readfirstlane((unsigned)v), hi = __builtin_amdgcn_readfirstlane((unsigned)(v >> 32));
    return ((unsigned long long)hi << 32) | lo;
}
struct PT {
    struct InTab { __device__ __forceinline__ const float* operator[](int i) const { return (const float*)(const __attribute__((address_space(1))) float*)ptab_get(i); } } in;
    float* out; unsigned char* ws;
    __device__ __forceinline__ PT() { out = (float*)(__attribute__((address_space(1))) float*)ptab_get(23); ws = (unsigned char*)(__attribute__((address_space(1))) unsigned char*)ptab_get(24); }
};

template <int ACT>
__device__ __forceinline__ void epi_tile_bf16(const f32x4 (&acc)[2][2][4][2], bf16* base, int pitch, int col0, int row0, float sc) {
#pragma unroll
    for (int ai = 0; ai < 2; ++ai)
#pragma unroll
        for (int m = 0; m < 4; ++m) {
            bf16* rowp = base + (size_t)(row0 + ai * 128 + m * 16) * pitch + col0;
#pragma unroll
            for (int bj = 0; bj < 2; ++bj) {
                float v[8];
#pragma unroll
                for (int j = 0; j < 4; ++j) { v[j] = acc[ai][bj][m][0][j]; v[4 + j] = acc[ai][bj][m][1][j]; }
#pragma unroll
                for (int j = 0; j < 8; ++j) { if (ACT == 1) v[j] = gelu_f(v[j]); else if (ACT == 2) v[j] = silu_f(v[j]); else if (ACT == 3) v[j] *= sc; }
                *(u32x4*)(rowp + bj * 128) = pack8(v);
            }
        }
}

struct EpiIn0 {
    static constexpr bool PERM = true, AFTER_DRAIN = false;
    bf16 *ycat, *vbuf, *za, *xbc; float* stats0;
    __device__ __forceinline__ void operator()(const f32x4 (&acc)[2][2][4][2], const pg8::Unit& u, int wr, int wc, int fr, int fq) const {
        const int pn = u.pn, row0 = u.pm * 256 + wr * 64 + fr, cl = wc * 32 + 8 * fq;
        if (pn < 8) { epi_tile_bf16<1>(acc, ycat, 4096, pn * 256 + cl, row0, 1.f); }
        else if (pn < 16) {
#pragma unroll
            for (int ai = 0; ai < 2; ++ai)
#pragma unroll
                for (int m = 0; m < 4; ++m) {
                    const int row = row0 + ai * 128 + m * 16;
                    bf16* rowp = vbuf + (size_t)row * 2048 + (pn - 8) * 256 + cl;
                    float s = 0.f, ss = 0.f;
#pragma unroll
                    for (int bj = 0; bj < 2; ++bj) {
                        float v[8];
#pragma unroll
                        for (int j = 0; j < 4; ++j) { v[j] = gelu_f(acc[ai][bj][m][0][j]); v[4 + j] = gelu_f(acc[ai][bj][m][1][j]); }
#pragma unroll
                        for (int j = 0; j < 8; ++j) { s += v[j]; ss += v[j] * v[j]; }
                        *(u32x4*)(rowp + bj * 128) = pack8(v);
                    }
                    s += __shfl_xor(s, 16); s += __shfl_xor(s, 32); ss += __shfl_xor(ss, 16); ss += __shfl_xor(ss, 32);
                    if (fq == 0) { atomic_addf(stats0 + 2 * row, s); atomic_addf(stats0 + 2 * row + 1, ss); }
                }
        }
        else if (pn < 24) { epi_tile_bf16<2>(acc, za, 2048, (pn - 16) * 256 + cl, row0, 1.f); }
        else if (pn < 32) { epi_tile_bf16<2>(acc, ycat, 4096, 2048 + (pn - 24) * 256 + cl, row0, 1.f); }
        else { epi_tile_bf16<0>(acc, xbc, 3072, (pn - 32) * 256 + cl, row0, 1.f); }
    }
};

__device__ __forceinline__ void dt_tasks(const PT& p, int lane, int wave) {
    if (wave >= 2) return;
    unsigned char* ws = p.ws; const bf16* H0 = (const bf16*)(ws + WS_H0); const bf16* Wdt = (const bf16*)(ws + WS_W0IN) + (size_t)11264 * 2048; float* DT = (float*)(ws + WS_DT);
    const int r32 = lane & 31, h = lane >> 5;
    for (int task = wave * gridDim.x + blockIdx.x; task < 512; task += 2 * gridDim.x) {
        const bf16* ap = Wdt + (size_t)r32 * 2048 + 8 * h; const bf16* bp = H0 + (size_t)(task * 32 + r32) * 2048 + 8 * h;
        f32x16 acc;
#pragma unroll
        for (int i = 0; i < 16; ++i) acc[i] = 0.f;
#pragma unroll 8
        for (int st = 0; st < 128; ++st) acc = mfma32(ld_frag16(ap + 16 * st), ld_frag16(bp + 16 * st), acc);
#pragma unroll
        for (int qd = 0; qd < 4; ++qd) {
            const int j0 = 8 * qd + 4 * h; const f32x4 bb = *(const f32x4*)(p.in[9] + j0); f32x4 v;
#pragma unroll
            for (int j = 0; j < 4; ++j) { const float x = acc[4 * qd + j] + bb[j]; v[j] = x > 20.f ? x : log1pf(__expf(x)); }
            *(f32x4*)(DT + (size_t)(task * 32 + r32) * 32 + j0) = v;
        }
    }
}
template <bool RB16> struct EpiResT {
    static constexpr bool PERM = true, AFTER_DRAIN = false;
    const void* resid; float* outf; bf16* outb; float* stats;
    __device__ __forceinline__ void operator()(const f32x4 (&acc)[2][2][4][2], const pg8::Unit& u, int wr, int wc, int fr, int fq) const {
        const int row0 = u.pm * 256 + wr * 64 + fr, col0 = u.pn * 256 + wc * 32 + 8 * fq;
#pragma unroll
        for (int ai = 0; ai < 2; ++ai)
#pragma unroll
            for (int m = 0; m < 4; ++m) {
                const int row = row0 + ai * 128 + m * 16; const size_t off = (size_t)row * 2048 + col0;
                float ss = 0.f;
#pragma unroll
                for (int bj = 0; bj < 2; ++bj) {
                    f32x4 r0, r1;
                    if (RB16) { float f[8]; unpack8(*(const u32x4*)((const bf16*)resid + off + bj * 128), f); r0 = (f32x4){f[0], f[1], f[2], f[3]}; r1 = (f32x4){f[4], f[5], f[6], f[7]}; }
                    else { r0 = *(const f32x4*)((const float*)resid + off + bj * 128); r1 = *(const f32x4*)((const float*)resid + off + bj * 128 + 4); }
                    r0 = r0 + acc[ai][bj][m][0]; r1 = r1 + acc[ai][bj][m][1];
                    if (outf) { *(f32x4*)(outf + off + bj * 128) = r0; *(f32x4*)(outf + off + bj * 128 + 4) = r1; }
                    ss += (r0[0] * r0[0] + r0[1] * r0[1]) + (r0[2] * r0[2] + r0[3] * r0[3]) + (r1[0] * r1[0] + r1[1] * r1[1]) + (r1[2] * r1[2] + r1[3] * r1[3]);
                    if (outb) { u32x4 w; w.x = pk2(r0[0], r0[1]); w.y = pk2(r0[2], r0[3]); w.z = pk2(r1[0], r1[1]); w.w = pk2(r1[2], r1[3]); *(u32x4*)(outb + off + bj * 128) = w; }
                }
                ss += __shfl_xor(ss, 16); ss += __shfl_xor(ss, 32);
                if (fq == 0) atomic_addf(stats + row, ss);
            }
    }
};

struct EpiIn1 {
    static constexpr bool PERM = true, AFTER_DRAIN = false;
    bf16 *q, *k, *v, *g; const float* stats1;
    __device__ __forceinline__ void operator()(const f32x4 (&acc)[2][2][4][2], const pg8::Unit& u, int wr, int wc, int fr, int fq) const {
        const int seg = u.pn >> 3, row0 = u.pm * 256 + wr * 64 + fr, col0 = (u.pn & 7) * 256 + wc * 32 + 8 * fq;
        bf16* base = seg == 0 ? q : (seg == 1 ? k : (seg == 2 ? v : g));
        const float sc = seg == 0 ? QSCALE : 1.f;
#pragma unroll
        for (int ai = 0; ai < 2; ++ai)
#pragma unroll
            for (int m = 0; m < 4; ++m) {
                const int row = row0 + ai * 128 + m * 16;
                const float rs = rsqrtf(stats1[row] * (1.f / 2048.f) + EPS) * sc;
                bf16* rowp = base + (size_t)row * 2048 + col0;
#pragma unroll
                for (int bj = 0; bj < 2; ++bj) {
                    float v8[8];
#pragma unroll
                    for (int j = 0; j < 4; ++j) { v8[j] = acc[ai][bj][m][0][j] * rs; v8[4 + j] = acc[ai][bj][m][1][j] * rs; }
                    if (seg == 3) {
#pragma unroll
                        for (int j = 0; j < 8; ++j) v8[j] = silu_f(v8[j]);
                    }
                    *(u32x4*)(rowp + bj * 128) = pack8(v8);
                }
            }
    }
};

__device__ __forceinline__ void transpose_item(const float* W, int K, int N, bf16* WT, int item, int lane, const float* kscale) {
    const int nblk = N / 32, kb = item / nblk, nb = item % nblk, kq = lane & 7, c4 = lane >> 3;
    const int k0 = 64 * kb + 8 * kq, n0 = 32 * nb + 4 * c4;
    f32x4 v[8];
#pragma unroll
    for (int i = 0; i < 8; ++i) v[i] = *(const f32x4*)(W + (size_t)(k0 + i) * N + n0);
    if (kscale) {
        const f32x4 g0 = *(const f32x4*)(kscale + k0), g1 = *(const f32x4*)(kscale + k0 + 4);
#pragma unroll
        for (int i = 0; i < 4; ++i) { v[i] = v[i] * g0[i]; v[4 + i] = v[4 + i] * g1[i]; }
    }
#pragma unroll
    for (int j = 0; j < 4; ++j) {
        u32x4 o; o.x = pk2(v[0][j], v[1][j]); o.y = pk2(v[2][j], v[3][j]); o.z = pk2(v[4][j], v[5][j]); o.w = pk2(v[6][j], v[7][j]);
        *(u32x4*)(WT + (size_t)(n0 + j) * K + k0) = o;
    }
}

__device__ __forceinline__ void phase0(const PT& p, LAS unsigned char* lds, int tid, int lane, int wave) {
    unsigned char* ws = p.ws;
    const int gw = blockIdx.x * 8 + wave, NGW = gridDim.x * 8;
    const int gt = blockIdx.x * 512 + tid, NGT = gridDim.x * 512;
    for (int i = gt; i < 65536; i += NGT) ((float*)(ws + WS_ST0))[i] = 0.f;
    constexpr int I0 = 32 * (N0R / 32), I1 = 64 * 64, I2 = 32 * 256, I3 = 32 * 64;
    for (int it = gw; it < I0 + I1 + I2 + I3; it += NGW) {
        int r = it;
        if (r < I0) { transpose_item(p.in[2], 2048, N0R, (bf16*)(ws + WS_W0IN), r, lane, nullptr); continue; } r -= I0;
        if (r < I1) { transpose_item(p.in[13], 4096, 2048, (bf16*)(ws + WS_W0OUT), r, lane, nullptr); continue; } r -= I1;
        if (r < I2) { transpose_item(p.in[15], 2048, 8192, (bf16*)(ws + WS_W1IN), r, lane, p.in[14]); continue; } r -= I2;
        transpose_item(p.in[21], 2048, 2048, (bf16*)(ws + WS_W1OUT), r, lane, nullptr);
    }
    for (int i = gt; i < 16 * 128 * 128 / 8; i += NGT) {
        const int e = i * 8, t = (e >> 7) & 127, s0 = e & 127; const float* src = p.in[5] + e; float v[8];
#pragma unroll
        for (int j = 0; j < 8; ++j) v[j] = (s0 + j <= t) ? src[j] : 0.f;
        ((u32x4*)(ws + WS_WSP))[i] = pack8(v);
    }
    const float* g0 = p.in[1]; bf16* H0 = (bf16*)(ws + WS_H0);
    for (int m = gw; m < M; m += NGW) {
        const f32x4* xr = (const f32x4*)(p.in[0] + (size_t)m * 2048) + lane; f32x4 v[8]; float s = 0.f;
#pragma unroll
        for (int j = 0; j < 8; ++j) { v[j] = xr[64 * j]; s += (v[j].x * v[j].x + v[j].y * v[j].y) + (v[j].z * v[j].z + v[j].w * v[j].w); }
        const float rs = rsqrtf(wave_sum(s) * (1.f / 2048.f) + EPS);
        u32x2* o = (u32x2*)(H0 + (size_t)m * 2048) + lane;
#pragma unroll
        for (int j = 0; j < 8; ++j) { const f32x4 g = ((const f32x4*)g0)[lane + 64 * j]; u32x2 w; w.x = pk2(v[j].x * rs * g.x, v[j].y * rs * g.y); w.y = pk2(v[j].z * rs * g.z, v[j].w * rs * g.w); o[64 * j] = w; }
    }
}

__device__ __forceinline__ void phase_layout(const PT& p, int tid) {
    unsigned char* ws = p.ws; unsigned char* dob = (unsigned char*)p.out;
    const bf16* Vb = (const bf16*)(ws + WS_V); const float* st0 = (const float*)(ws + WS_ST0);
    const bf16* XBC = (const bf16*)(dob + DO_XBC);
    bf16 *vT = (bf16*)(ws + WS_VT), *xT = (bf16*)(ws + WS_XT), *Bn = (bf16*)(dob + DO_BN), *BT = (bf16*)(dob + DO_BT), *Cn = (bf16*)(ws + WS_CN);
    const int t = tid & 255, so = t >> 4, co = t & 15;
    for (int pi = blockIdx.x * 2 + (tid >> 8); pi < 128 * 24; pi += gridDim.x * 2) {
        const int bc = pi / 24, k = 16 + pi % 24; const int tok0 = bc * 128 + so * 8;
        float o[8][8];
        if (k < 16) {
            const int ch0 = k * 128 + co * 8;
            float g[8], bb[8];
#pragma unroll
            for (int j = 0; j < 8; ++j) { g[j] = p.in[3][ch0 + j]; bb[j] = p.in[4][ch0 + j]; }
#pragma unroll
            for (int i = 0; i < 8; ++i) {
                const int row = tok0 + i; float f[8]; unpack8(*(const u32x4*)(Vb + (size_t)row * 2048 + ch0), f);
                const float mu = st0[2 * row] * (1.f / 2048.f), var = st0[2 * row + 1] * (1.f / 2048.f) - mu * mu, rs = rsqrtf(fmaxf(var, 0.f) + EPS);
#pragma unroll
                for (int j = 0; j < 8; ++j) o[i][j] = (f[j] - mu) * rs * g[j] + bb[j];
            }
#pragma unroll
            for (int j = 0; j < 8; ++j) { float c8[8];
#pragma unroll
                for (int i = 0; i < 8; ++i) c8[i] = o[i][j];
                *(u32x4*)(vT + ((size_t)bc * 2048 + ch0 + j) * 128 + so * 8) = pack8(c8); }
        } else {
            const int sc0 = (k - 16) * 128 + co * 8;
            float cw[4][8], cb[8];
#pragma unroll
            for (int j = 0; j < 8; ++j) { cb[j] = p.in[8][sc0 + j];
#pragma unroll
                for (int kk = 0; kk < 4; ++kk) cw[kk][j] = p.in[7][kk * 3072 + sc0 + j]; }
            const int pos0 = (bc & 15) * 128 + so * 8;
            float xw[11][8];
#pragma unroll
            for (int ii = 0; ii < 11; ++ii) {
                if (pos0 - 3 + ii >= 0) unpack8(*(const u32x4*)(XBC + (size_t)(tok0 - 3 + ii) * 3072 + sc0), xw[ii]);
                else {
#pragma unroll
                    for (int j = 0; j < 8; ++j) xw[ii][j] = 0.f;
                }
            }
#pragma unroll
            for (int i = 0; i < 8; ++i)
#pragma unroll
                for (int j = 0; j < 8; ++j) { float a = cb[j];
#pragma unroll
                    for (int kk = 0; kk < 4; ++kk) a += cw[kk][j] * xw[i + kk][j];
                    o[i][j] = silu_f(a); }
            if (k < 32) {
#pragma unroll
                for (int j = 0; j < 8; ++j) { float c8[8];
#pragma unroll
                    for (int i = 0; i < 8; ++i) c8[i] = o[i][j];
                    *(u32x4*)(xT + ((size_t)bc * 2048 + sc0 + j) * 128 + so * 8) = pack8(c8); }
            } else if (k < 36) {
                const int n0 = sc0 - 2048;
#pragma unroll
                for (int i = 0; i < 8; ++i) *(u32x4*)(Bn + (size_t)(tok0 + i) * 512 + n0) = pack8(o[i]);
#pragma unroll
                for (int j = 0; j < 8; ++j) { float c8[8];
#pragma unroll
                    for (int i = 0; i < 8; ++i) c8[i] = o[i][j];
                    *(u32x4*)(BT + ((size_t)bc * 512 + n0 + j) * 128 + so * 8) = pack8(c8); }
            } else {
                const int n0 = sc0 - 2560;
#pragma unroll
                for (int i = 0; i < 8; ++i) *(u32x4*)(Cn + (size_t)(tok0 + i) * 512 + n0) = pack8(o[i]);
            }
        }
    }
}

__device__ __forceinline__ void chunk_cumsum(const float* DT, const float* a_log, int tok0, int hh, int lane, float& d0, float& d1, float& c0, float& c1, float& tot) {
    d0 = DT[(size_t)(tok0 + 2 * lane) * 32 + hh]; d1 = DT[(size_t)(tok0 + 2 * lane + 1) * 32 + hh];
    const float A = -__expf(a_log[hh]); const float x0 = d0 * A, x1 = d1 * A; float ps = x0 + x1;
#pragma unroll
    for (int o = 1; o < 64; o <<= 1) { const float t = __shfl_up(ps, o); if (lane >= o) ps += t; }
    c1 = ps; c0 = ps - x1; tot = __shfl(ps, 63);
}

__device__ __forceinline__ void phase_mix(const PT& p, LAS unsigned char* lds, int tid, int lane, int wave) {
    unsigned char* ws = p.ws; unsigned char* dob = (unsigned char*)p.out;
    const int r32 = lane & 31, h = lane >> 5;
    bf16* Ycat = (bf16*)(ws + WS_YCAT); const bf16* ZA = (const bf16*)(ws + WS_ZA); const bf16* Vb = (const bf16*)(ws + WS_V); const float* st0 = (const float*)(ws + WS_ST0); const bf16* Wsp = (const bf16*)(ws + WS_WSP);
    const bf16* xT = (const bf16*)(ws + WS_XT); const bf16* BT = (const bf16*)(dob + DO_BT); const float* DT = (const float*)(ws + WS_DT);
    bf16* ST = (bf16*)(ws + WS_STATES); float* CD = (float*)(ws + WS_CD);
    LAS float* wtab = (LAS float*)lds;
    constexpr int NG = 128 * 16, NS = NBATCH * 15 * 4;
    for (int it = blockIdx.x; it < NG + NS; it += gridDim.x) {
        if (it < NG) {
            const int bc = it >> 4, g = it & 15, cb = wave & 3, th = wave >> 2;
            const int ch0 = g * 128 + cb * 32;
            __syncthreads();
            {
                const int c16 = tid & 15; float lg[8], lb[8];
#pragma unroll
                for (int j = 0; j < 8; ++j) { lg[j] = p.in[3][g * 128 + 8 * c16 + j]; lb[j] = p.in[4][g * 128 + 8 * c16 + j]; }
#pragma unroll
                for (int i = 0; i < 4; ++i) {
                    const int row = (tid >> 4) + 32 * i; const size_t tokr = (size_t)bc * 128 + row;
                    float f[8]; unpack8(*(const u32x4*)(Vb + tokr * 2048 + g * 128 + 8 * c16), f);
                    const float mu = st0[2 * tokr] * (1.f / 2048.f), var = st0[2 * tokr + 1] * (1.f / 2048.f) - mu * mu, rs = rsqrtf(fmaxf(var, 0.f) + EPS);
#pragma unroll
                    for (int j = 0; j < 8; ++j) f[j] = (f[j] - mu) * rs * lg[j] + lb[j];
                    *(LAS u32x4*)(lds + row * 272 + 16 * c16) = pack8(f);
                    *(LAS u32x4*)(lds + GM_UOFF + row * 272 + 16 * c16) = *(const u32x4*)(Ycat + tokr * 4096 + g * 128 + 8 * c16);
                    *(LAS u32x4*)(lds + GM_ZOFF + row * 272 + 16 * c16) = *(const u32x4*)(ZA + tokr * 2048 + g * 128 + 8 * c16);
                }
            }
            __syncthreads();
            const LAS unsigned char* ap = lds + (8 * h + ((lane & 15) >> 2)) * 272 + (cb * 32 + 16 * ((lane >> 4) & 1)) * 2 + (lane & 3) * 8;
            f32x16 acc[2];
#pragma unroll
            for (int i = 0; i < 16; ++i) { acc[0][i] = 0.f; acc[1][i] = 0.f; }
#pragma unroll
            for (int st = 0; st < 8; ++st) {
                const v4i16_t lo = __builtin_amdgcn_ds_read_tr16_b64_v4i16((LAS v4i16_t*)(ap + 16 * st * 272)), hi = __builtin_amdgcn_ds_read_tr16_b64_v4i16((LAS v4i16_t*)(ap + (16 * st + 4) * 272));
                const bf16x8 a = {lo[0], lo[1], lo[2], lo[3], hi[0], hi[1], hi[2], hi[3]};
#pragma unroll
                for (int t2 = 0; t2 < 2; ++t2) { const int tb = 2 * th + t2;
                    if (st < 2 * (tb + 1)) { const bf16x8 b = ld_frag16(Wsp + ((size_t)g * 128 + tb * 32 + r32) * 128 + 16 * st + 8 * h); acc[t2] = mfma32(a, b, acc[t2]); } }
            }
#pragma unroll
            for (int t2 = 0; t2 < 2; ++t2) {
                const int t = (2 * th + t2) * 32 + r32; const float sb = p.in[6][g * 128 + t];
#pragma unroll
                for (int qd = 0; qd < 4; ++qd) {
                    const int cl = cb * 32 + 8 * qd + 4 * h;
                    LAS u32x2* up = (LAS u32x2*)(lds + GM_UOFF + t * 272 + cl * 2); const u32x2 uu = *up, zz = *(const LAS u32x2*)(lds + GM_ZOFF + t * 272 + cl * 2);
                    const float y0 = bflo(uu.x) * (acc[t2][4 * qd] + sb) * bflo(zz.x), y1 = bfhi(uu.x) * (acc[t2][4 * qd + 1] + sb) * bfhi(zz.x);
                    const float y2 = bflo(uu.y) * (acc[t2][4 * qd + 2] + sb) * bflo(zz.y), y3 = bfhi(uu.y) * (acc[t2][4 * qd + 3] + sb) * bfhi(zz.y);
                    u32x2 w; w.x = pk2(y0, y1); w.y = pk2(y2, y3); *up = w;
                }
            }
            __syncthreads();
            { const int c16 = tid & 15;
#pragma unroll
              for (int i = 0; i < 4; ++i) { const int row = (tid >> 4) + 32 * i; *(u32x4*)(Ycat + ((size_t)bc * 128 + row) * 4096 + g * 128 + 8 * c16) = *(const LAS u32x4*)(lds + GM_UOFF + row * 272 + 16 * c16); } }
        } else {
            const int id = it - NG, b = id / 60, c = (id / 4) % 15, grp = id & 3; const int bc = b * 16 + c, tok0 = bc * 128;
            __syncthreads();
            { const int hh = grp * 8 + wave; float d0, d1, c0, c1, tot; chunk_cumsum(DT, p.in[10], tok0, hh, lane, d0, d1, c0, c1, tot);
              wtab[wave * 128 + 2 * lane] = d0 * __expf(tot - c0); wtab[wave * 128 + 2 * lane + 1] = d1 * __expf(tot - c1);
              if (lane == 0) CD[bc * 32 + hh] = __expf(tot); }
            __syncthreads();
#pragma unroll 1
            for (int tk = 0; tk < 2; ++tk) {
                const int r = (wave >> 1) + 4 * tk, pb = wave & 1, hh = grp * 8 + r;
                const bf16* ap = xT + ((size_t)bc * 2048 + hh * 64 + pb * 32 + r32) * 128 + 8 * h;
                const bf16* bp = BT + ((size_t)bc * 512 + grp * 128 + r32) * 128 + 8 * h;
                f32x16 acc[4];
#pragma unroll
                for (int nb = 0; nb < 4; ++nb)
#pragma unroll
                    for (int i = 0; i < 16; ++i) acc[nb][i] = 0.f;
#pragma unroll
                for (int st = 0; st < 8; ++st) {
                    float f[8]; unpack8(*(const u32x4*)(ap + 16 * st), f);
                    const f32x4 w0 = *(const LAS f32x4*)(wtab + r * 128 + 16 * st + 8 * h), w1 = *(const LAS f32x4*)(wtab + r * 128 + 16 * st + 8 * h + 4);
                    f[0] *= w0.x; f[1] *= w0.y; f[2] *= w0.z; f[3] *= w0.w; f[4] *= w1.x; f[5] *= w1.y; f[6] *= w1.z; f[7] *= w1.w;
                    const bf16x8 a = __builtin_bit_cast(bf16x8, pack8(f));
#pragma unroll
                    for (int nb = 0; nb < 4; ++nb) { const bf16x8 bfr = ld_frag16(bp + (size_t)nb * 32 * 128 + 16 * st); acc[nb] = mfma32(a, bfr, acc[nb]); }
                }
                bf16* sp = ST + ((size_t)(bc * 32 + hh) * 64 + pb * 32) * 128;
#pragma unroll
                for (int nb = 0; nb < 4; ++nb)
#pragma unroll
                    for (int i = 0; i < 16; ++i) sp[(size_t)crow(i, h) * 128 + nb * 32 + r32] = (bf16)(pk2(acc[nb][i], 0.f) & 0xffffu);
            }
        }
    }
}

__device__ __forceinline__ void phase_scan(const PT& p, int tid) {
    unsigned char* ws = p.ws; const bf16* ST = (const bf16*)(ws + WS_STATES); const float* CD = (const float*)(ws + WS_CD); bf16* PV = (bf16*)((unsigned char*)p.out + DO_PREV);
    for (int id = blockIdx.x * 512 + tid; id < NBATCH * 32 * 64 * 16; id += gridDim.x * 512) {
        const int b = id >> 15, rem = id & 32767, hh = rem >> 10;
        float run[8];
#pragma unroll
        for (int j = 0; j < 8; ++j) run[j] = 0.f;
#pragma unroll
        for (int c = 0; c < 16; ++c) {
            const size_t off = ((size_t)(b * 16 + c) * 32 * 64 * 16 + rem) * 8;
            *(u32x4*)(PV + off) = pack8(run);
            if (c < 15) { float s[8]; unpack8(*(const u32x4*)(ST + off), s); const float cd = CD[(b * 16 + c) * 32 + hh];
#pragma unroll
                for (int j = 0; j < 8; ++j) run[j] = run[j] * cd + s[j]; }
        }
    }
}

__device__ __forceinline__ void phase_ssd_y(const PT& p, LAS unsigned char* lds, int tid, int lane, int wave) {
    unsigned char* ws = p.ws; unsigned char* dob = (unsigned char*)p.out;
    const int r32 = lane & 31, h = lane >> 5, half = wave >> 2, lb = wave & 3;
    bf16* Ycat = (bf16*)(ws + WS_YCAT); const bf16* xT = (const bf16*)(ws + WS_XT); const bf16* Bn = (const bf16*)(dob + DO_BN); const bf16* Cn = (const bf16*)(ws + WS_CN);
    const bf16* PV = (const bf16*)(dob + DO_PREV); const float* DT = (const float*)(ws + WS_DT);
    LAS float* acum = (LAS float*)lds + half * 2048; LAS float* dtt = acum + 1024;
    for (int base = blockIdx.x * 2; base < 128 * 4; base += gridDim.x * 2) {
        const int it = base + half, bc = it >> 2, grp = it & 3, tok0 = bc * 128;
        __syncthreads();
#pragma unroll 1
        for (int k = 0; k < 2; ++k) { const int r = lb + 4 * k, hh = grp * 8 + r; float d0, d1, c0, c1, tot; chunk_cumsum(DT, p.in[10], tok0, hh, lane, d0, d1, c0, c1, tot);
          acum[r * 128 + 2 * lane] = c0; acum[r * 128 + 2 * lane + 1] = c1; dtt[r * 128 + 2 * lane] = d0; dtt[r * 128 + 2 * lane + 1] = d1; }
        __syncthreads();
        const int l = lb * 32 + r32; const size_t tok = (size_t)tok0 + l;
        bf16x8 cf[8];
#pragma unroll
        for (int st = 0; st < 8; ++st) cf[st] = ld_frag16(Cn + tok * 512 + grp * 128 + 16 * st + 8 * h);
        f32x16 X[4];
#pragma unroll
        for (int sb = 0; sb < 4; ++sb) {
#pragma unroll
            for (int i = 0; i < 16; ++i) X[sb][i] = 0.f;
            if (sb <= lb) {
#pragma unroll
                for (int st = 0; st < 8; ++st) X[sb] = mfma32(ld_frag16(Bn + ((size_t)tok0 + sb * 32 + r32) * 512 + grp * 128 + 16 * st + 8 * h), cf[st], X[sb]);
            }
        }
        float ssq = 0.f;
#pragma unroll 1
        for (int r = 0; r < 8; ++r) {
            const int hh = grp * 8 + r;
            f32x16 acc[2];
#pragma unroll
            for (int pb = 0; pb < 2; ++pb) {
#pragma unroll
                for (int i = 0; i < 16; ++i) acc[pb][i] = 0.f;
                const bf16* pp = PV + ((size_t)(bc * 32 + hh) * 64 + pb * 32 + r32) * 128 + 8 * h;
#pragma unroll
                for (int st = 0; st < 8; ++st) acc[pb] = mfma32(ld_frag16(pp + 16 * st), cf[st], acc[pb]);
            }
            const float al = acum[r * 128 + l]; const float el = __expf(al); const float dsk = p.in[11][hh];
#pragma unroll
            for (int pb = 0; pb < 2; ++pb)
#pragma unroll
                for (int i = 0; i < 16; ++i) acc[pb][i] *= el;
            const bf16* xrow = xT + ((size_t)bc * 2048 + hh * 64 + r32) * 128 + 4 * h;
#pragma unroll
            for (int sb = 0; sb < 4; ++sb) {
                if (sb <= lb) {
                    f32x16 mm;
#pragma unroll
                    for (int qd = 0; qd < 4; ++qd) {
                        const int s0 = sb * 32 + 8 * qd + 4 * h;
                        const f32x4 as = *(const LAS f32x4*)(acum + r * 128 + s0), ds = *(const LAS f32x4*)(dtt + r * 128 + s0);
#pragma unroll
                        for (int j = 0; j < 4; ++j) { const float v = X[sb][4 * qd + j] * __expf(al - as[j]) * ds[j]; mm[4 * qd + j] = (s0 + j < l) ? v : ((s0 + j == l) ? v + dsk : 0.f); }
                    }
#pragma unroll
                    for (int s2 = 0; s2 < 2; ++s2) { const bf16x8 bfr = pack_frag(mm, s2);
#pragma unroll
                        for (int pb = 0; pb < 2; ++pb) acc[pb] = mfma32(ld_frag8x2(xrow + (size_t)pb * 32 * 128 + sb * 32 + 16 * s2), bfr, acc[pb]); }
                }
            }
#pragma unroll
            for (int pb = 0; pb < 2; ++pb)
#pragma unroll
                for (int qd = 0; qd < 4; ++qd) {
                    const int ch = hh * 64 + pb * 32 + 8 * qd + 4 * h;
                    u32x2* yp = (u32x2*)(Ycat + tok * 4096 + 2048 + ch); const u32x2 zz = *yp;
                    const float y0 = acc[pb][4 * qd] * bflo(zz.x), y1 = acc[pb][4 * qd + 1] * bfhi(zz.x);
                    const float y2 = acc[pb][4 * qd + 2] * bflo(zz.y), y3 = acc[pb][4 * qd + 3] * bfhi(zz.y);
                    ssq += (y0 * y0 + y1 * y1) + (y2 * y2 + y3 * y3);
                    u32x2 w; w.x = pk2(y0, y1); w.y = pk2(y2, y3); *yp = w;
                }
        }
        ssq += __shfl_xor(ssq, 32);
        const float rs = rsqrtf(ssq * (1.f / 512.f) + EPS);
#pragma unroll 1
        for (int r = 0; r < 8; ++r) {
#pragma unroll
            for (int pq = 0; pq < 8; ++pq) {
                const int ch = (grp * 8 + r) * 64 + (pq >> 2) * 32 + 8 * (pq & 3) + 4 * h;
                u32x2* yp = (u32x2*)(Ycat + tok * 4096 + 2048 + ch); const u32x2 yy = *yp; const f32x4 g = *(const f32x4*)(p.in[12] + ch);
                u32x2 w; w.x = pk2(bflo(yy.x) * rs * g.x, bfhi(yy.x) * rs * g.y); w.y = pk2(bflo(yy.y) * rs * g.z, bfhi(yy.y) * rs * g.w); *yp = w;
            }
        }
    }
}

constexpr int AK_PITCH = 272, AV_PITCH = 272, A_KOFF = 0, A_VOFF = 128 * AK_PITCH, A_STAGE = A_VOFF + 128 * AV_PITCH;
static_assert(2 * A_STAGE <= PTAB_OFF && 4 * 16384 <= A_STAGE, "attention LDS map");
__device__ __forceinline__ float max3f(float a, float b, float c) { return fmaxf(fmaxf(a, b), c); }
__device__ __forceinline__ void attn_unit(const PT& p, LAS unsigned char* lds, int tid, int lane, int wave, int b, int hd, int qb, float lam) {
    unsigned char* ws = p.ws;
    const bf16* Qb = (const bf16*)(ws + WS_Q); const bf16* Kb = (const bf16*)(ws + WS_K); const bf16* Vb = (const bf16*)(ws + WS_VV); const bf16* Gb = (const bf16*)((unsigned char*)p.out + DO_G);
    bf16* Ob = (bf16*)(ws + WS_O);
    const int r32 = lane & 31, h = lane >> 5, mp = wave >> 2, wq = wave & 3;
    const int qw0 = qb * 128 + 32 * wq, q = qw0 + r32; const unsigned tokq = (unsigned)(b * SEQ + q), tokb = (unsigned)(b * SEQ);
    const float slope2 = fexp2(-0.5f * (float)(hd + 1)) * LOG2E;
    bf16x8 qf[4];
#pragma unroll
    for (int ds = 0; ds < 4; ++ds) qf[ds] = ld_frag16(Qb + (tokq * 2048u + (unsigned)(hd * 128 + mp * 64 + 16 * ds + 8 * h)));
    float mrun = -INFINITY, lsum = 0.f;
    f32x16 oT[4];
#pragma unroll
    for (int db = 0; db < 4; ++db)
#pragma unroll
        for (int i = 0; i < 16; ++i) oT[db][i] = 0.f;
    const int ntiles = qb + 1;
    u32x4 preV[4], preK[4];
#define PREFETCH(t) do { \
        _Pragma("unroll") for (int i_ = 0; i_ < 4; ++i_) { const int pid_ = tid + 512 * i_, row_ = pid_ >> 4, c16_ = pid_ & 15; const unsigned go_ = (tokb + (unsigned)((t) * 128 + row_)) * 2048u + (unsigned)(hd * 128 + 8 * c16_); \
            preK[i_] = *(const u32x4*)(Kb + go_); preV[i_] = *(const u32x4*)(Vb + go_); } \
    } while (0)
    PREFETCH(0);
    const LAS unsigned char* kbase0 = lds + A_KOFF + r32 * AK_PITCH + (mp * 64 + 8 * h) * 2;
    const LAS unsigned char* vbase0 = lds + A_VOFF + (4 * h + ((lane & 15) >> 2)) * AV_PITCH + ((lane >> 4) & 1) * 32 + (lane & 3) * 8;
#define STAGE_WRITE(stg) do { \
        _Pragma("unroll") for (int i_ = 0; i_ < 4; ++i_) { const int pid_ = tid + 512 * i_, row_ = pid_ >> 4, c16_ = pid_ & 15; \
            *(LAS u32x4*)(lds + (stg) * A_STAGE + A_KOFF + row_ * AK_PITCH + 16 * c16_) = preK[i_]; *(LAS u32x4*)(lds + (stg) * A_STAGE + A_VOFF + row_ * AV_PITCH + 16 * c16_) = preV[i_]; } \
    } while (0)
    __syncthreads();
    STAGE_WRITE(0);
    asm volatile("" : "+v"(qf[0]), "+v"(qf[1]), "+v"(qf[2]), "+v"(qf[3]));
    __syncthreads();
#pragma unroll 1
    for (int t = 0; t < ntiles; ++t) {
        const int stg = t & 1;
        if (t + 1 < ntiles) PREFETCH(t + 1);
        const LAS unsigned char* kbase = kbase0 + stg * A_STAGE; const LAS unsigned char* vbase = vbase0 + stg * A_STAGE;
        const bool diag = (t == qb);
#pragma unroll 1
        for (int sub = 0; sub < 2; ++sub) {
            const int nact = diag ? min(2, max(0, wq + 1 - 2 * sub)) : 2;
            if (nact > 0) {
                float sl = slope2; asm volatile("" : "+v"(sl));
                const float bq = sl * (float)(t * 128 + sub * 64 + 4 * h - q);
                const LAS unsigned char* kb0 = kbase + sub * 64 * AK_PITCH; const LAS unsigned char* vb0 = vbase + sub * 64 * AV_PITCH;
                f32x16 s[2];
#pragma unroll
                for (int kb = 0; kb < 2; ++kb) {
                    if (kb < nact) {
                        const float bk = bq + sl * (float)(32 * kb);
#pragma unroll
                        for (int i = 0; i < 16; ++i) s[kb][i] = __builtin_fmaf(sl, (float)((i & 3) + 8 * (i >> 2)), bk);
#pragma unroll
                        for (int ds = 0; ds < 4; ++ds) s[kb] = mfma32(__builtin_bit_cast(bf16x8, *(const LAS u32x4*)(kb0 + kb * 32 * AK_PITCH + ds * 32)), qf[ds], s[kb]);
                    } else {
#pragma unroll
                        for (int i = 0; i < 16; ++i) s[kb][i] = -INFINITY;
                    }
                }
                if (diag) {
#pragma unroll
                    for (int kb = 0; kb < 2; ++kb) if (2 * sub + kb == wq) {
#pragma unroll
                        for (int i = 0; i < 16; ++i) if (crow(i, h) > r32) s[kb][i] = -INFINITY; }
                }
                float mx = -INFINITY;
#pragma unroll
                for (int kb = 0; kb < 2; ++kb)
#pragma unroll
                    for (int i = 0; i < 16; i += 2) mx = max3f(mx, s[kb][i], s[kb][i + 1]);
                mx = fmaxf(mx, __shfl_xor(mx, 32));
                const float mnew = fmaxf(mrun, mx), alpha = fexp2(mrun - mnew); mrun = mnew;
                float rs = 0.f;
#pragma unroll
                for (int kb = 0; kb < 2; ++kb)
#pragma unroll
                    for (int i = 0; i < 16; ++i) { s[kb][i] = fexp2(s[kb][i] - mnew); rs += s[kb][i]; }
                lsum = lsum * alpha + rs;
                if (__builtin_amdgcn_ballot_w64(alpha != 1.0f) != 0ull) {
#pragma unroll
                    for (int db = 0; db < 4; ++db)
#pragma unroll
                        for (int i = 0; i < 16; ++i) oT[db][i] *= alpha;
                }
#pragma unroll
                for (int kb = 0; kb < 2; ++kb) if (kb < nact) {
#pragma unroll
                    for (int s2 = 0; s2 < 2; ++s2) {
                        const bf16x8 pf = pack_frag(s[kb], s2);
#pragma unroll
                        for (int db = 0; db < 4; ++db) {
                            const LAS unsigned char* vp = vb0 + (kb * 32 + 16 * s2) * AV_PITCH + db * 64;
                            const v4i16_t lo = __builtin_amdgcn_ds_read_tr16_b64_v4i16((LAS v4i16_t*)vp), hi = __builtin_amdgcn_ds_read_tr16_b64_v4i16((LAS v4i16_t*)(vp + 8 * AV_PITCH));
                            const bf16x8 vf = {lo[0], lo[1], lo[2], lo[3], hi[0], hi[1], hi[2], hi[3]};
                            oT[db] = mfma32(vf, pf, oT[db]);
                        }
                    }
                }
            }
        }
        if (t + 1 < ntiles) STAGE_WRITE(stg ^ 1);
        __syncthreads();
    }
#undef PREFETCH
#undef STAGE_WRITE
    const float lt = lsum + __shfl_xor(lsum, 32);
    LAS float* xch = (LAS float*)(lds + (ntiles & 1) * A_STAGE + wq * 16384);
    if (mp == 1) { const float sc = lam / lt;
#pragma unroll
        for (int db = 0; db < 4; ++db)
#pragma unroll
            for (int i = 0; i < 16; ++i) xch[(db * 16 + i) * 64 + lane] = oT[db][i] * sc; }
    __syncthreads();
    if (mp == 0) {
        const float i1 = 1.f / lt; float ss = 0.f;
#pragma unroll
        for (int db = 0; db < 4; ++db)
#pragma unroll
            for (int i = 0; i < 16; ++i) { const float o = oT[db][i] * i1 - xch[(db * 16 + i) * 64 + lane]; oT[db][i] = o; ss += o * o; }
        ss += __shfl_xor(ss, 32);
        const float rn = rsqrtf(ss * (1.f / 128.f) + EPS) * (1.f - LAMBDA_INIT);
#pragma unroll
        for (int db = 0; db < 4; ++db)
#pragma unroll
            for (int qd = 0; qd < 4; ++qd) {
                const int d = db * 32 + 8 * qd + 4 * h; const unsigned off = tokq * 2048u + (unsigned)(hd * 128 + d);
                const u32x2 gg = *(const u32x2*)(Gb + off); const f32x4 sg = *(const f32x4*)(p.in[20] + d);
                u32x2 w; w.x = pk2(oT[db][4 * qd] * rn * sg.x * bflo(gg.x), oT[db][4 * qd + 1] * rn * sg.y * bfhi(gg.x));
                w.y = pk2(oT[db][4 * qd + 2] * rn * sg.z * bflo(gg.y), oT[db][4 * qd + 3] * rn * sg.w * bfhi(gg.y));
                *(u32x2*)(Ob + off) = w;
            }
    }
}

__device__ __forceinline__ void phase_attn(const PT& p, LAS unsigned char* lds, int tid, int lane, int wave) {
    const float s1 = wave_sum(p.in[16][lane] * p.in[17][lane]), s2 = wave_sum(p.in[18][lane] * p.in[19][lane]);
    const float lam = __expf(s1) - __expf(s2) + LAMBDA_INIT;
#pragma unroll 1
    for (int u = blockIdx.x; u < NBATCH * 16 * 8; u += gridDim.x) {
        const int j = u & 7, hd = (u >> 3) & 15, b = u >> 7;
#pragma unroll 1
        for (int k = 0; k < 2; ++k) attn_unit(p, lds, tid, lane, wave, b, hd, k == 0 ? 15 - j : j, lam);
    }
}

__device__ __forceinline__ void phase_final(const PT& p, int lane, int wave) {
    const float* st2 = (const float*)(p.ws + WS_ST2); const float* g = p.in[22]; const bf16* X2 = (const bf16*)(p.ws + WS_X2B);
    for (int m = blockIdx.x * 8 + wave; m < M; m += gridDim.x * 8) {
        const float rs = rsqrtf(st2[m] * (1.f / 2048.f) + EPS);
        const u32x4* xr = (const u32x4*)(X2 + (size_t)m * 2048) + lane; f32x4* orow = (f32x4*)(p.out + (size_t)m * 2048);
#pragma unroll
        for (int j = 0; j < 4; ++j) {
            float f[8]; unpack8(xr[64 * j], f); const int c = 8 * (lane + 64 * j);
            const f32x4 g0 = *(const f32x4*)(g + c), g1 = *(const f32x4*)(g + c + 4);
            orow[(c >> 2)] = (f32x4){f[0] * rs * g0.x, f[1] * rs * g0.y, f[2] * rs * g0.z, f[3] * rs * g0.w};
            orow[(c >> 2) + 1] = (f32x4){f[4] * rs * g1.x, f[5] * rs * g1.y, f[6] * rs * g1.z, f[7] * rs * g1.w};
        }
    }
}

constexpr size_t WS_BAR = 384 * 1024;
constexpr int XBST_OFF = PTAB_OFF + 256;
typedef __attribute__((address_space(1))) unsigned gu32;
#define XB_TMO      128
#define XB_XCNT(j)  (256  + 64 * (j))
#define XB_XSUB(j)  (1280 + 64 * (j))
#define XB_XGEN(j)  (2304 + 64 * (j))
#define XB_TOP      3328
#define XB_TOPGEN   3392
#define XCD_BAR_WORDS 3456
#define XB_SPIN_CAP (1u << 18)

__device__ __forceinline__ unsigned xb_ld(unsigned* p)              { return __hip_atomic_load(p, __ATOMIC_RELAXED, __HIP_MEMORY_SCOPE_AGENT); }
__device__ __forceinline__ unsigned xb_add(unsigned* p, unsigned v) { return __hip_atomic_fetch_add(p, v, __ATOMIC_RELAXED, __HIP_MEMORY_SCOPE_AGENT); }
__device__ __forceinline__ unsigned xb_xcc_id() { return (unsigned)__builtin_amdgcn_s_getreg((3 << 11) | 20) & 0xFu; }
#define XB_SPIN(cond, bar) do { unsigned _sp = 0; while (cond) { __builtin_amdgcn_s_sleep(1); \
    if ((++_sp & 255u) == 0u) { if (xb_ld(&(bar)[XB_TMO])) break; if (_sp > XB_SPIN_CAP) { atomicAdd(&(bar)[XB_TMO], 1u); break; } } } } while (0)

struct XcdBarrier {
    unsigned* bar; unsigned x;
    volatile LAS unsigned* st;
};

__device__ __forceinline__ XcdBarrier xcd_barrier_post(unsigned* bar, volatile LAS unsigned* st) {
    XcdBarrier b; b.bar = bar; b.x = xb_xcc_id(); b.st = st;
    if (threadIdx.x == 0) (void)xb_add(&bar[XB_XCNT(b.x)], 1u);
    return b;
}
__device__ __forceinline__ void xcd_barrier_complete(unsigned* bar, unsigned x, unsigned& nloc, unsigned& nx) {
    const unsigned G = gridDim.x * gridDim.y * gridDim.z;
    unsigned sum, cnt, mine, sp = 0u;
    for (;;) {
        sum = 0u; cnt = 0u; mine = 0u;
#pragma unroll
        for (unsigned j = 0; j < 16; ++j) { const unsigned c = xb_ld(&bar[XB_XCNT(j)]); sum += c; cnt += (c > 0u) ? 1u : 0u; mine = (j == x) ? c : mine; }
        if (sum == G) break;
        __builtin_amdgcn_s_sleep(1);
        if ((++sp & 255u) == 0u) { if (xb_ld(&bar[XB_TMO])) break; if (sp > XB_SPIN_CAP) { atomicAdd(&bar[XB_TMO], 1u); break; } }
    }
    nloc = mine > 0u ? mine : 1u; nx = cnt > 0u ? cnt : 1u;
}

__device__ __forceinline__ void xcd_barrier(const XcdBarrier& b) {
    asm volatile("s_waitcnt vmcnt(0)" ::: "memory");
    __syncthreads();
    if (threadIdx.x == 0) {
        unsigned* bar = b.bar;
        __builtin_amdgcn_s_waitcnt(0);
        unsigned nloc = b.st[0], nx = b.st[1];
        if (nloc == 0u) { xcd_barrier_complete(bar, b.x, nloc, nx); b.st[0] = nloc; b.st[1] = nx; }
        const unsigned old = xb_add(&bar[XB_XSUB(b.x)], 1u);
        const unsigned gen = old / nloc;
        if (old + 1u == (gen + 1u) * nloc) {
            __builtin_amdgcn_fence(__ATOMIC_RELEASE, "agent");
            asm volatile("s_waitcnt vmcnt(0)" ::: "memory");
            const unsigned og = xb_add(&bar[XB_TOP], 1u);
            const unsigned tg = og / nx;
            if (og + 1u == (tg + 1u) * nx) xb_add(&bar[XB_TOPGEN], 1u);
            else XB_SPIN(xb_ld(&bar[XB_TOPGEN]) == tg, bar);
            __builtin_amdgcn_fence(__ATOMIC_ACQUIRE, "agent");
            xb_add(&bar[XB_XGEN(b.x)], 1u);
            asm volatile("s_waitcnt vmcnt(0)" ::: "memory");
        } else {
            XB_SPIN(xb_ld(&bar[XB_XGEN(b.x)]) == gen, bar);
            __builtin_amdgcn_fence(__ATOMIC_ACQUIRE, "agent");
            asm volatile("s_waitcnt vmcnt(0)" ::: "memory");
        }
    }
    __syncthreads();
}

__global__ void __launch_bounds__(512) fwd_megakernel(Params pa) {
    extern __shared__ __attribute__((aligned(16))) unsigned char lds_raw[];
    cg::grid_group grid = cg::this_grid();
    LAS unsigned char* lds = (LAS unsigned char*)lds_raw;
    if (threadIdx.x < 25) {
        unsigned long long v = 0;
#pragma unroll
        for (int i = 0; i < 23; ++i) if ((int)threadIdx.x == i) v = (unsigned long long)pa.in[i];
        if (threadIdx.x == 23) v = (unsigned long long)pa.out;
        if (threadIdx.x == 24) v = (unsigned long long)pa.ws;
        ((LAS unsigned long long*)(lds + PTAB_OFF))[threadIdx.x] = v;
    }
    if (threadIdx.x < 2) ((LAS unsigned*)(lds + XBST_OFF))[threadIdx.x] = 0u;
    __syncthreads();
    const XcdBarrier bar = xcd_barrier_post((unsigned*)(pa.ws + WS_BAR), (volatile LAS unsigned*)(lds + XBST_OFF));
#ifndef PHMASK
#define PHMASK 0x3ff
#endif
#define PH(n) (((PHMASK) >> (n)) & 1)
#define TLW int tid_ = threadIdx.x; asm volatile("" : "+v"(tid_)); const int tid = tid_, lane = tid & 63, wave = __builtin_amdgcn_readfirstlane(tid >> 6); (void)tid; (void)lane; (void)wave
#define GRIDV const int G = gridDim.x, c = blockIdx.x
    if (PH(0)) { PT p; TLW; phase0(p, lds, tid, lane, wave); }
    if (gridDim.x == 0x7fffffffu) grid.sync();
    xcd_barrier(bar);
    if (PH(1)) {
        PT p; GRIDV; unsigned char* ws = p.ws; unsigned char* dob = (unsigned char*)p.out;
        pg8::Gemm g{(const pg8::bf16_t*)(ws + WS_H0), (const pg8::bf16_t*)(ws + WS_W0IN), M, N0P, 2048}; pg8::StaticOrder S; S.init(M, N0P, G, c);
        EpiIn0 E{(bf16*)(ws + WS_YCAT), (bf16*)(ws + WS_V), (bf16*)(ws + WS_ZA), (bf16*)(dob + DO_XBC), (float*)(ws + WS_ST0)};
        pg8::gemm_phase<EpiIn0, pg8::StaticOrder, true, true>(lds, g, S, E);
        { TLW; dt_tasks(p, lane, wave); }
    }
    xcd_barrier(bar);
    if (PH(2)) { PT p; TLW; phase_layout(p, tid); }
    xcd_barrier(bar);
    if (PH(3)) { PT p; TLW; phase_mix(p, lds, tid, lane, wave); }
    xcd_barrier(bar);
    if (PH(4)) { PT p; TLW; phase_scan(p, tid); }
    xcd_barrier(bar);
    if (PH(5)) { PT p; TLW; phase_ssd_y(p, lds, tid, lane, wave); }
    xcd_barrier(bar);
    if (PH(6)) {
        PT p; GRIDV; unsigned char* ws = p.ws;
        pg8::Gemm g{(const pg8::bf16_t*)(ws + WS_YCAT), (const pg8::bf16_t*)(ws + WS_W0OUT), M, 2048, 4096}; pg8::StaticOrder S; S.init(M, 2048, G, c);
        EpiResT<false> E{p.in[0], nullptr, (bf16*)(ws + WS_X1B), (float*)(ws + WS_ST1)};
        pg8::gemm_phase<EpiResT<false>, pg8::StaticOrder, true, true>(lds, g, S, E);
    }
    xcd_barrier(bar);
    if (PH(6)) {
        PT p; GRIDV; unsigned char* ws = p.ws; unsigned char* dob = (unsigned char*)p.out;
        pg8::Gemm g{(const pg8::bf16_t*)(ws + WS_X1B), (const pg8::bf16_t*)(ws + WS_W1IN), M, 8192, 2048}; pg8::StaticOrder S; S.init(M, 8192, G, c);
        EpiIn1 E{(bf16*)(ws + WS_Q), (bf16*)(ws + WS_K), (bf16*)(ws + WS_VV), (bf16*)(dob + DO_G), (const float*)(ws + WS_ST1)};
        pg8::gemm_phase<EpiIn1, pg8::StaticOrder, true, true>(lds, g, S, E);
    }
    xcd_barrier(bar);
    if (PH(7)) { PT p; TLW; phase_attn(p, lds, tid, lane, wave); }
    xcd_barrier(bar);
    if (PH(8)) {
        PT p; GRIDV; unsigned char* ws = p.ws;
        pg8::Gemm g{(const pg8::bf16_t*)(ws + WS_O), (const pg8::bf16_t*)(ws + WS_W1OUT), M, 2048, 2048}; pg8::StaticOrder S; S.init(M, 2048, G, c);
        EpiResT<true> E{(const void*)(ws + WS_X1B), nullptr, (bf16*)(ws + WS_X2B), (float*)(ws + WS_ST2)};
        pg8::gemm_phase<EpiResT<true>, pg8::StaticOrder, true, true>(lds, g, S, E);
    }
    xcd_barrier(bar);
    if (PH(9)) { PT p; TLW; phase_final(p, lane, wave); }
}

extern "C" void kernel_launch(void* const* d_in, const int* in_sizes, int n_in, void* d_out, int out_size, void* d_ws, size_t ws_size, hipStream_t stream) {
    static int grid = 0;
    if (grid == 0) {
        if (n_in != 23 || out_size != M * DM || ws_size < WS_END) { fprintf(stderr, "kernel_launch: unexpected shapes (n_in %d out %d ws %zu)\n", n_in, out_size, ws_size); grid = -1; return; }
        int dev = 0, cus = 0, per_cu = 0;
        hipGetDevice(&dev); hipDeviceGetAttribute(&cus, hipDeviceAttributeMultiprocessorCount, dev);
        hipFuncSetAttribute((const void*)fwd_megakernel, hipFuncAttributeMaxDynamicSharedMemorySize, LDS_BYTES);
        hipOccupancyMaxActiveBlocksPerMultiprocessor(&per_cu, (const void*)fwd_megakernel, 512, LDS_BYTES);
        if (per_cu < 1) { fprintf(stderr, "kernel_launch: occupancy query says %d blocks per CU\n", per_cu); per_cu = 1; }
        (void)hipGetLastError();
        grid = cus;
    }
    if (grid < 0) return;
    Params p{};
    for (int i = 0; i < 23; ++i) p.in[i] = (const float*)d_in[i];
    p.out = (float*)d_out; p.ws = (unsigned char*)d_ws;
    if (hipMemsetAsync((char*)d_ws + WS_BAR, 0, XCD_BAR_WORDS * 4, stream) != hipSuccess) { fprintf(stderr, "kernel_launch: memset of the barrier words failed\n"); return; }
    void* args[] = {&p};
    hipError_t e = hipLaunchCooperativeKernel((const void*)fwd_megakernel, dim3(grid), dim3(512), args, LDS_BYTES, stream);
    if (e != hipSuccess) fprintf(stderr, "cooperative launch failed: %s (grid %d)\n", hipGetErrorString(e), grid);
}
```

```cpp
#include <hip/hip_runtime.h>
#include <hip/hip_cooperative_groups.h>
#include <cstdio>
#include <cstdint>
#include <cmath>
namespace cg = cooperative_groups;
namespace pg8 {
#define PG8_LAS __attribute__((address_space(3)))
typedef unsigned short bf16_t;
typedef short bf16x8 __attribute__((ext_vector_type(8)));
typedef float f32x4 __attribute__((ext_vector_type(4)));
typedef unsigned u32x4 __attribute__((ext_vector_type(4)));
constexpr int BM = 256, BK = 64, HALF = 128, HTB = HALF * BK * 2  , STAGE_BYTES = 8 * HTB, NXCD = 8, WGM = 8;

__host__ __device__ __forceinline__ int lds_byte(int r, int c) { const int st = (r >> 4) * 2 + (c >> 5), rr = r & 15, cc = c & 31, ob = rr * 64 + cc * 2; return st * 1024 + (ob ^ (((ob >> 9) & 1) << 5)); }
__host__ __device__ __forceinline__ void stage_rc(int b, int& R, int& C) { const int st = b / 1024, sb = b % 1024, swz = sb ^ (((sb >> 9) & 1) << 5); R = (st >> 1) * 16 + swz / 64; C = (st & 1) * 32 + (swz % 64) / 2; }
__host__ __device__ __forceinline__ int perm32(int rho) { const int n = rho >> 4, i = rho & 15; return 8 * (i >> 2) + 4 * n + (i & 3); }

struct Unit { int pm, pn; };
struct Gemm { const bf16_t* A; const bf16_t* Bt; int M, N, K; };

struct StaticOrder {
    int nM, nN, nwg, G, c;
    __host__ __device__ void init(int M, int N, int G_, int c_) { nM = M / BM; nN = N / BM; nwg = nM * nN; G = G_; c = c_; }
    __host__ __device__ bool next(int i, Unit& u) const {
        const long L = (long)i * G + c; if (L >= nwg) return false;
        int wgid = (int)L; { const int q = nwg / NXCD, r = nwg % NXCD, xcd = wgid % NXCD, off = wgid / NXCD; wgid = (xcd < r ? xcd * (q + 1) : r * (q + 1) + (xcd - r) * q) + off; }
        const int nig = WGM * nN, gid = wgid / nig, fm = gid * WGM, gsz = (nM - fm) < WGM ? (nM - fm) : WGM;
        u.pm = fm + ((wgid % nig) % gsz); u.pn = (wgid % nig) / gsz; return true;
    }
    __device__ __forceinline__ void a_ready(const Unit&) const {}
    __device__ __forceinline__ void done(const Unit&) const {}
};

template <class Epi, class Sched, bool ALIGN_EPI = false, bool SP2 = false>
__device__ __forceinline__ void gemm_phase(PG8_LAS unsigned char* lds, const Gemm g, const Sched& S, const Epi& E) {
    int tid_ = threadIdx.x; asm volatile("" : "+v"(tid_));
    const int tid = tid_, wid = __builtin_amdgcn_readfirstlane(tid >> 6), lane = tid & 63, wr = wid >> 2, wc = wid & 3, fr = lane & 15, fq = lane >> 4;
    const int K = g.K, nt = K / BK;
    unsigned voffA[2], voffB[2];
#pragma unroll
    for (int i = 0; i < 2; ++i) { int R, C; stage_rc(tid * 16 + i * 8192, R, C); const int Rb = Epi::PERM ? ((R & ~31) + perm32(R & 31)) : R;
        voffA[i] = (unsigned)(R * K + C) * 2u; voffB[i] = (unsigned)(Rb * K + C) * 2u; }
    const size_t kstep = (size_t)(BK * 2);
    const size_t hstep = (size_t)HALF * K * 2;
    const size_t tstep = 2 * hstep;
    const unsigned ldsw = (unsigned)wid * 1024u;
    const int aoff = lds_byte(wr * 64 + fr, fq * 8), boff = lds_byte(wc * 32 + fr, fq * 8);
#define PG8_SA(b, h) (((b) * 2 + (h)) * HTB)
#define PG8_SB(b, h) ((4 + (b) * 2 + (h)) * HTB)
#define PG8_STAGE(bufoff, gbase, voff) do { _Pragma("unroll") for (int _i = 0; _i < 2; ++_i) \
        __builtin_amdgcn_global_load_lds((const unsigned*)((const char*)(gbase) + (voff)[_i]), (PG8_LAS unsigned*)(lds + (bufoff) + ldsw + _i * 8192), 16, 0, 0); } while (0)
#define PG8_LDA(dst, b, h) do { _Pragma("unroll") for (int m = 0; m < 4; ++m) _Pragma("unroll") for (int k = 0; k < 2; ++k) dst[m][k] = *(const PG8_LAS bf16x8*)(lds + PG8_SA(b, h) + aoff + m * 2048 + k * 1024); } while (0)
#define PG8_LDB(dst, b, h) do { _Pragma("unroll") for (int n = 0; n < 2; ++n) _Pragma("unroll") for (int k = 0; k < 2; ++k) dst[n][k] = *(const PG8_LAS bf16x8*)(lds + PG8_SB(b, h) + boff + n * 2048 + k * 1024); } while (0)
#define PG8_MMA(ai, bj, At, Bt) do { __builtin_amdgcn_s_setprio(1); _Pragma("unroll") for (int m = 0; m < 4; ++m) _Pragma("unroll") for (int n = 0; n < 2; ++n) _Pragma("unroll") for (int k = 0; k < 2; ++k) \
        acc[ai][bj][m][n] = __builtin_amdgcn_mfma_f32_16x16x32_bf16(Bt[n][k], At[m][k], acc[ai][bj][m][n], 0, 0, 0); __builtin_amdgcn_s_setprio(0); } while (0)
#define PG8_WAIT_V(n) asm volatile("s_waitcnt vmcnt(" #n ")" ::: "memory")
#define PG8_WAIT_L(n) asm volatile("s_waitcnt lgkmcnt(" #n ")" ::: "memory")
#define PG8_BAR __builtin_amdgcn_s_barrier()
#define PG8_SCHED __builtin_amdgcn_sched_barrier(0)
    Unit cur, nxt; int ui = 0;
    if (!S.next(0, cur)) return;
    f32x4 acc[2][2][4][2];
#pragma unroll
    for (int a = 0; a < 2; ++a)
#pragma unroll
        for (int b = 0; b < 2; ++b)
#pragma unroll
            for (int m = 0; m < 4; ++m)
#pragma unroll
                for (int n = 0; n < 2; ++n) acc[a][b][m][n] = (f32x4){0.f, 0.f, 0.f, 0.f};
    bf16x8 At[4][2], B0[2][2], B1[2][2];
    const char* cA = (const char*)g.A + (size_t)cur.pm * tstep; const char* cB = (const char*)g.Bt + (size_t)cur.pn * tstep;
    S.a_ready(cur);
    if constexpr (SP2) {
        PG8_STAGE(PG8_SB(0, 0), cB, voffB); PG8_STAGE(PG8_SB(0, 1), cB + hstep, voffB); PG8_STAGE(PG8_SA(0, 0), cA, voffA); PG8_STAGE(PG8_SA(0, 1), cA + hstep, voffA);
        if (wr == 1) PG8_BAR;
        PG8_WAIT_V(2); PG8_BAR;
        PG8_STAGE(PG8_SB(1, 0), cB + kstep, voffB); PG8_STAGE(PG8_SA(1, 0), cA + kstep, voffA); PG8_STAGE(PG8_SB(1, 1), cB + hstep + kstep, voffB);
        PG8_WAIT_V(6); PG8_BAR;
    } else {
        PG8_STAGE(PG8_SB(0, 0), cB, voffB); PG8_STAGE(PG8_SA(0, 0), cA, voffA); PG8_STAGE(PG8_SB(0, 1), cB + hstep, voffB); PG8_STAGE(PG8_SA(0, 1), cA + hstep, voffA);
        if (wr == 1) PG8_BAR;
        PG8_WAIT_V(4); PG8_BAR;
        PG8_STAGE(PG8_SB(1, 0), cB + kstep, voffB); PG8_STAGE(PG8_SA(1, 0), cA + kstep, voffA); PG8_STAGE(PG8_SB(1, 1), cB + hstep + kstep, voffB);
        PG8_WAIT_V(6); PG8_BAR;
    }
    for (;;) {
        const bool has_next = S.next(ui + 1, nxt);
        const char* nA = has_next ? (const char*)g.A + (size_t)nxt.pm * tstep : cA; const char* nB = has_next ? (const char*)g.Bt + (size_t)nxt.pn * tstep : cB;
        for (int t = 0; t < nt; t += 2) {
            const bool last = (t == nt - 2);
            const char* a1 = cA + (size_t)(t + 1) * kstep;
            const char* a2 = last ? nA : cA + (size_t)(t + 2) * kstep; const char* b2 = last ? nB : cB + (size_t)(t + 2) * kstep;
            const char* a3 = a2 + kstep; const char* b3 = b2 + kstep;
            if (last && has_next) S.a_ready(nxt);
            if constexpr (SP2) {
            PG8_LDB(B0, 0, 0); PG8_LDB(B1, 0, 1); PG8_SCHED; PG8_LDA(At, 0, 0); PG8_STAGE(PG8_SA(1, 1), a1 + hstep, voffA);
            PG8_WAIT_V(8); PG8_WAIT_L(0); PG8_BAR; PG8_MMA(0, 0, At, B0); PG8_MMA(0, 1, At, B1); PG8_BAR; PG8_SCHED;
            PG8_LDA(At, 0, 1); PG8_STAGE(PG8_SB(0, 0), b2, voffB); PG8_STAGE(PG8_SB(0, 1), b2 + hstep, voffB); PG8_STAGE(PG8_SA(0, 0), a2, voffA);
            PG8_WAIT_V(8); PG8_WAIT_L(0); PG8_BAR; PG8_MMA(1, 0, At, B0); PG8_MMA(1, 1, At, B1); PG8_BAR; PG8_SCHED;
            PG8_LDB(B0, 1, 0); PG8_LDB(B1, 1, 1); PG8_SCHED; PG8_LDA(At, 1, 0); PG8_STAGE(PG8_SA(0, 1), a2 + hstep, voffA);
            PG8_WAIT_V(8); PG8_WAIT_L(0); PG8_BAR; PG8_MMA(0, 0, At, B0); PG8_MMA(0, 1, At, B1); PG8_BAR; PG8_SCHED;
            PG8_LDA(At, 1, 1); PG8_STAGE(PG8_SB(1, 0), b3, voffB); PG8_STAGE(PG8_SB(1, 1), b3 + hstep, voffB); PG8_STAGE(PG8_SA(1, 0), a3, voffA);
            PG8_WAIT_V(8); PG8_WAIT_L(0); PG8_BAR; PG8_MMA(1, 0, At, B0); PG8_MMA(1, 1, At, B1); PG8_BAR; PG8_SCHED;
            } else {
            PG8_LDB(B0, 0, 0); PG8_SCHED; PG8_LDA(At, 0, 0); PG8_STAGE(PG8_SA(1, 1), a1 + hstep, voffA);
            PG8_WAIT_L(8); PG8_BAR; PG8_WAIT_L(0); PG8_MMA(0, 0, At, B0); PG8_BAR; PG8_SCHED;
            PG8_LDB(B1, 0, 1); PG8_STAGE(PG8_SB(0, 0), b2, voffB);
            PG8_BAR; PG8_WAIT_L(0); PG8_MMA(0, 1, At, B1); PG8_BAR;
            PG8_LDA(At, 0, 1); PG8_STAGE(PG8_SA(0, 0), a2, voffA);
            PG8_BAR; PG8_WAIT_L(0); PG8_MMA(1, 0, At, B0); PG8_BAR; PG8_SCHED;
            PG8_STAGE(PG8_SB(0, 1), b2 + hstep, voffB);
            PG8_WAIT_V(6); PG8_BAR; PG8_MMA(1, 1, At, B1); PG8_BAR;
            PG8_LDB(B0, 1, 0); PG8_SCHED; PG8_LDA(At, 1, 0); PG8_STAGE(PG8_SA(0, 1), a2 + hstep, voffA);
            PG8_WAIT_L(8); PG8_BAR; PG8_WAIT_L(0); PG8_MMA(0, 0, At, B0); PG8_BAR; PG8_SCHED;
            PG8_LDB(B1, 1, 1); PG8_STAGE(PG8_SB(1, 0), b3, voffB);
            PG8_BAR; PG8_WAIT_L(0); PG8_MMA(0, 1, At, B1); PG8_BAR;
            PG8_LDA(At, 1, 1); PG8_STAGE(PG8_SA(1, 0), a3, voffA);
            PG8_BAR; PG8_WAIT_L(0); PG8_MMA(1, 0, At, B0); PG8_BAR; PG8_SCHED;
            PG8_STAGE(PG8_SB(1, 1), b3 + hstep, voffB);
            PG8_WAIT_V(6); PG8_BAR; PG8_MMA(1, 1, At, B1); PG8_BAR;
            }
        }
        if constexpr (ALIGN_EPI) { if (wr == 0) PG8_BAR; }
        if constexpr (!Epi::AFTER_DRAIN) { E(acc, cur, wr, wc, fr, fq); S.done(cur); }
        if (!has_next) break;
#pragma unroll
        for (int a = 0; a < 2; ++a)
#pragma unroll
            for (int b = 0; b < 2; ++b)
#pragma unroll
                for (int m = 0; m < 4; ++m)
#pragma unroll
                    for (int n = 0; n < 2; ++n) acc[a][b][m][n] = (f32x4){0.f, 0.f, 0.f, 0.f};
        cur = nxt; cA = nA; cB = nB; ++ui;
        if constexpr (ALIGN_EPI) { if (wr == 1) PG8_BAR; }
    }
    PG8_WAIT_V(0);
    if constexpr (!ALIGN_EPI) { if (wr == 0) PG8_BAR; }
    PG8_BAR;
    if constexpr (Epi::AFTER_DRAIN) { E.fused(acc, cur, wr, wc, fr, fq, lds, wid, lane); S.done(cur); }
#undef PG8_SA
#undef PG8_SB
#undef PG8_STAGE
#undef PG8_LDA
#undef PG8_LDB
#undef PG8_MMA
#undef PG8_WAIT_V
#undef PG8_WAIT_L
#undef PG8_BAR
#undef PG8_SCHED
}
}

#define LAS __attribute__((address_space(3)))
typedef unsigned short bf16;
typedef unsigned u32x4 __attribute__((ext_vector_type(4)));
typedef unsigned u32x2 __attribute__((ext_vector_type(2)));
typedef float f32x4 __attribute__((ext_vector_type(4)));
typedef float f32x16 __attribute__((ext_vector_type(16)));
typedef short bf16x8 __attribute__((ext_vector_type(8)));
typedef short v4i16_t __attribute__((ext_vector_type(4)));

constexpr int M = 16384, DM = 2048, SEQ = 2048, NBATCH = 8, NCH = 16;
constexpr int N0P = 11264, N0R = 11296;
constexpr float EPS = 1e-5f;
constexpr float LOG2E = 1.4426950408889634f;
constexpr float QSCALE = 0.125f * LOG2E;
constexpr float LAMBDA_INIT = 0.35550906f;
constexpr size_t MiB = 1u << 20;
constexpr size_t WS_ST0 = 0, WS_ST1 = 128 * 1024, WS_ST2 = 192 * 1024, WS_CD = 256 * 1024, WS_LAM = 300 * 1024;
constexpr size_t WS_DT = 1 * MiB, WS_WSP = 3 * MiB, WS_W0IN = 4 * MiB, WS_W0OUT = 49 * MiB, WS_W1IN = 65 * MiB, WS_W1OUT = 97 * MiB;
constexpr size_t WS_YCAT = 105 * MiB, WS_ZA = 233 * MiB, WS_V = 297 * MiB, WS_H0 = 361 * MiB, WS_XT = 425 * MiB, WS_CN = 489 * MiB, WS_END = 505 * MiB;
constexpr size_t WS_Q = WS_YCAT, WS_K = WS_YCAT + 64 * MiB, WS_X1 = WS_ZA, WS_STATES = WS_V, WS_VT = WS_H0, WS_X1B = WS_H0, WS_O = WS_ZA, WS_VV = WS_XT, WS_X2B = WS_YCAT;
constexpr size_t DO_XBC = 0, DO_BN = 96 * MiB, DO_BT = 112 * MiB, DO_PREV = 0, DO_G = 0;
constexpr int LDS_BYTES = 147456;
constexpr int GM_UOFF = 128 * 272, GM_ZOFF = 2 * 128 * 272;

__device__ __forceinline__ unsigned pk2(float lo, float hi) {
    typedef float f2 __attribute__((ext_vector_type(2))); typedef __bf16 b2 __attribute__((ext_vector_type(2)));
    f2 v = {lo, hi}; b2 b = __builtin_convertvector(v, b2); return __builtin_bit_cast(unsigned, b);
}
__device__ __forceinline__ float bflo(unsigned u) { return __uint_as_float(u << 16); }
__device__ __forceinline__ float bfhi(unsigned u) { return __uint_as_float(u & 0xffff0000u); }
__device__ __forceinline__ void unpack8(u32x4 r, float* f) { f[0] = bflo(r.x); f[1] = bfhi(r.x); f[2] = bflo(r.y); f[3] = bfhi(r.y); f[4] = bflo(r.z); f[5] = bfhi(r.z); f[6] = bflo(r.w); f[7] = bfhi(r.w); }
__device__ __forceinline__ u32x4 pack8(const float* f) { u32x4 o; o.x = pk2(f[0], f[1]); o.y = pk2(f[2], f[3]); o.z = pk2(f[4], f[5]); o.w = pk2(f[6], f[7]); return o; }
__device__ __forceinline__ float fexp2(float x) { return __builtin_amdgcn_exp2f(x); }
__device__ __forceinline__ float gelu_f(float x) { const float z = 1.5957691216057308f * (x + 0.044715f * x * x * x); return x * __builtin_amdgcn_rcpf(1.0f + __expf(-z)); }
__device__ __forceinline__ float silu_f(float x) { return x * __builtin_amdgcn_rcpf(1.0f + __expf(-x)); }
__device__ __forceinline__ int crow(int r, int h) { return (r & 3) + 8 * (r >> 2) + 4 * h; }
__device__ __forceinline__ f32x16 mfma32(bf16x8 a, bf16x8 b, f32x16 c) { return __builtin_amdgcn_mfma_f32_32x32x16_bf16(a, b, c, 0, 0, 0); }
__device__ __forceinline__ bf16x8 ld_frag16(const bf16* p) { return __builtin_bit_cast(bf16x8, *(const u32x4*)p); }
__device__ __forceinline__ bf16x8 ld_frag8x2(const bf16* p) { const u32x2 lo = *(const u32x2*)p, hi = *(const u32x2*)(p + 8); u32x4 v; v.x = lo.x; v.y = lo.y; v.z = hi.x; v.w = hi.y; return __builtin_bit_cast(bf16x8, v); }
__device__ __forceinline__ bf16x8 pack_frag(const f32x16& x, int s) {
    u32x4 v; v.x = pk2(x[8 * s], x[8 * s + 1]); v.y = pk2(x[8 * s + 2], x[8 * s + 3]); v.z = pk2(x[8 * s + 4], x[8 * s + 5]); v.w = pk2(x[8 * s + 6], x[8 * s + 7]); return __builtin_bit_cast(bf16x8, v);
}
__device__ __forceinline__ float wave_sum(float v) {
#pragma unroll
    for (int o = 1; o < 64; o <<= 1) v += __shfl_xor(v, o);
    return v;
}
#define LDS_WAIT() asm volatile("s_waitcnt lgkmcnt(0)" ::: "memory")
__device__ __forceinline__ void atomic_addf(float* p, float v) { __hip_atomic_fetch_add(p, v, __ATOMIC_RELAXED, __HIP_MEMORY_SCOPE_AGENT); }

struct Params { const float* in[23]; float* out; unsigned char* ws; };
constexpr int PTAB_OFF = LDS_BYTES - 512;
__device__ __forceinline__ unsigned long long ptab_get(int i) {
    const unsigned long long v = ((const LAS unsigned long long*)(PTAB_OFF))[i];
    const unsigned lo = __builtin_amdgcn_readfirstlane((unsigned)v), hi = __builtin_amdgcn_readfirstlane((unsigned)(v >> 32));
    return ((unsigned long long)hi << 32) | lo;
}
struct PT {
    struct InTab { __device__ __forceinline__ const float* operator[](int i) const { return (const float*)(const __attribute__((address_space(1))) float*)ptab_get(i); } } in;
    float* out; unsigned char* ws;
    __device__ __forceinline__ PT() { out = (float*)(__attribute__((address_space(1))) float*)ptab_get(23); ws = (unsigned char*)(__attribute__((address_space(1))) unsigned char*)ptab_get(24); }
};

template <int ACT>
__device__ __forceinline__ void epi_tile_bf16(const f32x4 (&acc)[2][2][4][2], bf16* base, int pitch, int col0, int row0, float sc) {
#pragma unroll
    for (int ai = 0; ai < 2; ++ai)
#pragma unroll
        for (int m = 0; m < 4; ++m) {
            bf16* rowp = base + (size_t)(row0 + ai * 128 + m * 16) * pitch + col0;
#pragma unroll
            for (int bj = 0; bj < 2; ++bj) {
                float v[8];
#pragma unroll
                for (int j = 0; j < 4; ++j) { v[j] = acc[ai][bj][m][0][j]; v[4 + j] = acc[ai][bj][m][1][j]; }
#pragma unroll
                for (int j = 0; j < 8; ++j) { if (ACT == 1) v[j] = gelu_f(v[j]); else if (ACT == 2) v[j] = silu_f(v[j]); else if (ACT == 3) v[j] *= sc; }
                *(u32x4*)(rowp + bj * 128) = pack8(v);
            }
        }
}

struct EpiIn0 {
    static constexpr bool PERM = true, AFTER_DRAIN = false;
    bf16 *ycat, *vbuf, *za, *xbc; float* stats0;
    __device__ __forceinline__ void operator()(const f32x4 (&acc)[2][2][4][2], const pg8::Unit& u, int wr, int wc, int fr, int fq) const {
        const int pn = u.pn, row0 = u.pm * 256 + wr * 64 + fr, cl = wc * 32 + 8 * fq;
        if (pn < 8) { epi_tile_bf16<1>(acc, ycat, 4096, pn * 256 + cl, row0, 1.f); }
        else if (pn < 16) {
#pragma unroll
            for (int ai = 0; ai < 2; ++ai)
#pragma unroll
                for (int m = 0; m < 4; ++m) {
                    const int row = row0 + ai * 128 + m * 16;
                    bf16* rowp = vbuf + (size_t)row * 2048 + (pn - 8) * 256 + cl;
                    float s = 0.f, ss = 0.f;
#pragma unroll
                    for (int bj = 0; bj < 2; ++bj) {
                        float v[8];
#pragma unroll
                        for (int j = 0; j < 4; ++j) { v[j] = gelu_f(acc[ai][bj][m][0][j]); v[4 + j] = gelu_f(acc[ai][bj][m][1][j]); }
#pragma unroll
                        for (int j = 0; j < 8; ++j) { s += v[j]; ss += v[j] * v[j]; }
                        *(u32x4*)(rowp + bj * 128) = pack8(v);
                    }
                    s += __shfl_xor(s, 16); s += __shfl_xor(s, 32); ss += __shfl_xor(ss, 16); ss += __shfl_xor(ss, 32);
                    if (fq == 0) { atomic_addf(stats0 + 2 * row, s); atomic_addf(stats0 + 2 * row + 1, ss); }
                }
        }
        else if (pn < 24) { epi_tile_bf16<2>(acc, za, 2048, (pn - 16) * 256 + cl, row0, 1.f); }
        else if (pn < 32) { epi_tile_bf16<2>(acc, ycat, 4096, 2048 + (pn - 24) * 256 + cl, row0, 1.f); }
        else { epi_tile_bf16<0>(acc, xbc, 3072, (pn - 32) * 256 + cl, row0, 1.f); }
    }
};

__device__ __forceinline__ void dt_tasks(const PT& p, int lane, int wave) {
    if (wave >= 2) return;
    unsigned char* ws = p.ws; const bf16* H0 = (const bf16*)(ws + WS_H0); const bf16* Wdt = (const bf16*)(ws + WS_W0IN) + (size_t)11264 * 2048; float* DT = (float*)(ws + WS_DT);
    const int r32 = lane & 31, h = lane >> 5;
    for (int task = wave * gridDim.x + blockIdx.x; task < 512; task += 2 * gridDim.x) {
        const bf16* ap = Wdt + (size_t)r32 * 2048 + 8 * h; const bf16* bp = H0 + (size_t)(task * 32 + r32) * 2048 + 8 * h;
        f32x16 acc;
#pragma unroll
        for (int i = 0; i < 16; ++i) acc[i] = 0.f;
#pragma unroll 8
        for (int st = 0; st < 128; ++st) acc = mfma32(ld_frag16(ap + 16 * st), ld_frag16(bp + 16 * st), acc);
#pragma unroll
        for (int qd = 0; qd < 4; ++qd) {
            const int j0 = 8 * qd + 4 * h; const f32x4 bb = *(const f32x4*)(p.in[9] + j0); f32x4 v;
#pragma unroll
            for (int j = 0; j < 4; ++j) { const float x = acc[4 * qd + j] + bb[j]; v[j] = x > 20.f ? x : log1pf(__expf(x)); }
            *(f32x4*)(DT + (size_t)(task * 32 + r32) * 32 + j0) = v;
        }
    }
}
template <bool RB16> struct EpiResT {
    static constexpr bool PERM = true, AFTER_DRAIN = false;
    const void* resid; float* outf; bf16* outb; float* stats;
    __device__ __forceinline__ void operator()(const f32x4 (&acc)[2][2][4][2], const pg8::Unit& u, int wr, int wc, int fr, int fq) const {
        const int row0 = u.pm * 256 + wr * 64 + fr, col0 = u.pn * 256 + wc * 32 + 8 * fq;
#pragma unroll
        for (int ai = 0; ai < 2; ++ai)
#pragma unroll
            for (int m = 0; m < 4; ++m) {
                const int row = row0 + ai * 128 + m * 16; const size_t off = (size_t)row * 2048 + col0;
                float ss = 0.f;
#pragma unroll
                for (int bj = 0; bj < 2; ++bj) {
                    f32x4 r0, r1;
                    if (RB16) { float f[8]; unpack8(*(const u32x4*)((const bf16*)resid + off + bj * 128), f); r0 = (f32x4){f[0], f[1], f[2], f[3]}; r1 = (f32x4){f[4], f[5], f[6], f[7]}; }
                    else { r0 = *(const f32x4*)((const float*)resid + off + bj * 128); r1 = *(const f32x4*)((const float*)resid + off + bj * 128 + 4); }
                    r0 = r0 + acc[ai][bj][m][0]; r1 = r1 + acc[ai][bj][m][1];
                    if (outf) { *(f32x4*)(outf + off + bj * 128) = r0; *(f32x4*)(outf + off + bj * 128 + 4) = r1; }
                    ss += (r0[0] * r0[0] + r0[1] * r0[1]) + (r0[2] * r0[2] + r0[3] * r0[3]) + (r1[0] * r1[0] + r1[1] * r1[1]) + (r1[2] * r1[2] + r1[3] * r1[3]);
                    if (outb) { u32x4 w; w.x = pk2(r0[0], r0[1]); w.y = pk2(r0[2], r0[3]); w.z = pk2(r1[0], r1[1]); w.w = pk2(r1[2], r1[3]); *(u32x4*)(outb + off + bj * 128) = w; }
                }
                ss += __shfl_xor(ss, 16); ss += __shfl_xor(ss, 32);
                if (fq == 0) atomic_addf(stats + row, ss);
            }
    }
};

struct EpiIn1 {
    static constexpr bool PERM = true, AFTER_DRAIN = false;
    bf16 *q, *k, *v, *g; const float* stats1;
    __device__ __forceinline__ void operator()(const f32x4 (&acc)[2][2][4][2], const pg8::Unit& u, int wr, int wc, int fr, int fq) const {
        const int seg = u.pn >> 3, row0 = u.pm * 256 + wr * 64 + fr, col0 = (u.pn & 7) * 256 + wc * 32 + 8 * fq;
        bf16* base = seg == 0 ? q : (seg == 1 ? k : (seg == 2 ? v : g));
        const float sc = seg == 0 ? QSCALE : 1.f;
#pragma unroll
        for (int ai = 0; ai < 2; ++ai)
#pragma unroll
            for (int m = 0; m < 4; ++m) {
                const int row = row0 + ai * 128 + m * 16;
                const float rs = rsqrtf(stats1[row] * (1.f / 2048.f) + EPS) * sc;
                bf16* rowp = base + (size_t)row * 2048 + col0;
#pragma unroll
                for (int bj = 0; bj < 2; ++bj) {
                    float v8[8];
#pragma unroll
                    for (int j = 0; j < 4; ++j) { v8[j] = acc[ai][bj][m][0][j] * rs; v8[4 + j] = acc[ai][bj][m][1][j] * rs; }
                    if (seg == 3) {
#pragma unroll
                        for (int j = 0; j < 8; ++j) v8[j] = silu_f(v8[j]);
                    }
                    *(u32x4*)(rowp + bj * 128) = pack8(v8);
                }
            }
    }
};

__device__ __forceinline__ void transpose_item(const float* W, int K, int N, bf16* WT, int item, int lane, const float* kscale) {
    const int nblk = N / 32, kb = item / nblk, nb = item % nblk, kq = lane & 7, c4 = lane >> 3;
    const int k0 = 64 * kb + 8 * kq, n0 = 32 * nb + 4 * c4;
    f32x4 v[8];
#pragma unroll
    for (int i = 0; i < 8; ++i) v[i] = *(const f32x4*)(W + (size_t)(k0 + i) * N + n0);
    if (kscale) {
        const f32x4 g0 = *(const f32x4*)(kscale + k0), g1 = *(const f32x4*)(kscale + k0 + 4);
#pragma unroll
        for (int i = 0; i < 4; ++i) { v[i] = v[i] * g0[i]; v[4 + i] = v[4 + i] * g1[i]; }
    }
#pragma unroll
    for (int j = 0; j < 4; ++j) {
        u32x4 o; o.x = pk2(v[0][j], v[1][j]); o.y = pk2(v[2][j], v[3][j]); o.z = pk2(v[4][j], v[5][j]); o.w = pk2(v[6][j], v[7][j]);
        *(u32x4*)(WT + (size_t)(n0 + j) * K + k0) = o;
    }
}

__device__ __forceinline__ void phase0(const PT& p, LAS unsigned char* lds, int tid, int lane, int wave) {
    unsigned char* ws = p.ws;
    const int gw = blockIdx.x * 8 + wave, NGW = gridDim.x * 8;
    const int gt = blockIdx.x * 512 + tid, NGT = gridDim.x * 512;
    for (int i = gt; i < 65536; i += NGT) ((float*)(ws + WS_ST0))[i] = 0.f;
    constexpr int I0 = 32 * (N0R / 32), I1 = 64 * 64, I2 = 32 * 256, I3 = 32 * 64;
    for (int it = gw; it < I0 + I1 + I2 + I3; it += NGW) {
        int r = it;
        if (r < I0) { transpose_item(p.in[2], 2048, N0R, (bf16*)(ws + WS_W0IN), r, lane, nullptr); continue; } r -= I0;
        if (r < I1) { transpose_item(p.in[13], 4096, 2048, (bf16*)(ws + WS_W0OUT), r, lane, nullptr); continue; } r -= I1;
        if (r < I2) { transpose_item(p.in[15], 2048, 8192, (bf16*)(ws + WS_W1IN), r, lane, p.in[14]); continue; } r -= I2;
        transpose_item(p.in[21], 2048, 2048, (bf16*)(ws + WS_W1OUT), r, lane, nullptr);
    }
    for (int i = gt; i < 16 * 128 * 128 / 8; i += NGT) {
        const int e = i * 8, t = (e >> 7) & 127, s0 = e & 127; const float* src = p.in[5] + e; float v[8];
#pragma unroll
        for (int j = 0; j < 8; ++j) v[j] = (s0 + j <= t) ? src[j] : 0.f;
        ((u32x4*)(ws + WS_WSP))[i] = pack8(v);
    }
    const float* g0 = p.in[1]; bf16* H0 = (bf16*)(ws + WS_H0);
    for (int m = gw; m < M; m += NGW) {
        const f32x4* xr = (const f32x4*)(p.in[0] + (size_t)m * 2048) + lane; f32x4 v[8]; float s = 0.f;
#pragma unroll
        for (int j = 0; j < 8; ++j) { v[j] = xr[64 * j]; s += (v[j].x * v[j].x + v[j].y * v[j].y) + (v[j].z * v[j].z + v[j].w * v[j].w); }
        const float rs = rsqrtf(wave_sum(s) * (1.f / 2048.f) + EPS);
        u32x2* o = (u32x2*)(H0 + (size_t)m * 2048) + lane;
#pragma unroll
        for (int j = 0; j < 8; ++j) { const f32x4 g = ((const f32x4*)g0)[lane + 64 * j]; u32x2 w; w.x = pk2(v[j].x * rs * g.x, v[j].y * rs * g.y); w.y = pk2(v[j].z * rs * g.z, v[j].w * rs * g.w); o[64 * j] = w; }
    }
}

__device__ __forceinline__ void phase_layout(const PT& p, int tid) {
    unsigned char* ws = p.ws; unsigned char* dob = (unsigned char*)p.out;
    const bf16* Vb = (const bf16*)(ws + WS_V); const float* st0 = (const float*)(ws + WS_ST0);
    const bf16* XBC = (const bf16*)(dob + DO_XBC);
    bf16 *vT = (bf16*)(ws + WS_VT), *xT = (bf16*)(ws + WS_XT), *Bn = (bf16*)(dob + DO_BN), *BT = (bf16*)(dob + DO_BT), *Cn = (bf16*)(ws + WS_CN);
    const int t = tid & 255, so = t >> 4, co = t & 15;
    for (int pi = blockIdx.x * 2 + (tid >> 8); pi < 128 * 24; pi += gridDim.x * 2) {
        const int bc = pi / 24, k = 16 + pi % 24; const int tok0 = bc * 128 + so * 8;
        float o[8][8];
        if (k < 16) {
            const int ch0 = k * 128 + co * 8;
            float g[8], bb[8];
#pragma unroll
            for (int j = 0; j < 8; ++j) { g[j] = p.in[3][ch0 + j]; bb[j] = p.in[4][ch0 + j]; }
#pragma unroll
            for (int i = 0; i < 8; ++i) {
                const int row = tok0 + i; float f[8]; unpack8(*(const u32x4*)(Vb + (size_t)row * 2048 + ch0), f);
                const float mu = st0[2 * row] * (1.f / 2048.f), var = st0[2 * row + 1] * (1.f / 2048.f) - mu * mu, rs = rsqrtf(fmaxf(var, 0.f) + EPS);
#pragma unroll
                for (int j = 0; j < 8; ++j) o[i][j] = (f[j] - mu) * rs * g[j] + bb[j];
            }
#pragma unroll
            for (int j = 0; j < 8; ++j) { float c8[8];
#pragma unroll
                for (int i = 0; i < 8; ++i) c8[i] = o[i][j];
                *(u32x4*)(vT + ((size_t)bc * 2048 + ch0 + j) * 128 + so * 8) = pack8(c8); }
        } else {
            const int sc0 = (k - 16) * 128 + co * 8;
            float cw[4][8], cb[8];
#pragma unroll
            for (int j = 0; j < 8; ++j) { cb[j] = p.in[8][sc0 + j];
#pragma unroll
                for (int kk = 0; kk < 4; ++kk) cw[kk][j] = p.in[7][kk * 3072 + sc0 + j]; }
            const int pos0 = (bc & 15) * 128 + so * 8;
            float xw[11][8];
#pragma unroll
            for (int ii = 0; ii < 11; ++ii) {
                if (pos0 - 3 + ii >= 0) unpack8(*(const u32x4*)(XBC + (size_t)(tok0 - 3 + ii) * 3072 + sc0), xw[ii]);
                else {
#pragma unroll
                    for (int j = 0; j < 8; ++j) xw[ii][j] = 0.f;
                }
            }
#pragma unroll
            for (int i = 0; i < 8; ++i)
#pragma unroll
                for (int j = 0; j < 8; ++j) { float a = cb[j];
#pragma unroll
                    for (int kk = 0; kk < 4; ++kk) a += cw[kk][j] * xw[i + kk][j];
                    o[i][j] = silu_f(a); }
            if (k < 32) {
#pragma unroll
                for (int j = 0; j < 8; ++j) { float c8[8];
#pragma unroll
                    for (int i = 0; i < 8; ++i) c8[i] = o[i][j];
                    *(u32x4*)(xT + ((size_t)bc * 2048 + sc0 + j) * 128 + so * 8) = pack8(c8); }
            } else if (k < 36) {
                const int n0 = sc0 - 2048;
#pragma unroll
                for (int i = 0; i < 8; ++i) *(u32x4*)(Bn + (size_t)(tok0 + i) * 512 + n0) = pack8(o[i]);
#pragma unroll
                for (int j = 0; j < 8; ++j) { float c8[8];
#pragma unroll
                    for (int i = 0; i < 8; ++i) c8[i] = o[i][j];
                    *(u32x4*)(BT + ((size_t)bc * 512 + n0 + j) * 128 + so * 8) = pack8(c8); }
            } else {
                const int n0 = sc0 - 2560;
#pragma unroll
                for (int i = 0; i < 8; ++i) *(u32x4*)(Cn + (size_t)(tok0 + i) * 512 + n0) = pack8(o[i]);
            }
        }
    }
}

__device__ __forceinline__ void chunk_cumsum(const float* DT, const float* a_log, int tok0, int hh, int lane, float& d0, float& d1, float& c0, float& c1, float& tot) {
    d0 = DT[(size_t)(tok0 + 2 * lane) * 32 + hh]; d1 = DT[(size_t)(tok0 + 2 * lane + 1) * 32 + hh];
    const float A = -__expf(a_log[hh]); const float x0 = d0 * A, x1 = d1 * A; float ps = x0 + x1;
#pragma unroll
    for (int o = 1; o < 64; o <<= 1) { const float t = __shfl_up(ps, o); if (lane >= o) ps += t; }
    c1 = ps; c0 = ps - x1; tot = __shfl(ps, 63);
}

__device__ __forceinline__ void phase_mix(const PT& p, LAS unsigned char* lds, int tid, int lane, int wave) {
    unsigned char* ws = p.ws; unsigned char* dob = (unsigned char*)p.out;
    const int r32 = lane & 31, h = lane >> 5;
    bf16* Ycat = (bf16*)(ws + WS_YCAT); const bf16* ZA = (const bf16*)(ws + WS_ZA); const bf16* Vb = (const bf16*)(ws + WS_V); const float* st0 = (const float*)(ws + WS_ST0); const bf16* Wsp = (const bf16*)(ws + WS_WSP);
    const bf16* xT = (const bf16*)(ws + WS_XT); const bf16* BT = (const bf16*)(dob + DO_BT); const float* DT = (const float*)(ws + WS_DT);
    bf16* ST = (bf16*)(ws + WS_STATES); float* CD = (float*)(ws + WS_CD);
    LAS float* wtab = (LAS float*)lds;
    constexpr int NG = 128 * 16, NS = NBATCH * 15 * 4;
    for (int it = blockIdx.x; it < NG + NS; it += gridDim.x) {
        if (it < NG) {
            const int bc = it >> 4, g = it & 15, cb = wave & 3, th = wave >> 2;
            const int ch0 = g * 128 + cb * 32;
            __syncthreads();
            {
                const int c16 = tid & 15; float lg[8], lb[8];
#pragma unroll
                for (int j = 0; j < 8; ++j) { lg[j] = p.in[3][g * 128 + 8 * c16 + j]; lb[j] = p.in[4][g * 128 + 8 * c16 + j]; }
#pragma unroll
                for (int i = 0; i < 4; ++i) {
                    const int row = (tid >> 4) + 32 * i; const size_t tokr = (size_t)bc * 128 + row;
                    float f[8]; unpack8(*(const u32x4*)(Vb + tokr * 2048 + g * 128 + 8 * c16), f);
                    const float mu = st0[2 * tokr] * (1.f / 2048.f), var = st0[2 * tokr + 1] * (1.f / 2048.f) - mu * mu, rs = rsqrtf(fmaxf(var, 0.f) + EPS);
#pragma unroll
                    for (int j = 0; j < 8; ++j) f[j] = (f[j] - mu) * rs * lg[j] + lb[j];
                    *(LAS u32x4*)(lds + row * 272 + 16 * c16) = pack8(f);
                    *(LAS u32x4*)(lds + GM_UOFF + row * 272 + 16 * c16) = *(const u32x4*)(Ycat + tokr * 4096 + g * 128 + 8 * c16);
                    *(LAS u32x4*)(lds + GM_ZOFF + row * 272 + 16 * c16) = *(const u32x4*)(ZA + tokr * 2048 + g * 128 + 8 * c16);
                }
            }
            __syncthreads();
            const LAS unsigned char* ap = lds + (8 * h + ((lane & 15) >> 2)) * 272 + (cb * 32 + 16 * ((lane >> 4) & 1)) * 2 + (lane & 3) * 8;
            f32x16 acc[2];
#pragma unroll
            for (int i = 0; i < 16; ++i) { acc[0][i] = 0.f; acc[1][i] = 0.f; }
#pragma unroll
            for (int st = 0; st < 8; ++st) {
                const v4i16_t lo = __builtin_amdgcn_ds_read_tr16_b64_v4i16((LAS v4i16_t*)(ap + 16 * st * 272)), hi = __builtin_amdgcn_ds_read_tr16_b64_v4i16((LAS v4i16_t*)(ap + (16 * st + 4) * 272));
                const bf16x8 a = {lo[0], lo[1], lo[2], lo[3], hi[0], hi[1], hi[2], hi[3]};
#pragma unroll
                for (int t2 = 0; t2 < 2; ++t2) { const int tb = 2 * th + t2;
                    if (st < 2 * (tb + 1)) { const bf16x8 b = ld_frag16(Wsp + ((size_t)g * 128 + tb * 32 + r32) * 128 + 16 * st + 8 * h); acc[t2] = mfma32(a, b, acc[t2]); } }
            }
#pragma unroll
            for (int t2 = 0; t2 < 2; ++t2) {
                const int t = (2 * th + t2) * 32 + r32; const float sb = p.in[6][g * 128 + t];
#pragma unroll
                for (int qd = 0; qd < 4; ++qd) {
                    const int cl = cb * 32 + 8 * qd + 4 * h;
                    LAS u32x2* up = (LAS u32x2*)(lds + GM_UOFF + t * 272 + cl * 2); const u32x2 uu = *up, zz = *(const LAS u32x2*)(lds + GM_ZOFF + t * 272 + cl * 2);
                    const float y0 = bflo(uu.x) * (acc[t2][4 * qd] + sb) * bflo(zz.x), y1 = bfhi(uu.x) * (acc[t2][4 * qd + 1] + sb) * bfhi(zz.x);
                    const float y2 = bflo(uu.y) * (acc[t2][4 * qd + 2] + sb) * bflo(zz.y), y3 = bfhi(uu.y) * (acc[t2][4 * qd + 3] + sb) * bfhi(zz.y);
                    u32x2 w; w.x = pk2(y0, y1); w.y = pk2(y2, y3); *up = w;
                }
            }
            __syncthreads();
            { const int c16 = tid & 15;
#pragma unroll
              for (int i = 0; i < 4; ++i) { const int row = (tid >> 4) + 32 * i; *(u32x4*)(Ycat + ((size_t)bc * 128 + row) * 4096 + g * 128 + 8 * c16) = *(const LAS u32x4*)(lds + GM_UOFF + row * 272 + 16 * c16); } }
        } else {
            const int id = it - NG, b = id / 60, c = (id / 4) % 15, grp = id & 3; const int bc = b * 16 + c, tok0 = bc * 128;
            __syncthreads();
            { const int hh = grp * 8 + wave; float d0, d1, c0, c1, tot; chunk_cumsum(DT, p.in[10], tok0, hh, lane, d0, d1, c0, c1, tot);
              wtab[wave * 128 + 2 * lane] = d0 * __expf(tot - c0); wtab[wave * 128 + 2 * lane + 1] = d1 * __expf(tot - c1);
              if (lane == 0) CD[bc * 32 + hh] = __expf(tot); }
            __syncthreads();
#pragma unroll 1
            for (int tk = 0; tk < 2; ++tk) {
                const int r = (wave >> 1) + 4 * tk, pb = wave & 1, hh = grp * 8 + r;
                const bf16* ap = xT + ((size_t)bc * 2048 + hh * 64 + pb * 32 + r32) * 128 + 8 * h;
                const bf16* bp = BT + ((size_t)bc * 512 + grp * 128 + r32) * 128 + 8 * h;
                f32x16 acc[4];
#pragma unroll
                for (int nb = 0; nb < 4; ++nb)
#pragma unroll
                    for (int i = 0; i < 16; ++i) acc[nb][i] = 0.f;
#pragma unroll
                for (int st = 0; st < 8; ++st) {
                    float f[8]; unpack8(*(const u32x4*)(ap + 16 * st), f);
                    const f32x4 w0 = *(const LAS f32x4*)(wtab + r * 128 + 16 * st + 8 * h), w1 = *(const LAS f32x4*)(wtab + r * 128 + 16 * st + 8 * h + 4);
                    f[0] *= w0.x; f[1] *= w0.y; f[2] *= w0.z; f[3] *= w0.w; f[4] *= w1.x; f[5] *= w1.y; f[6] *= w1.z; f[7] *= w1.w;
                    const bf16x8 a = __builtin_bit_cast(bf16x8, pack8(f));
#pragma unroll
                    for (int nb = 0; nb < 4; ++nb) { const bf16x8 bfr = ld_frag16(bp + (size_t)nb * 32 * 128 + 16 * st); acc[nb] = mfma32(a, bfr, acc[nb]); }
                }
                bf16* sp = ST + ((size_t)(bc * 32 + hh) * 64 + pb * 32) * 128;
#pragma unroll
                for (int nb = 0; nb < 4; ++nb)
#pragma unroll
                    for (int i = 0; i < 16; ++i) sp[(size_t)crow(i, h) * 128 + nb * 32 + r32] = (bf16)(pk2(acc[nb][i], 0.f) & 0xffffu);
            }
        }
    }
}

__device__ __forceinline__ void phase_scan(const PT& p, int tid) {
    unsigned char* ws = p.ws; const bf16* ST = (const bf16*)(ws + WS_STATES); const float* CD = (const float*)(ws + WS_CD); bf16* PV = (bf16*)((unsigned char*)p.out + DO_PREV);
    for (int id = blockIdx.x * 512 + tid; id < NBATCH * 32 * 64 * 16; id += gridDim.x * 512) {
        const int b = id >> 15, rem = id & 32767, hh = rem >> 10;
        float run[8];
#pragma unroll
        for (int j = 0; j < 8; ++j) run[j] = 0.f;
#pragma unroll
        for (int c = 0; c < 16; ++c) {
            const size_t off = ((size_t)(b * 16 + c) * 32 * 64 * 16 + rem) * 8;
            *(u32x4*)(PV + off) = pack8(run);
            if (c < 15) { float s[8]; unpack8(*(const u32x4*)(ST + off), s); const float cd = CD[(b * 16 + c) * 32 + hh];
#pragma unroll
                for (int j = 0; j < 8; ++j) run[j] = run[j] * cd + s[j]; }
        }
    }
}

constexpr int SY_TILE = 9728, SY_TP = 1040;
static_assert(SY_TILE + 128 * SY_TP <= PTAB_OFF, "ssd_y LDS map");
__device__ __forceinline__ void phase_ssd_y(const PT& p, LAS unsigned char* lds, int tid, int lane, int wave) {
    unsigned char* ws = p.ws; unsigned char* dob = (unsigned char*)p.out;
    const int r32 = lane & 31, h = lane >> 5;
    bf16* Ycat = (bf16*)(ws + WS_YCAT); const bf16* xT = (const bf16*)(ws + WS_XT); const bf16* Bn = (const bf16*)(dob + DO_BN); const bf16* Cn = (const bf16*)(ws + WS_CN);
    const bf16* PV = (const bf16*)(dob + DO_PREV); const float* DT = (const float*)(ws + WS_DT);
    LAS float* acum = (LAS float*)lds; LAS float* dtt = acum + 1024; LAS float* ssqp = dtt + 1024; LAS float* rsT = ssqp + 256;
    LAS unsigned char* tile = lds + SY_TILE;
    for (int it = blockIdx.x; it < 128 * 4; it += gridDim.x) {
        const int bc = it >> 2, grp = it & 3, tok0 = bc * 128;
        __syncthreads();
        { const int hh = grp * 8 + wave; float d0, d1, c0, c1, tot; chunk_cumsum(DT, p.in[10], tok0, hh, lane, d0, d1, c0, c1, tot);
          acum[wave * 128 + 2 * lane] = c0; acum[wave * 128 + 2 * lane + 1] = c1; dtt[wave * 128 + 2 * lane] = d0; dtt[wave * 128 + 2 * lane + 1] = d1; }
#pragma unroll 4
        for (int i = 0; i < 16; ++i) { const int pid = tid + 512 * i, row = pid >> 6, c8 = pid & 63;
            *(LAS u32x4*)(tile + row * SY_TP + 16 * c8) = *(const u32x4*)(Ycat + ((size_t)tok0 + row) * 4096 + 2048 + grp * 512 + 8 * c8); }
        __syncthreads();
        const int pb = wave >> 2, lb = wave & 3, l = lb * 32 + r32; const size_t tok = (size_t)tok0 + l;
        bf16x8 cf[8];
#pragma unroll
        for (int st = 0; st < 8; ++st) cf[st] = ld_frag16(Cn + tok * 512 + grp * 128 + 16 * st + 8 * h);
        f32x16 X[4];
#pragma unroll
        for (int sb = 0; sb < 4; ++sb) {
#pragma unroll
            for (int i = 0; i < 16; ++i) X[sb][i] = 0.f;
            if (sb <= lb) {
#pragma unroll
                for (int st = 0; st < 8; ++st) X[sb] = mfma32(ld_frag16(Bn + ((size_t)tok0 + sb * 32 + r32) * 512 + grp * 128 + 16 * st + 8 * h), cf[st], X[sb]);
            }
        }
        float ssq = 0.f;
#pragma unroll 2
        for (int r = 0; r < 8; ++r) {
            const int hh = grp * 8 + r;
            f32x16 acc;
#pragma unroll
            for (int i = 0; i < 16; ++i) acc[i] = 0.f;
            const bf16* pp = PV + ((size_t)(bc * 32 + hh) * 64 + pb * 32 + r32) * 128 + 8 * h;
#pragma unroll
            for (int st = 0; st < 8; ++st) acc = mfma32(ld_frag16(pp + 16 * st), cf[st], acc);
            const float al = acum[r * 128 + l]; const float el = __expf(al); const float dsk = p.in[11][hh];
#pragma unroll
            for (int i = 0; i < 16; ++i) acc[i] *= el;
            const bf16* xrow = xT + ((size_t)bc * 2048 + hh * 64 + pb * 32 + r32) * 128 + 4 * h;
#pragma unroll
            for (int sb = 0; sb < 4; ++sb) {
                if (sb <= lb) {
                    f32x16 mm;
#pragma unroll
                    for (int qd = 0; qd < 4; ++qd) {
                        const int s0 = sb * 32 + 8 * qd + 4 * h;
                        const f32x4 as = *(const LAS f32x4*)(acum + r * 128 + s0), ds = *(const LAS f32x4*)(dtt + r * 128 + s0);
#pragma unroll
                        for (int j = 0; j < 4; ++j) { const float v = X[sb][4 * qd + j] * __expf(al - as[j]) * ds[j]; mm[4 * qd + j] = (s0 + j < l) ? v : ((s0 + j == l) ? v + dsk : 0.f); }
                    }
#pragma unroll
                    for (int s2 = 0; s2 < 2; ++s2) acc = mfma32(ld_frag8x2(xrow + sb * 32 + 16 * s2), pack_frag(mm, s2), acc);
                }
            }
#pragma unroll
            for (int qd = 0; qd < 4; ++qd) {
                LAS u32x2* yp = (LAS u32x2*)(tile + l * SY_TP + (r * 64 + pb * 32 + 8 * qd + 4 * h) * 2); const u32x2 zz = *yp;
                const float y0 = acc[4 * qd] * bflo(zz.x), y1 = acc[4 * qd + 1] * bfhi(zz.x);
                const float y2 = acc[4 * qd + 2] * bflo(zz.y), y3 = acc[4 * qd + 3] * bfhi(zz.y);
                ssq += (y0 * y0 + y1 * y1) + (y2 * y2 + y3 * y3);
                u32x2 w; w.x = pk2(y0, y1); w.y = pk2(y2, y3); *yp = w;
            }
        }
        ssq += __shfl_xor(ssq, 32);
        if (h == 0) ssqp[pb * 128 + l] = ssq;
        __syncthreads();
        if (pb == 0 && h == 0) rsT[l] = rsqrtf((ssqp[l] + ssqp[128 + l]) * (1.f / 512.f) + EPS);
        __syncthreads();
#pragma unroll 4
        for (int i = 0; i < 16; ++i) { const int pid = tid + 512 * i, row = pid >> 6, c8 = pid & 63; const int ch = grp * 512 + 8 * c8;
            float f[8]; unpack8(*(const LAS u32x4*)(tile + row * SY_TP + 16 * c8), f);
            const float rs = rsT[row]; const f32x4 g0 = *(const f32x4*)(p.in[12] + ch), g1 = *(const f32x4*)(p.in[12] + ch + 4);
            f[0] *= rs * g0.x; f[1] *= rs * g0.y; f[2] *= rs * g0.z; f[3] *= rs * g0.w; f[4] *= rs * g1.x; f[5] *= rs * g1.y; f[6] *= rs * g1.z; f[7] *= rs * g1.w;
            *(u32x4*)(Ycat + ((size_t)tok0 + row) * 4096 + 2048 + ch) = pack8(f); }
    }
}

constexpr int AK_PITCH = 272, AV_PITCH = 272, A_KOFF = 0, A_VOFF = 128 * AK_PITCH, A_STAGE = A_VOFF + 128 * AV_PITCH;
static_assert(2 * A_STAGE <= PTAB_OFF && 4 * 16384 <= A_STAGE, "attention LDS map");
__device__ __forceinline__ float max3f(float a, float b, float c) { return fmaxf(fmaxf(a, b), c); }
__device__ __forceinline__ void attn_unit(const PT& p, LAS unsigned char* lds, int tid, int lane, int wave, int b, int hd, int qb, float lam) {
    unsigned char* ws = p.ws;
    const bf16* Qb = (const bf16*)(ws + WS_Q); const bf16* Kb = (const bf16*)(ws + WS_K); const bf16* Vb = (const bf16*)(ws + WS_VV); const bf16* Gb = (const bf16*)((unsigned char*)p.out + DO_G);
    bf16* Ob = (bf16*)(ws + WS_O);
    const int r32 = lane & 31, h = lane >> 5, mp = wave >> 2, wq = wave & 3;
    const int qw0 = qb * 128 + 32 * wq, q = qw0 + r32; const unsigned tokq = (unsigned)(b * SEQ + q), tokb = (unsigned)(b * SEQ);
    const float slope2 = fexp2(-0.5f * (float)(hd + 1)) * LOG2E;
    bf16x8 qf[4];
#pragma unroll
    for (int ds = 0; ds < 4; ++ds) qf[ds] = ld_frag16(Qb + (tokq * 2048u + (unsigned)(hd * 128 + mp * 64 + 16 * ds + 8 * h)));
    float mrun = -INFINITY, lsum = 0.f;
    f32x16 oT[4];
#pragma unroll
    for (int db = 0; db < 4; ++db)
#pragma unroll
        for (int i = 0; i < 16; ++i) oT[db][i] = 0.f;
    const int ntiles = qb + 1;
    u32x4 preV[4], preK[4];
#define PREFETCH(t) do { \
        _Pragma("unroll") for (int i_ = 0; i_ < 4; ++i_) { const int pid_ = tid + 512 * i_, row_ = pid_ >> 4, c16_ = pid_ & 15; const unsigned go_ = (tokb + (unsigned)((t) * 128 + row_)) * 2048u + (unsigned)(hd * 128 + 8 * c16_); \
            preK[i_] = *(const u32x4*)(Kb + go_); preV[i_] = *(const u32x4*)(Vb + go_); } \
    } while (0)
    PREFETCH(0);
    const LAS unsigned char* kbase0 = lds + A_KOFF + r32 * AK_PITCH + (mp * 64 + 8 * h) * 2;
    const LAS unsigned char* vbase0 = lds + A_VOFF + (4 * h + ((lane & 15) >> 2)) * AV_PITCH + ((lane >> 4) & 1) * 32 + (lane & 3) * 8;
#define STAGE_WRITE(stg) do { \
        _Pragma("unroll") for (int i_ = 0; i_ < 4; ++i_) { const int pid_ = tid + 512 * i_, row_ = pid_ >> 4, c16_ = pid_ & 15; \
            *(LAS u32x4*)(lds + (stg) * A_STAGE + A_KOFF + row_ * AK_PITCH + 16 * c16_) = preK[i_]; *(LAS u32x4*)(lds + (stg) * A_STAGE + A_VOFF + row_ * AV_PITCH + 16 * c16_) = preV[i_]; } \
    } while (0)
    __syncthreads();
    STAGE_WRITE(0);
    asm volatile("" : "+v"(qf[0]), "+v"(qf[1]), "+v"(qf[2]), "+v"(qf[3]));
    __syncthreads();
#pragma unroll 1
    for (int t = 0; t < ntiles; ++t) {
        const int stg = t & 1;
        if (t + 1 < ntiles) PREFETCH(t + 1);
        const LAS unsigned char* kbase = kbase0 + stg * A_STAGE; const LAS unsigned char* vbase = vbase0 + stg * A_STAGE;
        const bool diag = (t == qb);
#pragma unroll 1
        for (int sub = 0; sub < 2; ++sub) {
            const int nact = diag ? min(2, max(0, wq + 1 - 2 * sub)) : 2;
            if (nact > 0) {
                float sl = slope2; asm volatile("" : "+v"(sl));
                const float bq = sl * (float)(t * 128 + sub * 64 + 4 * h - q);
                const LAS unsigned char* kb0 = kbase + sub * 64 * AK_PITCH; const LAS unsigned char* vb0 = vbase + sub * 64 * AV_PITCH;
                f32x16 s[2];
#pragma unroll
                for (int kb = 0; kb < 2; ++kb) {
                    if (kb < nact) {
                        const float bk = bq + sl * (float)(32 * kb);
#pragma unroll
                        for (int i = 0; i < 16; ++i) s[kb][i] = __builtin_fmaf(sl, (float)((i & 3) + 8 * (i >> 2)), bk);
#pragma unroll
                        for (int ds = 0; ds < 4; ++ds) s[kb] = mfma32(__builtin_bit_cast(bf16x8, *(const LAS u32x4*)(kb0 + kb * 32 * AK_PITCH + ds * 32)), qf[ds], s[kb]);
                    } else {
#pragma unroll
                        for (int i = 0; i < 16; ++i) s[kb][i] = -INFINITY;
                    }
                }
                if (diag) {
#pragma unroll
                    for (int kb = 0; kb < 2; ++kb) if (2 * sub + kb == wq) {
#pragma unroll
                        for (int i = 0; i < 16; ++i) if (crow(i, h) > r32) s[kb][i] = -INFINITY; }
                }
                float mx = -INFINITY;
#pragma unroll
                for (int kb = 0; kb < 2; ++kb)
#pragma unroll
                    for (int i = 0; i < 16; i += 2) mx = max3f(mx, s[kb][i], s[kb][i + 1]);
                mx = fmaxf(mx, __shfl_xor(mx, 32));
                const float mnew = fmaxf(mrun, mx), alpha = fexp2(mrun - mnew); mrun = mnew;
                float rs = 0.f;
#pragma unroll
                for (int kb = 0; kb < 2; ++kb)
#pragma unroll
                    for (int i = 0; i < 16; ++i) { s[kb][i] = fexp2(s[kb][i] - mnew); rs += s[kb][i]; }
                lsum = lsum * alpha + rs;
                if (__builtin_amdgcn_ballot_w64(alpha != 1.0f) != 0ull) {
#pragma unroll
                    for (int db = 0; db < 4; ++db)
#pragma unroll
                        for (int i = 0; i < 16; ++i) oT[db][i] *= alpha;
                }
#pragma unroll
                for (int kb = 0; kb < 2; ++kb) if (kb < nact) {
#pragma unroll
                    for (int s2 = 0; s2 < 2; ++s2) {
                        const bf16x8 pf = pack_frag(s[kb], s2);
#pragma unroll
                        for (int db = 0; db < 4; ++db) {
                            const LAS unsigned char* vp = vb0 + (kb * 32 + 16 * s2) * AV_PITCH + db * 64;
                            const v4i16_t lo = __builtin_amdgcn_ds_read_tr16_b64_v4i16((LAS v4i16_t*)vp), hi = __builtin_amdgcn_ds_read_tr16_b64_v4i16((LAS v4i16_t*)(vp + 8 * AV_PITCH));
                            const bf16x8 vf = {lo[0], lo[1], lo[2], lo[3], hi[0], hi[1], hi[2], hi[3]};
                            oT[db] = mfma32(vf, pf, oT[db]);
                        }
                    }
                }
            }
        }
        if (t + 1 < ntiles) STAGE_WRITE(stg ^ 1);
        __syncthreads();
    }
#undef PREFETCH
#undef STAGE_WRITE
    const float lt = lsum + __shfl_xor(lsum, 32);
    LAS float* xch = (LAS float*)(lds + (ntiles & 1) * A_STAGE + wq * 16384);
    if (mp == 1) { const float sc = lam / lt;
#pragma unroll
        for (int db = 0; db < 4; ++db)
#pragma unroll
            for (int i = 0; i < 16; ++i) xch[(db * 16 + i) * 64 + lane] = oT[db][i] * sc; }
    __syncthreads();
    if (mp == 0) {
        const float i1 = 1.f / lt; float ss = 0.f;
#pragma unroll
        for (int db = 0; db < 4; ++db)
#pragma unroll
            for (int i = 0; i < 16; ++i) { const float o = oT[db][i] * i1 - xch[(db * 16 + i) * 64 + lane]; oT[db][i] = o; ss += o * o; }
        ss += __shfl_xor(ss, 32);
        const float rn = rsqrtf(ss * (1.f / 128.f) + EPS) * (1.f - LAMBDA_INIT);
#pragma unroll
        for (int db = 0; db < 4; ++db)
#pragma unroll
            for (int qd = 0; qd < 4; ++qd) {
                const int d = db * 32 + 8 * qd + 4 * h; const unsigned off = tokq * 2048u + (unsigned)(hd * 128 + d);
                const u32x2 gg = *(const u32x2*)(Gb + off); const f32x4 sg = *(const f32x4*)(p.in[20] + d);
                u32x2 w; w.x = pk2(oT[db][4 * qd] * rn * sg.x * bflo(gg.x), oT[db][4 * qd + 1] * rn * sg.y * bfhi(gg.x));
                w.y = pk2(oT[db][4 * qd + 2] * rn * sg.z * bflo(gg.y), oT[db][4 * qd + 3] * rn * sg.w * bfhi(gg.y));
                *(u32x2*)(Ob + off) = w;
            }
    }
}

__device__ __forceinline__ void phase_attn(const PT& p, LAS unsigned char* lds, int tid, int lane, int wave) {
    const float s1 = wave_sum(p.in[16][lane] * p.in[17][lane]), s2 = wave_sum(p.in[18][lane] * p.in[19][lane]);
    const float lam = __expf(s1) - __expf(s2) + LAMBDA_INIT;
#pragma unroll 1
    for (int u = blockIdx.x; u < NBATCH * 16 * 8; u += gridDim.x) {
        const int j = u & 7, hd = (u >> 3) & 15, b = u >> 7;
#pragma unroll 1
        for (int k = 0; k < 2; ++k) attn_unit(p, lds, tid, lane, wave, b, hd, k == 0 ? 15 - j : j, lam);
    }
}

__device__ __forceinline__ void phase_final(const PT& p, int lane, int wave) {
    const float* st2 = (const float*)(p.ws + WS_ST2); const float* g = p.in[22]; const bf16* X2 = (const bf16*)(p.ws + WS_X2B);
    for (int m = blockIdx.x * 8 + wave; m < M; m += gridDim.x * 8) {
        const float rs = rsqrtf(st2[m] * (1.f / 2048.f) + EPS);
        const u32x4* xr = (const u32x4*)(X2 + (size_t)m * 2048) + lane; f32x4* orow = (f32x4*)(p.out + (size_t)m * 2048);
#pragma unroll
        for (int j = 0; j < 4; ++j) {
            float f[8]; unpack8(xr[64 * j], f); const int c = 8 * (lane + 64 * j);
            const f32x4 g0 = *(const f32x4*)(g + c), g1 = *(const f32x4*)(g + c + 4);
            orow[(c >> 2)] = (f32x4){f[0] * rs * g0.x, f[1] * rs * g0.y, f[2] * rs * g0.z, f[3] * rs * g0.w};
            orow[(c >> 2) + 1] = (f32x4){f[4] * rs * g1.x, f[5] * rs * g1.y, f[6] * rs * g1.z, f[7] * rs * g1.w};
        }
    }
}

constexpr size_t WS_BAR = 384 * 1024;
constexpr int XBST_OFF = PTAB_OFF + 256;
typedef __attribute__((address_space(1))) unsigned gu32;
#define XB_TMO      128
#define XB_XCNT(j)  (256  + 64 * (j))
#define XB_XSUB(j)  (1280 + 64 * (j))
#define XB_XGEN(j)  (2304 + 64 * (j))
#define XB_TOP      3328
#define XB_TOPGEN   3392
#define XCD_BAR_WORDS 3456
#define XB_SPIN_CAP (1u << 18)

__device__ __forceinline__ unsigned xb_ld(unsigned* p)              { return __hip_atomic_load(p, __ATOMIC_RELAXED, __HIP_MEMORY_SCOPE_AGENT); }
__device__ __forceinline__ unsigned xb_add(unsigned* p, unsigned v) { return __hip_atomic_fetch_add(p, v, __ATOMIC_RELAXED, __HIP_MEMORY_SCOPE_AGENT); }
__device__ __forceinline__ unsigned xb_xcc_id() { return (unsigned)__builtin_amdgcn_s_getreg((3 << 11) | 20) & 0xFu; }
#define XB_SPIN(cond, bar) do { unsigned _sp = 0; while (cond) { __builtin_amdgcn_s_sleep(1); \
    if ((++_sp & 255u) == 0u) { if (xb_ld(&(bar)[XB_TMO])) break; if (_sp > XB_SPIN_CAP) { atomicAdd(&(bar)[XB_TMO], 1u); break; } } } } while (0)

struct XcdBarrier {
    unsigned* bar; unsigned x;
    volatile LAS unsigned* st;
};

__device__ __forceinline__ XcdBarrier xcd_barrier_post(unsigned* bar, volatile LAS unsigned* st) {
    XcdBarrier b; b.bar = bar; b.x = xb_xcc_id(); b.st = st;
    if (threadIdx.x == 0) (void)xb_add(&bar[XB_XCNT(b.x)], 1u);
    return b;
}
__device__ __forceinline__ void xcd_barrier_complete(unsigned* bar, unsigned x, unsigned& nloc, unsigned& nx) {
    const unsigned G = gridDim.x * gridDim.y * gridDim.z;
    unsigned sum, cnt, mine, sp = 0u;
    for (;;) {
        sum = 0u; cnt = 0u; mine = 0u;
#pragma unroll
        for (unsigned j = 0; j < 16; ++j) { const unsigned c = xb_ld(&bar[XB_XCNT(j)]); sum += c; cnt += (c > 0u) ? 1u : 0u; mine = (j == x) ? c : mine; }
        if (sum == G) break;
        __builtin_amdgcn_s_sleep(1);
        if ((++sp & 255u) == 0u) { if (xb_ld(&bar[XB_TMO])) break; if (sp > XB_SPIN_CAP) { atomicAdd(&bar[XB_TMO], 1u); break; } }
    }
    nloc = mine > 0u ? mine : 1u; nx = cnt > 0u ? cnt : 1u;
}

__device__ __forceinline__ void xcd_barrier(const XcdBarrier& b) {
    asm volatile("s_waitcnt vmcnt(0)" ::: "memory");
    __syncthreads();
    if (threadIdx.x == 0) {
        unsigned* bar = b.bar;
        __builtin_amdgcn_s_waitcnt(0);
        unsigned nloc = b.st[0], nx = b.st[1];
        if (nloc == 0u) { xcd_barrier_complete(bar, b.x, nloc, nx); b.st[0] = nloc; b.st[1] = nx; }
        const unsigned old = xb_add(&bar[XB_XSUB(b.x)], 1u);
        const unsigned gen = old / nloc;
        if (old + 1u == (gen + 1u) * nloc) {
            __builtin_amdgcn_fence(__ATOMIC_RELEASE, "agent");
            asm volatile("s_waitcnt vmcnt(0)" ::: "memory");
            const unsigned og = xb_add(&bar[XB_TOP], 1u);
            const unsigned tg = og / nx;
            if (og + 1u == (tg + 1u) * nx) xb_add(&bar[XB_TOPGEN], 1u);
            else XB_SPIN(xb_ld(&bar[XB_TOPGEN]) == tg, bar);
            __builtin_amdgcn_fence(__ATOMIC_ACQUIRE, "agent");
            xb_add(&bar[XB_XGEN(b.x)], 1u);
            asm volatile("s_waitcnt vmcnt(0)" ::: "memory");
        } else {
            XB_SPIN(xb_ld(&bar[XB_XGEN(b.x)]) == gen, bar);
            __builtin_amdgcn_fence(__ATOMIC_ACQUIRE, "agent");
            asm volatile("s_waitcnt vmcnt(0)" ::: "memory");
        }
    }
    __syncthreads();
}

__global__ void __launch_bounds__(512) fwd_megakernel(Params pa) {
    extern __shared__ __attribute__((aligned(16))) unsigned char lds_raw[];
    cg::grid_group grid = cg::this_grid();
    LAS unsigned char* lds = (LAS unsigned char*)lds_raw;
    if (threadIdx.x < 25) {
        unsigned long long v = 0;
#pragma unroll
        for (int i = 0; i < 23; ++i) if ((int)threadIdx.x == i) v = (unsigned long long)pa.in[i];
        if (threadIdx.x == 23) v = (unsigned long long)pa.out;
        if (threadIdx.x == 24) v = (unsigned long long)pa.ws;
        ((LAS unsigned long long*)(lds + PTAB_OFF))[threadIdx.x] = v;
    }
    if (threadIdx.x < 2) ((LAS unsigned*)(lds + XBST_OFF))[threadIdx.x] = 0u;
    __syncthreads();
    const XcdBarrier bar = xcd_barrier_post((unsigned*)(pa.ws + WS_BAR), (volatile LAS unsigned*)(lds + XBST_OFF));
#ifndef PHMASK
#define PHMASK 0x3ff
#endif
#define PH(n) (((PHMASK) >> (n)) & 1)
#define TLW int tid_ = threadIdx.x; asm volatile("" : "+v"(tid_)); const int tid = tid_, lane = tid & 63, wave = __builtin_amdgcn_readfirstlane(tid >> 6); (void)tid; (void)lane; (void)wave
#define GRIDV const int G = gridDim.x, c = blockIdx.x
    if (PH(0)) { PT p; TLW; phase0(p, lds, tid, lane, wave); }
    if (gridDim.x == 0x7fffffffu) grid.sync();
    xcd_barrier(bar);
    if (PH(1)) {
        PT p; GRIDV; unsigned char* ws = p.ws; unsigned char* dob = (unsigned char*)p.out;
        pg8::Gemm g{(const pg8::bf16_t*)(ws + WS_H0), (const pg8::bf16_t*)(ws + WS_W0IN), M, N0P, 2048}; pg8::StaticOrder S; S.init(M, N0P, G, c);
        EpiIn0 E{(bf16*)(ws + WS_YCAT), (bf16*)(ws + WS_V), (bf16*)(ws + WS_ZA), (bf16*)(dob + DO_XBC), (float*)(ws + WS_ST0)};
        pg8::gemm_phase<EpiIn0, pg8::StaticOrder, true, true>(lds, g, S, E);
        { TLW; dt_tasks(p, lane, wave); }
    }
    xcd_barrier(bar);
    if (PH(2)) { PT p; TLW; phase_layout(p, tid); }
    xcd_barrier(bar);
    if (PH(3)) { PT p; TLW; phase_mix(p, lds, tid, lane, wave); }
    xcd_barrier(bar);
    if (PH(4)) { PT p; TLW; phase_scan(p, tid); }
    xcd_barrier(bar);
    if (PH(5)) { PT p; TLW; phase_ssd_y(p, lds, tid, lane, wave); }
    xcd_barrier(bar);
    if (PH(6)) {
        PT p; GRIDV; unsigned char* ws = p.ws;
        pg8::Gemm g{(const pg8::bf16_t*)(ws + WS_YCAT), (const pg8::bf16_t*)(ws + WS_W0OUT), M, 2048, 4096}; pg8::StaticOrder S; S.init(M, 2048, G, c);
        EpiResT<false> E{p.in[0], nullptr, (bf16*)(ws + WS_X1B), (float*)(ws + WS_ST1)};
        pg8::gemm_phase<EpiResT<false>, pg8::StaticOrder, true, true>(lds, g, S, E);
    }
    xcd_barrier(bar);
    if (PH(6)) {
        PT p; GRIDV; unsigned char* ws = p.ws; unsigned char* dob = (unsigned char*)p.out;
        pg8::Gemm g{(const pg8::bf16_t*)(ws + WS_X1B), (const pg8::bf16_t*)(ws + WS_W1IN), M, 8192, 2048}; pg8::StaticOrder S; S.init(M, 8192, G, c);
        EpiIn1 E{(bf16*)(ws + WS_Q), (bf16*)(ws + WS_K), (bf16*)(ws + WS_VV), (bf16*)(dob + DO_G), (const float*)(ws + WS_ST1)};
        pg8::gemm_phase<EpiIn1, pg8::StaticOrder, true, true>(lds, g, S, E);
    }
    xcd_barrier(bar);
    if (PH(7)) { PT p; TLW; phase_attn(p, lds, tid, lane, wave); }
    xcd_barrier(bar);
    if (PH(8)) {
        PT p; GRIDV; unsigned char* ws = p.ws;
        pg8::Gemm g{(const pg8::bf16_t*)(ws + WS_O), (const pg8::bf16_t*)(ws + WS_W1OUT), M, 2048, 2048}; pg8::StaticOrder S; S.init(M, 2048, G, c);
        EpiResT<true> E{(const void*)(ws + WS_X1B), nullptr, (bf16*)(ws + WS_X2B), (float*)(ws + WS_ST2)};
        pg8::gemm_phase<EpiResT<true>, pg8::StaticOrder, true, true>(lds, g, S, E);
    }
    xcd_barrier(bar);
    if (PH(9)) { PT p; TLW; phase_final(p, lane, wave); }
}

extern "C" void kernel_launch(void* const* d_in, const int* in_sizes, int n_in, void* d_out, int out_size, void* d_ws, size_t ws_size, hipStream_t stream) {
    static int grid = 0;
    if (grid == 0) {
        if (n_in != 23 || out_size != M * DM || ws_size < WS_END) { fprintf(stderr, "kernel_launch: unexpected shapes (n_in %d out %d ws %zu)\n", n_in, out_size, ws_size); grid = -1; return; }
        int dev = 0, cus = 0, per_cu = 0;
        hipGetDevice(&dev); hipDeviceGetAttribute(&cus, hipDeviceAttributeMultiprocessorCount, dev);
        hipFuncSetAttribute((const void*)fwd_megakernel, hipFuncAttributeMaxDynamicSharedMemorySize, LDS_BYTES);
        hipOccupancyMaxActiveBlocksPerMultiprocessor(&per_cu, (const void*)fwd_megakernel, 512, LDS_BYTES);
        if (per_cu < 1) { fprintf(stderr, "kernel_launch: occupancy query says %d blocks per CU\n", per_cu); per_cu = 1; }
        (void)hipGetLastError();
        grid = cus;
    }
    if (grid < 0) return;
    Params p{};
    for (int i = 0; i < 23; ++i) p.in[i] = (const float*)d_in[i];
    p.out = (float*)d_out; p.ws = (unsigned char*)d_ws;
    if (hipMemsetAsync((char*)d_ws + WS_BAR, 0, XCD_BAR_WORDS * 4, stream) != hipSuccess) { fprintf(stderr, "kernel_launch: memset of the barrier words failed\n"); return; }
    void* args[] = {&p};
    hipError_t e = hipLaunchCooperativeKernel((const void*)fwd_megakernel, dim3(grid), dim3(512), args, LDS_BYTES, stream);
    if (e != hipSuccess) fprintf(stderr, "cooperative launch failed: %s (grid %d)\n", hipGetErrorString(e), grid);
}
```

```cpp
#include <hip/hip_runtime.h>
#include <hip/hip_cooperative_groups.h>
#include <cstdio>
#include <cstdint>
#include <cmath>
namespace cg = cooperative_groups;
namespace pg8 {
#define PG8_LAS __attribute__((address_space(3)))
typedef unsigned short bf16_t;
typedef short bf16x8 __attribute__((ext_vector_type(8)));
typedef float f32x4 __attribute__((ext_vector_type(4)));
typedef unsigned u32x4 __attribute__((ext_vector_type(4)));
constexpr int BM = 256, BK = 64, HALF = 128, HTB = HALF * BK * 2  , STAGE_BYTES = 8 * HTB, NXCD = 8, WGM = 8;

__host__ __device__ __forceinline__ int lds_byte(int r, int c) { const int st = (r >> 4) * 2 + (c >> 5), rr = r & 15, cc = c & 31, ob = rr * 64 + cc * 2; return st * 1024 + (ob ^ (((ob >> 9) & 1) << 5)); }
__host__ __device__ __forceinline__ void stage_rc(int b, int& R, int& C) { const int st = b / 1024, sb = b % 1024, swz = sb ^ (((sb >> 9) & 1) << 5); R = (st >> 1) * 16 + swz / 64; C = (st & 1) * 32 + (swz % 64) / 2; }
__host__ __device__ __forceinline__ int perm32(int rho) { const int n = rho >> 4, i = rho & 15; return 8 * (i >> 2) + 4 * n + (i & 3); }

struct Unit { int pm, pn; };
struct Gemm { const bf16_t* A; const bf16_t* Bt; int M, N, K; };

struct StaticOrder {
    int nM, nN, nwg, G, c;
    __host__ __device__ void init(int M, int N, int G_, int c_) { nM = M / BM; nN = N / BM; nwg = nM * nN; G = G_; c = c_; }
    __host__ __device__ bool next(int i, Unit& u) const {
        const long L = (long)i * G + c; if (L >= nwg) return false;
        int wgid = (int)L; { const int q = nwg / NXCD, r = nwg % NXCD, xcd = wgid % NXCD, off = wgid / NXCD; wgid = (xcd < r ? xcd * (q + 1) : r * (q + 1) + (xcd - r) * q) + off; }
        const int nig = WGM * nN, gid = wgid / nig, fm = gid * WGM, gsz = (nM - fm) < WGM ? (nM - fm) : WGM;
        u.pm = fm + ((wgid % nig) % gsz); u.pn = (wgid % nig) / gsz; return true;
    }
    __device__ __forceinline__ void a_ready(const Unit&) const {}
    __device__ __forceinline__ void done(const Unit&) const {}
};

template <class Epi, class Sched, bool ALIGN_EPI = false, bool SP2 = false>
__device__ __forceinline__ void gemm_phase(PG8_LAS unsigned char* lds, const Gemm g, const Sched& S, const Epi& E) {
    int tid_ = threadIdx.x; asm volatile("" : "+v"(tid_));
    const int tid = tid_, wid = __builtin_amdgcn_readfirstlane(tid >> 6), lane = tid & 63, wr = wid >> 2, wc = wid & 3, fr = lane & 15, fq = lane >> 4;
    const int K = g.K, nt = K / BK;
    unsigned voffA[2], voffB[2];
#pragma unroll
    for (int i = 0; i < 2; ++i) { int R, C; stage_rc(tid * 16 + i * 8192, R, C); const int Rb = Epi::PERM ? ((R & ~31) + perm32(R & 31)) : R;
        voffA[i] = (unsigned)(R * K + C) * 2u; voffB[i] = (unsigned)(Rb * K + C) * 2u; }
    const size_t kstep = (size_t)(BK * 2);
    const size_t hstep = (size_t)HALF * K * 2;
    const size_t tstep = 2 * hstep;
    const unsigned ldsw = (unsigned)wid * 1024u;
    const int aoff = lds_byte(wr * 64 + fr, fq * 8), boff = lds_byte(wc * 32 + fr, fq * 8);
#define PG8_SA(b, h) (((b) * 2 + (h)) * HTB)
#define PG8_SB(b, h) ((4 + (b) * 2 + (h)) * HTB)
#define PG8_STAGE(bufoff, gbase, voff) do { _Pragma("unroll") for (int _i = 0; _i < 2; ++_i) \
        __builtin_amdgcn_global_load_lds((const unsigned*)((const char*)(gbase) + (voff)[_i]), (PG8_LAS unsigned*)(lds + (bufoff) + ldsw + _i * 8192), 16, 0, 0); } while (0)
#define PG8_LDA(dst, b, h) do { _Pragma("unroll") for (int m = 0; m < 4; ++m) _Pragma("unroll") for (int k = 0; k < 2; ++k) dst[m][k] = *(const PG8_LAS bf16x8*)(lds + PG8_SA(b, h) + aoff + m * 2048 + k * 1024); } while (0)
#define PG8_LDB(dst, b, h) do { _Pragma("unroll") for (int n = 0; n < 2; ++n) _Pragma("unroll") for (int k = 0; k < 2; ++k) dst[n][k] = *(const PG8_LAS bf16x8*)(lds + PG8_SB(b, h) + boff + n * 2048 + k * 1024); } while (0)
#define PG8_MMA(ai, bj, At, Bt) do { __builtin_amdgcn_s_setprio(1); _Pragma("unroll") for (int m = 0; m < 4; ++m) _Pragma("unroll") for (int n = 0; n < 2; ++n) _Pragma("unroll") for (int k = 0; k < 2; ++k) \
        acc[ai][bj][m][n] = __builtin_amdgcn_mfma_f32_16x16x32_bf16(Bt[n][k], At[m][k], acc[ai][bj][m][n], 0, 0, 0); __builtin_amdgcn_s_setprio(0); } while (0)
#define PG8_WAIT_V(n) asm volatile("s_waitcnt vmcnt(" #n ")" ::: "memory")
#define PG8_WAIT_L(n) asm volatile("s_waitcnt lgkmcnt(" #n ")" ::: "memory")
#define PG8_BAR __builtin_amdgcn_s_barrier()
#define PG8_SCHED __builtin_amdgcn_sched_barrier(0)
    Unit cur, nxt; int ui = 0;
    if (!S.next(0, cur)) return;
    f32x4 acc[2][2][4][2];
#pragma unroll
    for (int a = 0; a < 2; ++a)
#pragma unroll
        for (int b = 0; b < 2; ++b)
#pragma unroll
            for (int m = 0; m < 4; ++m)
#pragma unroll
                for (int n = 0; n < 2; ++n) acc[a][b][m][n] = (f32x4){0.f, 0.f, 0.f, 0.f};
    bf16x8 At[4][2], B0[2][2], B1[2][2];
    const char* cA = (const char*)g.A + (size_t)cur.pm * tstep; const char* cB = (const char*)g.Bt + (size_t)cur.pn * tstep;
    S.a_ready(cur);
    if constexpr (SP2) {
        PG8_STAGE(PG8_SB(0, 0), cB, voffB); PG8_STAGE(PG8_SB(0, 1), cB + hstep, voffB); PG8_STAGE(PG8_SA(0, 0), cA, voffA); PG8_STAGE(PG8_SA(0, 1), cA + hstep, voffA);
        if (wr == 1) PG8_BAR;
        PG8_WAIT_V(2); PG8_BAR;
        PG8_STAGE(PG8_SB(1, 0), cB + kstep, voffB); PG8_STAGE(PG8_SA(1, 0), cA + kstep, voffA); PG8_STAGE(PG8_SB(1, 1), cB + hstep + kstep, voffB);
        PG8_WAIT_V(6); PG8_BAR;
    } else {
        PG8_STAGE(PG8_SB(0, 0), cB, voffB); PG8_STAGE(PG8_SA(0, 0), cA, voffA); PG8_STAGE(PG8_SB(0, 1), cB + hstep, voffB); PG8_STAGE(PG8_SA(0, 1), cA + hstep, voffA);
        if (wr == 1) PG8_BAR;
        PG8_WAIT_V(4); PG8_BAR;
        PG8_STAGE(PG8_SB(1, 0), cB + kstep, voffB); PG8_STAGE(PG8_SA(1, 0), cA + kstep, voffA); PG8_STAGE(PG8_SB(1, 1), cB + hstep + kstep, voffB);
        PG8_WAIT_V(6); PG8_BAR;
    }
    for (;;) {
        const bool has_next = S.next(ui + 1, nxt);
        const char* nA = has_next ? (const char*)g.A + (size_t)nxt.pm * tstep : cA; const char* nB = has_next ? (const char*)g.Bt + (size_t)nxt.pn * tstep : cB;
        for (int t = 0; t < nt; t += 2) {
            const bool last = (t == nt - 2);
            const char* a1 = cA + (size_t)(t + 1) * kstep;
            const char* a2 = last ? nA : cA + (size_t)(t + 2) * kstep; const char* b2 = last ? nB : cB + (size_t)(t + 2) * kstep;
            const char* a3 = a2 + kstep; const char* b3 = b2 + kstep;
            if (last && has_next) S.a_ready(nxt);
            if constexpr (SP2) {
            PG8_LDB(B0, 0, 0); PG8_LDB(B1, 0, 1); PG8_SCHED; PG8_LDA(At, 0, 0); PG8_STAGE(PG8_SA(1, 1), a1 + hstep, voffA);
            PG8_WAIT_V(8); PG8_WAIT_L(0); PG8_BAR; PG8_MMA(0, 0, At, B0); PG8_MMA(0, 1, At, B1); PG8_BAR; PG8_SCHED;
            PG8_LDA(At, 0, 1); PG8_STAGE(PG8_SB(0, 0), b2, voffB); PG8_STAGE(PG8_SB(0, 1), b2 + hstep, voffB); PG8_STAGE(PG8_SA(0, 0), a2, voffA);
            PG8_WAIT_V(8); PG8_WAIT_L(0); PG8_BAR; PG8_MMA(1, 0, At, B0); PG8_MMA(1, 1, At, B1); PG8_BAR; PG8_SCHED;
            PG8_LDB(B0, 1, 0); PG8_LDB(B1, 1, 1); PG8_SCHED; PG8_LDA(At, 1, 0); PG8_STAGE(PG8_SA(0, 1), a2 + hstep, voffA);
            PG8_WAIT_V(8); PG8_WAIT_L(0); PG8_BAR; PG8_MMA(0, 0, At, B0); PG8_MMA(0, 1, At, B1); PG8_BAR; PG8_SCHED;
            PG8_LDA(At, 1, 1); PG8_STAGE(PG8_SB(1, 0), b3, voffB); PG8_STAGE(PG8_SB(1, 1), b3 + hstep, voffB); PG8_STAGE(PG8_SA(1, 0), a3, voffA);
            PG8_WAIT_V(8); PG8_WAIT_L(0); PG8_BAR; PG8_MMA(1, 0, At, B0); PG8_MMA(1, 1, At, B1); PG8_BAR; PG8_SCHED;
            } else {
            PG8_LDB(B0, 0, 0); PG8_SCHED; PG8_LDA(At, 0, 0); PG8_STAGE(PG8_SA(1, 1), a1 + hstep, voffA);
            PG8_WAIT_L(8); PG8_BAR; PG8_WAIT_L(0); PG8_MMA(0, 0, At, B0); PG8_BAR; PG8_SCHED;
            PG8_LDB(B1, 0, 1); PG8_STAGE(PG8_SB(0, 0), b2, voffB);
            PG8_BAR; PG8_WAIT_L(0); PG8_MMA(0, 1, At, B1); PG8_BAR;
            PG8_LDA(At, 0, 1); PG8_STAGE(PG8_SA(0, 0), a2, voffA);
            PG8_BAR; PG8_WAIT_L(0); PG8_MMA(1, 0, At, B0); PG8_BAR; PG8_SCHED;
            PG8_STAGE(PG8_SB(0, 1), b2 + hstep, voffB);
            PG8_WAIT_V(6); PG8_BAR; PG8_MMA(1, 1, At, B1); PG8_BAR;
            PG8_LDB(B0, 1, 0); PG8_SCHED; PG8_LDA(At, 1, 0); PG8_STAGE(PG8_SA(0, 1), a2 + hstep, voffA);
            PG8_WAIT_L(8); PG8_BAR; PG8_WAIT_L(0); PG8_MMA(0, 0, At, B0); PG8_BAR; PG8_SCHED;
            PG8_LDB(B1, 1, 1); PG8_STAGE(PG8_SB(1, 0), b3, voffB);
            PG8_BAR; PG8_WAIT_L(0); PG8_MMA(0, 1, At, B1); PG8_BAR;
            PG8_LDA(At, 1, 1); PG8_STAGE(PG8_SA(1, 0), a3, voffA);
            PG8_BAR; PG8_WAIT_L(0); PG8_MMA(1, 0, At, B0); PG8_BAR; PG8_SCHED;
            PG8_STAGE(PG8_SB(1, 1), b3 + hstep, voffB);
            PG8_WAIT_V(6); PG8_BAR; PG8_MMA(1, 1, At, B1); PG8_BAR;
            }
        }
        if constexpr (ALIGN_EPI) { if (wr == 0) PG8_BAR; }
        if constexpr (!Epi::AFTER_DRAIN) { E(acc, cur, wr, wc, fr, fq); S.done(cur); }
        if (!has_next) break;
#pragma unroll
        for (int a = 0; a < 2; ++a)
#pragma unroll
            for (int b = 0; b < 2; ++b)
#pragma unroll
                for (int m = 0; m < 4; ++m)
#pragma unroll
                    for (int n = 0; n < 2; ++n) acc[a][b][m][n] = (f32x4){0.f, 0.f, 0.f, 0.f};
        cur = nxt; cA = nA; cB = nB; ++ui;
        if constexpr (ALIGN_EPI) { if (wr == 1) PG8_BAR; }
    }
    PG8_WAIT_V(0);
    if constexpr (!ALIGN_EPI) { if (wr == 0) PG8_BAR; }
    PG8_BAR;
    if constexpr (Epi::AFTER_DRAIN) { E.fused(acc, cur, wr, wc, fr, fq, lds, wid, lane); S.done(cur); }
#undef PG8_SA
#undef PG8_SB
#undef PG8_STAGE
#undef PG8_LDA
#undef PG8_LDB
#undef PG8_MMA
#undef PG8_WAIT_V
#undef PG8_WAIT_L
#undef PG8_BAR
#undef PG8_SCHED
}
}

#define LAS __attribute__((address_space(3)))
typedef unsigned short bf16;
typedef unsigned u32x4 __attribute__((ext_vector_type(4)));
typedef unsigned u32x2 __attribute__((ext_vector_type(2)));
typedef float f32x4 __attribute__((ext_vector_type(4)));
typedef float f32x16 __attribute__((ext_vector_type(16)));
typedef short bf16x8 __attribute__((ext_vector_type(8)));
typedef short v4i16_t __attribute__((ext_vector_type(4)));

constexpr int M = 16384, DM = 2048, SEQ = 2048, NBATCH = 8, NCH = 16;
constexpr int N0P = 11264, N0R = 11296;
constexpr float EPS = 1e-5f;
constexpr float LOG2E = 1.4426950408889634f;
constexpr float QSCALE = 0.125f * LOG2E;
constexpr float LAMBDA_INIT = 0.35550906f;
constexpr size_t MiB = 1u << 20;
constexpr size_t WS_ST0 = 0, WS_ST1 = 128 * 1024, WS_ST2 = 192 * 1024, WS_CD = 256 * 1024, WS_LAM = 300 * 1024;
constexpr size_t WS_DT = 1 * MiB, WS_WSP = 3 * MiB, WS_W0IN = 4 * MiB, WS_W0OUT = 49 * MiB, WS_W1IN = 65 * MiB, WS_W1OUT = 97 * MiB;
constexpr size_t WS_YCAT = 105 * MiB, WS_ZA = 233 * MiB, WS_V = 297 * MiB, WS_H0 = 361 * MiB, WS_XT = 425 * MiB, WS_CN = 489 * MiB, WS_END = 505 * MiB;
constexpr size_t WS_Q = WS_YCAT, WS_K = WS_YCAT + 64 * MiB, WS_X1 = WS_ZA, WS_STATES = WS_V, WS_VT = WS_H0, WS_X1B = WS_H0, WS_O = WS_ZA, WS_VV = WS_XT, WS_X2B = WS_YCAT;
constexpr size_t DO_XBC = 0, DO_BN = 96 * MiB, DO_BT = 112 * MiB, DO_PREV = 0, DO_G = 0;
constexpr int LDS_BYTES = 147456;
constexpr int ST_BOFF = 4096;
constexpr int GM_UOFF = 128 * 272, GM_ZOFF = 2 * 128 * 272, GM_WOFF = 3 * 128 * 272;
static_assert(4 * 128 * 272 <= LDS_BYTES - 512, "gMLP LDS map");

__device__ __forceinline__ unsigned pk2(float lo, float hi) {
    typedef float f2 __attribute__((ext_vector_type(2))); typedef __bf16 b2 __attribute__((ext_vector_type(2)));
    f2 v = {lo, hi}; b2 b = __builtin_convertvector(v, b2); return __builtin_bit_cast(unsigned, b);
}
__device__ __forceinline__ float bflo(unsigned u) { return __uint_as_float(u << 16); }
__device__ __forceinline__ float bfhi(unsigned u) { return __uint_as_float(u & 0xffff0000u); }
__device__ __forceinline__ void unpack8(u32x4 r, float* f) { f[0] = bflo(r.x); f[1] = bfhi(r.x); f[2] = bflo(r.y); f[3] = bfhi(r.y); f[4] = bflo(r.z); f[5] = bfhi(r.z); f[6] = bflo(r.w); f[7] = bfhi(r.w); }
__device__ __forceinline__ u32x4 pack8(const float* f) { u32x4 o; o.x = pk2(f[0], f[1]); o.y = pk2(f[2], f[3]); o.z = pk2(f[4], f[5]); o.w = pk2(f[6], f[7]); return o; }
__device__ __forceinline__ float fexp2(float x) { return __builtin_amdgcn_exp2f(x); }
__device__ __forceinline__ float gelu_f(float x) { const float z = 1.5957691216057308f * (x + 0.044715f * x * x * x); return x * __builtin_amdgcn_rcpf(1.0f + __expf(-z)); }
__device__ __forceinline__ float silu_f(float x) { return x * __builtin_amdgcn_rcpf(1.0f + __expf(-x)); }
__device__ __forceinline__ int crow(int r, int h) { return (r & 3) + 8 * (r >> 2) + 4 * h; }
__device__ __forceinline__ f32x16 mfma32(bf16x8 a, bf16x8 b, f32x16 c) { return __builtin_amdgcn_mfma_f32_32x32x16_bf16(a, b, c, 0, 0, 0); }
__device__ __forceinline__ bf16x8 ld_frag16(const bf16* p) { return __builtin_bit_cast(bf16x8, *(const u32x4*)p); }
__device__ __forceinline__ bf16x8 ld_frag8x2(const bf16* p) { const u32x2 lo = *(const u32x2*)p, hi = *(const u32x2*)(p + 8); u32x4 v; v.x = lo.x; v.y = lo.y; v.z = hi.x; v.w = hi.y; return __builtin_bit_cast(bf16x8, v); }
__device__ __forceinline__ bf16x8 pack_frag(const f32x16& x, int s) {
    u32x4 v; v.x = pk2(x[8 * s], x[8 * s + 1]); v.y = pk2(x[8 * s + 2], x[8 * s + 3]); v.z = pk2(x[8 * s + 4], x[8 * s + 5]); v.w = pk2(x[8 * s + 6], x[8 * s + 7]); return __builtin_bit_cast(bf16x8, v);
}
__device__ __forceinline__ float wave_sum(float v) {
#pragma unroll
    for (int o = 1; o < 64; o <<= 1) v += __shfl_xor(v, o);
    return v;
}
#define LDS_WAIT() asm volatile("s_waitcnt lgkmcnt(0)" ::: "memory")
__device__ __forceinline__ void atomic_addf(float* p, float v) { __hip_atomic_fetch_add(p, v, __ATOMIC_RELAXED, __HIP_MEMORY_SCOPE_AGENT); }

struct Params { const float* in[23]; float* out; unsigned char* ws; };
constexpr int PTAB_OFF = LDS_BYTES - 512;
__device__ __forceinline__ unsigned long long ptab_get(int i) {
    const unsigned long long v = ((const LAS unsigned long long*)(PTAB_OFF))[i];
    const unsigned lo = __builtin_amdgcn_readfirstlane((unsigned)v), hi = __builtin_amdgcn_readfirstlane((unsigned)(v >> 32));
    return ((unsigned long long)hi << 32) | lo;
}
struct PT {
    struct InTab { __device__ __forceinline__ const float* operator[](int i) const { return (const float*)(const __attribute__((address_space(1))) float*)ptab_get(i); } } in;
    float* out; unsigned char* ws;
    __device__ __forceinline__ PT() { out = (float*)(__attribute__((address_space(1))) float*)ptab_get(23); ws = (unsigned char*)(__attribute__((address_space(1))) unsigned char*)ptab_get(24); }
};

template <int ACT>
__device__ __forceinline__ void epi_tile_bf16(const f32x4 (&acc)[2][2][4][2], bf16* base, int pitch, int col0, int row0, float sc) {
#pragma unroll
    for (int ai = 0; ai < 2; ++ai)
#pragma unroll
        for (int m = 0; m < 4; ++m) {
            bf16* rowp = base + (size_t)(row0 + ai * 128 + m * 16) * pitch + col0;
#pragma unroll
            for (int bj = 0; bj < 2; ++bj) {
                float v[8];
#pragma unroll
                for (int j = 0; j < 4; ++j) { v[j] = acc[ai][bj][m][0][j]; v[4 + j] = acc[ai][bj][m][1][j]; }
#pragma unroll
                for (int j = 0; j < 8; ++j) { if (ACT == 1) v[j] = gelu_f(v[j]); else if (ACT == 2) v[j] = silu_f(v[j]); else if (ACT == 3) v[j] *= sc; }
                *(u32x4*)(rowp + bj * 128) = pack8(v);
            }
        }
}

struct EpiIn0 {
    static constexpr bool PERM = true, AFTER_DRAIN = false;
    bf16 *ycat, *vbuf, *za, *xbc; float* stats0;
    __device__ __forceinline__ void operator()(const f32x4 (&acc)[2][2][4][2], const pg8::Unit& u, int wr, int wc, int fr, int fq) const {
        const int pn = u.pn, row0 = u.pm * 256 + wr * 64 + fr, cl = wc * 32 + 8 * fq;
        if (pn < 8) { epi_tile_bf16<1>(acc, ycat, 4096, pn * 256 + cl, row0, 1.f); }
        else if (pn < 16) {
#pragma unroll
            for (int ai = 0; ai < 2; ++ai)
#pragma unroll
                for (int m = 0; m < 4; ++m) {
                    const int row = row0 + ai * 128 + m * 16;
                    bf16* rowp = vbuf + (size_t)row * 2048 + (pn - 8) * 256 + cl;
                    float s = 0.f, ss = 0.f;
#pragma unroll
                    for (int bj = 0; bj < 2; ++bj) {
                        float v[8];
#pragma unroll
                        for (int j = 0; j < 4; ++j) { v[j] = gelu_f(acc[ai][bj][m][0][j]); v[4 + j] = gelu_f(acc[ai][bj][m][1][j]); }
#pragma unroll
                        for (int j = 0; j < 8; ++j) { s += v[j]; ss += v[j] * v[j]; }
                        *(u32x4*)(rowp + bj * 128) = pack8(v);
                    }
                    s += __shfl_xor(s, 16); s += __shfl_xor(s, 32); ss += __shfl_xor(ss, 16); ss += __shfl_xor(ss, 32);
                    if (fq == 0) { atomic_addf(stats0 + 2 * row, s); atomic_addf(stats0 + 2 * row + 1, ss); }
                }
        }
        else if (pn < 24) { epi_tile_bf16<2>(acc, za, 2048, (pn - 16) * 256 + cl, row0, 1.f); }
        else if (pn < 32) { epi_tile_bf16<2>(acc, ycat, 4096, 2048 + (pn - 24) * 256 + cl, row0, 1.f); }
        else { epi_tile_bf16<0>(acc, xbc, 3072, (pn - 32) * 256 + cl, row0, 1.f); }
    }
};

__device__ __forceinline__ void dt_tasks(const PT& p, int lane, int wave) {
    if (wave >= 2) return;
    unsigned char* ws = p.ws; const bf16* H0 = (const bf16*)(ws + WS_H0); const bf16* Wdt = (const bf16*)(ws + WS_W0IN) + (size_t)11264 * 2048; float* DT = (float*)(ws + WS_DT);
    const int r32 = lane & 31, h = lane >> 5;
    for (int task = wave * gridDim.x + blockIdx.x; task < 512; task += 2 * gridDim.x) {
        const bf16* ap = Wdt + (size_t)r32 * 2048 + 8 * h; const bf16* bp = H0 + (size_t)(task * 32 + r32) * 2048 + 8 * h;
        f32x16 acc;
#pragma unroll
        for (int i = 0; i < 16; ++i) acc[i] = 0.f;
#pragma unroll 8
        for (int st = 0; st < 128; ++st) acc = mfma32(ld_frag16(ap + 16 * st), ld_frag16(bp + 16 * st), acc);
#pragma unroll
        for (int qd = 0; qd < 4; ++qd) {
            const int j0 = 8 * qd + 4 * h; const f32x4 bb = *(const f32x4*)(p.in[9] + j0); f32x4 v;
#pragma unroll
            for (int j = 0; j < 4; ++j) { const float x = acc[4 * qd + j] + bb[j]; v[j] = x > 20.f ? x : log1pf(__expf(x)); }
            *(f32x4*)(DT + (size_t)(task * 32 + r32) * 32 + j0) = v;
        }
    }
}
template <bool RB16> struct EpiResT {
    static constexpr bool PERM = true, AFTER_DRAIN = false;
    const void* resid; float* outf; bf16* outb; float* stats;
    __device__ __forceinline__ void operator()(const f32x4 (&acc)[2][2][4][2], const pg8::Unit& u, int wr, int wc, int fr, int fq) const {
        const int row0 = u.pm * 256 + wr * 64 + fr, col0 = u.pn * 256 + wc * 32 + 8 * fq;
#pragma unroll
        for (int ai = 0; ai < 2; ++ai)
#pragma unroll
            for (int m = 0; m < 4; ++m) {
                const int row = row0 + ai * 128 + m * 16; const size_t off = (size_t)row * 2048 + col0;
                float ss = 0.f;
#pragma unroll
                for (int bj = 0; bj < 2; ++bj) {
                    f32x4 r0, r1;
                    if (RB16) { float f[8]; unpack8(*(const u32x4*)((const bf16*)resid + off + bj * 128), f); r0 = (f32x4){f[0], f[1], f[2], f[3]}; r1 = (f32x4){f[4], f[5], f[6], f[7]}; }
                    else { r0 = *(const f32x4*)((const float*)resid + off + bj * 128); r1 = *(const f32x4*)((const float*)resid + off + bj * 128 + 4); }
                    r0 = r0 + acc[ai][bj][m][0]; r1 = r1 + acc[ai][bj][m][1];
                    if (outf) { *(f32x4*)(outf + off + bj * 128) = r0; *(f32x4*)(outf + off + bj * 128 + 4) = r1; }
                    ss += (r0[0] * r0[0] + r0[1] * r0[1]) + (r0[2] * r0[2] + r0[3] * r0[3]) + (r1[0] * r1[0] + r1[1] * r1[1]) + (r1[2] * r1[2] + r1[3] * r1[3]);
                    if (outb) { u32x4 w; w.x = pk2(r0[0], r0[1]); w.y = pk2(r0[2], r0[3]); w.z = pk2(r1[0], r1[1]); w.w = pk2(r1[2], r1[3]); *(u32x4*)(outb + off + bj * 128) = w; }
                }
                ss += __shfl_xor(ss, 16); ss += __shfl_xor(ss, 32);
                if (fq == 0) atomic_addf(stats + row, ss);
            }
    }
};

struct EpiIn1 {
    static constexpr bool PERM = true, AFTER_DRAIN = false;
    bf16 *q, *k, *v, *g; const float* stats1;
    __device__ __forceinline__ void operator()(const f32x4 (&acc)[2][2][4][2], const pg8::Unit& u, int wr, int wc, int fr, int fq) const {
        const int seg = u.pn >> 3, row0 = u.pm * 256 + wr * 64 + fr, col0 = (u.pn & 7) * 256 + wc * 32 + 8 * fq;
        bf16* base = seg == 0 ? q : (seg == 1 ? k : (seg == 2 ? v : g));
        const float sc = seg == 0 ? QSCALE : 1.f;
#pragma unroll
        for (int ai = 0; ai < 2; ++ai)
#pragma unroll
            for (int m = 0; m < 4; ++m) {
                const int row = row0 + ai * 128 + m * 16;
                const float rs = rsqrtf(stats1[row] * (1.f / 2048.f) + EPS) * sc;
                bf16* rowp = base + (size_t)row * 2048 + col0;
#pragma unroll
                for (int bj = 0; bj < 2; ++bj) {
                    float v8[8];
#pragma unroll
                    for (int j = 0; j < 4; ++j) { v8[j] = acc[ai][bj][m][0][j] * rs; v8[4 + j] = acc[ai][bj][m][1][j] * rs; }
                    if (seg == 3) {
#pragma unroll
                        for (int j = 0; j < 8; ++j) v8[j] = silu_f(v8[j]);
                    }
                    *(u32x4*)(rowp + bj * 128) = pack8(v8);
                }
            }
    }
};

__device__ __forceinline__ void transpose_item(const float* W, int K, int N, bf16* WT, int item, int lane, const float* kscale) {
    const int nblk = N / 32, kb = item / nblk, nb = item % nblk, kq = lane & 7, c4 = lane >> 3;
    const int k0 = 64 * kb + 8 * kq, n0 = 32 * nb + 4 * c4;
    f32x4 v[8];
#pragma unroll
    for (int i = 0; i < 8; ++i) v[i] = *(const f32x4*)(W + (size_t)(k0 + i) * N + n0);
    if (kscale) {
        const f32x4 g0 = *(const f32x4*)(kscale + k0), g1 = *(const f32x4*)(kscale + k0 + 4);
#pragma unroll
        for (int i = 0; i < 4; ++i) { v[i] = v[i] * g0[i]; v[4 + i] = v[4 + i] * g1[i]; }
    }
#pragma unroll
    for (int j = 0; j < 4; ++j) {
        u32x4 o; o.x = pk2(v[0][j], v[1][j]); o.y = pk2(v[2][j], v[3][j]); o.z = pk2(v[4][j], v[5][j]); o.w = pk2(v[6][j], v[7][j]);
        *(u32x4*)(WT + (size_t)(n0 + j) * K + k0) = o;
    }
}

__device__ __forceinline__ void phase0(const PT& p, LAS unsigned char* lds, int tid, int lane, int wave) {
    unsigned char* ws = p.ws;
    const int gw = blockIdx.x * 8 + wave, NGW = gridDim.x * 8;
    const int gt = blockIdx.x * 512 + tid, NGT = gridDim.x * 512;
    for (int i = gt; i < 65536; i += NGT) ((float*)(ws + WS_ST0))[i] = 0.f;
    constexpr int I0 = 32 * (N0R / 32), I1 = 64 * 64, I2 = 32 * 256, I3 = 32 * 64;
    for (int it = gw; it < I0 + I1 + I2 + I3; it += NGW) {
        int r = it;
        if (r < I0) { transpose_item(p.in[2], 2048, N0R, (bf16*)(ws + WS_W0IN), r, lane, nullptr); continue; } r -= I0;
        if (r < I1) { transpose_item(p.in[13], 4096, 2048, (bf16*)(ws + WS_W0OUT), r, lane, nullptr); continue; } r -= I1;
        if (r < I2) { transpose_item(p.in[15], 2048, 8192, (bf16*)(ws + WS_W1IN), r, lane, p.in[14]); continue; } r -= I2;
        transpose_item(p.in[21], 2048, 2048, (bf16*)(ws + WS_W1OUT), r, lane, nullptr);
    }
    for (int i = gt; i < 16 * 128 * 128 / 8; i += NGT) {
        const int e = i * 8, t = (e >> 7) & 127, s0 = e & 127; const float* src = p.in[5] + e; float v[8];
#pragma unroll
        for (int j = 0; j < 8; ++j) v[j] = (s0 + j <= t) ? src[j] : 0.f;
        ((u32x4*)(ws + WS_WSP))[i] = pack8(v);
    }
    const float* g0 = p.in[1]; bf16* H0 = (bf16*)(ws + WS_H0);
    for (int m = gw; m < M; m += NGW) {
        const f32x4* xr = (const f32x4*)(p.in[0] + (size_t)m * 2048) + lane; f32x4 v[8]; float s = 0.f;
#pragma unroll
        for (int j = 0; j < 8; ++j) { v[j] = xr[64 * j]; s += (v[j].x * v[j].x + v[j].y * v[j].y) + (v[j].z * v[j].z + v[j].w * v[j].w); }
        const float rs = rsqrtf(wave_sum(s) * (1.f / 2048.f) + EPS);
        u32x2* o = (u32x2*)(H0 + (size_t)m * 2048) + lane;
#pragma unroll
        for (int j = 0; j < 8; ++j) { const f32x4 g = ((const f32x4*)g0)[lane + 64 * j]; u32x2 w; w.x = pk2(v[j].x * rs * g.x, v[j].y * rs * g.y); w.y = pk2(v[j].z * rs * g.z, v[j].w * rs * g.w); o[64 * j] = w; }
    }
}

__device__ __forceinline__ void phase_layout(const PT& p, int tid) {
    unsigned char* ws = p.ws; unsigned char* dob = (unsigned char*)p.out;
    const bf16* Vb = (const bf16*)(ws + WS_V); const float* st0 = (const float*)(ws + WS_ST0);
    const bf16* XBC = (const bf16*)(dob + DO_XBC);
    bf16 *vT = (bf16*)(ws + WS_VT), *xT = (bf16*)(ws + WS_XT), *Bn = (bf16*)(dob + DO_BN), *BT = (bf16*)(dob + DO_BT), *Cn = (bf16*)(ws + WS_CN);
    const int t = tid & 255, so = t >> 4, co = t & 15;
    for (int pi = blockIdx.x * 2 + (tid >> 8); pi < 128 * 24; pi += gridDim.x * 2) {
        const int bc = pi / 24, k = 16 + pi % 24; const int tok0 = bc * 128 + so * 8;
        float o[8][8];
        if (k < 16) {
            const int ch0 = k * 128 + co * 8;
            float g[8], bb[8];
#pragma unroll
            for (int j = 0; j < 8; ++j) { g[j] = p.in[3][ch0 + j]; bb[j] = p.in[4][ch0 + j]; }
#pragma unroll
            for (int i = 0; i < 8; ++i) {
                const int row = tok0 + i; float f[8]; unpack8(*(const u32x4*)(Vb + (size_t)row * 2048 + ch0), f);
                const float mu = st0[2 * row] * (1.f / 2048.f), var = st0[2 * row + 1] * (1.f / 2048.f) - mu * mu, rs = rsqrtf(fmaxf(var, 0.f) + EPS);
#pragma unroll
                for (int j = 0; j < 8; ++j) o[i][j] = (f[j] - mu) * rs * g[j] + bb[j];
            }
#pragma unroll
            for (int j = 0; j < 8; ++j) { float c8[8];
#pragma unroll
                for (int i = 0; i < 8; ++i) c8[i] = o[i][j];
                *(u32x4*)(vT + ((size_t)bc * 2048 + ch0 + j) * 128 + so * 8) = pack8(c8); }
        } else {
            const int sc0 = (k - 16) * 128 + co * 8;
            float cw[4][8], cb[8];
#pragma unroll
            for (int j = 0; j < 8; ++j) { cb[j] = p.in[8][sc0 + j];
#pragma unroll
                for (int kk = 0; kk < 4; ++kk) cw[kk][j] = p.in[7][kk * 3072 + sc0 + j]; }
            const int pos0 = (bc & 15) * 128 + so * 8;
            float xw[11][8];
#pragma unroll
            for (int ii = 0; ii < 11; ++ii) {
                if (pos0 - 3 + ii >= 0) unpack8(*(const u32x4*)(XBC + (size_t)(tok0 - 3 + ii) * 3072 + sc0), xw[ii]);
                else {
#pragma unroll
                    for (int j = 0; j < 8; ++j) xw[ii][j] = 0.f;
                }
            }
#pragma unroll
            for (int i = 0; i < 8; ++i)
#pragma unroll
                for (int j = 0; j < 8; ++j) { float a = cb[j];
#pragma unroll
                    for (int kk = 0; kk < 4; ++kk) a += cw[kk][j] * xw[i + kk][j];
                    o[i][j] = silu_f(a); }
            if (k < 32) {
#pragma unroll
                for (int j = 0; j < 8; ++j) { float c8[8];
#pragma unroll
                    for (int i = 0; i < 8; ++i) c8[i] = o[i][j];
                    *(u32x4*)(xT + ((size_t)bc * 2048 + sc0 + j) * 128 + so * 8) = pack8(c8); }
            } else if (k < 36) {
                const int n0 = sc0 - 2048;
#pragma unroll
                for (int i = 0; i < 8; ++i) *(u32x4*)(Bn + (size_t)(tok0 + i) * 512 + n0) = pack8(o[i]);
#pragma unroll
                for (int j = 0; j < 8; ++j) { float c8[8];
#pragma unroll
                    for (int i = 0; i < 8; ++i) c8[i] = o[i][j];
                    *(u32x4*)(BT + ((size_t)bc * 512 + n0 + j) * 128 + so * 8) = pack8(c8); }
            } else {
                const int n0 = sc0 - 2560;
#pragma unroll
                for (int i = 0; i < 8; ++i) *(u32x4*)(Cn + (size_t)(tok0 + i) * 512 + n0) = pack8(o[i]);
            }
        }
    }
}

__device__ __forceinline__ void chunk_cumsum(const float* DT, const float* a_log, int tok0, int hh, int lane, float& d0, float& d1, float& c0, float& c1, float& tot) {
    d0 = DT[(size_t)(tok0 + 2 * lane) * 32 + hh]; d1 = DT[(size_t)(tok0 + 2 * lane + 1) * 32 + hh];
    const float A = -__expf(a_log[hh]); const float x0 = d0 * A, x1 = d1 * A; float ps = x0 + x1;
#pragma unroll
    for (int o = 1; o < 64; o <<= 1) { const float t = __shfl_up(ps, o); if (lane >= o) ps += t; }
    c1 = ps; c0 = ps - x1; tot = __shfl(ps, 63);
}

__device__ __forceinline__ void phase_mix(const PT& p, LAS unsigned char* lds, int tid, int lane, int wave) {
    unsigned char* ws = p.ws; unsigned char* dob = (unsigned char*)p.out;
    const int r32 = lane & 31, h = lane >> 5;
    bf16* Ycat = (bf16*)(ws + WS_YCAT); const bf16* ZA = (const bf16*)(ws + WS_ZA); const bf16* Vb = (const bf16*)(ws + WS_V); const float* st0 = (const float*)(ws + WS_ST0); const bf16* Wsp = (const bf16*)(ws + WS_WSP);
    const bf16* xT = (const bf16*)(ws + WS_XT); const bf16* BT = (const bf16*)(dob + DO_BT); const float* DT = (const float*)(ws + WS_DT);
    bf16* ST = (bf16*)(ws + WS_STATES); float* CD = (float*)(ws + WS_CD);
    LAS float* wtab = (LAS float*)lds;
    constexpr int NG = 128 * 16, NS = NBATCH * 15 * 4;
    for (int it = blockIdx.x; it < NG + NS; it += gridDim.x) {
        if (it < NG) {
            const int bc = it >> 4, g = it & 15, cb = wave & 3, th = wave >> 2;
            const int ch0 = g * 128 + cb * 32;
            __syncthreads();
            {
                const int c16 = tid & 15; float lg[8], lb[8];
#pragma unroll
                for (int j = 0; j < 8; ++j) { lg[j] = p.in[3][g * 128 + 8 * c16 + j]; lb[j] = p.in[4][g * 128 + 8 * c16 + j]; }
#pragma unroll
                for (int i = 0; i < 4; ++i) {
                    const int row = (tid >> 4) + 32 * i; const size_t tokr = (size_t)bc * 128 + row;
                    float f[8]; unpack8(*(const u32x4*)(Vb + tokr * 2048 + g * 128 + 8 * c16), f);
                    const float mu = st0[2 * tokr] * (1.f / 2048.f), var = st0[2 * tokr + 1] * (1.f / 2048.f) - mu * mu, rs = rsqrtf(fmaxf(var, 0.f) + EPS);
#pragma unroll
                    for (int j = 0; j < 8; ++j) f[j] = (f[j] - mu) * rs * lg[j] + lb[j];
                    *(LAS u32x4*)(lds + row * 272 + 16 * c16) = pack8(f);
                    *(LAS u32x4*)(lds + GM_UOFF + row * 272 + 16 * c16) = *(const u32x4*)(Ycat + tokr * 4096 + g * 128 + 8 * c16);
                    *(LAS u32x4*)(lds + GM_ZOFF + row * 272 + 16 * c16) = *(const u32x4*)(ZA + tokr * 2048 + g * 128 + 8 * c16);
                    *(LAS u32x4*)(lds + GM_WOFF + row * 272 + 16 * c16) = *(const u32x4*)(Wsp + ((size_t)g * 128 + row) * 128 + 8 * c16);
                }
            }
            __syncthreads();
            const LAS unsigned char* ap = lds + (8 * h + ((lane & 15) >> 2)) * 272 + (cb * 32 + 16 * ((lane >> 4) & 1)) * 2 + (lane & 3) * 8;
            f32x16 acc[2];
#pragma unroll
            for (int i = 0; i < 16; ++i) { acc[0][i] = 0.f; acc[1][i] = 0.f; }
#pragma unroll
            for (int st = 0; st < 8; ++st) {
                const v4i16_t lo = __builtin_amdgcn_ds_read_tr16_b64_v4i16((LAS v4i16_t*)(ap + 16 * st * 272)), hi = __builtin_amdgcn_ds_read_tr16_b64_v4i16((LAS v4i16_t*)(ap + (16 * st + 4) * 272));
                const bf16x8 a = {lo[0], lo[1], lo[2], lo[3], hi[0], hi[1], hi[2], hi[3]};
#pragma unroll
                for (int t2 = 0; t2 < 2; ++t2) { const int tb = 2 * th + t2;
                    if (st < 2 * (tb + 1)) { const bf16x8 b = __builtin_bit_cast(bf16x8, *(const LAS u32x4*)(lds + GM_WOFF + (tb * 32 + r32) * 272 + (16 * st + 8 * h) * 2)); acc[t2] = mfma32(a, b, acc[t2]); } }
                __builtin_amdgcn_sched_barrier(0);
            }
#pragma unroll
            for (int t2 = 0; t2 < 2; ++t2) {
                const int t = (2 * th + t2) * 32 + r32; const float sb = p.in[6][g * 128 + t];
#pragma unroll
                for (int qd = 0; qd < 4; ++qd) {
                    const int cl = cb * 32 + 8 * qd + 4 * h;
                    LAS u32x2* up = (LAS u32x2*)(lds + GM_UOFF + t * 272 + cl * 2); const u32x2 uu = *up, zz = *(const LAS u32x2*)(lds + GM_ZOFF + t * 272 + cl * 2);
                    const float y0 = bflo(uu.x) * (acc[t2][4 * qd] + sb) * bflo(zz.x), y1 = bfhi(uu.x) * (acc[t2][4 * qd + 1] + sb) * bfhi(zz.x);
                    const float y2 = bflo(uu.y) * (acc[t2][4 * qd + 2] + sb) * bflo(zz.y), y3 = bfhi(uu.y) * (acc[t2][4 * qd + 3] + sb) * bfhi(zz.y);
                    u32x2 w; w.x = pk2(y0, y1); w.y = pk2(y2, y3); *up = w;
                }
            }
            __syncthreads();
            { const int c16 = tid & 15;
#pragma unroll
              for (int i = 0; i < 4; ++i) { const int row = (tid >> 4) + 32 * i; *(u32x4*)(Ycat + ((size_t)bc * 128 + row) * 4096 + g * 128 + 8 * c16) = *(const LAS u32x4*)(lds + GM_UOFF + row * 272 + 16 * c16); } }
        } else {
            const int id = it - NG, b = id / 60, c = (id / 4) % 15, grp = id & 3; const int bc = b * 16 + c, tok0 = bc * 128;
            __syncthreads();
            { const int hh = grp * 8 + wave; float d0, d1, c0, c1, tot; chunk_cumsum(DT, p.in[10], tok0, hh, lane, d0, d1, c0, c1, tot);
              wtab[wave * 128 + 2 * lane] = d0 * __expf(tot - c0); wtab[wave * 128 + 2 * lane + 1] = d1 * __expf(tot - c1);
              if (lane == 0) CD[bc * 32 + hh] = __expf(tot); }
#pragma unroll
            for (int i = 0; i < 4; ++i) { const int pid = tid + 512 * i, row = pid >> 4, c16 = pid & 15;
                *(LAS u32x4*)(lds + ST_BOFF + row * 272 + 16 * c16) = *(const u32x4*)(BT + ((size_t)bc * 512 + grp * 128 + row) * 128 + 8 * c16); }
            __syncthreads();
#pragma unroll 1
            for (int tk = 0; tk < 2; ++tk) {
                const int r = (wave >> 1) + 4 * tk, pb = wave & 1, hh = grp * 8 + r;
                const bf16* ap = xT + ((size_t)bc * 2048 + hh * 64 + pb * 32 + r32) * 128 + 8 * h;
                const LAS unsigned char* bp = lds + ST_BOFF + r32 * 272 + 16 * h;
                f32x16 acc[4];
#pragma unroll
                for (int nb = 0; nb < 4; ++nb)
#pragma unroll
                    for (int i = 0; i < 16; ++i) acc[nb][i] = 0.f;
#pragma unroll
                for (int st = 0; st < 8; ++st) {
                    float f[8]; unpack8(*(const u32x4*)(ap + 16 * st), f);
                    const f32x4 w0 = *(const LAS f32x4*)(wtab + r * 128 + 16 * st + 8 * h), w1 = *(const LAS f32x4*)(wtab + r * 128 + 16 * st + 8 * h + 4);
                    f[0] *= w0.x; f[1] *= w0.y; f[2] *= w0.z; f[3] *= w0.w; f[4] *= w1.x; f[5] *= w1.y; f[6] *= w1.z; f[7] *= w1.w;
                    const bf16x8 a = __builtin_bit_cast(bf16x8, pack8(f));
#pragma unroll
                    for (int nb = 0; nb < 4; ++nb) { const bf16x8 bfr = __builtin_bit_cast(bf16x8, *(const LAS u32x4*)(bp + nb * 32 * 272 + 32 * st)); acc[nb] = mfma32(a, bfr, acc[nb]); }
                    __builtin_amdgcn_sched_barrier(0);
                }
                bf16* sp = ST + ((size_t)(bc * 32 + hh) * 64 + pb * 32) * 128;
#pragma unroll
                for (int nb = 0; nb < 4; ++nb)
#pragma unroll
                    for (int i = 0; i < 16; ++i) sp[(size_t)crow(i, h) * 128 + nb * 32 + r32] = (bf16)(pk2(acc[nb][i], 0.f) & 0xffffu);
            }
        }
    }
}

__device__ __forceinline__ void phase_scan(const PT& p, int tid) {
    unsigned char* ws = p.ws; const bf16* ST = (const bf16*)(ws + WS_STATES); const float* CD = (const float*)(ws + WS_CD); bf16* PV = (bf16*)((unsigned char*)p.out + DO_PREV);
    for (int id = blockIdx.x * 512 + tid; id < NBATCH * 32 * 64 * 16; id += gridDim.x * 512) {
        const int b = id >> 15, rem = id & 32767, hh = rem >> 10;
        float run[8];
#pragma unroll
        for (int j = 0; j < 8; ++j) run[j] = 0.f;
#pragma unroll
        for (int c = 0; c < 16; ++c) {
            const size_t off = ((size_t)(b * 16 + c) * 32 * 64 * 16 + rem) * 8;
            *(u32x4*)(PV + off) = pack8(run);
            if (c < 15) { float s[8]; unpack8(*(const u32x4*)(ST + off), s); const float cd = CD[(b * 16 + c) * 32 + hh];
#pragma unroll
                for (int j = 0; j < 8; ++j) run[j] = run[j] * cd + s[j]; }
        }
    }
}

constexpr int SY_TILE = 9728, SY_TP = 1040;
static_assert(SY_TILE + 128 * SY_TP <= PTAB_OFF, "ssd_y LDS map");
__device__ __forceinline__ void phase_ssd_y(const PT& p, LAS unsigned char* lds, int tid, int lane, int wave) {
    unsigned char* ws = p.ws; unsigned char* dob = (unsigned char*)p.out;
    const int r32 = lane & 31, h = lane >> 5;
    bf16* Ycat = (bf16*)(ws + WS_YCAT); const bf16* xT = (const bf16*)(ws + WS_XT); const bf16* Bn = (const bf16*)(dob + DO_BN); const bf16* Cn = (const bf16*)(ws + WS_CN);
    const bf16* PV = (const bf16*)(dob + DO_PREV); const float* DT = (const float*)(ws + WS_DT);
    LAS float* acum = (LAS float*)lds; LAS float* dtt = acum + 1024; LAS float* ssqp = dtt + 1024; LAS float* rsT = ssqp + 256;
    LAS unsigned char* tile = lds + SY_TILE;
    for (int it = blockIdx.x; it < 128 * 4; it += gridDim.x) {
        const int bc = it >> 2, grp = it & 3, tok0 = bc * 128;
        __syncthreads();
        { const int hh = grp * 8 + wave; float d0, d1, c0, c1, tot; chunk_cumsum(DT, p.in[10], tok0, hh, lane, d0, d1, c0, c1, tot);
          acum[wave * 128 + 2 * lane] = c0; acum[wave * 128 + 2 * lane + 1] = c1; dtt[wave * 128 + 2 * lane] = d0; dtt[wave * 128 + 2 * lane + 1] = d1; }
#pragma unroll 4
        for (int i = 0; i < 16; ++i) { const int pid = tid + 512 * i, row = pid >> 6, c8 = pid & 63;
            *(LAS u32x4*)(tile + row * SY_TP + 16 * c8) = *(const u32x4*)(Ycat + ((size_t)tok0 + row) * 4096 + 2048 + grp * 512 + 8 * c8); }
        __syncthreads();
        const int pb = wave >> 2, lb = wave & 3, l = lb * 32 + r32; const size_t tok = (size_t)tok0 + l;
        bf16x8 cf[8];
#pragma unroll
        for (int st = 0; st < 8; ++st) cf[st] = ld_frag16(Cn + tok * 512 + grp * 128 + 16 * st + 8 * h);
        f32x16 X[4];
#pragma unroll
        for (int sb = 0; sb < 4; ++sb) {
#pragma unroll
            for (int i = 0; i < 16; ++i) X[sb][i] = 0.f;
            if (sb <= lb) {
#pragma unroll
                for (int st = 0; st < 8; ++st) X[sb] = mfma32(ld_frag16(Bn + ((size_t)tok0 + sb * 32 + r32) * 512 + grp * 128 + 16 * st + 8 * h), cf[st], X[sb]);
            }
        }
        float ssq = 0.f;
#pragma unroll 2
        for (int r = 0; r < 8; ++r) {
            const int hh = grp * 8 + r;
            f32x16 acc;
#pragma unroll
            for (int i = 0; i < 16; ++i) acc[i] = 0.f;
            const bf16* pp = PV + ((size_t)(bc * 32 + hh) * 64 + pb * 32 + r32) * 128 + 8 * h;
#pragma unroll
            for (int st = 0; st < 8; ++st) acc = mfma32(ld_frag16(pp + 16 * st), cf[st], acc);
            const float al = acum[r * 128 + l]; const float el = __expf(al); const float dsk = p.in[11][hh];
#pragma unroll
            for (int i = 0; i < 16; ++i) acc[i] *= el;
            const bf16* xrow = xT + ((size_t)bc * 2048 + hh * 64 + pb * 32 + r32) * 128 + 4 * h;
#pragma unroll
            for (int sb = 0; sb < 4; ++sb) {
                if (sb <= lb) {
                    f32x16 mm;
#pragma unroll
                    for (int qd = 0; qd < 4; ++qd) {
                        const int s0 = sb * 32 + 8 * qd + 4 * h;
                        const f32x4 as = *(const LAS f32x4*)(acum + r * 128 + s0), ds = *(const LAS f32x4*)(dtt + r * 128 + s0);
#pragma unroll
                        for (int j = 0; j < 4; ++j) { const float v = X[sb][4 * qd + j] * __expf(al - as[j]) * ds[j]; mm[4 * qd + j] = (s0 + j < l) ? v : ((s0 + j == l) ? v + dsk : 0.f); }
                    }
#pragma unroll
                    for (int s2 = 0; s2 < 2; ++s2) acc = mfma32(ld_frag8x2(xrow + sb * 32 + 16 * s2), pack_frag(mm, s2), acc);
                }
            }
#pragma unroll
            for (int qd = 0; qd < 4; ++qd) {
                LAS u32x2* yp = (LAS u32x2*)(tile + l * SY_TP + (r * 64 + pb * 32 + 8 * qd + 4 * h) * 2); const u32x2 zz = *yp;
                const float y0 = acc[4 * qd] * bflo(zz.x), y1 = acc[4 * qd + 1] * bfhi(zz.x);
                const float y2 = acc[4 * qd + 2] * bflo(zz.y), y3 = acc[4 * qd + 3] * bfhi(zz.y);
                ssq += (y0 * y0 + y1 * y1) + (y2 * y2 + y3 * y3);
                u32x2 w; w.x = pk2(y0, y1); w.y = pk2(y2, y3); *yp = w;
            }
        }
        ssq += __shfl_xor(ssq, 32);
        if (h == 0) ssqp[pb * 128 + l] = ssq;
        __syncthreads();
        if (pb == 0 && h == 0) rsT[l] = rsqrtf((ssqp[l] + ssqp[128 + l]) * (1.f / 512.f) + EPS);
        __syncthreads();
#pragma unroll 4
        for (int i = 0; i < 16; ++i) { const int pid = tid + 512 * i, row = pid >> 6, c8 = pid & 63; const int ch = grp * 512 + 8 * c8;
            float f[8]; unpack8(*(const LAS u32x4*)(tile + row * SY_TP + 16 * c8), f);
            const float rs = rsT[row]; const f32x4 g0 = *(const f32x4*)(p.in[12] + ch), g1 = *(const f32x4*)(p.in[12] + ch + 4);
            f[0] *= rs * g0.x; f[1] *= rs * g0.y; f[2] *= rs * g0.z; f[3] *= rs * g0.w; f[4] *= rs * g1.x; f[5] *= rs * g1.y; f[6] *= rs * g1.z; f[7] *= rs * g1.w;
            *(u32x4*)(Ycat + ((size_t)tok0 + row) * 4096 + 2048 + ch) = pack8(f); }
    }
}

constexpr int AK_PITCH = 272, AV_PITCH = 272, A_KOFF = 0, A_VOFF = 128 * AK_PITCH, A_STAGE = A_VOFF + 128 * AV_PITCH;
static_assert(2 * A_STAGE <= PTAB_OFF && 4 * 16384 <= A_STAGE, "attention LDS map");
__device__ __forceinline__ float max3f(float a, float b, float c) { return fmaxf(fmaxf(a, b), c); }
__device__ __forceinline__ void attn_unit(const PT& p, LAS unsigned char* lds, int tid, int lane, int wave, int b, int hd, int qb, float lam) {
    unsigned char* ws = p.ws;
    const bf16* Qb = (const bf16*)(ws + WS_Q); const bf16* Kb = (const bf16*)(ws + WS_K); const bf16* Vb = (const bf16*)(ws + WS_VV); const bf16* Gb = (const bf16*)((unsigned char*)p.out + DO_G);
    bf16* Ob = (bf16*)(ws + WS_O);
    const int r32 = lane & 31, h = lane >> 5, mp = wave >> 2, wq = wave & 3;
    const int qw0 = qb * 128 + 32 * wq, q = qw0 + r32; const unsigned tokq = (unsigned)(b * SEQ + q), tokb = (unsigned)(b * SEQ);
    const float slope2 = fexp2(-0.5f * (float)(hd + 1)) * LOG2E;
    bf16x8 qf[4];
#pragma unroll
    for (int ds = 0; ds < 4; ++ds) qf[ds] = ld_frag16(Qb + (tokq * 2048u + (unsigned)(hd * 128 + mp * 64 + 16 * ds + 8 * h)));
    float mrun = -INFINITY, lsum = 0.f;
    f32x16 oT[4];
#pragma unroll
    for (int db = 0; db < 4; ++db)
#pragma unroll
        for (int i = 0; i < 16; ++i) oT[db][i] = 0.f;
    const int ntiles = qb + 1;
    u32x4 preV[4], preK[4];
#define PREFETCH(t) do { \
        _Pragma("unroll") for (int i_ = 0; i_ < 4; ++i_) { const int pid_ = tid + 512 * i_, row_ = pid_ >> 4, c16_ = pid_ & 15; const unsigned go_ = (tokb + (unsigned)((t) * 128 + row_)) * 2048u + (unsigned)(hd * 128 + 8 * c16_); \
            preK[i_] = *(const u32x4*)(Kb + go_); preV[i_] = *(const u32x4*)(Vb + go_); } \
    } while (0)
    PREFETCH(0);
    const LAS unsigned char* kbase0 = lds + A_KOFF + r32 * AK_PITCH + (mp * 64 + 8 * h) * 2;
    const LAS unsigned char* vbase0 = lds + A_VOFF + (4 * h + ((lane & 15) >> 2)) * AV_PITCH + ((lane >> 4) & 1) * 32 + (lane & 3) * 8;
#define STAGE_WRITE(stg) do { \
        _Pragma("unroll") for (int i_ = 0; i_ < 4; ++i_) { const int pid_ = tid + 512 * i_, row_ = pid_ >> 4, c16_ = pid_ & 15; \
            *(LAS u32x4*)(lds + (stg) * A_STAGE + A_KOFF + row_ * AK_PITCH + 16 * c16_) = preK[i_]; *(LAS u32x4*)(lds + (stg) * A_STAGE + A_VOFF + row_ * AV_PITCH + 16 * c16_) = preV[i_]; } \
    } while (0)
    __syncthreads();
    STAGE_WRITE(0);
    asm volatile("" : "+v"(qf[0]), "+v"(qf[1]), "+v"(qf[2]), "+v"(qf[3]));
    __syncthreads();
#pragma unroll 1
    for (int t = 0; t < ntiles; ++t) {
        const int stg = t & 1;
        if (t + 1 < ntiles) PREFETCH(t + 1);
        const LAS unsigned char* kbase = kbase0 + stg * A_STAGE; const LAS unsigned char* vbase = vbase0 + stg * A_STAGE;
        const bool diag = (t == qb);
#pragma unroll 1
        for (int sub = 0; sub < 2; ++sub) {
            const int nact = diag ? min(2, max(0, wq + 1 - 2 * sub)) : 2;
            if (nact > 0) {
                float sl = slope2; asm volatile("" : "+v"(sl));
                const float bq = sl * (float)(t * 128 + sub * 64 + 4 * h - q);
                const LAS unsigned char* kb0 = kbase + sub * 64 * AK_PITCH; const LAS unsigned char* vb0 = vbase + sub * 64 * AV_PITCH;
                f32x16 s[2];
#pragma unroll
                for (int kb = 0; kb < 2; ++kb) {
                    if (kb < nact) {
                        const float bk = bq + sl * (float)(32 * kb);
#pragma unroll
                        for (int i = 0; i < 16; ++i) s[kb][i] = __builtin_fmaf(sl, (float)((i & 3) + 8 * (i >> 2)), bk);
#pragma unroll
                        for (int ds = 0; ds < 4; ++ds) s[kb] = mfma32(__builtin_bit_cast(bf16x8, *(const LAS u32x4*)(kb0 + kb * 32 * AK_PITCH + ds * 32)), qf[ds], s[kb]);
                    } else {
#pragma unroll
                        for (int i = 0; i < 16; ++i) s[kb][i] = -INFINITY;
                    }
                }
                if (diag) {
#pragma unroll
                    for (int kb = 0; kb < 2; ++kb) if (2 * sub + kb == wq) {
#pragma unroll
                        for (int i = 0; i < 16; ++i) if (crow(i, h) > r32) s[kb][i] = -INFINITY; }
                }
                float mx = -INFINITY;
#pragma unroll
                for (int kb = 0; kb < 2; ++kb)
#pragma unroll
                    for (int i = 0; i < 16; i += 2) mx = max3f(mx, s[kb][i], s[kb][i + 1]);
                mx = fmaxf(mx, __shfl_xor(mx, 32));
                const float mnew = fmaxf(mrun, mx), alpha = fexp2(mrun - mnew); mrun = mnew;
                float rs = 0.f;
#pragma unroll
                for (int kb = 0; kb < 2; ++kb)
#pragma unroll
                    for (int i = 0; i < 16; ++i) { s[kb][i] = fexp2(s[kb][i] - mnew); rs += s[kb][i]; }
                lsum = lsum * alpha + rs;
                if (__builtin_amdgcn_ballot_w64(alpha != 1.0f) != 0ull) {
#pragma unroll
                    for (int db = 0; db < 4; ++db)
#pragma unroll
                        for (int i = 0; i < 16; ++i) oT[db][i] *= alpha;
                }
#pragma unroll
                for (int kb = 0; kb < 2; ++kb) if (kb < nact) {
#pragma unroll
                    for (int s2 = 0; s2 < 2; ++s2) {
                        const bf16x8 pf = pack_frag(s[kb], s2);
#pragma unroll
                        for (int db = 0; db < 4; ++db) {
                            const LAS unsigned char* vp = vb0 + (kb * 32 + 16 * s2) * AV_PITCH + db * 64;
                            const v4i16_t lo = __builtin_amdgcn_ds_read_tr16_b64_v4i16((LAS v4i16_t*)vp), hi = __builtin_amdgcn_ds_read_tr16_b64_v4i16((LAS v4i16_t*)(vp + 8 * AV_PITCH));
                            const bf16x8 vf = {lo[0], lo[1], lo[2], lo[3], hi[0], hi[1], hi[2], hi[3]};
                            oT[db] = mfma32(vf, pf, oT[db]);
                        }
                    }
                }
            }
        }
        if (t + 1 < ntiles) STAGE_WRITE(stg ^ 1);
        __syncthreads();
    }
#undef PREFETCH
#undef STAGE_WRITE
    const float lt = lsum + __shfl_xor(lsum, 32);
    LAS float* xch = (LAS float*)(lds + (ntiles & 1) * A_STAGE + wq * 16384);
    if (mp == 1) { const float sc = lam / lt;
#pragma unroll
        for (int db = 0; db < 4; ++db)
#pragma unroll
            for (int i = 0; i < 16; ++i) xch[(db * 16 + i) * 64 + lane] = oT[db][i] * sc; }
    __syncthreads();
    if (mp == 0) {
        const float i1 = 1.f / lt; float ss = 0.f;
#pragma unroll
        for (int db = 0; db < 4; ++db)
#pragma unroll
            for (int i = 0; i < 16; ++i) { const float o = oT[db][i] * i1 - xch[(db * 16 + i) * 64 + lane]; oT[db][i] = o; ss += o * o; }
        ss += __shfl_xor(ss, 32);
        const float rn = rsqrtf(ss * (1.f / 128.f) + EPS) * (1.f - LAMBDA_INIT);
#pragma unroll
        for (int db = 0; db < 4; ++db)
#pragma unroll
            for (int qd = 0; qd < 4; ++qd) {
                const int d = db * 32 + 8 * qd + 4 * h; const unsigned off = tokq * 2048u + (unsigned)(hd * 128 + d);
                const u32x2 gg = *(const u32x2*)(Gb + off); const f32x4 sg = *(const f32x4*)(p.in[20] + d);
                u32x2 w; w.x = pk2(oT[db][4 * qd] * rn * sg.x * bflo(gg.x), oT[db][4 * qd + 1] * rn * sg.y * bfhi(gg.x));
                w.y = pk2(oT[db][4 * qd + 2] * rn * sg.z * bflo(gg.y), oT[db][4 * qd + 3] * rn * sg.w * bfhi(gg.y));
                *(u32x2*)(Ob + off) = w;
            }
    }
}

__device__ __forceinline__ void phase_attn(const PT& p, LAS unsigned char* lds, int tid, int lane, int wave) {
    const float s1 = wave_sum(p.in[16][lane] * p.in[17][lane]), s2 = wave_sum(p.in[18][lane] * p.in[19][lane]);
    const float lam = __expf(s1) - __expf(s2) + LAMBDA_INIT;
#pragma unroll 1
    for (int u = blockIdx.x; u < NBATCH * 16 * 8; u += gridDim.x) {
        const int j = u & 7, hd = (u >> 3) & 15, b = u >> 7;
#pragma unroll 1
        for (int k = 0; k < 2; ++k) attn_unit(p, lds, tid, lane, wave, b, hd, k == 0 ? 15 - j : j, lam);
    }
}

__device__ __forceinline__ void phase_final(const PT& p, int lane, int wave) {
    const float* st2 = (const float*)(p.ws + WS_ST2); const float* g = p.in[22]; const bf16* X2 = (const bf16*)(p.ws + WS_X2B);
    for (int m = blockIdx.x * 8 + wave; m < M; m += gridDim.x * 8) {
        const float rs = rsqrtf(st2[m] * (1.f / 2048.f) + EPS);
        const u32x4* xr = (const u32x4*)(X2 + (size_t)m * 2048) + lane; f32x4* orow = (f32x4*)(p.out + (size_t)m * 2048);
#pragma unroll
        for (int j = 0; j < 4; ++j) {
            float f[8]; unpack8(xr[64 * j], f); const int c = 8 * (lane + 64 * j);
            const f32x4 g0 = *(const f32x4*)(g + c), g1 = *(const f32x4*)(g + c + 4);
            orow[(c >> 2)] = (f32x4){f[0] * rs * g0.x, f[1] * rs * g0.y, f[2] * rs * g0.z, f[3] * rs * g0.w};
            orow[(c >> 2) + 1] = (f32x4){f[4] * rs * g1.x, f[5] * rs * g1.y, f[6] * rs * g1.z, f[7] * rs * g1.w};
        }
    }
}

constexpr size_t WS_BAR = 384 * 1024;
constexpr int XBST_OFF = PTAB_OFF + 256;
typedef __attribute__((address_space(1))) unsigned gu32;
#define XB_TMO      128
#define XB_XCNT(j)  (256  + 64 * (j))
#define XB_XSUB(j)  (1280 + 64 * (j))
#define XB_XGEN(j)  (2304 + 64 * (j))
#define XB_TOP      3328
#define XB_TOPGEN   3392
#define XCD_BAR_WORDS 3456
#define XB_SPIN_CAP (1u << 18)

__device__ __forceinline__ unsigned xb_ld(unsigned* p)              { return __hip_atomic_load(p, __ATOMIC_RELAXED, __HIP_MEMORY_SCOPE_AGENT); }
__device__ __forceinline__ unsigned xb_add(unsigned* p, unsigned v) { return __hip_atomic_fetch_add(p, v, __ATOMIC_RELAXED, __HIP_MEMORY_SCOPE_AGENT); }
__device__ __forceinline__ unsigned xb_xcc_id() { return (unsigned)__builtin_amdgcn_s_getreg((3 << 11) | 20) & 0xFu; }
#define XB_SPIN(cond, bar) do { unsigned _sp = 0; while (cond) { __builtin_amdgcn_s_sleep(1); \
    if ((++_sp & 255u) == 0u) { if (xb_ld(&(bar)[XB_TMO])) break; if (_sp > XB_SPIN_CAP) { atomicAdd(&(bar)[XB_TMO], 1u); break; } } } } while (0)

struct XcdBarrier {
    unsigned* bar; unsigned x;
    volatile LAS unsigned* st;
};

__device__ __forceinline__ XcdBarrier xcd_barrier_post(unsigned* bar, volatile LAS unsigned* st) {
    XcdBarrier b; b.bar = bar; b.x = xb_xcc_id(); b.st = st;
    if (threadIdx.x == 0) (void)xb_add(&bar[XB_XCNT(b.x)], 1u);
    return b;
}
__device__ __forceinline__ void xcd_barrier_complete(unsigned* bar, unsigned x, unsigned& nloc, unsigned& nx) {
    const unsigned G = gridDim.x * gridDim.y * gridDim.z;
    unsigned sum, cnt, mine, sp = 0u;
    for (;;) {
        sum = 0u; cnt = 0u; mine = 0u;
#pragma unroll
        for (unsigned j = 0; j < 16; ++j) { const unsigned c = xb_ld(&bar[XB_XCNT(j)]); sum += c; cnt += (c > 0u) ? 1u : 0u; mine = (j == x) ? c : mine; }
        if (sum == G) break;
        __builtin_amdgcn_s_sleep(1);
        if ((++sp & 255u) == 0u) { if (xb_ld(&bar[XB_TMO])) break; if (sp > XB_SPIN_CAP) { atomicAdd(&bar[XB_TMO], 1u); break; } }
    }
    nloc = mine > 0u ? mine : 1u; nx = cnt > 0u ? cnt : 1u;
}

__device__ __forceinline__ void xcd_barrier(const XcdBarrier& b) {
    asm volatile("s_waitcnt vmcnt(0)" ::: "memory");
    __syncthreads();
    if (threadIdx.x == 0) {
        unsigned* bar = b.bar;
        __builtin_amdgcn_s_waitcnt(0);
        unsigned nloc = b.st[0], nx = b.st[1];
        if (nloc == 0u) { xcd_barrier_complete(bar, b.x, nloc, nx); b.st[0] = nloc; b.st[1] = nx; }
        const unsigned old = xb_add(&bar[XB_XSUB(b.x)], 1u);
        const unsigned gen = old / nloc;
        if (old + 1u == (gen + 1u) * nloc) {
            __builtin_amdgcn_fence(__ATOMIC_RELEASE, "agent");
            asm volatile("s_waitcnt vmcnt(0)" ::: "memory");
            const unsigned og = xb_add(&bar[XB_TOP], 1u);
            const unsigned tg = og / nx;
            if (og + 1u == (tg + 1u) * nx) xb_add(&bar[XB_TOPGEN], 1u);
            else XB_SPIN(xb_ld(&bar[XB_TOPGEN]) == tg, bar);
            __builtin_amdgcn_fence(__ATOMIC_ACQUIRE, "agent");
            xb_add(&bar[XB_XGEN(b.x)], 1u);
            asm volatile("s_waitcnt vmcnt(0)" ::: "memory");
        } else {
            XB_SPIN(xb_ld(&bar[XB_XGEN(b.x)]) == gen, bar);
            __builtin_amdgcn_fence(__ATOMIC_ACQUIRE, "agent");
            asm volatile("s_waitcnt vmcnt(0)" ::: "memory");
        }
    }
    __syncthreads();
}

__global__ void __launch_bounds__(512) fwd_megakernel(Params pa) {
    extern __shared__ __attribute__((aligned(16))) unsigned char lds_raw[];
    cg::grid_group grid = cg::this_grid();
    LAS unsigned char* lds = (LAS unsigned char*)lds_raw;
    if (threadIdx.x < 25) {
        unsigned long long v = 0;
#pragma unroll
        for (int i = 0; i < 23; ++i) if ((int)threadIdx.x == i) v = (unsigned long long)pa.in[i];
        if (threadIdx.x == 23) v = (unsigned long long)pa.out;
        if (threadIdx.x == 24) v = (unsigned long long)pa.ws;
        ((LAS unsigned long long*)(lds + PTAB_OFF))[threadIdx.x] = v;
    }
    if (threadIdx.x < 2) ((LAS unsigned*)(lds + XBST_OFF))[threadIdx.x] = 0u;
    __syncthreads();
    const XcdBarrier bar = xcd_barrier_post((unsigned*)(pa.ws + WS_BAR), (volatile LAS unsigned*)(lds + XBST_OFF));
#ifndef PHMASK
#define PHMASK 0x3ff
#endif
#define PH(n) (((PHMASK) >> (n)) & 1)
#define TLW int tid_ = threadIdx.x; asm volatile("" : "+v"(tid_)); const int tid = tid_, lane = tid & 63, wave = __builtin_amdgcn_readfirstlane(tid >> 6); (void)tid; (void)lane; (void)wave
#define GRIDV const int G = gridDim.x, c = blockIdx.x
    if (PH(0)) { PT p; TLW; phase0(p, lds, tid, lane, wave); }
    if (gridDim.x == 0x7fffffffu) grid.sync();
    xcd_barrier(bar);
    if (PH(1)) {
        PT p; GRIDV; unsigned char* ws = p.ws; unsigned char* dob = (unsigned char*)p.out;
        pg8::Gemm g{(const pg8::bf16_t*)(ws + WS_H0), (const pg8::bf16_t*)(ws + WS_W0IN), M, N0P, 2048}; pg8::StaticOrder S; S.init(M, N0P, G, c);
        EpiIn0 E{(bf16*)(ws + WS_YCAT), (bf16*)(ws + WS_V), (bf16*)(ws + WS_ZA), (bf16*)(dob + DO_XBC), (float*)(ws + WS_ST0)};
        pg8::gemm_phase<EpiIn0, pg8::StaticOrder, true, true>(lds, g, S, E);
        { TLW; dt_tasks(p, lane, wave); }
    }
    xcd_barrier(bar);
    if (PH(2)) { PT p; TLW; phase_layout(p, tid); }
    xcd_barrier(bar);
    if (PH(3)) { PT p; TLW; phase_mix(p, lds, tid, lane, wave); }
    xcd_barrier(bar);
    if (PH(4)) { PT p; TLW; phase_scan(p, tid); }
    xcd_barrier(bar);
    if (PH(5)) { PT p; TLW; phase_ssd_y(p, lds, tid, lane, wave); }
    xcd_barrier(bar);
    if (PH(6)) {
        PT p; GRIDV; unsigned char* ws = p.ws;
        pg8::Gemm g{(const pg8::bf16_t*)(ws + WS_YCAT), (const pg8::bf16_t*)(ws + WS_W0OUT), M, 2048, 4096}; pg8::StaticOrder S; S.init(M, 2048, G, c);
        EpiResT<false> E{p.in[0], nullptr, (bf16*)(ws + WS_X1B), (float*)(ws + WS_ST1)};
        pg8::gemm_phase<EpiResT<false>, pg8::StaticOrder, true, true>(lds, g, S, E);
    }
    xcd_barrier(bar);
    if (PH(6)) {
        PT p; GRIDV; unsigned char* ws = p.ws; unsigned char* dob = (unsigned char*)p.out;
        pg8::Gemm g{(const pg8::bf16_t*)(ws + WS_X1B), (const pg8::bf16_t*)(ws + WS_W1IN), M, 8192, 2048}; pg8::StaticOrder S; S.init(M, 8192, G, c);
        EpiIn1 E{(bf16*)(ws + WS_Q), (bf16*)(ws + WS_K), (bf16*)(ws + WS_VV), (bf16*)(dob + DO_G), (const float*)(ws + WS_ST1)};
        pg8::gemm_phase<EpiIn1, pg8::StaticOrder, true, true>(lds, g, S, E);
    }
    xcd_barrier(bar);
    if (PH(7)) { PT p; TLW; phase_attn(p, lds, tid, lane, wave); }
    xcd_barrier(bar);
    if (PH(8)) {
        PT p; GRIDV; unsigned char* ws = p.ws;
        pg8::Gemm g{(const pg8::bf16_t*)(ws + WS_O), (const pg8::bf16_t*)(ws + WS_W1OUT), M, 2048, 2048}; pg8::StaticOrder S; S.init(M, 2048, G, c);
        EpiResT<true> E{(const void*)(ws + WS_X1B), nullptr, (bf16*)(ws + WS_X2B), (float*)(ws + WS_ST2)};
        pg8::gemm_phase<EpiResT<true>, pg8::StaticOrder, true, true>(lds, g, S, E);
    }
    xcd_barrier(bar);
    if (PH(9)) { PT p; TLW; phase_final(p, lane, wave); }
}

extern "C" void kernel_launch(void* const* d_in, const int* in_sizes, int n_in, void* d_out, int out_size, void* d_ws, size_t ws_size, hipStream_t stream) {
    static int grid = 0;
    if (grid == 0) {
        if (n_in != 23 || out_size != M * DM || ws_size < WS_END) { fprintf(stderr, "kernel_launch: unexpected shapes (n_in %d out %d ws %zu)\n", n_in, out_size, ws_size); grid = -1; return; }
        int dev = 0, cus = 0, per_cu = 0;
        hipGetDevice(&dev); hipDeviceGetAttribute(&cus, hipDeviceAttributeMultiprocessorCount, dev);
        hipFuncSetAttribute((const void*)fwd_megakernel, hipFuncAttributeMaxDynamicSharedMemorySize, LDS_BYTES);
        hipOccupancyMaxActiveBlocksPerMultiprocessor(&per_cu, (const void*)fwd_megakernel, 512, LDS_BYTES);
        if (per_cu < 1) { fprintf(stderr, "kernel_launch: occupancy query says %d blocks per CU\n", per_cu); per_cu = 1; }
        (void)hipGetLastError();
        grid = cus;
    }
    if (grid < 0) return;
    Params p{};
    for (int i = 0; i < 23; ++i) p.in[i] = (const float*)d_in[i];
    p.out = (float*)d_out; p.ws = (unsigned char*)d_ws;
    if (hipMemsetAsync((char*)d_ws + WS_BAR, 0, XCD_BAR_WORDS * 4, stream) != hipSuccess) { fprintf(stderr, "kernel_launch: memset of the barrier words failed\n"); return; }
    void* args[] = {&p};
    hipError_t e = hipLaunchCooperativeKernel((const void*)fwd_megakernel, dim3(grid), dim3(512), args, LDS_BYTES, stream);
    if (e != hipSuccess) fprintf(stderr, "cooperative launch failed: %s (grid %d)\n", hipGetErrorString(e), grid);
}
```

```cpp
#include <hip/hip_runtime.h>
#include <hip/hip_cooperative_groups.h>
#include <cstdio>
#include <cstdint>
#include <cmath>
namespace cg = cooperative_groups;
namespace pg8 {
#define PG8_LAS __attribute__((address_space(3)))
typedef unsigned short bf16_t;
typedef short bf16x8 __attribute__((ext_vector_type(8)));
typedef float f32x4 __attribute__((ext_vector_type(4)));
typedef unsigned u32x4 __attribute__((ext_vector_type(4)));
constexpr int BM = 256, BK = 64, HALF = 128, HTB = HALF * BK * 2  , STAGE_BYTES = 8 * HTB, NXCD = 8, WGM = 8;

__host__ __device__ __forceinline__ int lds_byte(int r, int c) { const int st = (r >> 4) * 2 + (c >> 5), rr = r & 15, cc = c & 31, ob = rr * 64 + cc * 2; return st * 1024 + (ob ^ (((ob >> 9) & 1) << 5)); }
__host__ __device__ __forceinline__ void stage_rc(int b, int& R, int& C) { const int st = b / 1024, sb = b % 1024, swz = sb ^ (((sb >> 9) & 1) << 5); R = (st >> 1) * 16 + swz / 64; C = (st & 1) * 32 + (swz % 64) / 2; }
__host__ __device__ __forceinline__ int perm32(int rho) { const int n = rho >> 4, i = rho & 15; return 8 * (i >> 2) + 4 * n + (i & 3); }

struct Unit { int pm, pn; };
struct Gemm { const bf16_t* A; const bf16_t* Bt; int M, N, K; };

struct StaticOrder {
    int nM, nN, nwg, G, c;
    __host__ __device__ void init(int M, int N, int G_, int c_) { nM = M / BM; nN = N / BM; nwg = nM * nN; G = G_; c = c_; }
    __host__ __device__ bool next(int i, Unit& u) const {
        const long L = (long)i * G + c; if (L >= nwg) return false;
        int wgid = (int)L; { const int q = nwg / NXCD, r = nwg % NXCD, xcd = wgid % NXCD, off = wgid / NXCD; wgid = (xcd < r ? xcd * (q + 1) : r * (q + 1) + (xcd - r) * q) + off; }
        const int nig = WGM * nN, gid = wgid / nig, fm = gid * WGM, gsz = (nM - fm) < WGM ? (nM - fm) : WGM;
        u.pm = fm + ((wgid % nig) % gsz); u.pn = (wgid % nig) / gsz; return true;
    }
    __device__ __forceinline__ void a_ready(const Unit&) const {}
    __device__ __forceinline__ void done(const Unit&) const {}
};

template <class Epi, class Sched, bool ALIGN_EPI = false, bool SP2 = false>
__device__ __forceinline__ void gemm_phase(PG8_LAS unsigned char* lds, const Gemm g, const Sched& S, const Epi& E) {
    int tid_ = threadIdx.x; asm volatile("" : "+v"(tid_));
    const int tid = tid_, wid = __builtin_amdgcn_readfirstlane(tid >> 6), lane = tid & 63, wr = wid >> 2, wc = wid & 3, fr = lane & 15, fq = lane >> 4;
    const int K = g.K, nt = K / BK;
    unsigned voffA[2], voffB[2];
#pragma unroll
    for (int i = 0; i < 2; ++i) { int R, C; stage_rc(tid * 16 + i * 8192, R, C); const int Rb = Epi::PERM ? ((R & ~31) + perm32(R & 31)) : R;
        voffA[i] = (unsigned)(R * K + C) * 2u; voffB[i] = (unsigned)(Rb * K + C) * 2u; }
    const size_t kstep = (size_t)(BK * 2);
    const size_t hstep = (size_t)HALF * K * 2;
    const size_t tstep = 2 * hstep;
    const unsigned ldsw = (unsigned)wid * 1024u;
    const int aoff = lds_byte(wr * 64 + fr, fq * 8), boff = lds_byte(wc * 32 + fr, fq * 8);
#define PG8_SA(b, h) (((b) * 2 + (h)) * HTB)
#define PG8_SB(b, h) ((4 + (b) * 2 + (h)) * HTB)
#define PG8_STAGE(bufoff, gbase, voff) do { _Pragma("unroll") for (int _i = 0; _i < 2; ++_i) \
        __builtin_amdgcn_global_load_lds((const unsigned*)((const char*)(gbase) + (voff)[_i]), (PG8_LAS unsigned*)(lds + (bufoff) + ldsw + _i * 8192), 16, 0, 0); } while (0)
#define PG8_LDA(dst, b, h) do { _Pragma("unroll") for (int m = 0; m < 4; ++m) _Pragma("unroll") for (int k = 0; k < 2; ++k) dst[m][k] = *(const PG8_LAS bf16x8*)(lds + PG8_SA(b, h) + aoff + m * 2048 + k * 1024); } while (0)
#define PG8_LDB(dst, b, h) do { _Pragma("unroll") for (int n = 0; n < 2; ++n) _Pragma("unroll") for (int k = 0; k < 2; ++k) dst[n][k] = *(const PG8_LAS bf16x8*)(lds + PG8_SB(b, h) + boff + n * 2048 + k * 1024); } while (0)
#define PG8_MMA(ai, bj, At, Bt) do { __builtin_amdgcn_s_setprio(1); _Pragma("unroll") for (int m = 0; m < 4; ++m) _Pragma("unroll") for (int n = 0; n < 2; ++n) _Pragma("unroll") for (int k = 0; k < 2; ++k) \
        acc[ai][bj][m][n] = __builtin_amdgcn_mfma_f32_16x16x32_bf16(Bt[n][k], At[m][k], acc[ai][bj][m][n], 0, 0, 0); __builtin_amdgcn_s_setprio(0); } while (0)
#define PG8_WAIT_V(n) asm volatile("s_waitcnt vmcnt(" #n ")" ::: "memory")
#define PG8_WAIT_L(n) asm volatile("s_waitcnt lgkmcnt(" #n ")" ::: "memory")
#define PG8_BAR __builtin_amdgcn_s_barrier()
#define PG8_SCHED __builtin_amdgcn_sched_barrier(0)
    Unit cur, nxt; int ui = 0;
    if (!S.next(0, cur)) return;
    f32x4 acc[2][2][4][2];
#pragma unroll
    for (int a = 0; a < 2; ++a)
#pragma unroll
        for (int b = 0; b < 2; ++b)
#pragma unroll
            for (int m = 0; m < 4; ++m)
#pragma unroll
                for (int n = 0; n < 2; ++n) acc[a][b][m][n] = (f32x4){0.f, 0.f, 0.f, 0.f};
    bf16x8 At[4][2], B0[2][2], B1[2][2];
    const char* cA = (const char*)g.A + (size_t)cur.pm * tstep; const char* cB = (const char*)g.Bt + (size_t)cur.pn * tstep;
    S.a_ready(cur);
    if constexpr (SP2) {
        PG8_STAGE(PG8_SB(0, 0), cB, voffB); PG8_STAGE(PG8_SB(0, 1), cB + hstep, voffB); PG8_STAGE(PG8_SA(0, 0), cA, voffA); PG8_STAGE(PG8_SA(0, 1), cA + hstep, voffA);
        if (wr == 1) PG8_BAR;
        PG8_WAIT_V(2); PG8_BAR;
        PG8_STAGE(PG8_SB(1, 0), cB + kstep, voffB); PG8_STAGE(PG8_SA(1, 0), cA + kstep, voffA); PG8_STAGE(PG8_SB(1, 1), cB + hstep + kstep, voffB);
        PG8_WAIT_V(6); PG8_BAR;
    } else {
        PG8_STAGE(PG8_SB(0, 0), cB, voffB); PG8_STAGE(PG8_SA(0, 0), cA, voffA); PG8_STAGE(PG8_SB(0, 1), cB + hstep, voffB); PG8_STAGE(PG8_SA(0, 1), cA + hstep, voffA);
        if (wr == 1) PG8_BAR;
        PG8_WAIT_V(4); PG8_BAR;
        PG8_STAGE(PG8_SB(1, 0), cB + kstep, voffB); PG8_STAGE(PG8_SA(1, 0), cA + kstep, voffA); PG8_STAGE(PG8_SB(1, 1), cB + hstep + kstep, voffB);
        PG8_WAIT_V(6); PG8_BAR;
    }
    for (;;) {
        const bool has_next = S.next(ui + 1, nxt);
        const char* nA = has_next ? (const char*)g.A + (size_t)nxt.pm * tstep : cA; const char* nB = has_next ? (const char*)g.Bt + (size_t)nxt.pn * tstep : cB;
        for (int t = 0; t < nt; t += 2) {
            const bool last = (t == nt - 2);
            const char* a1 = cA + (size_t)(t + 1) * kstep;
            const char* a2 = last ? nA : cA + (size_t)(t + 2) * kstep; const char* b2 = last ? nB : cB + (size_t)(t + 2) * kstep;
            const char* a3 = a2 + kstep; const char* b3 = b2 + kstep;
            if (last && has_next) S.a_ready(nxt);
            if constexpr (SP2) {
            PG8_LDB(B0, 0, 0); PG8_LDB(B1, 0, 1); PG8_SCHED; PG8_LDA(At, 0, 0); PG8_STAGE(PG8_SA(1, 1), a1 + hstep, voffA);
            PG8_WAIT_V(8); PG8_WAIT_L(0); PG8_BAR; PG8_MMA(0, 0, At, B0); PG8_MMA(0, 1, At, B1); PG8_BAR; PG8_SCHED;
            PG8_LDA(At, 0, 1); PG8_STAGE(PG8_SB(0, 0), b2, voffB); PG8_STAGE(PG8_SB(0, 1), b2 + hstep, voffB); PG8_STAGE(PG8_SA(0, 0), a2, voffA);
            PG8_WAIT_V(8); PG8_WAIT_L(0); PG8_BAR; PG8_MMA(1, 0, At, B0); PG8_MMA(1, 1, At, B1); PG8_BAR; PG8_SCHED;
            PG8_LDB(B0, 1, 0); PG8_LDB(B1, 1, 1); PG8_SCHED; PG8_LDA(At, 1, 0); PG8_STAGE(PG8_SA(0, 1), a2 + hstep, voffA);
            PG8_WAIT_V(8); PG8_WAIT_L(0); PG8_BAR; PG8_MMA(0, 0, At, B0); PG8_MMA(0, 1, At, B1); PG8_BAR; PG8_SCHED;
            PG8_LDA(At, 1, 1); PG8_STAGE(PG8_SB(1, 0), b3, voffB); PG8_STAGE(PG8_SB(1, 1), b3 + hstep, voffB); PG8_STAGE(PG8_SA(1, 0), a3, voffA);
            PG8_WAIT_V(8); PG8_WAIT_L(0); PG8_BAR; PG8_MMA(1, 0, At, B0); PG8_MMA(1, 1, At, B1); PG8_BAR; PG8_SCHED;
            } else {
            PG8_LDB(B0, 0, 0); PG8_SCHED; PG8_LDA(At, 0, 0); PG8_STAGE(PG8_SA(1, 1), a1 + hstep, voffA);
            PG8_WAIT_L(8); PG8_BAR; PG8_WAIT_L(0); PG8_MMA(0, 0, At, B0); PG8_BAR; PG8_SCHED;
            PG8_LDB(B1, 0, 1); PG8_STAGE(PG8_SB(0, 0), b2, voffB);
            PG8_BAR; PG8_WAIT_L(0); PG8_MMA(0, 1, At, B1); PG8_BAR;
            PG8_LDA(At, 0, 1); PG8_STAGE(PG8_SA(0, 0), a2, voffA);
            PG8_BAR; PG8_WAIT_L(0); PG8_MMA(1, 0, At, B0); PG8_BAR; PG8_SCHED;
            PG8_STAGE(PG8_SB(0, 1), b2 + hstep, voffB);
            PG8_WAIT_V(6); PG8_BAR; PG8_MMA(1, 1, At, B1); PG8_BAR;
            PG8_LDB(B0, 1, 0); PG8_SCHED; PG8_LDA(At, 1, 0); PG8_STAGE(PG8_SA(0, 1), a2 + hstep, voffA);
            PG8_WAIT_L(8); PG8_BAR; PG8_WAIT_L(0); PG8_MMA(0, 0, At, B0); PG8_BAR; PG8_SCHED;
            PG8_LDB(B1, 1, 1); PG8_STAGE(PG8_SB(1, 0), b3, voffB);
            PG8_BAR; PG8_WAIT_L(0); PG8_MMA(0, 1, At, B1); PG8_BAR;
            PG8_LDA(At, 1, 1); PG8_STAGE(PG8_SA(1, 0), a3, voffA);
            PG8_BAR; PG8_WAIT_L(0); PG8_MMA(1, 0, At, B0); PG8_BAR; PG8_SCHED;
            PG8_STAGE(PG8_SB(1, 1), b3 + hstep, voffB);
            PG8_WAIT_V(6); PG8_BAR; PG8_MMA(1, 1, At, B1); PG8_BAR;
            }
        }
        if constexpr (ALIGN_EPI) { if (wr == 0) PG8_BAR; }
        if constexpr (!Epi::AFTER_DRAIN) { E(acc, cur, wr, wc, fr, fq); S.done(cur); }
        if (!has_next) break;
#pragma unroll
        for (int a = 0; a < 2; ++a)
#pragma unroll
            for (int b = 0; b < 2; ++b)
#pragma unroll
                for (int m = 0; m < 4; ++m)
#pragma unroll
                    for (int n = 0; n < 2; ++n) acc[a][b][m][n] = (f32x4){0.f, 0.f, 0.f, 0.f};
        cur = nxt; cA = nA; cB = nB; ++ui;
        if constexpr (ALIGN_EPI) { if (wr == 1) PG8_BAR; }
    }
    PG8_WAIT_V(0);
    if constexpr (!ALIGN_EPI) { if (wr == 0) PG8_BAR; }
    PG8_BAR;
    if constexpr (Epi::AFTER_DRAIN) { E.fused(acc, cur, wr, wc, fr, fq, lds, wid, lane); S.done(cur); }
#undef PG8_SA
#undef PG8_SB
#undef PG8_STAGE
#undef PG8_LDA
#undef PG8_LDB
#undef PG8_MMA
#undef PG8_WAIT_V
#undef PG8_WAIT_L
#undef PG8_BAR
#undef PG8_SCHED
}
}

#define LAS __attribute__((address_space(3)))
typedef unsigned short bf16;
typedef unsigned u32x4 __attribute__((ext_vector_type(4)));
typedef unsigned u32x2 __attribute__((ext_vector_type(2)));
typedef float f32x4 __attribute__((ext_vector_type(4)));
typedef float f32x16 __attribute__((ext_vector_type(16)));
typedef short bf16x8 __attribute__((ext_vector_type(8)));
typedef short v4i16_t __attribute__((ext_vector_type(4)));

constexpr int M = 16384, DM = 2048, SEQ = 2048, NBATCH = 8, NCH = 16;
constexpr int N0P = 11264, N0R = 11296;
constexpr float EPS = 1e-5f;
constexpr float LOG2E = 1.4426950408889634f;
constexpr float QSCALE = 0.125f * LOG2E;
constexpr float LAMBDA_INIT = 0.35550906f;
constexpr size_t MiB = 1u << 20;
constexpr size_t WS_ST0 = 0, WS_ST1 = 128 * 1024, WS_ST2 = 192 * 1024, WS_CD = 256 * 1024, WS_LAM = 300 * 1024;
constexpr size_t WS_DT = 1 * MiB, WS_WSP = 3 * MiB, WS_W0IN = 4 * MiB, WS_W0OUT = 49 * MiB, WS_W1IN = 65 * MiB, WS_W1OUT = 97 * MiB;
constexpr size_t WS_YCAT = 105 * MiB, WS_ZA = 233 * MiB, WS_V = 297 * MiB, WS_H0 = 361 * MiB, WS_XT = 425 * MiB, WS_CN = 489 * MiB, WS_END = 505 * MiB;
constexpr size_t WS_Q = WS_YCAT, WS_K = WS_YCAT + 64 * MiB, WS_X1 = WS_ZA, WS_STATES = WS_V, WS_VT = WS_H0, WS_X1B = WS_H0, WS_O = WS_ZA, WS_VV = WS_XT, WS_X2B = WS_YCAT;
constexpr size_t DO_XBC = 0, DO_BN = 96 * MiB, DO_BT = 112 * MiB, DO_PREV = 0, DO_G = 0;
constexpr int LDS_BYTES = 147456;
constexpr int ST_BOFF = 4096;
constexpr int GM_UOFF = 128 * 272, GM_ZOFF = 2 * 128 * 272, GM_WOFF = 3 * 128 * 272;
static_assert(4 * 128 * 272 <= LDS_BYTES - 512, "gMLP LDS map");

__device__ __forceinline__ unsigned pk2(float lo, float hi) {
    typedef float f2 __attribute__((ext_vector_type(2))); typedef __bf16 b2 __attribute__((ext_vector_type(2)));
    f2 v = {lo, hi}; b2 b = __builtin_convertvector(v, b2); return __builtin_bit_cast(unsigned, b);
}
__device__ __forceinline__ float bflo(unsigned u) { return __uint_as_float(u << 16); }
__device__ __forceinline__ float bfhi(unsigned u) { return __uint_as_float(u & 0xffff0000u); }
__device__ __forceinline__ void unpack8(u32x4 r, float* f) { f[0] = bflo(r.x); f[1] = bfhi(r.x); f[2] = bflo(r.y); f[3] = bfhi(r.y); f[4] = bflo(r.z); f[5] = bfhi(r.z); f[6] = bflo(r.w); f[7] = bfhi(r.w); }
__device__ __forceinline__ u32x4 pack8(const float* f) { u32x4 o; o.x = pk2(f[0], f[1]); o.y = pk2(f[2], f[3]); o.z = pk2(f[4], f[5]); o.w = pk2(f[6], f[7]); return o; }
__device__ __forceinline__ float fexp2(float x) { return __builtin_amdgcn_exp2f(x); }
__device__ __forceinline__ float gelu_f(float x) { const float z = 1.5957691216057308f * (x + 0.044715f * x * x * x); return x * __builtin_amdgcn_rcpf(1.0f + __expf(-z)); }
__device__ __forceinline__ float silu_f(float x) { return x * __builtin_amdgcn_rcpf(1.0f + __expf(-x)); }
__device__ __forceinline__ int crow(int r, int h) { return (r & 3) + 8 * (r >> 2) + 4 * h; }
__device__ __forceinline__ f32x16 mfma32(bf16x8 a, bf16x8 b, f32x16 c) { return __builtin_amdgcn_mfma_f32_32x32x16_bf16(a, b, c, 0, 0, 0); }
__device__ __forceinline__ bf16x8 ld_frag16(const bf16* p) { return __builtin_bit_cast(bf16x8, *(const u32x4*)p); }
__device__ __forceinline__ bf16x8 ld_frag8x2(const bf16* p) { const u32x2 lo = *(const u32x2*)p, hi = *(const u32x2*)(p + 8); u32x4 v; v.x = lo.x; v.y = lo.y; v.z = hi.x; v.w = hi.y; return __builtin_bit_cast(bf16x8, v); }
__device__ __forceinline__ bf16x8 pack_frag(const f32x16& x, int s) {
    u32x4 v; v.x = pk2(x[8 * s], x[8 * s + 1]); v.y = pk2(x[8 * s + 2], x[8 * s + 3]); v.z = pk2(x[8 * s + 4], x[8 * s + 5]); v.w = pk2(x[8 * s + 6], x[8 * s + 7]); return __builtin_bit_cast(bf16x8, v);
}
__device__ __forceinline__ float wave_sum(float v) {
#pragma unroll
    for (int o = 1; o < 64; o <<= 1) v += __shfl_xor(v, o);
    return v;
}
#define LDS_WAIT() asm volatile("s_waitcnt lgkmcnt(0)" ::: "memory")
__device__ __forceinline__ void atomic_addf(float* p, float v) { __hip_atomic_fetch_add(p, v, __ATOMIC_RELAXED, __HIP_MEMORY_SCOPE_AGENT); }

struct Params { const float* in[23]; float* out; unsigned char* ws; };
constexpr int PTAB_OFF = LDS_BYTES - 512;
__device__ __forceinline__ unsigned long long ptab_get(int i) {
    const unsigned long long v = ((const LAS unsigned long long*)(PTAB_OFF))[i];
    const unsigned lo = __builtin_amdgcn_readfirstlane((unsigned)v), hi = __builtin_amdgcn_readfirstlane((unsigned)(v >> 32));
    return ((unsigned long long)hi << 32) | lo;
}
struct PT {
    struct InTab { __device__ __forceinline__ const float* operator[](int i) const { return (const float*)(const __attribute__((address_space(1))) float*)ptab_get(i); } } in;
    float* out; unsigned char* ws;
    __device__ __forceinline__ PT() { out = (float*)(__attribute__((address_space(1))) float*)ptab_get(23); ws = (unsigned char*)(__attribute__((address_space(1))) unsigned char*)ptab_get(24); }
};

template <int ACT>
__device__ __forceinline__ void epi_tile_bf16(const f32x4 (&acc)[2][2][4][2], bf16* base, int pitch, int col0, int row0, float sc) {
#pragma unroll
    for (int ai = 0; ai < 2; ++ai)
#pragma unroll
        for (int m = 0; m < 4; ++m) {
            bf16* rowp = base + (size_t)(row0 + ai * 128 + m * 16) * pitch + col0;
#pragma unroll
            for (int bj = 0; bj < 2; ++bj) {
                float v[8];
#pragma unroll
                for (int j = 0; j < 4; ++j) { v[j] = acc[ai][bj][m][0][j]; v[4 + j] = acc[ai][bj][m][1][j]; }
#pragma unroll
                for (int j = 0; j < 8; ++j) { if (ACT == 1) v[j] = gelu_f(v[j]); else if (ACT == 2) v[j] = silu_f(v[j]); else if (ACT == 3) v[j] *= sc; }
                *(u32x4*)(rowp + bj * 128) = pack8(v);
            }
        }
}

struct EpiIn0 {
    static constexpr bool PERM = true, AFTER_DRAIN = false;
    bf16 *ycat, *vbuf, *za, *xbc; float* stats0;
    __device__ __forceinline__ void operator()(const f32x4 (&acc)[2][2][4][2], const pg8::Unit& u, int wr, int wc, int fr, int fq) const {
        const int pn = u.pn, row0 = u.pm * 256 + wr * 64 + fr, cl = wc * 32 + 8 * fq;
        if (pn < 8) { epi_tile_bf16<1>(acc, ycat, 4096, pn * 256 + cl, row0, 1.f); }
        else if (pn < 16) {
#pragma unroll
            for (int ai = 0; ai < 2; ++ai)
#pragma unroll
                for (int m = 0; m < 4; ++m) {
                    const int row = row0 + ai * 128 + m * 16;
                    bf16* rowp = vbuf + (size_t)row * 2048 + (pn - 8) * 256 + cl;
                    float s = 0.f, ss = 0.f;
#pragma unroll
                    for (int bj = 0; bj < 2; ++bj) {
                        float v[8];
#pragma unroll
                        for (int j = 0; j < 4; ++j) { v[j] = gelu_f(acc[ai][bj][m][0][j]); v[4 + j] = gelu_f(acc[ai][bj][m][1][j]); }
#pragma unroll
                        for (int j = 0; j < 8; ++j) { s += v[j]; ss += v[j] * v[j]; }
                        *(u32x4*)(rowp + bj * 128) = pack8(v);
                    }
                    s += __shfl_xor(s, 16); s += __shfl_xor(s, 32); ss += __shfl_xor(ss, 16); ss += __shfl_xor(ss, 32);
                    if (fq == 0) { atomic_addf(stats0 + 2 * row, s); atomic_addf(stats0 + 2 * row + 1, ss); }
                }
        }
        else if (pn < 24) { epi_tile_bf16<2>(acc, za, 2048, (pn - 16) * 256 + cl, row0, 1.f); }
        else if (pn < 32) { epi_tile_bf16<2>(acc, ycat, 4096, 2048 + (pn - 24) * 256 + cl, row0, 1.f); }
        else { epi_tile_bf16<0>(acc, xbc, 3072, (pn - 32) * 256 + cl, row0, 1.f); }
    }
};

__device__ __forceinline__ void dt_tasks(const PT& p, LAS unsigned char* lds, int lane, int wave) {
    unsigned char* ws = p.ws; const bf16* H0 = (const bf16*)(ws + WS_H0); const bf16* Wdt = (const bf16*)(ws + WS_W0IN) + (size_t)11264 * 2048; float* DT = (float*)(ws + WS_DT);
    const int r32 = lane & 31, h = lane >> 5, kq = wave & 3;
    for (int base = blockIdx.x * 2; base < 512; base += gridDim.x * 2) {
        const int task = base + (wave >> 2);
        const bf16* ap = Wdt + (size_t)r32 * 2048 + 512 * kq + 8 * h; const bf16* bp = H0 + (size_t)(task * 32 + r32) * 2048 + 512 * kq + 8 * h;
        f32x16 acc;
#pragma unroll
        for (int i = 0; i < 16; ++i) acc[i] = 0.f;
#pragma unroll 8
        for (int st = 0; st < 32; ++st) acc = mfma32(ld_frag16(ap + 16 * st), ld_frag16(bp + 16 * st), acc);
        LAS float* part = (LAS float*)lds + wave * 1024;
        __syncthreads();
        if (kq != 0) {
#pragma unroll
            for (int i = 0; i < 16; ++i) part[i * 64 + lane] = acc[i]; }
        __syncthreads();
        if (kq == 0) {
#pragma unroll
            for (int i = 0; i < 16; ++i) acc[i] += part[1024 + i * 64 + lane] + part[2048 + i * 64 + lane] + part[3072 + i * 64 + lane];
#pragma unroll
            for (int qd = 0; qd < 4; ++qd) {
                const int j0 = 8 * qd + 4 * h; const f32x4 bb = *(const f32x4*)(p.in[9] + j0); f32x4 v;
#pragma unroll
                for (int j = 0; j < 4; ++j) { const float x = acc[4 * qd + j] + bb[j]; v[j] = x > 20.f ? x : log1pf(__expf(x)); }
                *(f32x4*)(DT + (size_t)(task * 32 + r32) * 32 + j0) = v;
            }
        }
    }
}

template <bool RB16> struct EpiResT {
    static constexpr bool PERM = true, AFTER_DRAIN = false;
    const void* resid; float* outf; bf16* outb; float* stats;
    __device__ __forceinline__ void operator()(const f32x4 (&acc)[2][2][4][2], const pg8::Unit& u, int wr, int wc, int fr, int fq) const {
        const int row0 = u.pm * 256 + wr * 64 + fr, col0 = u.pn * 256 + wc * 32 + 8 * fq;
#pragma unroll
        for (int ai = 0; ai < 2; ++ai)
#pragma unroll
            for (int m = 0; m < 4; ++m) {
                const int row = row0 + ai * 128 + m * 16; const size_t off = (size_t)row * 2048 + col0;
                float ss = 0.f;
#pragma unroll
                for (int bj = 0; bj < 2; ++bj) {
                    f32x4 r0, r1;
                    if (RB16) { float f[8]; unpack8(*(const u32x4*)((const bf16*)resid + off + bj * 128), f); r0 = (f32x4){f[0], f[1], f[2], f[3]}; r1 = (f32x4){f[4], f[5], f[6], f[7]}; }
                    else { r0 = *(const f32x4*)((const float*)resid + off + bj * 128); r1 = *(const f32x4*)((const float*)resid + off + bj * 128 + 4); }
                    r0 = r0 + acc[ai][bj][m][0]; r1 = r1 + acc[ai][bj][m][1];
                    if (outf) { *(f32x4*)(outf + off + bj * 128) = r0; *(f32x4*)(outf + off + bj * 128 + 4) = r1; }
                    ss += (r0[0] * r0[0] + r0[1] * r0[1]) + (r0[2] * r0[2] + r0[3] * r0[3]) + (r1[0] * r1[0] + r1[1] * r1[1]) + (r1[2] * r1[2] + r1[3] * r1[3]);
                    if (outb) { u32x4 w; w.x = pk2(r0[0], r0[1]); w.y = pk2(r0[2], r0[3]); w.z = pk2(r1[0], r1[1]); w.w = pk2(r1[2], r1[3]); *(u32x4*)(outb + off + bj * 128) = w; }
                }
                ss += __shfl_xor(ss, 16); ss += __shfl_xor(ss, 32);
                if (fq == 0) atomic_addf(stats + row, ss);
            }
    }
};

struct EpiIn1 {
    static constexpr bool PERM = true, AFTER_DRAIN = false;
    bf16 *q, *k, *v, *g; const float* stats1;
    __device__ __forceinline__ void operator()(const f32x4 (&acc)[2][2][4][2], const pg8::Unit& u, int wr, int wc, int fr, int fq) const {
        const int seg = u.pn >> 3, row0 = u.pm * 256 + wr * 64 + fr, col0 = (u.pn & 7) * 256 + wc * 32 + 8 * fq;
        bf16* base = seg == 0 ? q : (seg == 1 ? k : (seg == 2 ? v : g));
        const float sc = seg == 0 ? QSCALE : 1.f;
#pragma unroll
        for (int ai = 0; ai < 2; ++ai)
#pragma unroll
            for (int m = 0; m < 4; ++m) {
                const int row = row0 + ai * 128 + m * 16;
                const float rs = rsqrtf(stats1[row] * (1.f / 2048.f) + EPS) * sc;
                bf16* rowp = base + (size_t)row * 2048 + col0;
#pragma unroll
                for (int bj = 0; bj < 2; ++bj) {
                    float v8[8];
#pragma unroll
                    for (int j = 0; j < 4; ++j) { v8[j] = acc[ai][bj][m][0][j] * rs; v8[4 + j] = acc[ai][bj][m][1][j] * rs; }
                    if (seg == 3) {
#pragma unroll
                        for (int j = 0; j < 8; ++j) v8[j] = silu_f(v8[j]);
                    }
                    *(u32x4*)(rowp + bj * 128) = pack8(v8);
                }
            }
    }
};

__device__ __forceinline__ void transpose_item(const float* W, int K, int N, bf16* WT, int item, int lane, const float* kscale) {
    const int nblk = N / 32, kb = item / nblk, nb = item % nblk, kq = lane & 7, c4 = lane >> 3;
    const int k0 = 64 * kb + 8 * kq, n0 = 32 * nb + 4 * c4;
    f32x4 v[8];
#pragma unroll
    for (int i = 0; i < 8; ++i) v[i] = *(const f32x4*)(W + (size_t)(k0 + i) * N + n0);
    if (kscale) {
        const f32x4 g0 = *(const f32x4*)(kscale + k0), g1 = *(const f32x4*)(kscale + k0 + 4);
#pragma unroll
        for (int i = 0; i < 4; ++i) { v[i] = v[i] * g0[i]; v[4 + i] = v[4 + i] * g1[i]; }
    }
#pragma unroll
    for (int j = 0; j < 4; ++j) {
        u32x4 o; o.x = pk2(v[0][j], v[1][j]); o.y = pk2(v[2][j], v[3][j]); o.z = pk2(v[4][j], v[5][j]); o.w = pk2(v[6][j], v[7][j]);
        *(u32x4*)(WT + (size_t)(n0 + j) * K + k0) = o;
    }
}

__device__ __forceinline__ void phase0(const PT& p, LAS unsigned char* lds, int tid, int lane, int wave) {
    unsigned char* ws = p.ws;
    const int gw = blockIdx.x * 8 + wave, NGW = gridDim.x * 8;
    const int gt = blockIdx.x * 512 + tid, NGT = gridDim.x * 512;
    for (int i = gt; i < 65536; i += NGT) ((float*)(ws + WS_ST0))[i] = 0.f;
    constexpr int I0 = 32 * (N0R / 32), I1 = 64 * 64, I2 = 32 * 256, I3 = 32 * 64;
    for (int it = gw; it < I0 + I1 + I2 + I3; it += NGW) {
        int r = it;
        if (r < I0) { transpose_item(p.in[2], 2048, N0R, (bf16*)(ws + WS_W0IN), r, lane, nullptr); continue; } r -= I0;
        if (r < I1) { transpose_item(p.in[13], 4096, 2048, (bf16*)(ws + WS_W0OUT), r, lane, nullptr); continue; } r -= I1;
        if (r < I2) { transpose_item(p.in[15], 2048, 8192, (bf16*)(ws + WS_W1IN), r, lane, p.in[14]); continue; } r -= I2;
        transpose_item(p.in[21], 2048, 2048, (bf16*)(ws + WS_W1OUT), r, lane, nullptr);
    }
    for (int i = gt; i < 16 * 128 * 128 / 8; i += NGT) {
        const int e = i * 8, t = (e >> 7) & 127, s0 = e & 127; const float* src = p.in[5] + e; float v[8];
#pragma unroll
        for (int j = 0; j < 8; ++j) v[j] = (s0 + j <= t) ? src[j] : 0.f;
        ((u32x4*)(ws + WS_WSP))[i] = pack8(v);
    }
    const float* g0 = p.in[1]; bf16* H0 = (bf16*)(ws + WS_H0);
    for (int m = gw; m < M; m += NGW) {
        const f32x4* xr = (const f32x4*)(p.in[0] + (size_t)m * 2048) + lane; f32x4 v[8]; float s = 0.f;
#pragma unroll
        for (int j = 0; j < 8; ++j) { v[j] = xr[64 * j]; s += (v[j].x * v[j].x + v[j].y * v[j].y) + (v[j].z * v[j].z + v[j].w * v[j].w); }
        const float rs = rsqrtf(wave_sum(s) * (1.f / 2048.f) + EPS);
        u32x2* o = (u32x2*)(H0 + (size_t)m * 2048) + lane;
#pragma unroll
        for (int j = 0; j < 8; ++j) { const f32x4 g = ((const f32x4*)g0)[lane + 64 * j]; u32x2 w; w.x = pk2(v[j].x * rs * g.x, v[j].y * rs * g.y); w.y = pk2(v[j].z * rs * g.z, v[j].w * rs * g.w); o[64 * j] = w; }
    }
}

__device__ __forceinline__ void phase_layout(const PT& p, int tid) {
    unsigned char* ws = p.ws; unsigned char* dob = (unsigned char*)p.out;
    const bf16* Vb = (const bf16*)(ws + WS_V); const float* st0 = (const float*)(ws + WS_ST0);
    const bf16* XBC = (const bf16*)(dob + DO_XBC);
    bf16 *vT = (bf16*)(ws + WS_VT), *xT = (bf16*)(ws + WS_XT), *Bn = (bf16*)(dob + DO_BN), *BT = (bf16*)(dob + DO_BT), *Cn = (bf16*)(ws + WS_CN);
    const int t = tid & 255, so = t >> 4, co = t & 15;
    for (int pi = blockIdx.x * 2 + (tid >> 8); pi < 128 * 24; pi += gridDim.x * 2) {
        const int bc = pi / 24, k = 16 + pi % 24; const int tok0 = bc * 128 + so * 8;
        float o[8][8];
        if (k < 16) {
            const int ch0 = k * 128 + co * 8;
            float g[8], bb[8];
#pragma unroll
            for (int j = 0; j < 8; ++j) { g[j] = p.in[3][ch0 + j]; bb[j] = p.in[4][ch0 + j]; }
#pragma unroll
            for (int i = 0; i < 8; ++i) {
                const int row = tok0 + i; float f[8]; unpack8(*(const u32x4*)(Vb + (size_t)row * 2048 + ch0), f);
                const float mu = st0[2 * row] * (1.f / 2048.f), var = st0[2 * row + 1] * (1.f / 2048.f) - mu * mu, rs = rsqrtf(fmaxf(var, 0.f) + EPS);
#pragma unroll
                for (int j = 0; j < 8; ++j) o[i][j] = (f[j] - mu) * rs * g[j] + bb[j];
            }
#pragma unroll
            for (int j = 0; j < 8; ++j) { float c8[8];
#pragma unroll
                for (int i = 0; i < 8; ++i) c8[i] = o[i][j];
                *(u32x4*)(vT + ((size_t)bc * 2048 + ch0 + j) * 128 + so * 8) = pack8(c8); }
        } else {
            const int sc0 = (k - 16) * 128 + co * 8;
            float cw[4][8], cb[8];
#pragma unroll
            for (int j = 0; j < 8; ++j) { cb[j] = p.in[8][sc0 + j];
#pragma unroll
                for (int kk = 0; kk < 4; ++kk) cw[kk][j] = p.in[7][kk * 3072 + sc0 + j]; }
            const int pos0 = (bc & 15) * 128 + so * 8;
            float xw[11][8];
#pragma unroll
            for (int ii = 0; ii < 11; ++ii) {
                if (pos0 - 3 + ii >= 0) unpack8(*(const u32x4*)(XBC + (size_t)(tok0 - 3 + ii) * 3072 + sc0), xw[ii]);
                else {
#pragma unroll
                    for (int j = 0; j < 8; ++j) xw[ii][j] = 0.f;
                }
            }
#pragma unroll
            for (int i = 0; i < 8; ++i)
#pragma unroll
                for (int j = 0; j < 8; ++j) { float a = cb[j];
#pragma unroll
                    for (int kk = 0; kk < 4; ++kk) a += cw[kk][j] * xw[i + kk][j];
                    o[i][j] = silu_f(a); }
            if (k < 32) {
#pragma unroll
                for (int j = 0; j < 8; ++j) { float c8[8];
#pragma unroll
                    for (int i = 0; i < 8; ++i) c8[i] = o[i][j];
                    *(u32x4*)(xT + ((size_t)bc * 2048 + sc0 + j) * 128 + so * 8) = pack8(c8); }
            } else if (k < 36) {
                const int n0 = sc0 - 2048;
#pragma unroll
                for (int i = 0; i < 8; ++i) *(u32x4*)(Bn + (size_t)(tok0 + i) * 512 + n0) = pack8(o[i]);
#pragma unroll
                for (int j = 0; j < 8; ++j) { float c8[8];
#pragma unroll
                    for (int i = 0; i < 8; ++i) c8[i] = o[i][j];
                    *(u32x4*)(BT + ((size_t)bc * 512 + n0 + j) * 128 + so * 8) = pack8(c8); }
            } else {
                const int n0 = sc0 - 2560;
#pragma unroll
                for (int i = 0; i < 8; ++i) *(u32x4*)(Cn + (size_t)(tok0 + i) * 512 + n0) = pack8(o[i]);
            }
        }
    }
}

__device__ __forceinline__ void chunk_cumsum(const float* DT, const float* a_log, int tok0, int hh, int lane, float& d0, float& d1, float& c0, float& c1, float& tot) {
    d0 = DT[(size_t)(tok0 + 2 * lane) * 32 + hh]; d1 = DT[(size_t)(tok0 + 2 * lane + 1) * 32 + hh];
    const float A = -__expf(a_log[hh]); const float x0 = d0 * A, x1 = d1 * A; float ps = x0 + x1;
#pragma unroll
    for (int o = 1; o < 64; o <<= 1) { const float t = __shfl_up(ps, o); if (lane >= o) ps += t; }
    c1 = ps; c0 = ps - x1; tot = __shfl(ps, 63);
}

__device__ __forceinline__ void phase_mix(const PT& p, LAS unsigned char* lds, int tid, int lane, int wave) {
    unsigned char* ws = p.ws; unsigned char* dob = (unsigned char*)p.out;
    const int r32 = lane & 31, h = lane >> 5;
    bf16* Ycat = (bf16*)(ws + WS_YCAT); const bf16* ZA = (const bf16*)(ws + WS_ZA); const bf16* Vb = (const bf16*)(ws + WS_V); const float* st0 = (const float*)(ws + WS_ST0); const bf16* Wsp = (const bf16*)(ws + WS_WSP);
    const bf16* xT = (const bf16*)(ws + WS_XT); const bf16* BT = (const bf16*)(dob + DO_BT); const float* DT = (const float*)(ws + WS_DT);
    bf16* ST = (bf16*)(ws + WS_STATES); float* CD = (float*)(ws + WS_CD);
    LAS float* wtab = (LAS float*)lds;
    constexpr int NG = 128 * 16, NS = NBATCH * 15 * 4;
    for (int it = blockIdx.x; it < NG + NS; it += gridDim.x) {
        if (it < NG) {
            const int bc = it >> 4, g = it & 15, cb = wave & 3, th = wave >> 2;
            const int ch0 = g * 128 + cb * 32;
            __syncthreads();
            {
                const int c16 = tid & 15; float lg[8], lb[8];
#pragma unroll
                for (int j = 0; j < 8; ++j) { lg[j] = p.in[3][g * 128 + 8 * c16 + j]; lb[j] = p.in[4][g * 128 + 8 * c16 + j]; }
#pragma unroll
                for (int i = 0; i < 4; ++i) {
                    const int row = (tid >> 4) + 32 * i; const size_t tokr = (size_t)bc * 128 + row;
                    float f[8]; unpack8(*(const u32x4*)(Vb + tokr * 2048 + g * 128 + 8 * c16), f);
                    const float mu = st0[2 * tokr] * (1.f / 2048.f), var = st0[2 * tokr + 1] * (1.f / 2048.f) - mu * mu, rs = rsqrtf(fmaxf(var, 0.f) + EPS);
#pragma unroll
                    for (int j = 0; j < 8; ++j) f[j] = (f[j] - mu) * rs * lg[j] + lb[j];
                    *(LAS u32x4*)(lds + row * 272 + 16 * c16) = pack8(f);
                    *(LAS u32x4*)(lds + GM_UOFF + row * 272 + 16 * c16) = *(const u32x4*)(Ycat + tokr * 4096 + g * 128 + 8 * c16);
                    *(LAS u32x4*)(lds + GM_ZOFF + row * 272 + 16 * c16) = *(const u32x4*)(ZA + tokr * 2048 + g * 128 + 8 * c16);
                    *(LAS u32x4*)(lds + GM_WOFF + row * 272 + 16 * c16) = *(const u32x4*)(Wsp + ((size_t)g * 128 + row) * 128 + 8 * c16);
                }
            }
            __syncthreads();
            const LAS unsigned char* ap = lds + (8 * h + ((lane & 15) >> 2)) * 272 + (cb * 32 + 16 * ((lane >> 4) & 1)) * 2 + (lane & 3) * 8;
            f32x16 acc[2];
#pragma unroll
            for (int i = 0; i < 16; ++i) { acc[0][i] = 0.f; acc[1][i] = 0.f; }
#pragma unroll
            for (int st = 0; st < 8; ++st) {
                const v4i16_t lo = __builtin_amdgcn_ds_read_tr16_b64_v4i16((LAS v4i16_t*)(ap + 16 * st * 272)), hi = __builtin_amdgcn_ds_read_tr16_b64_v4i16((LAS v4i16_t*)(ap + (16 * st + 4) * 272));
                const bf16x8 a = {lo[0], lo[1], lo[2], lo[3], hi[0], hi[1], hi[2], hi[3]};
#pragma unroll
                for (int t2 = 0; t2 < 2; ++t2) { const int tb = 2 * th + t2;
                    if (st < 2 * (tb + 1)) { const bf16x8 b = __builtin_bit_cast(bf16x8, *(const LAS u32x4*)(lds + GM_WOFF + (tb * 32 + r32) * 272 + (16 * st + 8 * h) * 2)); acc[t2] = mfma32(a, b, acc[t2]); } }
                __builtin_amdgcn_sched_barrier(0);
            }
#pragma unroll
            for (int t2 = 0; t2 < 2; ++t2) {
                const int t = (2 * th + t2) * 32 + r32; const float sb = p.in[6][g * 128 + t];
#pragma unroll
                for (int qd = 0; qd < 4; ++qd) {
                    const int cl = cb * 32 + 8 * qd + 4 * h;
                    LAS u32x2* up = (LAS u32x2*)(lds + GM_UOFF + t * 272 + cl * 2); const u32x2 uu = *up, zz = *(const LAS u32x2*)(lds + GM_ZOFF + t * 272 + cl * 2);
                    const float y0 = bflo(uu.x) * (acc[t2][4 * qd] + sb) * bflo(zz.x), y1 = bfhi(uu.x) * (acc[t2][4 * qd + 1] + sb) * bfhi(zz.x);
                    const float y2 = bflo(uu.y) * (acc[t2][4 * qd + 2] + sb) * bflo(zz.y), y3 = bfhi(uu.y) * (acc[t2][4 * qd + 3] + sb) * bfhi(zz.y);
                    u32x2 w; w.x = pk2(y0, y1); w.y = pk2(y2, y3); *up = w;
                }
            }
            __syncthreads();
            { const int c16 = tid & 15;
#pragma unroll
              for (int i = 0; i < 4; ++i) { const int row = (tid >> 4) + 32 * i; *(u32x4*)(Ycat + ((size_t)bc * 128 + row) * 4096 + g * 128 + 8 * c16) = *(const LAS u32x4*)(lds + GM_UOFF + row * 272 + 16 * c16); } }
        } else {
            const int id = it - NG, b = id / 60, c = (id / 4) % 15, grp = id & 3; const int bc = b * 16 + c, tok0 = bc * 128;
            __syncthreads();
            { const int hh = grp * 8 + wave; float d0, d1, c0, c1, tot; chunk_cumsum(DT, p.in[10], tok0, hh, lane, d0, d1, c0, c1, tot);
              wtab[wave * 128 + 2 * lane] = d0 * __expf(tot - c0); wtab[wave * 128 + 2 * lane + 1] = d1 * __expf(tot - c1);
              if (lane == 0) CD[bc * 32 + hh] = __expf(tot); }
#pragma unroll
            for (int i = 0; i < 4; ++i) { const int pid = tid + 512 * i, row = pid >> 4, c16 = pid & 15;
                *(LAS u32x4*)(lds + ST_BOFF + row * 272 + 16 * c16) = *(const u32x4*)(BT + ((size_t)bc * 512 + grp * 128 + row) * 128 + 8 * c16); }
            __syncthreads();
#pragma unroll 1
            for (int tk = 0; tk < 2; ++tk) {
                const int r = (wave >> 1) + 4 * tk, pb = wave & 1, hh = grp * 8 + r;
                const bf16* ap = xT + ((size_t)bc * 2048 + hh * 64 + pb * 32 + r32) * 128 + 8 * h;
                const LAS unsigned char* bp = lds + ST_BOFF + r32 * 272 + 16 * h;
                f32x16 acc[4];
#pragma unroll
                for (int nb = 0; nb < 4; ++nb)
#pragma unroll
                    for (int i = 0; i < 16; ++i) acc[nb][i] = 0.f;
#pragma unroll
                for (int st = 0; st < 8; ++st) {
                    float f[8]; unpack8(*(const u32x4*)(ap + 16 * st), f);
                    const f32x4 w0 = *(const LAS f32x4*)(wtab + r * 128 + 16 * st + 8 * h), w1 = *(const LAS f32x4*)(wtab + r * 128 + 16 * st + 8 * h + 4);
                    f[0] *= w0.x; f[1] *= w0.y; f[2] *= w0.z; f[3] *= w0.w; f[4] *= w1.x; f[5] *= w1.y; f[6] *= w1.z; f[7] *= w1.w;
                    const bf16x8 a = __builtin_bit_cast(bf16x8, pack8(f));
#pragma unroll
                    for (int nb = 0; nb < 4; ++nb) { const bf16x8 bfr = __builtin_bit_cast(bf16x8, *(const LAS u32x4*)(bp + nb * 32 * 272 + 32 * st)); acc[nb] = mfma32(a, bfr, acc[nb]); }
                    __builtin_amdgcn_sched_barrier(0);
                }
                bf16* sp = ST + ((size_t)(bc * 32 + hh) * 64 + pb * 32) * 128;
#pragma unroll
                for (int nb = 0; nb < 4; ++nb)
#pragma unroll
                    for (int i = 0; i < 16; ++i) sp[(size_t)crow(i, h) * 128 + nb * 32 + r32] = (bf16)(pk2(acc[nb][i], 0.f) & 0xffffu);
            }
        }
    }
}

__device__ __forceinline__ void phase_scan(const PT& p, int tid) {
    unsigned char* ws = p.ws; const bf16* ST = (const bf16*)(ws + WS_STATES); const float* CD = (const float*)(ws + WS_CD); bf16* PV = (bf16*)((unsigned char*)p.out + DO_PREV);
    for (int id = blockIdx.x * 512 + tid; id < NBATCH * 32 * 64 * 16; id += gridDim.x * 512) {
        const int b = id >> 15, rem = id & 32767, hh = rem >> 10;
        float run[8];
#pragma unroll
        for (int j = 0; j < 8; ++j) run[j] = 0.f;
#pragma unroll
        for (int c = 0; c < 16; ++c) {
            const size_t off = ((size_t)(b * 16 + c) * 32 * 64 * 16 + rem) * 8;
            *(u32x4*)(PV + off) = pack8(run);
            if (c < 15) { float s[8]; unpack8(*(const u32x4*)(ST + off), s); const float cd = CD[(b * 16 + c) * 32 + hh];
#pragma unroll
                for (int j = 0; j < 8; ++j) run[j] = run[j] * cd + s[j]; }
        }
    }
}

constexpr int SY_TILE = 9728, SY_TP = 1040;
static_assert(SY_TILE + 128 * SY_TP <= PTAB_OFF, "ssd_y LDS map");
__device__ __forceinline__ void phase_ssd_y(const PT& p, LAS unsigned char* lds, int tid, int lane, int wave) {
    unsigned char* ws = p.ws; unsigned char* dob = (unsigned char*)p.out;
    const int r32 = lane & 31, h = lane >> 5;
    bf16* Ycat = (bf16*)(ws + WS_YCAT); const bf16* xT = (const bf16*)(ws + WS_XT); const bf16* Bn = (const bf16*)(dob + DO_BN); const bf16* Cn = (const bf16*)(ws + WS_CN);
    const bf16* PV = (const bf16*)(dob + DO_PREV); const float* DT = (const float*)(ws + WS_DT);
    LAS float* acum = (LAS float*)lds; LAS float* dtt = acum + 1024; LAS float* ssqp = dtt + 1024; LAS float* rsT = ssqp + 256;
    LAS unsigned char* tile = lds + SY_TILE;
    for (int it = blockIdx.x; it < 128 * 4; it += gridDim.x) {
        const int bc = it >> 2, grp = it & 3, tok0 = bc * 128;
        __syncthreads();
        { const int hh = grp * 8 + wave; float d0, d1, c0, c1, tot; chunk_cumsum(DT, p.in[10], tok0, hh, lane, d0, d1, c0, c1, tot);
          acum[wave * 128 + 2 * lane] = c0; acum[wave * 128 + 2 * lane + 1] = c1; dtt[wave * 128 + 2 * lane] = d0; dtt[wave * 128 + 2 * lane + 1] = d1; }
#pragma unroll 4
        for (int i = 0; i < 16; ++i) { const int pid = tid + 512 * i, row = pid >> 6, c8 = pid & 63;
            *(LAS u32x4*)(tile + row * SY_TP + 16 * c8) = *(const u32x4*)(Ycat + ((size_t)tok0 + row) * 4096 + 2048 + grp * 512 + 8 * c8); }
        __syncthreads();
        const int pb = wave >> 2, lb = wave & 3, l = lb * 32 + r32; const size_t tok = (size_t)tok0 + l;
        bf16x8 cf[8];
#pragma unroll
        for (int st = 0; st < 8; ++st) cf[st] = ld_frag16(Cn + tok * 512 + grp * 128 + 16 * st + 8 * h);
        f32x16 X[4];
#pragma unroll
        for (int sb = 0; sb < 4; ++sb) {
#pragma unroll
            for (int i = 0; i < 16; ++i) X[sb][i] = 0.f;
            if (sb <= lb) {
#pragma unroll
                for (int st = 0; st < 8; ++st) X[sb] = mfma32(ld_frag16(Bn + ((size_t)tok0 + sb * 32 + r32) * 512 + grp * 128 + 16 * st + 8 * h), cf[st], X[sb]);
            }
        }
        float ssq = 0.f;
#pragma unroll 2
        for (int r = 0; r < 8; ++r) {
            const int hh = grp * 8 + r;
            f32x16 acc;
#pragma unroll
            for (int i = 0; i < 16; ++i) acc[i] = 0.f;
            const bf16* pp = PV + ((size_t)(bc * 32 + hh) * 64 + pb * 32 + r32) * 128 + 8 * h;
#pragma unroll
            for (int st = 0; st < 8; ++st) acc = mfma32(ld_frag16(pp + 16 * st), cf[st], acc);
            const float al = acum[r * 128 + l]; const float el = __expf(al); const float dsk = p.in[11][hh];
#pragma unroll
            for (int i = 0; i < 16; ++i) acc[i] *= el;
            const bf16* xrow = xT + ((size_t)bc * 2048 + hh * 64 + pb * 32 + r32) * 128 + 4 * h;
#pragma unroll
            for (int sb = 0; sb < 4; ++sb) {
                if (sb <= lb) {
                    f32x16 mm;
#pragma unroll
                    for (int qd = 0; qd < 4; ++qd) {
                        const int s0 = sb * 32 + 8 * qd + 4 * h;
                        const f32x4 as = *(const LAS f32x4*)(acum + r * 128 + s0), ds = *(const LAS f32x4*)(dtt + r * 128 + s0);
#pragma unroll
                        for (int j = 0; j < 4; ++j) { const float v = X[sb][4 * qd + j] * __expf(al - as[j]) * ds[j]; mm[4 * qd + j] = (s0 + j < l) ? v : ((s0 + j == l) ? v + dsk : 0.f); }
                    }
#pragma unroll
                    for (int s2 = 0; s2 < 2; ++s2) acc = mfma32(ld_frag8x2(xrow + sb * 32 + 16 * s2), pack_frag(mm, s2), acc);
                }
            }
#pragma unroll
            for (int qd = 0; qd < 4; ++qd) {
                LAS u32x2* yp = (LAS u32x2*)(tile + l * SY_TP + (r * 64 + pb * 32 + 8 * qd + 4 * h) * 2); const u32x2 zz = *yp;
                const float y0 = acc[4 * qd] * bflo(zz.x), y1 = acc[4 * qd + 1] * bfhi(zz.x);
                const float y2 = acc[4 * qd + 2] * bflo(zz.y), y3 = acc[4 * qd + 3] * bfhi(zz.y);
                ssq += (y0 * y0 + y1 * y1) + (y2 * y2 + y3 * y3);
                u32x2 w; w.x = pk2(y0, y1); w.y = pk2(y2, y3); *yp = w;
            }
        }
        ssq += __shfl_xor(ssq, 32);
        if (h == 0) ssqp[pb * 128 + l] = ssq;
        __syncthreads();
        if (pb == 0 && h == 0) rsT[l] = rsqrtf((ssqp[l] + ssqp[128 + l]) * (1.f / 512.f) + EPS);
        __syncthreads();
#pragma unroll 4
        for (int i = 0; i < 16; ++i) { const int pid = tid + 512 * i, row = pid >> 6, c8 = pid & 63; const int ch = grp * 512 + 8 * c8;
            float f[8]; unpack8(*(const LAS u32x4*)(tile + row * SY_TP + 16 * c8), f);
            const float rs = rsT[row]; const f32x4 g0 = *(const f32x4*)(p.in[12] + ch), g1 = *(const f32x4*)(p.in[12] + ch + 4);
            f[0] *= rs * g0.x; f[1] *= rs * g0.y; f[2] *= rs * g0.z; f[3] *= rs * g0.w; f[4] *= rs * g1.x; f[5] *= rs * g1.y; f[6] *= rs * g1.z; f[7] *= rs * g1.w;
            *(u32x4*)(Ycat + ((size_t)tok0 + row) * 4096 + 2048 + ch) = pack8(f); }
    }
}

constexpr int AK_PITCH = 272, AV_PITCH = 272, A_KOFF = 0, A_VOFF = 128 * AK_PITCH, A_STAGE = A_VOFF + 128 * AV_PITCH;
static_assert(2 * A_STAGE <= PTAB_OFF && 4 * 16384 <= A_STAGE, "attention LDS map");
__device__ __forceinline__ float max3f(float a, float b, float c) { return fmaxf(fmaxf(a, b), c); }
__device__ __forceinline__ void attn_unit(const PT& p, LAS unsigned char* lds, int tid, int lane, int wave, int b, int hd, int qb, float lam) {
    unsigned char* ws = p.ws;
    const bf16* Qb = (const bf16*)(ws + WS_Q); const bf16* Kb = (const bf16*)(ws + WS_K); const bf16* Vb = (const bf16*)(ws + WS_VV); const bf16* Gb = (const bf16*)((unsigned char*)p.out + DO_G);
    bf16* Ob = (bf16*)(ws + WS_O);
    const int r32 = lane & 31, h = lane >> 5, mp = wave >> 2, wq = wave & 3;
    const int qw0 = qb * 128 + 32 * wq, q = qw0 + r32; const unsigned tokq = (unsigned)(b * SEQ + q), tokb = (unsigned)(b * SEQ);
    const float slope2 = fexp2(-0.5f * (float)(hd + 1)) * LOG2E;
    bf16x8 qf[4];
#pragma unroll
    for (int ds = 0; ds < 4; ++ds) qf[ds] = ld_frag16(Qb + (tokq * 2048u + (unsigned)(hd * 128 + mp * 64 + 16 * ds + 8 * h)));
    float mrun = -INFINITY, lsum = 0.f;
    f32x16 oT[4];
#pragma unroll
    for (int db = 0; db < 4; ++db)
#pragma unroll
        for (int i = 0; i < 16; ++i) oT[db][i] = 0.f;
    const int ntiles = qb + 1;
    u32x4 preV[4], preK[4];
#define PREFETCH(t) do { \
        _Pragma("unroll") for (int i_ = 0; i_ < 4; ++i_) { const int pid_ = tid + 512 * i_, row_ = pid_ >> 4, c16_ = pid_ & 15; const unsigned go_ = (tokb + (unsigned)((t) * 128 + row_)) * 2048u + (unsigned)(hd * 128 + 8 * c16_); \
            preK[i_] = *(const u32x4*)(Kb + go_); preV[i_] = *(const u32x4*)(Vb + go_); } \
    } while (0)
    PREFETCH(0);
    const LAS unsigned char* kbase0 = lds + A_KOFF + r32 * AK_PITCH + (mp * 64 + 8 * h) * 2;
    const LAS unsigned char* vbase0 = lds + A_VOFF + (4 * h + ((lane & 15) >> 2)) * AV_PITCH + ((lane >> 4) & 1) * 32 + (lane & 3) * 8;
#define STAGE_WRITE(stg) do { \
        _Pragma("unroll") for (int i_ = 0; i_ < 4; ++i_) { const int pid_ = tid + 512 * i_, row_ = pid_ >> 4, c16_ = pid_ & 15; \
            *(LAS u32x4*)(lds + (stg) * A_STAGE + A_KOFF + row_ * AK_PITCH + 16 * c16_) = preK[i_]; *(LAS u32x4*)(lds + (stg) * A_STAGE + A_VOFF + row_ * AV_PITCH + 16 * c16_) = preV[i_]; } \
    } while (0)
    __syncthreads();
    STAGE_WRITE(0);
    asm volatile("" : "+v"(qf[0]), "+v"(qf[1]), "+v"(qf[2]), "+v"(qf[3]));
    __syncthreads();
#pragma unroll 1
    for (int t = 0; t < ntiles; ++t) {
        const int stg = t & 1;
        if (t + 1 < ntiles) PREFETCH(t + 1);
        const LAS unsigned char* kbase = kbase0 + stg * A_STAGE; const LAS unsigned char* vbase = vbase0 + stg * A_STAGE;
        const bool diag = (t == qb);
#pragma unroll 2
        for (int sub = 0; sub < 2; ++sub) {
            const int nact = diag ? min(2, max(0, wq + 1 - 2 * sub)) : 2;
            if (nact > 0) {
                float sl = slope2; asm volatile("" : "+v"(sl));
                const float bq = sl * (float)(t * 128 + sub * 64 + 4 * h - q);
                const LAS unsigned char* kb0 = kbase + sub * 64 * AK_PITCH; const LAS unsigned char* vb0 = vbase + sub * 64 * AV_PITCH;
                f32x16 s[2];
#pragma unroll
                for (int kb = 0; kb < 2; ++kb) {
                    if (kb < nact) {
                        const float bk = bq + sl * (float)(32 * kb);
#pragma unroll
                        for (int i = 0; i < 16; ++i) s[kb][i] = __builtin_fmaf(sl, (float)((i & 3) + 8 * (i >> 2)), bk);
#pragma unroll
                        for (int ds = 0; ds < 4; ++ds) s[kb] = mfma32(__builtin_bit_cast(bf16x8, *(const LAS u32x4*)(kb0 + kb * 32 * AK_PITCH + ds * 32)), qf[ds], s[kb]);
                    } else {
#pragma unroll
                        for (int i = 0; i < 16; ++i) s[kb][i] = -INFINITY;
                    }
                }
                if (diag) {
#pragma unroll
                    for (int kb = 0; kb < 2; ++kb) if (2 * sub + kb == wq) {
#pragma unroll
                        for (int i = 0; i < 16; ++i) if (crow(i, h) > r32) s[kb][i] = -INFINITY; }
                }
                float mx = -INFINITY;
#pragma unroll
                for (int kb = 0; kb < 2; ++kb)
#pragma unroll
                    for (int i = 0; i < 16; i += 2) mx = max3f(mx, s[kb][i], s[kb][i + 1]);
                mx = fmaxf(mx, __shfl_xor(mx, 32));
                const float mnew = fmaxf(mrun, mx), alpha = fexp2(mrun - mnew); mrun = mnew;
                float rs0 = 0.f, rs1 = 0.f, rs2 = 0.f, rs3 = 0.f;
#pragma unroll
                for (int kb = 0; kb < 2; ++kb)
#pragma unroll
                    for (int i = 0; i < 16; i += 4) { s[kb][i] = fexp2(s[kb][i] - mnew); s[kb][i + 1] = fexp2(s[kb][i + 1] - mnew); s[kb][i + 2] = fexp2(s[kb][i + 2] - mnew); s[kb][i + 3] = fexp2(s[kb][i + 3] - mnew);
                        rs0 += s[kb][i]; rs1 += s[kb][i + 1]; rs2 += s[kb][i + 2]; rs3 += s[kb][i + 3]; }
                lsum = lsum * alpha + ((rs0 + rs1) + (rs2 + rs3));
                if (__builtin_amdgcn_ballot_w64(alpha != 1.0f) != 0ull) {
#pragma unroll
                    for (int db = 0; db < 4; ++db)
#pragma unroll
                        for (int i = 0; i < 16; ++i) oT[db][i] *= alpha;
                }
#pragma unroll
                for (int kb = 0; kb < 2; ++kb) if (kb < nact) {
#pragma unroll
                    for (int s2 = 0; s2 < 2; ++s2) {
                        const bf16x8 pf = pack_frag(s[kb], s2);
#pragma unroll
                        for (int db = 0; db < 4; ++db) {
                            const LAS unsigned char* vp = vb0 + (kb * 32 + 16 * s2) * AV_PITCH + db * 64;
                            const v4i16_t lo = __builtin_amdgcn_ds_read_tr16_b64_v4i16((LAS v4i16_t*)vp), hi = __builtin_amdgcn_ds_read_tr16_b64_v4i16((LAS v4i16_t*)(vp + 8 * AV_PITCH));
                            const bf16x8 vf = {lo[0], lo[1], lo[2], lo[3], hi[0], hi[1], hi[2], hi[3]};
                            oT[db] = mfma32(vf, pf, oT[db]);
                        }
                    }
                }
            }
        }
        if (t + 1 < ntiles) STAGE_WRITE(stg ^ 1);
        __syncthreads();
    }
#undef PREFETCH
#undef STAGE_WRITE
    const float lt = lsum + __shfl_xor(lsum, 32);
    LAS float* xch = (LAS float*)(lds + (ntiles & 1) * A_STAGE + wq * 16384);
    if (mp == 1) { const float sc = lam / lt;
#pragma unroll
        for (int db = 0; db < 4; ++db)
#pragma unroll
            for (int i = 0; i < 16; ++i) xch[(db * 16 + i) * 64 + lane] = oT[db][i] * sc; }
    __syncthreads();
    if (mp == 0) {
        const float i1 = 1.f / lt; float ss = 0.f;
#pragma unroll
        for (int db = 0; db < 4; ++db)
#pragma unroll
            for (int i = 0; i < 16; ++i) { const float o = oT[db][i] * i1 - xch[(db * 16 + i) * 64 + lane]; oT[db][i] = o; ss += o * o; }
        ss += __shfl_xor(ss, 32);
        const float rn = rsqrtf(ss * (1.f / 128.f) + EPS) * (1.f - LAMBDA_INIT);
#pragma unroll
        for (int db = 0; db < 4; ++db)
#pragma unroll
            for (int qd = 0; qd < 4; ++qd) {
                const int d = db * 32 + 8 * qd + 4 * h; const unsigned off = tokq * 2048u + (unsigned)(hd * 128 + d);
                const u32x2 gg = *(const u32x2*)(Gb + off); const f32x4 sg = *(const f32x4*)(p.in[20] + d);
                u32x2 w; w.x = pk2(oT[db][4 * qd] * rn * sg.x * bflo(gg.x), oT[db][4 * qd + 1] * rn * sg.y * bfhi(gg.x));
                w.y = pk2(oT[db][4 * qd + 2] * rn * sg.z * bflo(gg.y), oT[db][4 * qd + 3] * rn * sg.w * bfhi(gg.y));
                *(u32x2*)(Ob + off) = w;
            }
    }
}

__device__ __forceinline__ void phase_attn(const PT& p, LAS unsigned char* lds, int tid, int lane, int wave) {
    const float s1 = wave_sum(p.in[16][lane] * p.in[17][lane]), s2 = wave_sum(p.in[18][lane] * p.in[19][lane]);
    const float lam = __expf(s1) - __expf(s2) + LAMBDA_INIT;
#pragma unroll 1
    for (int u = blockIdx.x; u < NBATCH * 16 * 8; u += gridDim.x) {
        const int j = u & 7, hd = (u >> 3) & 15, b = u >> 7;
#pragma unroll 1
        for (int k = 0; k < 2; ++k) attn_unit(p, lds, tid, lane, wave, b, hd, k == 0 ? 15 - j : j, lam);
    }
}

__device__ __forceinline__ void phase_final(const PT& p, int lane, int wave) {
    const float* st2 = (const float*)(p.ws + WS_ST2); const float* g = p.in[22]; const bf16* X2 = (const bf16*)(p.ws + WS_X2B);
    for (int m = blockIdx.x * 8 + wave; m < M; m += gridDim.x * 8) {
        const float rs = rsqrtf(st2[m] * (1.f / 2048.f) + EPS);
        const u32x4* xr = (const u32x4*)(X2 + (size_t)m * 2048) + lane; f32x4* orow = (f32x4*)(p.out + (size_t)m * 2048);
#pragma unroll
        for (int j = 0; j < 4; ++j) {
            float f[8]; unpack8(xr[64 * j], f); const int c = 8 * (lane + 64 * j);
            const f32x4 g0 = *(const f32x4*)(g + c), g1 = *(const f32x4*)(g + c + 4);
            orow[(c >> 2)] = (f32x4){f[0] * rs * g0.x, f[1] * rs * g0.y, f[2] * rs * g0.z, f[3] * rs * g0.w};
            orow[(c >> 2) + 1] = (f32x4){f[4] * rs * g1.x, f[5] * rs * g1.y, f[6] * rs * g1.z, f[7] * rs * g1.w};
        }
    }
}

constexpr size_t WS_BAR = 384 * 1024;
constexpr int XBST_OFF = PTAB_OFF + 256;
typedef __attribute__((address_space(1))) unsigned gu32;
#define XB_TMO      128
#define XB_XCNT(j)  (256  + 64 * (j))
#define XB_XSUB(j)  (1280 + 64 * (j))
#define XB_XGEN(j)  (2304 + 64 * (j))
#define XB_TOP      3328
#define XB_TOPGEN   3392
#define XCD_BAR_WORDS 3456
#define XB_SPIN_CAP (1u << 18)

__device__ __forceinline__ unsigned xb_ld(unsigned* p)              { return __hip_atomic_load(p, __ATOMIC_RELAXED, __HIP_MEMORY_SCOPE_AGENT); }
__device__ __forceinline__ unsigned xb_add(unsigned* p, unsigned v) { return __hip_atomic_fetch_add(p, v, __ATOMIC_RELAXED, __HIP_MEMORY_SCOPE_AGENT); }
__device__ __forceinline__ unsigned xb_xcc_id() { return (unsigned)__builtin_amdgcn_s_getreg((3 << 11) | 20) & 0xFu; }
#define XB_SPIN(cond, bar) do { unsigned _sp = 0; while (cond) { __builtin_amdgcn_s_sleep(1); \
    if ((++_sp & 255u) == 0u) { if (xb_ld(&(bar)[XB_TMO])) break; if (_sp > XB_SPIN_CAP) { atomicAdd(&(bar)[XB_TMO], 1u); break; } } } } while (0)

struct XcdBarrier {
    unsigned* bar; unsigned x;
    volatile LAS unsigned* st;
};

__device__ __forceinline__ XcdBarrier xcd_barrier_post(unsigned* bar, volatile LAS unsigned* st) {
    XcdBarrier b; b.bar = bar; b.x = xb_xcc_id(); b.st = st;
    if (threadIdx.x == 0) (void)xb_add(&bar[XB_XCNT(b.x)], 1u);
    return b;
}
__device__ __forceinline__ void xcd_barrier_complete(unsigned* bar, unsigned x, unsigned& nloc, unsigned& nx) {
    const unsigned G = gridDim.x * gridDim.y * gridDim.z;
    unsigned sum, cnt, mine, sp = 0u;
    for (;;) {
        sum = 0u; cnt = 0u; mine = 0u;
#pragma unroll
        for (unsigned j = 0; j < 16; ++j) { const unsigned c = xb_ld(&bar[XB_XCNT(j)]); sum += c; cnt += (c > 0u) ? 1u : 0u; mine = (j == x) ? c : mine; }
        if (sum == G) break;
        __builtin_amdgcn_s_sleep(1);
        if ((++sp & 255u) == 0u) { if (xb_ld(&bar[XB_TMO])) break; if (sp > XB_SPIN_CAP) { atomicAdd(&bar[XB_TMO], 1u); break; } }
    }
    nloc = mine > 0u ? mine : 1u; nx = cnt > 0u ? cnt : 1u;
}

__device__ __forceinline__ void xcd_barrier(const XcdBarrier& b) {
    asm volatile("s_waitcnt vmcnt(0)" ::: "memory");
    __syncthreads();
    if (threadIdx.x == 0) {
        unsigned* bar = b.bar;
        __builtin_amdgcn_s_waitcnt(0);
        unsigned nloc = b.st[0], nx = b.st[1];
        if (nloc == 0u) { xcd_barrier_complete(bar, b.x, nloc, nx); b.st[0] = nloc; b.st[1] = nx; }
        const unsigned old = xb_add(&bar[XB_XSUB(b.x)], 1u);
        const unsigned gen = old / nloc;
        if (old + 1u == (gen + 1u) * nloc) {
            __builtin_amdgcn_fence(__ATOMIC_RELEASE, "agent");
            asm volatile("s_waitcnt vmcnt(0)" ::: "memory");
            const unsigned og = xb_add(&bar[XB_TOP], 1u);
            const unsigned tg = og / nx;
            if (og + 1u == (tg + 1u) * nx) xb_add(&bar[XB_TOPGEN], 1u);
            else XB_SPIN(xb_ld(&bar[XB_TOPGEN]) == tg, bar);
            __builtin_amdgcn_fence(__ATOMIC_ACQUIRE, "agent");
            xb_add(&bar[XB_XGEN(b.x)], 1u);
            asm volatile("s_waitcnt vmcnt(0)" ::: "memory");
        } else {
            XB_SPIN(xb_ld(&bar[XB_XGEN(b.x)]) == gen, bar);
            __builtin_amdgcn_fence(__ATOMIC_ACQUIRE, "agent");
            asm volatile("s_waitcnt vmcnt(0)" ::: "memory");
        }
    }
    __syncthreads();
}

__global__ void __launch_bounds__(512) fwd_megakernel(Params pa) {
    extern __shared__ __attribute__((aligned(16))) unsigned char lds_raw[];
    cg::grid_group grid = cg::this_grid();
    LAS unsigned char* lds = (LAS unsigned char*)lds_raw;
    if (threadIdx.x < 25) {
        unsigned long long v = 0;
#pragma unroll
        for (int i = 0; i < 23; ++i) if ((int)threadIdx.x == i) v = (unsigned long long)pa.in[i];
        if (threadIdx.x == 23) v = (unsigned long long)pa.out;
        if (threadIdx.x == 24) v = (unsigned long long)pa.ws;
        ((LAS unsigned long long*)(lds + PTAB_OFF))[threadIdx.x] = v;
    }
    if (threadIdx.x < 2) ((LAS unsigned*)(lds + XBST_OFF))[threadIdx.x] = 0u;
    __syncthreads();
    const XcdBarrier bar = xcd_barrier_post((unsigned*)(pa.ws + WS_BAR), (volatile LAS unsigned*)(lds + XBST_OFF));
#ifndef PHMASK
#define PHMASK 0x3ff
#endif
#define PH(n) (((PHMASK) >> (n)) & 1)
#define TLW int tid_ = threadIdx.x; asm volatile("" : "+v"(tid_)); const int tid = tid_, lane = tid & 63, wave = __builtin_amdgcn_readfirstlane(tid >> 6); (void)tid; (void)lane; (void)wave
#define GRIDV const int G = gridDim.x, c = blockIdx.x
    if (PH(0)) { PT p; TLW; phase0(p, lds, tid, lane, wave); }
    if (gridDim.x == 0x7fffffffu) grid.sync();
    xcd_barrier(bar);
    if (PH(1)) {
        PT p; GRIDV; unsigned char* ws = p.ws; unsigned char* dob = (unsigned char*)p.out;
        pg8::Gemm g{(const pg8::bf16_t*)(ws + WS_H0), (const pg8::bf16_t*)(ws + WS_W0IN), M, N0P, 2048}; pg8::StaticOrder S; S.init(M, N0P, G, c);
        EpiIn0 E{(bf16*)(ws + WS_YCAT), (bf16*)(ws + WS_V), (bf16*)(ws + WS_ZA), (bf16*)(dob + DO_XBC), (float*)(ws + WS_ST0)};
        pg8::gemm_phase<EpiIn0, pg8::StaticOrder, true, true>(lds, g, S, E);
        { TLW; dt_tasks(p, lds, lane, wave); }
    }
    xcd_barrier(bar);
    if (PH(2)) { PT p; TLW; phase_layout(p, tid); }
    xcd_barrier(bar);
    if (PH(3)) { PT p; TLW; phase_mix(p, lds, tid, lane, wave); }
    xcd_barrier(bar);
    if (PH(4)) { PT p; TLW; phase_scan(p, tid); }
    xcd_barrier(bar);
    if (PH(5)) { PT p; TLW; phase_ssd_y(p, lds, tid, lane, wave); }
    xcd_barrier(bar);
    if (PH(6)) {
        PT p; GRIDV; unsigned char* ws = p.ws;
        pg8::Gemm g{(const pg8::bf16_t*)(ws + WS_YCAT), (const pg8::bf16_t*)(ws + WS_W0OUT), M, 2048, 4096}; pg8::StaticOrder S; S.init(M, 2048, G, c);
        EpiResT<false> E{p.in[0], nullptr, (bf16*)(ws + WS_X1B), (float*)(ws + WS_ST1)};
        pg8::gemm_phase<EpiResT<false>, pg8::StaticOrder, true, true>(lds, g, S, E);
    }
    xcd_barrier(bar);
    if (PH(6)) {
        PT p; GRIDV; unsigned char* ws = p.ws; unsigned char* dob = (unsigned char*)p.out;
        pg8::Gemm g{(const pg8::bf16_t*)(ws + WS_X1B), (const pg8::bf16_t*)(ws + WS_W1IN), M, 8192, 2048}; pg8::StaticOrder S; S.init(M, 8192, G, c);
        EpiIn1 E{(bf16*)(ws + WS_Q), (bf16*)(ws + WS_K), (bf16*)(ws + WS_VV), (bf16*)(dob + DO_G), (const float*)(ws + WS_ST1)};
        pg8::gemm_phase<EpiIn1, pg8::StaticOrder, true, true>(lds, g, S, E);
    }
    xcd_barrier(bar);
    if (PH(7)) { PT p; TLW; phase_attn(p, lds, tid, lane, wave); }
    xcd_barrier(bar);
    if (PH(8)) {
        PT p; GRIDV; unsigned char* ws = p.ws;
        pg8::Gemm g{(const pg8::bf16_t*)(ws + WS_O), (const pg8::bf16_t*)(ws + WS_W1OUT), M, 2048, 2048}; pg8::StaticOrder S; S.init(M, 2048, G, c);
        EpiResT<true> E{(const void*)(ws + WS_X1B), nullptr, (bf16*)(ws + WS_X2B), (float*)(ws + WS_ST2)};
        pg8::gemm_phase<EpiResT<true>, pg8::StaticOrder, true, true>(lds, g, S, E);
    }
    xcd_barrier(bar);
    if (PH(9)) { PT p; TLW; phase_final(p, lane, wave); }
}

extern "C" void kernel_launch(void* const* d_in, const int* in_sizes, int n_in, void* d_out, int out_size, void* d_ws, size_t ws_size, hipStream_t stream) {
    static int grid = 0;
    if (grid == 0) {
        if (n_in != 23 || out_size != M * DM || ws_size < WS_END) { fprintf(stderr, "kernel_launch: unexpected shapes (n_in %d out %d ws %zu)\n", n_in, out_size, ws_size); grid = -1; return; }
        int dev = 0, cus = 0, per_cu = 0;
        hipGetDevice(&dev); hipDeviceGetAttribute(&cus, hipDeviceAttributeMultiprocessorCount, dev);
        hipFuncSetAttribute((const void*)fwd_megakernel, hipFuncAttributeMaxDynamicSharedMemorySize, LDS_BYTES);
        hipOccupancyMaxActiveBlocksPerMultiprocessor(&per_cu, (const void*)fwd_megakernel, 512, LDS_BYTES);
        if (per_cu < 1) { fprintf(stderr, "kernel_launch: occupancy query says %d blocks per CU\n", per_cu); per_cu = 1; }
        (void)hipGetLastError();
        grid = cus;
    }
    if (grid < 0) return;
    Params p{};
    for (int i = 0; i < 23; ++i) p.in[i] = (const float*)d_in[i];
    p.out = (float*)d_out; p.ws = (unsigned char*)d_ws;
    if (hipMemsetAsync((char*)d_ws + WS_BAR, 0, XCD_BAR_WORDS * 4, stream) != hipSuccess) { fprintf(stderr, "kernel_launch: memset of the barrier words failed\n"); return; }
    void* args[] = {&p};
    hipError_t e = hipLaunchCooperativeKernel((const void*)fwd_megakernel, dim3(grid), dim3(512), args, LDS_BYTES, stream);
    if (e != hipSuccess) fprintf(stderr, "cooperative launch failed: %s (grid %d)\n", hipGetErrorString(e), grid);
}
```

```cpp
#include <hip/hip_runtime.h>
#include <hip/hip_cooperative_groups.h>
#include <cstdio>
#include <cstdint>
#include <cmath>
namespace cg = cooperative_groups;
namespace pg8 {
#define PG8_LAS __attribute__((address_space(3)))
typedef unsigned short bf16_t;
typedef short bf16x8 __attribute__((ext_vector_type(8)));
typedef float f32x4 __attribute__((ext_vector_type(4)));
typedef unsigned u32x4 __attribute__((ext_vector_type(4)));
constexpr int BM = 256, BK = 64, HALF = 128, HTB = HALF * BK * 2  , STAGE_BYTES = 8 * HTB, NXCD = 8, WGM = 8;

__host__ __device__ __forceinline__ int lds_byte(int r, int c) { const int st = (r >> 4) * 2 + (c >> 5), rr = r & 15, cc = c & 31, ob = rr * 64 + cc * 2; return st * 1024 + (ob ^ (((ob >> 9) & 1) << 5)); }
__host__ __device__ __forceinline__ void stage_rc(int b, int& R, int& C) { const int st = b / 1024, sb = b % 1024, swz = sb ^ (((sb >> 9) & 1) << 5); R = (st >> 1) * 16 + swz / 64; C = (st & 1) * 32 + (swz % 64) / 2; }
__host__ __device__ __forceinline__ int perm32(int rho) { const int n = rho >> 4, i = rho & 15; return 8 * (i >> 2) + 4 * n + (i & 3); }

struct Unit { int pm, pn; };
struct Gemm { const bf16_t* A; const bf16_t* Bt; int M, N, K; };

struct StaticOrder {
    int nM, nN, nwg, G, c;
    __host__ __device__ void init(int M, int N, int G_, int c_) { nM = M / BM; nN = N / BM; nwg = nM * nN; G = G_; c = c_; }
    __host__ __device__ bool next(int i, Unit& u) const {
        const long L = (long)i * G + c; if (L >= nwg) return false;
        int wgid = (int)L; { const int q = nwg / NXCD, r = nwg % NXCD, xcd = wgid % NXCD, off = wgid / NXCD; wgid = (xcd < r ? xcd * (q + 1) : r * (q + 1) + (xcd - r) * q) + off; }
        const int nig = WGM * nN, gid = wgid / nig, fm = gid * WGM, gsz = (nM - fm) < WGM ? (nM - fm) : WGM;
        u.pm = fm + ((wgid % nig) % gsz); u.pn = (wgid % nig) / gsz; return true;
    }
    __device__ __forceinline__ void a_ready(const Unit&) const {}
    __device__ __forceinline__ void done(const Unit&) const {}
};

template <class Epi, class Sched, bool ALIGN_EPI = false, bool SP2 = false>
__device__ __forceinline__ void gemm_phase(PG8_LAS unsigned char* lds, const Gemm g, const Sched& S, const Epi& E) {
    int tid_ = threadIdx.x; asm volatile("" : "+v"(tid_));
    const int tid = tid_, wid = __builtin_amdgcn_readfirstlane(tid >> 6), lane = tid & 63, wr = wid >> 2, wc = wid & 3, fr = lane & 15, fq = lane >> 4;
    const int K = g.K, nt = K / BK;
    unsigned voffA[2], voffB[2];
#pragma unroll
    for (int i = 0; i < 2; ++i) { int R, C; stage_rc(tid * 16 + i * 8192, R, C); const int Rb = Epi::PERM ? ((R & ~31) + perm32(R & 31)) : R;
        voffA[i] = (unsigned)(R * K + C) * 2u; voffB[i] = (unsigned)(Rb * K + C) * 2u; }
    const size_t kstep = (size_t)(BK * 2);
    const size_t hstep = (size_t)HALF * K * 2;
    const size_t tstep = 2 * hstep;
    const unsigned ldsw = (unsigned)wid * 1024u;
    const int aoff = lds_byte(wr * 64 + fr, fq * 8), boff = lds_byte(wc * 32 + fr, fq * 8);
#define PG8_SA(b, h) (((b) * 2 + (h)) * HTB)
#define PG8_SB(b, h) ((4 + (b) * 2 + (h)) * HTB)
#define PG8_STAGE(bufoff, gbase, voff) do { _Pragma("unroll") for (int _i = 0; _i < 2; ++_i) \
        __builtin_amdgcn_global_load_lds((const unsigned*)((const char*)(gbase) + (voff)[_i]), (PG8_LAS unsigned*)(lds + (bufoff) + ldsw + _i * 8192), 16, 0, 0); } while (0)
#define PG8_LDA(dst, b, h) do { _Pragma("unroll") for (int m = 0; m < 4; ++m) _Pragma("unroll") for (int k = 0; k < 2; ++k) dst[m][k] = *(const PG8_LAS bf16x8*)(lds + PG8_SA(b, h) + aoff + m * 2048 + k * 1024); } while (0)
#define PG8_LDB(dst, b, h) do { _Pragma("unroll") for (int n = 0; n < 2; ++n) _Pragma("unroll") for (int k = 0; k < 2; ++k) dst[n][k] = *(const PG8_LAS bf16x8*)(lds + PG8_SB(b, h) + boff + n * 2048 + k * 1024); } while (0)
#define PG8_MMA(ai, bj, At, Bt) do { __builtin_amdgcn_s_setprio(1); _Pragma("unroll") for (int m = 0; m < 4; ++m) _Pragma("unroll") for (int n = 0; n < 2; ++n) _Pragma("unroll") for (int k = 0; k < 2; ++k) \
        acc[ai][bj][m][n] = __builtin_amdgcn_mfma_f32_16x16x32_bf16(Bt[n][k], At[m][k], acc[ai][bj][m][n], 0, 0, 0); __builtin_amdgcn_s_setprio(0); } while (0)
#define PG8_WAIT_V(n) asm volatile("s_waitcnt vmcnt(" #n ")" ::: "memory")
#define PG8_WAIT_L(n) asm volatile("s_waitcnt lgkmcnt(" #n ")" ::: "memory")
#define PG8_BAR __builtin_amdgcn_s_barrier()
#define PG8_SCHED __builtin_amdgcn_sched_barrier(0)
    Unit cur, nxt; int ui = 0;
    if (!S.next(0, cur)) return;
    f32x4 acc[2][2][4][2];
#pragma unroll
    for (int a = 0; a < 2; ++a)
#pragma unroll
        for (int b = 0; b < 2; ++b)
#pragma unroll
            for (int m = 0; m < 4; ++m)
#pragma unroll
                for (int n = 0; n < 2; ++n) acc[a][b][m][n] = (f32x4){0.f, 0.f, 0.f, 0.f};
    bf16x8 At[4][2], B0[2][2], B1[2][2];
    const char* cA = (const char*)g.A + (size_t)cur.pm * tstep; const char* cB = (const char*)g.Bt + (size_t)cur.pn * tstep;
    S.a_ready(cur);
    if constexpr (SP2) {
        PG8_STAGE(PG8_SB(0, 0), cB, voffB); PG8_STAGE(PG8_SB(0, 1), cB + hstep, voffB); PG8_STAGE(PG8_SA(0, 0), cA, voffA); PG8_STAGE(PG8_SA(0, 1), cA + hstep, voffA);
        if (wr == 1) PG8_BAR;
        PG8_WAIT_V(2); PG8_BAR;
        PG8_STAGE(PG8_SB(1, 0), cB + kstep, voffB); PG8_STAGE(PG8_SA(1, 0), cA + kstep, voffA); PG8_STAGE(PG8_SB(1, 1), cB + hstep + kstep, voffB);
        PG8_WAIT_V(6); PG8_BAR;
    } else {
        PG8_STAGE(PG8_SB(0, 0), cB, voffB); PG8_STAGE(PG8_SA(0, 0), cA, voffA); PG8_STAGE(PG8_SB(0, 1), cB + hstep, voffB); PG8_STAGE(PG8_SA(0, 1), cA + hstep, voffA);
        if (wr == 1) PG8_BAR;
        PG8_WAIT_V(4); PG8_BAR;
        PG8_STAGE(PG8_SB(1, 0), cB + kstep, voffB); PG8_STAGE(PG8_SA(1, 0), cA + kstep, voffA); PG8_STAGE(PG8_SB(1, 1), cB + hstep + kstep, voffB);
        PG8_WAIT_V(6); PG8_BAR;
    }
    for (;;) {
        const bool has_next = S.next(ui + 1, nxt);
        const char* nA = has_next ? (const char*)g.A + (size_t)nxt.pm * tstep : cA; const char* nB = has_next ? (const char*)g.Bt + (size_t)nxt.pn * tstep : cB;
        for (int t = 0; t < nt; t += 2) {
            const bool last = (t == nt - 2);
            const char* a1 = cA + (size_t)(t + 1) * kstep;
            const char* a2 = last ? nA : cA + (size_t)(t + 2) * kstep; const char* b2 = last ? nB : cB + (size_t)(t + 2) * kstep;
            const char* a3 = a2 + kstep; const char* b3 = b2 + kstep;
            if (last && has_next) S.a_ready(nxt);
            if constexpr (SP2) {
            PG8_LDB(B0, 0, 0); PG8_LDB(B1, 0, 1); PG8_SCHED; PG8_LDA(At, 0, 0); PG8_STAGE(PG8_SA(1, 1), a1 + hstep, voffA);
            PG8_WAIT_V(8); PG8_WAIT_L(0); PG8_BAR; PG8_MMA(0, 0, At, B0); PG8_MMA(0, 1, At, B1); PG8_BAR; PG8_SCHED;
            PG8_LDA(At, 0, 1); PG8_STAGE(PG8_SB(0, 0), b2, voffB); PG8_STAGE(PG8_SB(0, 1), b2 + hstep, voffB); PG8_STAGE(PG8_SA(0, 0), a2, voffA);
            PG8_WAIT_V(8); PG8_WAIT_L(0); PG8_BAR; PG8_MMA(1, 0, At, B0); PG8_MMA(1, 1, At, B1); PG8_BAR; PG8_SCHED;
            PG8_LDB(B0, 1, 0); PG8_LDB(B1, 1, 1); PG8_SCHED; PG8_LDA(At, 1, 0); PG8_STAGE(PG8_SA(0, 1), a2 + hstep, voffA);
            PG8_WAIT_V(8); PG8_WAIT_L(0); PG8_BAR; PG8_MMA(0, 0, At, B0); PG8_MMA(0, 1, At, B1); PG8_BAR; PG8_SCHED;
            PG8_LDA(At, 1, 1); PG8_STAGE(PG8_SB(1, 0), b3, voffB); PG8_STAGE(PG8_SB(1, 1), b3 + hstep, voffB); PG8_STAGE(PG8_SA(1, 0), a3, voffA);
            PG8_WAIT_V(8); PG8_WAIT_L(0); PG8_BAR; PG8_MMA(1, 0, At, B0); PG8_MMA(1, 1, At, B1); PG8_BAR; PG8_SCHED;
            } else {
            PG8_LDB(B0, 0, 0); PG8_SCHED; PG8_LDA(At, 0, 0); PG8_STAGE(PG8_SA(1, 1), a1 + hstep, voffA);
            PG8_WAIT_L(8); PG8_BAR; PG8_WAIT_L(0); PG8_MMA(0, 0, At, B0); PG8_BAR; PG8_SCHED;
            PG8_LDB(B1, 0, 1); PG8_STAGE(PG8_SB(0, 0), b2, voffB);
            PG8_BAR; PG8_WAIT_L(0); PG8_MMA(0, 1, At, B1); PG8_BAR;
            PG8_LDA(At, 0, 1); PG8_STAGE(PG8_SA(0, 0), a2, voffA);
            PG8_BAR; PG8_WAIT_L(0); PG8_MMA(1, 0, At, B0); PG8_BAR; PG8_SCHED;
            PG8_STAGE(PG8_SB(0, 1), b2 + hstep, voffB);
            PG8_WAIT_V(6); PG8_BAR; PG8_MMA(1, 1, At, B1); PG8_BAR;
            PG8_LDB(B0, 1, 0); PG8_SCHED; PG8_LDA(At, 1, 0); PG8_STAGE(PG8_SA(0, 1), a2 + hstep, voffA);
            PG8_WAIT_L(8); PG8_BAR; PG8_WAIT_L(0); PG8_MMA(0, 0, At, B0); PG8_BAR; PG8_SCHED;
            PG8_LDB(B1, 1, 1); PG8_STAGE(PG8_SB(1, 0), b3, voffB);
            PG8_BAR; PG8_WAIT_L(0); PG8_MMA(0, 1, At, B1); PG8_BAR;
            PG8_LDA(At, 1, 1); PG8_STAGE(PG8_SA(1, 0), a3, voffA);
            PG8_BAR; PG8_WAIT_L(0); PG8_MMA(1, 0, At, B0); PG8_BAR; PG8_SCHED;
            PG8_STAGE(PG8_SB(1, 1), b3 + hstep, voffB);
            PG8_WAIT_V(6); PG8_BAR; PG8_MMA(1, 1, At, B1); PG8_BAR;
            }
        }
        if constexpr (ALIGN_EPI) { if (wr == 0) PG8_BAR; }
        if constexpr (!Epi::AFTER_DRAIN) { E(acc, cur, wr, wc, fr, fq); S.done(cur); }
        if (!has_next) break;
#pragma unroll
        for (int a = 0; a < 2; ++a)
#pragma unroll
            for (int b = 0; b < 2; ++b)
#pragma unroll
                for (int m = 0; m < 4; ++m)
#pragma unroll
                    for (int n = 0; n < 2; ++n) acc[a][b][m][n] = (f32x4){0.f, 0.f, 0.f, 0.f};
        cur = nxt; cA = nA; cB = nB; ++ui;
        if constexpr (ALIGN_EPI) { if (wr == 1) PG8_BAR; }
    }
    PG8_WAIT_V(0);
    if constexpr (!ALIGN_EPI) { if (wr == 0) PG8_BAR; }
    PG8_BAR;
    if constexpr (Epi::AFTER_DRAIN) { E.fused(acc, cur, wr, wc, fr, fq, lds, wid, lane); S.done(cur); }
#undef PG8_SA
#undef PG8_SB
#undef PG8_STAGE
#undef PG8_LDA
#undef PG8_LDB
#undef PG8_MMA
#undef PG8_WAIT_V
#undef PG8_WAIT_L
#undef PG8_BAR
#undef PG8_SCHED
}
}

#define LAS __attribute__((address_space(3)))
typedef unsigned short bf16;
typedef unsigned u32x4 __attribute__((ext_vector_type(4)));
typedef unsigned u32x2 __attribute__((ext_vector_type(2)));
typedef float f32x4 __attribute__((ext_vector_type(4)));
typedef float f32x16 __attribute__((ext_vector_type(16)));
typedef short bf16x8 __attribute__((ext_vector_type(8)));
typedef short v4i16_t __attribute__((ext_vector_type(4)));

constexpr int M = 16384, DM = 2048, SEQ = 2048, NBATCH = 8, NCH = 16;
constexpr int N0P = 11264, N0R = 11296;
constexpr float EPS = 1e-5f;
constexpr float LOG2E = 1.4426950408889634f;
constexpr float QSCALE = 0.125f * LOG2E;
constexpr float LAMBDA_INIT = 0.35550906f;
constexpr size_t MiB = 1u << 20;
constexpr size_t WS_ST0 = 0, WS_ST1 = 128 * 1024, WS_ST2 = 192 * 1024, WS_CD = 256 * 1024, WS_LAM = 300 * 1024;
constexpr size_t WS_RS0 = 320 * 1024;
constexpr size_t WS_DT = 1 * MiB, WS_WSP = 3 * MiB, WS_W0IN = 4 * MiB, WS_W0OUT = 49 * MiB, WS_W1IN = 65 * MiB, WS_W1OUT = 97 * MiB;
constexpr size_t WS_YCAT = 105 * MiB, WS_ZA = 233 * MiB, WS_V = 297 * MiB, WS_H0 = 361 * MiB, WS_XT = 425 * MiB, WS_CN = 489 * MiB, WS_END = 505 * MiB;
constexpr size_t WS_Q = WS_YCAT, WS_K = WS_YCAT + 64 * MiB, WS_X1 = WS_ZA, WS_STATES = WS_V, WS_VT = WS_H0, WS_X1B = WS_H0, WS_O = WS_ZA, WS_VV = WS_XT, WS_X2B = WS_YCAT;
constexpr size_t DO_XBC = 0, DO_BN = 96 * MiB, DO_BT = 112 * MiB, DO_PREV = 0, DO_G = 0;
constexpr int LDS_BYTES = 147456;
constexpr int ST_BOFF = 4096;
constexpr int GM_UOFF = 128 * 272, GM_ZOFF = 2 * 128 * 272, GM_WOFF = 3 * 128 * 272;
static_assert(4 * 128 * 272 <= LDS_BYTES - 512, "gMLP LDS map");

__device__ __forceinline__ unsigned pk2(float lo, float hi) {
    typedef float f2 __attribute__((ext_vector_type(2))); typedef __bf16 b2 __attribute__((ext_vector_type(2)));
    f2 v = {lo, hi}; b2 b = __builtin_convertvector(v, b2); return __builtin_bit_cast(unsigned, b);
}
__device__ __forceinline__ float bflo(unsigned u) { return __uint_as_float(u << 16); }
__device__ __forceinline__ float bfhi(unsigned u) { return __uint_as_float(u & 0xffff0000u); }
__device__ __forceinline__ void unpack8(u32x4 r, float* f) { f[0] = bflo(r.x); f[1] = bfhi(r.x); f[2] = bflo(r.y); f[3] = bfhi(r.y); f[4] = bflo(r.z); f[5] = bfhi(r.z); f[6] = bflo(r.w); f[7] = bfhi(r.w); }
__device__ __forceinline__ u32x4 pack8(const float* f) { u32x4 o; o.x = pk2(f[0], f[1]); o.y = pk2(f[2], f[3]); o.z = pk2(f[4], f[5]); o.w = pk2(f[6], f[7]); return o; }
__device__ __forceinline__ float fexp2(float x) { return __builtin_amdgcn_exp2f(x); }
__device__ __forceinline__ float gelu_f(float x) { const float z = 1.5957691216057308f * (x + 0.044715f * x * x * x); return x * __builtin_amdgcn_rcpf(1.0f + __expf(-z)); }
__device__ __forceinline__ float silu_f(float x) { return x * __builtin_amdgcn_rcpf(1.0f + __expf(-x)); }
__device__ __forceinline__ int crow(int r, int h) { return (r & 3) + 8 * (r >> 2) + 4 * h; }
__device__ __forceinline__ f32x16 mfma32(bf16x8 a, bf16x8 b, f32x16 c) { return __builtin_amdgcn_mfma_f32_32x32x16_bf16(a, b, c, 0, 0, 0); }
__device__ __forceinline__ bf16x8 ld_frag16(const bf16* p) { return __builtin_bit_cast(bf16x8, *(const u32x4*)p); }
__device__ __forceinline__ bf16x8 ld_frag8x2(const bf16* p) { const u32x2 lo = *(const u32x2*)p, hi = *(const u32x2*)(p + 8); u32x4 v; v.x = lo.x; v.y = lo.y; v.z = hi.x; v.w = hi.y; return __builtin_bit_cast(bf16x8, v); }
__device__ __forceinline__ bf16x8 pack_frag(const f32x16& x, int s) {
    u32x4 v; v.x = pk2(x[8 * s], x[8 * s + 1]); v.y = pk2(x[8 * s + 2], x[8 * s + 3]); v.z = pk2(x[8 * s + 4], x[8 * s + 5]); v.w = pk2(x[8 * s + 6], x[8 * s + 7]); return __builtin_bit_cast(bf16x8, v);
}
__device__ __forceinline__ float wave_sum(float v) {
#pragma unroll
    for (int o = 1; o < 64; o <<= 1) v += __shfl_xor(v, o);
    return v;
}
#define LDS_WAIT() asm volatile("s_waitcnt lgkmcnt(0)" ::: "memory")
__device__ __forceinline__ void atomic_addf(float* p, float v) { __hip_atomic_fetch_add(p, v, __ATOMIC_RELAXED, __HIP_MEMORY_SCOPE_AGENT); }

struct Params { const float* in[23]; float* out; unsigned char* ws; };
constexpr int PTAB_OFF = LDS_BYTES - 512;
__device__ __forceinline__ unsigned long long ptab_get(int i) {
    const unsigned long long v = ((const LAS unsigned long long*)(PTAB_OFF))[i];
    const unsigned lo = __builtin_amdgcn_readfirstlane((unsigned)v), hi = __builtin_amdgcn_readfirstlane((unsigned)(v >> 32));
    return ((unsigned long long)hi << 32) | lo;
}
struct PT {
    struct InTab { __device__ __forceinline__ const float* operator[](int i) const { return (const float*)(const __attribute__((address_space(1))) float*)ptab_get(i); } } in;
    float* out; unsigned char* ws;
    __device__ __forceinline__ PT() { out = (float*)(__attribute__((address_space(1))) float*)ptab_get(23); ws = (unsigned char*)(__attribute__((address_space(1))) unsigned char*)ptab_get(24); }
};

template <int ACT>
__device__ __forceinline__ void epi_tile_bf16(const f32x4 (&acc)[2][2][4][2], bf16* base, int pitch, int col0, int row0, float sc) {
#pragma unroll
    for (int ai = 0; ai < 2; ++ai)
#pragma unroll
        for (int m = 0; m < 4; ++m) {
            bf16* rowp = base + (size_t)(row0 + ai * 128 + m * 16) * pitch + col0;
#pragma unroll
            for (int bj = 0; bj < 2; ++bj) {
                float v[8];
#pragma unroll
                for (int j = 0; j < 4; ++j) { v[j] = acc[ai][bj][m][0][j]; v[4 + j] = acc[ai][bj][m][1][j]; }
#pragma unroll
                for (int j = 0; j < 8; ++j) { if (ACT == 1) v[j] = gelu_f(v[j]); else if (ACT == 2) v[j] = silu_f(v[j]); else if (ACT == 3) v[j] *= sc; }
                *(u32x4*)(rowp + bj * 128) = pack8(v);
            }
        }
}

struct EpiIn0 {
    static constexpr bool PERM = true, AFTER_DRAIN = false;
    bf16 *ycat, *vbuf, *za, *xbc; float* stats0;
    __device__ __forceinline__ void operator()(const f32x4 (&acc)[2][2][4][2], const pg8::Unit& u, int wr, int wc, int fr, int fq) const {
        const int pn = u.pn, row0 = u.pm * 256 + wr * 64 + fr, cl = wc * 32 + 8 * fq;
        if (pn < 8) { epi_tile_bf16<1>(acc, ycat, 4096, pn * 256 + cl, row0, 1.f); }
        else if (pn < 16) {
#pragma unroll
            for (int ai = 0; ai < 2; ++ai)
#pragma unroll
                for (int m = 0; m < 4; ++m) {
                    const int row = row0 + ai * 128 + m * 16;
                    bf16* rowp = vbuf + (size_t)row * 2048 + (pn - 8) * 256 + cl;
                    float s = 0.f, ss = 0.f;
#pragma unroll
                    for (int bj = 0; bj < 2; ++bj) {
                        float v[8];
#pragma unroll
                        for (int j = 0; j < 4; ++j) { v[j] = gelu_f(acc[ai][bj][m][0][j]); v[4 + j] = gelu_f(acc[ai][bj][m][1][j]); }
#pragma unroll
                        for (int j = 0; j < 8; ++j) { s += v[j]; ss += v[j] * v[j]; }
                        *(u32x4*)(rowp + bj * 128) = pack8(v);
                    }
                    s += __shfl_xor(s, 16); s += __shfl_xor(s, 32); ss += __shfl_xor(ss, 16); ss += __shfl_xor(ss, 32);
                    if (fq == 0) { atomic_addf(stats0 + 2 * row, s); atomic_addf(stats0 + 2 * row + 1, ss); }
                }
        }
        else if (pn < 24) { epi_tile_bf16<2>(acc, za, 2048, (pn - 16) * 256 + cl, row0, 1.f); }
        else if (pn < 32) { epi_tile_bf16<2>(acc, ycat, 4096, 2048 + (pn - 24) * 256 + cl, row0, 1.f); }
        else { epi_tile_bf16<0>(acc, xbc, 3072, (pn - 32) * 256 + cl, row0, 1.f); }
    }
};

__device__ __forceinline__ void dt_tasks(const PT& p, LAS unsigned char* lds, int lane, int wave) {
    unsigned char* ws = p.ws; const bf16* H0 = (const bf16*)(ws + WS_H0); const bf16* Wdt = (const bf16*)(ws + WS_W0IN) + (size_t)11264 * 2048; float* DT = (float*)(ws + WS_DT);
    const int r32 = lane & 31, h = lane >> 5, kq = wave & 3;
    for (int base = blockIdx.x * 2; base < 512; base += gridDim.x * 2) {
        const int task = base + (wave >> 2);
        const bf16* ap = Wdt + (size_t)r32 * 2048 + 512 * kq + 8 * h; const bf16* bp = H0 + (size_t)(task * 32 + r32) * 2048 + 512 * kq + 8 * h;
        f32x16 acc;
#pragma unroll
        for (int i = 0; i < 16; ++i) acc[i] = 0.f;
#pragma unroll 8
        for (int st = 0; st < 32; ++st) acc = mfma32(ld_frag16(ap + 16 * st), ld_frag16(bp + 16 * st), acc);
        LAS float* part = (LAS float*)lds + wave * 1024;
        __syncthreads();
        if (kq != 0) {
#pragma unroll
            for (int i = 0; i < 16; ++i) part[i * 64 + lane] = acc[i]; }
        __syncthreads();
        if (kq == 0) {
#pragma unroll
            for (int i = 0; i < 16; ++i) acc[i] += part[1024 + i * 64 + lane] + part[2048 + i * 64 + lane] + part[3072 + i * 64 + lane];
#pragma unroll
            for (int qd = 0; qd < 4; ++qd) {
                const int j0 = 8 * qd + 4 * h; const f32x4 bb = *(const f32x4*)(p.in[9] + j0); f32x4 v;
#pragma unroll
                for (int j = 0; j < 4; ++j) { const float x = acc[4 * qd + j] + bb[j]; v[j] = x > 20.f ? x : log1pf(__expf(x)); }
                *(f32x4*)(DT + (size_t)(task * 32 + r32) * 32 + j0) = v;
            }
        }
    }
}

template <int RMODE> struct EpiResT {
    static constexpr bool PERM = true, AFTER_DRAIN = false;
    const void* resid; float* outf; bf16* outb; float* stats; const float* rs0; const float* g0; const float* xf;
    __device__ __forceinline__ void operator()(const f32x4 (&acc)[2][2][4][2], const pg8::Unit& u, int wr, int wc, int fr, int fq) const {
        const int row0 = u.pm * 256 + wr * 64 + fr, col0 = u.pn * 256 + wc * 32 + 8 * fq;
        float gi[2][8]; unsigned gz = 0u;
        if (RMODE == 2) {
#pragma unroll
            for (int bj = 0; bj < 2; ++bj)
#pragma unroll
                for (int j = 0; j < 8; ++j) { const float g = g0[col0 + bj * 128 + j]; if (g == 0.f) gz |= 1u << (bj * 8 + j); gi[bj][j] = __builtin_amdgcn_rcpf(g); }
        }
#pragma unroll
        for (int ai = 0; ai < 2; ++ai)
#pragma unroll
            for (int m = 0; m < 4; ++m) {
                const int row = row0 + ai * 128 + m * 16; const size_t off = (size_t)row * 2048 + col0;
                float ss = 0.f, ri = 1.f;
                if (RMODE == 2) ri = __builtin_amdgcn_rcpf(rs0[row]);
#pragma unroll
                for (int bj = 0; bj < 2; ++bj) {
                    f32x4 r0, r1;
                    if (RMODE != 0) { float f[8]; unpack8(*(const u32x4*)((const bf16*)resid + off + bj * 128), f);
                        if (RMODE == 2) {
#pragma unroll
                            for (int j = 0; j < 8; ++j) f[j] *= ri * gi[bj][j];
                            if (gz != 0u) {
#pragma unroll
                                for (int j = 0; j < 8; ++j) if ((gz >> (bj * 8 + j)) & 1u) f[j] = xf[off + bj * 128 + j]; } }
                        r0 = (f32x4){f[0], f[1], f[2], f[3]}; r1 = (f32x4){f[4], f[5], f[6], f[7]}; }
                    else { r0 = *(const f32x4*)((const float*)resid + off + bj * 128); r1 = *(const f32x4*)((const float*)resid + off + bj * 128 + 4); }
                    r0 = r0 + acc[ai][bj][m][0]; r1 = r1 + acc[ai][bj][m][1];
                    if (outf) { *(f32x4*)(outf + off + bj * 128) = r0; *(f32x4*)(outf + off + bj * 128 + 4) = r1; }
                    ss += (r0[0] * r0[0] + r0[1] * r0[1]) + (r0[2] * r0[2] + r0[3] * r0[3]) + (r1[0] * r1[0] + r1[1] * r1[1]) + (r1[2] * r1[2] + r1[3] * r1[3]);
                    if (outb) { u32x4 w; w.x = pk2(r0[0], r0[1]); w.y = pk2(r0[2], r0[3]); w.z = pk2(r1[0], r1[1]); w.w = pk2(r1[2], r1[3]); *(u32x4*)(outb + off + bj * 128) = w; }
                }
                ss += __shfl_xor(ss, 16); ss += __shfl_xor(ss, 32);
                if (fq == 0) atomic_addf(stats + row, ss);
            }
    }
};

struct EpiIn1 {
    static constexpr bool PERM = true, AFTER_DRAIN = false;
    bf16 *q, *k, *v, *g; const float* stats1;
    __device__ __forceinline__ void operator()(const f32x4 (&acc)[2][2][4][2], const pg8::Unit& u, int wr, int wc, int fr, int fq) const {
        const int seg = u.pn >> 3, row0 = u.pm * 256 + wr * 64 + fr, col0 = (u.pn & 7) * 256 + wc * 32 + 8 * fq;
        bf16* base = seg == 0 ? q : (seg == 1 ? k : (seg == 2 ? v : g));
        const float sc = seg == 0 ? QSCALE : 1.f;
#pragma unroll
        for (int ai = 0; ai < 2; ++ai)
#pragma unroll
            for (int m = 0; m < 4; ++m) {
                const int row = row0 + ai * 128 + m * 16;
                const float rs = rsqrtf(stats1[row] * (1.f / 2048.f) + EPS) * sc;
                bf16* rowp = base + (size_t)row * 2048 + col0;
#pragma unroll
                for (int bj = 0; bj < 2; ++bj) {
                    float v8[8];
#pragma unroll
                    for (int j = 0; j < 4; ++j) { v8[j] = acc[ai][bj][m][0][j] * rs; v8[4 + j] = acc[ai][bj][m][1][j] * rs; }
                    if (seg == 3) {
#pragma unroll
                        for (int j = 0; j < 8; ++j) v8[j] = silu_f(v8[j]);
                    }
                    *(u32x4*)(rowp + bj * 128) = pack8(v8);
                }
            }
    }
};

__device__ __forceinline__ void transpose_item(const float* W, int K, int N, bf16* WT, int item, int lane, const float* kscale) {
    const int nblk = N / 32, kb = item / nblk, nb = item % nblk, kq = lane & 7, c4 = lane >> 3;
    const int k0 = 64 * kb + 8 * kq, n0 = 32 * nb + 4 * c4;
    f32x4 v[8];
#pragma unroll
    for (int i = 0; i < 8; ++i) v[i] = *(const f32x4*)(W + (size_t)(k0 + i) * N + n0);
    if (kscale) {
        const f32x4 g0 = *(const f32x4*)(kscale + k0), g1 = *(const f32x4*)(kscale + k0 + 4);
#pragma unroll
        for (int i = 0; i < 4; ++i) { v[i] = v[i] * g0[i]; v[4 + i] = v[4 + i] * g1[i]; }
    }
#pragma unroll
    for (int j = 0; j < 4; ++j) {
        u32x4 o; o.x = pk2(v[0][j], v[1][j]); o.y = pk2(v[2][j], v[3][j]); o.z = pk2(v[4][j], v[5][j]); o.w = pk2(v[6][j], v[7][j]);
        *(u32x4*)(WT + (size_t)(n0 + j) * K + k0) = o;
    }
}

__device__ __forceinline__ void phase0(const PT& p, LAS unsigned char* lds, int tid, int lane, int wave) {
    unsigned char* ws = p.ws;
    const int gw = blockIdx.x * 8 + wave, NGW = gridDim.x * 8;
    const int gt = blockIdx.x * 512 + tid, NGT = gridDim.x * 512;
    for (int i = gt; i < 65536; i += NGT) ((float*)(ws + WS_ST0))[i] = 0.f;
    constexpr int I0 = 32 * (N0R / 32), I1 = 64 * 64, I2 = 32 * 256, I3 = 32 * 64;
    for (int it = gw; it < I0 + I1 + I2 + I3; it += NGW) {
        int r = it;
        if (r < I0) { transpose_item(p.in[2], 2048, N0R, (bf16*)(ws + WS_W0IN), r, lane, nullptr); continue; } r -= I0;
        if (r < I1) { transpose_item(p.in[13], 4096, 2048, (bf16*)(ws + WS_W0OUT), r, lane, nullptr); continue; } r -= I1;
        if (r < I2) { transpose_item(p.in[15], 2048, 8192, (bf16*)(ws + WS_W1IN), r, lane, p.in[14]); continue; } r -= I2;
        transpose_item(p.in[21], 2048, 2048, (bf16*)(ws + WS_W1OUT), r, lane, nullptr);
    }
    for (int i = gt; i < 16 * 128 * 128 / 8; i += NGT) {
        const int e = i * 8, t = (e >> 7) & 127, s0 = e & 127; const float* src = p.in[5] + e; float v[8];
#pragma unroll
        for (int j = 0; j < 8; ++j) v[j] = (s0 + j <= t) ? src[j] : 0.f;
        ((u32x4*)(ws + WS_WSP))[i] = pack8(v);
    }
    const float* g0 = p.in[1]; bf16* H0 = (bf16*)(ws + WS_H0);
    for (int m = gw; m < M; m += NGW) {
        const f32x4* xr = (const f32x4*)(p.in[0] + (size_t)m * 2048) + lane; f32x4 v[8]; float s = 0.f;
#pragma unroll
        for (int j = 0; j < 8; ++j) { v[j] = xr[64 * j]; s += (v[j].x * v[j].x + v[j].y * v[j].y) + (v[j].z * v[j].z + v[j].w * v[j].w); }
        const float rs = rsqrtf(wave_sum(s) * (1.f / 2048.f) + EPS);
        if (lane == 0) ((float*)(ws + WS_RS0))[m] = rs;
        u32x2* o = (u32x2*)(H0 + (size_t)m * 2048) + lane;
#pragma unroll
        for (int j = 0; j < 8; ++j) { const f32x4 g = ((const f32x4*)g0)[lane + 64 * j]; u32x2 w; w.x = pk2(v[j].x * rs * g.x, v[j].y * rs * g.y); w.y = pk2(v[j].z * rs * g.z, v[j].w * rs * g.w); o[64 * j] = w; }
    }
}

__device__ __forceinline__ void phase_layout(const PT& p, int tid) {
    unsigned char* ws = p.ws; unsigned char* dob = (unsigned char*)p.out;
    const bf16* Vb = (const bf16*)(ws + WS_V); const float* st0 = (const float*)(ws + WS_ST0);
    const bf16* XBC = (const bf16*)(dob + DO_XBC);
    bf16 *vT = (bf16*)(ws + WS_VT), *xT = (bf16*)(ws + WS_XT), *Bn = (bf16*)(dob + DO_BN), *BT = (bf16*)(dob + DO_BT), *Cn = (bf16*)(ws + WS_CN);
    const int t = tid & 255, so = t >> 4, co = t & 15;
    for (int pi = blockIdx.x * 2 + (tid >> 8); pi < 128 * 24; pi += gridDim.x * 2) {
        const int bc = pi / 24, k = 16 + pi % 24; const int tok0 = bc * 128 + so * 8;
        float o[8][8];
        if (k < 16) {
            const int ch0 = k * 128 + co * 8;
            float g[8], bb[8];
#pragma unroll
            for (int j = 0; j < 8; ++j) { g[j] = p.in[3][ch0 + j]; bb[j] = p.in[4][ch0 + j]; }
#pragma unroll
            for (int i = 0; i < 8; ++i) {
                const int row = tok0 + i; float f[8]; unpack8(*(const u32x4*)(Vb + (size_t)row * 2048 + ch0), f);
                const float mu = st0[2 * row] * (1.f / 2048.f), var = st0[2 * row + 1] * (1.f / 2048.f) - mu * mu, rs = rsqrtf(fmaxf(var, 0.f) + EPS);
#pragma unroll
                for (int j = 0; j < 8; ++j) o[i][j] = (f[j] - mu) * rs * g[j] + bb[j];
            }
#pragma unroll
            for (int j = 0; j < 8; ++j) { float c8[8];
#pragma unroll
                for (int i = 0; i < 8; ++i) c8[i] = o[i][j];
                *(u32x4*)(vT + ((size_t)bc * 2048 + ch0 + j) * 128 + so * 8) = pack8(c8); }
        } else {
            const int sc0 = (k - 16) * 128 + co * 8;
            float cw[4][8], cb[8];
#pragma unroll
            for (int j = 0; j < 8; ++j) { cb[j] = p.in[8][sc0 + j];
#pragma unroll
                for (int kk = 0; kk < 4; ++kk) cw[kk][j] = p.in[7][kk * 3072 + sc0 + j]; }
            const int pos0 = (bc & 15) * 128 + so * 8;
            float xw[11][8];
#pragma unroll
            for (int ii = 0; ii < 11; ++ii) {
                if (pos0 - 3 + ii >= 0) unpack8(*(const u32x4*)(XBC + (size_t)(tok0 - 3 + ii) * 3072 + sc0), xw[ii]);
                else {
#pragma unroll
                    for (int j = 0; j < 8; ++j) xw[ii][j] = 0.f;
                }
            }
#pragma unroll
            for (int i = 0; i < 8; ++i)
#pragma unroll
                for (int j = 0; j < 8; ++j) { float a = cb[j];
#pragma unroll
                    for (int kk = 0; kk < 4; ++kk) a += cw[kk][j] * xw[i + kk][j];
                    o[i][j] = silu_f(a); }
            if (k < 32) {
#pragma unroll
                for (int j = 0; j < 8; ++j) { float c8[8];
#pragma unroll
                    for (int i = 0; i < 8; ++i) c8[i] = o[i][j];
                    *(u32x4*)(xT + ((size_t)bc * 2048 + sc0 + j) * 128 + so * 8) = pack8(c8); }
            } else if (k < 36) {
                const int n0 = sc0 - 2048;
#pragma unroll
                for (int i = 0; i < 8; ++i) *(u32x4*)(Bn + (size_t)(tok0 + i) * 512 + n0) = pack8(o[i]);
#pragma unroll
                for (int j = 0; j < 8; ++j) { float c8[8];
#pragma unroll
                    for (int i = 0; i < 8; ++i) c8[i] = o[i][j];
                    *(u32x4*)(BT + ((size_t)bc * 512 + n0 + j) * 128 + so * 8) = pack8(c8); }
            } else {
                const int n0 = sc0 - 2560;
#pragma unroll
                for (int i = 0; i < 8; ++i) *(u32x4*)(Cn + (size_t)(tok0 + i) * 512 + n0) = pack8(o[i]);
            }
        }
    }
}

__device__ __forceinline__ void chunk_cumsum(const float* DT, const float* a_log, int tok0, int hh, int lane, float& d0, float& d1, float& c0, float& c1, float& tot) {
    d0 = DT[(size_t)(tok0 + 2 * lane) * 32 + hh]; d1 = DT[(size_t)(tok0 + 2 * lane + 1) * 32 + hh];
    const float A = -__expf(a_log[hh]); const float x0 = d0 * A, x1 = d1 * A; float ps = x0 + x1;
#pragma unroll
    for (int o = 1; o < 64; o <<= 1) { const float t = __shfl_up(ps, o); if (lane >= o) ps += t; }
    c1 = ps; c0 = ps - x1; tot = __shfl(ps, 63);
}

__device__ __forceinline__ void phase_mix(const PT& p, LAS unsigned char* lds, int tid, int lane, int wave) {
    unsigned char* ws = p.ws; unsigned char* dob = (unsigned char*)p.out;
    const int r32 = lane & 31, h = lane >> 5;
    bf16* Ycat = (bf16*)(ws + WS_YCAT); const bf16* ZA = (const bf16*)(ws + WS_ZA); const bf16* Vb = (const bf16*)(ws + WS_V); const float* st0 = (const float*)(ws + WS_ST0); const bf16* Wsp = (const bf16*)(ws + WS_WSP);
    const bf16* xT = (const bf16*)(ws + WS_XT); const bf16* BT = (const bf16*)(dob + DO_BT); const float* DT = (const float*)(ws + WS_DT);
    bf16* ST = (bf16*)(ws + WS_STATES); float* CD = (float*)(ws + WS_CD);
    LAS float* wtab = (LAS float*)lds;
    constexpr int NG = 128 * 16, NS = NBATCH * 15 * 4;
    for (int it = blockIdx.x; it < NG + NS; it += gridDim.x) {
        if (it < NG) {
            const int bc = it >> 4, g = it & 15, cb = wave & 3, th = wave >> 2;
            const int ch0 = g * 128 + cb * 32;
            __syncthreads();
            {
                const int c16 = tid & 15; float lg[8], lb[8];
#pragma unroll
                for (int j = 0; j < 8; ++j) { lg[j] = p.in[3][g * 128 + 8 * c16 + j]; lb[j] = p.in[4][g * 128 + 8 * c16 + j]; }
#pragma unroll
                for (int i = 0; i < 4; ++i) {
                    const int row = (tid >> 4) + 32 * i; const size_t tokr = (size_t)bc * 128 + row;
                    float f[8]; unpack8(*(const u32x4*)(Vb + tokr * 2048 + g * 128 + 8 * c16), f);
                    const float mu = st0[2 * tokr] * (1.f / 2048.f), var = st0[2 * tokr + 1] * (1.f / 2048.f) - mu * mu, rs = rsqrtf(fmaxf(var, 0.f) + EPS);
#pragma unroll
                    for (int j = 0; j < 8; ++j) f[j] = (f[j] - mu) * rs * lg[j] + lb[j];
                    *(LAS u32x4*)(lds + row * 272 + 16 * c16) = pack8(f);
                    *(LAS u32x4*)(lds + GM_UOFF + row * 272 + 16 * c16) = *(const u32x4*)(Ycat + tokr * 4096 + g * 128 + 8 * c16);
                    *(LAS u32x4*)(lds + GM_ZOFF + row * 272 + 16 * c16) = *(const u32x4*)(ZA + tokr * 2048 + g * 128 + 8 * c16);
                    *(LAS u32x4*)(lds + GM_WOFF + row * 272 + 16 * c16) = *(const u32x4*)(Wsp + ((size_t)g * 128 + row) * 128 + 8 * c16);
                }
            }
            __syncthreads();
            const LAS unsigned char* ap = lds + (8 * h + ((lane & 15) >> 2)) * 272 + (cb * 32 + 16 * ((lane >> 4) & 1)) * 2 + (lane & 3) * 8;
            f32x16 acc[2];
#pragma unroll
            for (int i = 0; i < 16; ++i) { acc[0][i] = 0.f; acc[1][i] = 0.f; }
#pragma unroll
            for (int st = 0; st < 8; ++st) {
                const v4i16_t lo = __builtin_amdgcn_ds_read_tr16_b64_v4i16((LAS v4i16_t*)(ap + 16 * st * 272)), hi = __builtin_amdgcn_ds_read_tr16_b64_v4i16((LAS v4i16_t*)(ap + (16 * st + 4) * 272));
                const bf16x8 a = {lo[0], lo[1], lo[2], lo[3], hi[0], hi[1], hi[2], hi[3]};
#pragma unroll
                for (int t2 = 0; t2 < 2; ++t2) { const int tb = 2 * th + t2;
                    if (st < 2 * (tb + 1)) { const bf16x8 b = __builtin_bit_cast(bf16x8, *(const LAS u32x4*)(lds + GM_WOFF + (tb * 32 + r32) * 272 + (16 * st + 8 * h) * 2)); acc[t2] = mfma32(a, b, acc[t2]); } }
                __builtin_amdgcn_sched_barrier(0);
            }
#pragma unroll
            for (int t2 = 0; t2 < 2; ++t2) {
                const int t = (2 * th + t2) * 32 + r32; const float sb = p.in[6][g * 128 + t];
#pragma unroll
                for (int qd = 0; qd < 4; ++qd) {
                    const int cl = cb * 32 + 8 * qd + 4 * h;
                    LAS u32x2* up = (LAS u32x2*)(lds + GM_UOFF + t * 272 + cl * 2); const u32x2 uu = *up, zz = *(const LAS u32x2*)(lds + GM_ZOFF + t * 272 + cl * 2);
                    const float y0 = bflo(uu.x) * (acc[t2][4 * qd] + sb) * bflo(zz.x), y1 = bfhi(uu.x) * (acc[t2][4 * qd + 1] + sb) * bfhi(zz.x);
                    const float y2 = bflo(uu.y) * (acc[t2][4 * qd + 2] + sb) * bflo(zz.y), y3 = bfhi(uu.y) * (acc[t2][4 * qd + 3] + sb) * bfhi(zz.y);
                    u32x2 w; w.x = pk2(y0, y1); w.y = pk2(y2, y3); *up = w;
                }
            }
            __syncthreads();
            { const int c16 = tid & 15;
#pragma unroll
              for (int i = 0; i < 4; ++i) { const int row = (tid >> 4) + 32 * i; *(u32x4*)(Ycat + ((size_t)bc * 128 + row) * 4096 + g * 128 + 8 * c16) = *(const LAS u32x4*)(lds + GM_UOFF + row * 272 + 16 * c16); } }
        } else {
            const int id = it - NG, b = id / 60, c = (id / 4) % 15, grp = id & 3; const int bc = b * 16 + c, tok0 = bc * 128;
            __syncthreads();
            { const int hh = grp * 8 + wave; float d0, d1, c0, c1, tot; chunk_cumsum(DT, p.in[10], tok0, hh, lane, d0, d1, c0, c1, tot);
              wtab[wave * 128 + 2 * lane] = d0 * __expf(tot - c0); wtab[wave * 128 + 2 * lane + 1] = d1 * __expf(tot - c1);
              if (lane == 0) CD[bc * 32 + hh] = __expf(tot); }
#pragma unroll
            for (int i = 0; i < 4; ++i) { const int pid = tid + 512 * i, row = pid >> 4, c16 = pid & 15;
                *(LAS u32x4*)(lds + ST_BOFF + row * 272 + 16 * c16) = *(const u32x4*)(BT + ((size_t)bc * 512 + grp * 128 + row) * 128 + 8 * c16); }
            __syncthreads();
#pragma unroll 1
            for (int tk = 0; tk < 2; ++tk) {
                const int r = (wave >> 1) + 4 * tk, pb = wave & 1, hh = grp * 8 + r;
                const bf16* ap = xT + ((size_t)bc * 2048 + hh * 64 + pb * 32 + r32) * 128 + 8 * h;
                const LAS unsigned char* bp = lds + ST_BOFF + r32 * 272 + 16 * h;
                f32x16 acc[4];
#pragma unroll
                for (int nb = 0; nb < 4; ++nb)
#pragma unroll
                    for (int i = 0; i < 16; ++i) acc[nb][i] = 0.f;
#pragma unroll
                for (int st = 0; st < 8; ++st) {
                    float f[8]; unpack8(*(const u32x4*)(ap + 16 * st), f);
                    const f32x4 w0 = *(const LAS f32x4*)(wtab + r * 128 + 16 * st + 8 * h), w1 = *(const LAS f32x4*)(wtab + r * 128 + 16 * st + 8 * h + 4);
                    f[0] *= w0.x; f[1] *= w0.y; f[2] *= w0.z; f[3] *= w0.w; f[4] *= w1.x; f[5] *= w1.y; f[6] *= w1.z; f[7] *= w1.w;
                    const bf16x8 a = __builtin_bit_cast(bf16x8, pack8(f));
#pragma unroll
                    for (int nb = 0; nb < 4; ++nb) { const bf16x8 bfr = __builtin_bit_cast(bf16x8, *(const LAS u32x4*)(bp + nb * 32 * 272 + 32 * st)); acc[nb] = mfma32(a, bfr, acc[nb]); }
                    __builtin_amdgcn_sched_barrier(0);
                }
                bf16* sp = ST + ((size_t)(bc * 32 + hh) * 64 + pb * 32) * 128;
#pragma unroll
                for (int nb = 0; nb < 4; ++nb)
#pragma unroll
                    for (int i = 0; i < 16; ++i) sp[(size_t)crow(i, h) * 128 + nb * 32 + r32] = (bf16)(pk2(acc[nb][i], 0.f) & 0xffffu);
            }
        }
    }
}

__device__ __forceinline__ void phase_scan(const PT& p, int tid) {
    unsigned char* ws = p.ws; const bf16* ST = (const bf16*)(ws + WS_STATES); const float* CD = (const float*)(ws + WS_CD); bf16* PV = (bf16*)((unsigned char*)p.out + DO_PREV);
    for (int id = blockIdx.x * 512 + tid; id < NBATCH * 32 * 64 * 16; id += gridDim.x * 512) {
        const int b = id >> 15, rem = id & 32767, hh = rem >> 10;
        float run[8];
#pragma unroll
        for (int j = 0; j < 8; ++j) run[j] = 0.f;
#pragma unroll
        for (int c = 0; c < 16; ++c) {
            const size_t off = ((size_t)(b * 16 + c) * 32 * 64 * 16 + rem) * 8;
            *(u32x4*)(PV + off) = pack8(run);
            if (c < 15) { float s[8]; unpack8(*(const u32x4*)(ST + off), s); const float cd = CD[(b * 16 + c) * 32 + hh];
#pragma unroll
                for (int j = 0; j < 8; ++j) run[j] = run[j] * cd + s[j]; }
        }
    }
}

constexpr int SY_TILE = 9728, SY_TP = 1040;
static_assert(SY_TILE + 128 * SY_TP <= PTAB_OFF, "ssd_y LDS map");
__device__ __forceinline__ void phase_ssd_y(const PT& p, LAS unsigned char* lds, int tid, int lane, int wave) {
    unsigned char* ws = p.ws; unsigned char* dob = (unsigned char*)p.out;
    const int r32 = lane & 31, h = lane >> 5;
    bf16* Ycat = (bf16*)(ws + WS_YCAT); const bf16* xT = (const bf16*)(ws + WS_XT); const bf16* Bn = (const bf16*)(dob + DO_BN); const bf16* Cn = (const bf16*)(ws + WS_CN);
    const bf16* PV = (const bf16*)(dob + DO_PREV); const float* DT = (const float*)(ws + WS_DT);
    LAS float* acum = (LAS float*)lds; LAS float* dtt = acum + 1024; LAS float* ssqp = dtt + 1024; LAS float* rsT = ssqp + 256;
    LAS unsigned char* tile = lds + SY_TILE;
    for (int it = blockIdx.x; it < 128 * 4; it += gridDim.x) {
        const int bc = it >> 2, grp = it & 3, tok0 = bc * 128;
        __syncthreads();
        { const int hh = grp * 8 + wave; float d0, d1, c0, c1, tot; chunk_cumsum(DT, p.in[10], tok0, hh, lane, d0, d1, c0, c1, tot);
          acum[wave * 128 + 2 * lane] = c0; acum[wave * 128 + 2 * lane + 1] = c1; dtt[wave * 128 + 2 * lane] = d0; dtt[wave * 128 + 2 * lane + 1] = d1; }
#pragma unroll 4
        for (int i = 0; i < 16; ++i) { const int pid = tid + 512 * i, row = pid >> 6, c8 = pid & 63;
            *(LAS u32x4*)(tile + row * SY_TP + 16 * c8) = *(const u32x4*)(Ycat + ((size_t)tok0 + row) * 4096 + 2048 + grp * 512 + 8 * c8); }
        __syncthreads();
        const int pb = wave >> 2, lb = wave & 3, l = lb * 32 + r32; const size_t tok = (size_t)tok0 + l;
        bf16x8 cf[8];
#pragma unroll
        for (int st = 0; st < 8; ++st) cf[st] = ld_frag16(Cn + tok * 512 + grp * 128 + 16 * st + 8 * h);
        f32x16 X[4];
#pragma unroll
        for (int sb = 0; sb < 4; ++sb) {
#pragma unroll
            for (int i = 0; i < 16; ++i) X[sb][i] = 0.f;
            if (sb <= lb) {
#pragma unroll
                for (int st = 0; st < 8; ++st) X[sb] = mfma32(ld_frag16(Bn + ((size_t)tok0 + sb * 32 + r32) * 512 + grp * 128 + 16 * st + 8 * h), cf[st], X[sb]);
            }
        }
        float ssq = 0.f;
#pragma unroll 2
        for (int r = 0; r < 8; ++r) {
            const int hh = grp * 8 + r;
            f32x16 acc;
#pragma unroll
            for (int i = 0; i < 16; ++i) acc[i] = 0.f;
            const bf16* pp = PV + ((size_t)(bc * 32 + hh) * 64 + pb * 32 + r32) * 128 + 8 * h;
#pragma unroll
            for (int st = 0; st < 8; ++st) acc = mfma32(ld_frag16(pp + 16 * st), cf[st], acc);
            const float al = acum[r * 128 + l]; const float el = __expf(al); const float dsk = p.in[11][hh];
#pragma unroll
            for (int i = 0; i < 16; ++i) acc[i] *= el;
            const bf16* xrow = xT + ((size_t)bc * 2048 + hh * 64 + pb * 32 + r32) * 128 + 4 * h;
#pragma unroll
            for (int sb = 0; sb < 4; ++sb) {
                if (sb <= lb) {
                    f32x16 mm;
#pragma unroll
                    for (int qd = 0; qd < 4; ++qd) {
                        const int s0 = sb * 32 + 8 * qd + 4 * h;
                        const f32x4 as = *(const LAS f32x4*)(acum + r * 128 + s0), ds = *(const LAS f32x4*)(dtt + r * 128 + s0);
#pragma unroll
                        for (int j = 0; j < 4; ++j) { const float v = X[sb][4 * qd + j] * __expf(al - as[j]) * ds[j]; mm[4 * qd + j] = (s0 + j < l) ? v : ((s0 + j == l) ? v + dsk : 0.f); }
                    }
#pragma unroll
                    for (int s2 = 0; s2 < 2; ++s2) acc = mfma32(ld_frag8x2(xrow + sb * 32 + 16 * s2), pack_frag(mm, s2), acc);
                }
            }
#pragma unroll
            for (int qd = 0; qd < 4; ++qd) {
                LAS u32x2* yp = (LAS u32x2*)(tile + l * SY_TP + (r * 64 + pb * 32 + 8 * qd + 4 * h) * 2); const u32x2 zz = *yp;
                const float y0 = acc[4 * qd] * bflo(zz.x), y1 = acc[4 * qd + 1] * bfhi(zz.x);
                const float y2 = acc[4 * qd + 2] * bflo(zz.y), y3 = acc[4 * qd + 3] * bfhi(zz.y);
                ssq += (y0 * y0 + y1 * y1) + (y2 * y2 + y3 * y3);
                u32x2 w; w.x = pk2(y0, y1); w.y = pk2(y2, y3); *yp = w;
            }
        }
        ssq += __shfl_xor(ssq, 32);
        if (h == 0) ssqp[pb * 128 + l] = ssq;
        __syncthreads();
        if (pb == 0 && h == 0) rsT[l] = rsqrtf((ssqp[l] + ssqp[128 + l]) * (1.f / 512.f) + EPS);
        __syncthreads();
#pragma unroll 4
        for (int i = 0; i < 16; ++i) { const int pid = tid + 512 * i, row = pid >> 6, c8 = pid & 63; const int ch = grp * 512 + 8 * c8;
            float f[8]; unpack8(*(const LAS u32x4*)(tile + row * SY_TP + 16 * c8), f);
            const float rs = rsT[row]; const f32x4 g0 = *(const f32x4*)(p.in[12] + ch), g1 = *(const f32x4*)(p.in[12] + ch + 4);
            f[0] *= rs * g0.x; f[1] *= rs * g0.y; f[2] *= rs * g0.z; f[3] *= rs * g0.w; f[4] *= rs * g1.x; f[5] *= rs * g1.y; f[6] *= rs * g1.z; f[7] *= rs * g1.w;
            *(u32x4*)(Ycat + ((size_t)tok0 + row) * 4096 + 2048 + ch) = pack8(f); }
    }
}

constexpr int AK_PITCH = 272, AV_PITCH = 272, A_KOFF = 0, A_VOFF = 128 * AK_PITCH, A_STAGE = A_VOFF + 128 * AV_PITCH;
static_assert(2 * A_STAGE <= PTAB_OFF && 4 * 16384 <= A_STAGE, "attention LDS map");
__device__ __forceinline__ float max3f(float a, float b, float c) { return fmaxf(fmaxf(a, b), c); }
__device__ __forceinline__ void attn_unit(const PT& p, LAS unsigned char* lds, int tid, int lane, int wave, int b, int hd, int qb, float lam) {
    unsigned char* ws = p.ws;
    const bf16* Qb = (const bf16*)(ws + WS_Q); const bf16* Kb = (const bf16*)(ws + WS_K); const bf16* Vb = (const bf16*)(ws + WS_VV); const bf16* Gb = (const bf16*)((unsigned char*)p.out + DO_G);
    bf16* Ob = (bf16*)(ws + WS_O);
    const int r32 = lane & 31, h = lane >> 5, mp = wave >> 2, wq = wave & 3;
    const int qw0 = qb * 128 + 32 * wq, q = qw0 + r32; const unsigned tokq = (unsigned)(b * SEQ + q), tokb = (unsigned)(b * SEQ);
    const float slope2 = fexp2(-0.5f * (float)(hd + 1)) * LOG2E;
    bf16x8 qf[4];
#pragma unroll
    for (int ds = 0; ds < 4; ++ds) qf[ds] = ld_frag16(Qb + (tokq * 2048u + (unsigned)(hd * 128 + mp * 64 + 16 * ds + 8 * h)));
    float mrun = -INFINITY, lsum = 0.f;
    f32x16 oT[4];
#pragma unroll
    for (int db = 0; db < 4; ++db)
#pragma unroll
        for (int i = 0; i < 16; ++i) oT[db][i] = 0.f;
    const int ntiles = qb + 1;
    u32x4 preV[4], preK[4];
#define PREFETCH(t) do { \
        _Pragma("unroll") for (int i_ = 0; i_ < 4; ++i_) { const int pid_ = tid + 512 * i_, row_ = pid_ >> 4, c16_ = pid_ & 15; const unsigned go_ = (tokb + (unsigned)((t) * 128 + row_)) * 2048u + (unsigned)(hd * 128 + 8 * c16_); \
            preK[i_] = *(const u32x4*)(Kb + go_); preV[i_] = *(const u32x4*)(Vb + go_); } \
    } while (0)
    PREFETCH(0);
    const LAS unsigned char* kbase0 = lds + A_KOFF + r32 * AK_PITCH + (mp * 64 + 8 * h) * 2;
    const LAS unsigned char* vbase0 = lds + A_VOFF + (4 * h + ((lane & 15) >> 2)) * AV_PITCH + ((lane >> 4) & 1) * 32 + (lane & 3) * 8;
#define STAGE_WRITE(stg) do { \
        _Pragma("unroll") for (int i_ = 0; i_ < 4; ++i_) { const int pid_ = tid + 512 * i_, row_ = pid_ >> 4, c16_ = pid_ & 15; \
            *(LAS u32x4*)(lds + (stg) * A_STAGE + A_KOFF + row_ * AK_PITCH + 16 * c16_) = preK[i_]; *(LAS u32x4*)(lds + (stg) * A_STAGE + A_VOFF + row_ * AV_PITCH + 16 * c16_) = preV[i_]; } \
    } while (0)
    __syncthreads();
    STAGE_WRITE(0);
    asm volatile("" : "+v"(qf[0]), "+v"(qf[1]), "+v"(qf[2]), "+v"(qf[3]));
    __syncthreads();
#pragma unroll 1
    for (int t = 0; t < ntiles; ++t) {
        const int stg = t & 1;
        if (t + 1 < ntiles) PREFETCH(t + 1);
        const LAS unsigned char* kbase = kbase0 + stg * A_STAGE; const LAS unsigned char* vbase = vbase0 + stg * A_STAGE;
        const bool diag = (t == qb);
#pragma unroll 2
        for (int sub = 0; sub < 2; ++sub) {
            const int nact = diag ? min(2, max(0, wq + 1 - 2 * sub)) : 2;
            if (nact > 0) {
                float sl = slope2; asm volatile("" : "+v"(sl));
                const float bq = sl * (float)(t * 128 + sub * 64 + 4 * h - q);
                const LAS unsigned char* kb0 = kbase + sub * 64 * AK_PITCH; const LAS unsigned char* vb0 = vbase + sub * 64 * AV_PITCH;
                f32x16 s[2];
#pragma unroll
                for (int kb = 0; kb < 2; ++kb) {
                    if (kb < nact) {
                        const float bk = bq + sl * (float)(32 * kb);
#pragma unroll
                        for (int i = 0; i < 16; ++i) s[kb][i] = __builtin_fmaf(sl, (float)((i & 3) + 8 * (i >> 2)), bk);
#pragma unroll
                        for (int ds = 0; ds < 4; ++ds) s[kb] = mfma32(__builtin_bit_cast(bf16x8, *(const LAS u32x4*)(kb0 + kb * 32 * AK_PITCH + ds * 32)), qf[ds], s[kb]);
                    } else {
#pragma unroll
                        for (int i = 0; i < 16; ++i) s[kb][i] = -INFINITY;
                    }
                }
                if (diag) {
#pragma unroll
                    for (int kb = 0; kb < 2; ++kb) if (2 * sub + kb == wq) {
#pragma unroll
                        for (int i = 0; i < 16; ++i) if (crow(i, h) > r32) s[kb][i] = -INFINITY; }
                }
                float mx = -INFINITY;
#pragma unroll
                for (int kb = 0; kb < 2; ++kb)
#pragma unroll
                    for (int i = 0; i < 16; i += 2) mx = max3f(mx, s[kb][i], s[kb][i + 1]);
                mx = fmaxf(mx, __shfl_xor(mx, 32));
                const float mnew = fmaxf(mrun, mx), alpha = fexp2(mrun - mnew); mrun = mnew;
                float rs0 = 0.f, rs1 = 0.f, rs2 = 0.f, rs3 = 0.f;
#pragma unroll
                for (int kb = 0; kb < 2; ++kb)
#pragma unroll
                    for (int i = 0; i < 16; i += 4) { s[kb][i] = fexp2(s[kb][i] - mnew); s[kb][i + 1] = fexp2(s[kb][i + 1] - mnew); s[kb][i + 2] = fexp2(s[kb][i + 2] - mnew); s[kb][i + 3] = fexp2(s[kb][i + 3] - mnew);
                        rs0 += s[kb][i]; rs1 += s[kb][i + 1]; rs2 += s[kb][i + 2]; rs3 += s[kb][i + 3]; }
                lsum = lsum * alpha + ((rs0 + rs1) + (rs2 + rs3));
                if (__builtin_amdgcn_ballot_w64(alpha != 1.0f) != 0ull) {
#pragma unroll
                    for (int db = 0; db < 4; ++db)
#pragma unroll
                        for (int i = 0; i < 16; ++i) oT[db][i] *= alpha;
                }
#pragma unroll
                for (int kb = 0; kb < 2; ++kb) if (kb < nact) {
#pragma unroll
                    for (int s2 = 0; s2 < 2; ++s2) {
                        const bf16x8 pf = pack_frag(s[kb], s2);
#pragma unroll
                        for (int db = 0; db < 4; ++db) {
                            const LAS unsigned char* vp = vb0 + (kb * 32 + 16 * s2) * AV_PITCH + db * 64;
                            const v4i16_t lo = __builtin_amdgcn_ds_read_tr16_b64_v4i16((LAS v4i16_t*)vp), hi = __builtin_amdgcn_ds_read_tr16_b64_v4i16((LAS v4i16_t*)(vp + 8 * AV_PITCH));
                            const bf16x8 vf = {lo[0], lo[1], lo[2], lo[3], hi[0], hi[1], hi[2], hi[3]};
                            oT[db] = mfma32(vf, pf, oT[db]);
                        }
                    }
                }
            }
        }
        if (t + 1 < ntiles) STAGE_WRITE(stg ^ 1);
        __syncthreads();
    }
#undef PREFETCH
#undef STAGE_WRITE
    const float lt = lsum + __shfl_xor(lsum, 32);
    LAS float* xch = (LAS float*)(lds + (ntiles & 1) * A_STAGE + wq * 16384);
    if (mp == 1) { const float sc = lam / lt;
#pragma unroll
        for (int db = 0; db < 4; ++db)
#pragma unroll
            for (int i = 0; i < 16; ++i) xch[(db * 16 + i) * 64 + lane] = oT[db][i] * sc; }
    __syncthreads();
    if (mp == 0) {
        const float i1 = 1.f / lt; float ss = 0.f;
#pragma unroll
        for (int db = 0; db < 4; ++db)
#pragma unroll
            for (int i = 0; i < 16; ++i) { const float o = oT[db][i] * i1 - xch[(db * 16 + i) * 64 + lane]; oT[db][i] = o; ss += o * o; }
        ss += __shfl_xor(ss, 32);
        const float rn = rsqrtf(ss * (1.f / 128.f) + EPS) * (1.f - LAMBDA_INIT);
#pragma unroll
        for (int db = 0; db < 4; ++db)
#pragma unroll
            for (int qd = 0; qd < 4; ++qd) {
                const int d = db * 32 + 8 * qd + 4 * h; const unsigned off = tokq * 2048u + (unsigned)(hd * 128 + d);
                const u32x2 gg = *(const u32x2*)(Gb + off); const f32x4 sg = *(const f32x4*)(p.in[20] + d);
                u32x2 w; w.x = pk2(oT[db][4 * qd] * rn * sg.x * bflo(gg.x), oT[db][4 * qd + 1] * rn * sg.y * bfhi(gg.x));
                w.y = pk2(oT[db][4 * qd + 2] * rn * sg.z * bflo(gg.y), oT[db][4 * qd + 3] * rn * sg.w * bfhi(gg.y));
                *(u32x2*)(Ob + off) = w;
            }
    }
}

__device__ __forceinline__ void phase_attn(const PT& p, LAS unsigned char* lds, int tid, int lane, int wave) {
    const float s1 = wave_sum(p.in[16][lane] * p.in[17][lane]), s2 = wave_sum(p.in[18][lane] * p.in[19][lane]);
    const float lam = __expf(s1) - __expf(s2) + LAMBDA_INIT;
#pragma unroll 1
    for (int u = blockIdx.x; u < NBATCH * 16 * 8; u += gridDim.x) {
        const int j = u & 7, hd = (u >> 3) & 15, b = u >> 7;
#pragma unroll 1
        for (int k = 0; k < 2; ++k) attn_unit(p, lds, tid, lane, wave, b, hd, k == 0 ? 15 - j : j, lam);
    }
}

__device__ __forceinline__ void phase_final(const PT& p, int lane, int wave) {
    const float* st2 = (const float*)(p.ws + WS_ST2); const float* g = p.in[22]; const bf16* X2 = (const bf16*)(p.ws + WS_X2B);
    for (int m = blockIdx.x * 8 + wave; m < M; m += gridDim.x * 8) {
        const float rs = rsqrtf(st2[m] * (1.f / 2048.f) + EPS);
        const u32x4* xr = (const u32x4*)(X2 + (size_t)m * 2048) + lane; f32x4* orow = (f32x4*)(p.out + (size_t)m * 2048);
#pragma unroll
        for (int j = 0; j < 4; ++j) {
            float f[8]; unpack8(xr[64 * j], f); const int c = 8 * (lane + 64 * j);
            const f32x4 g0 = *(const f32x4*)(g + c), g1 = *(const f32x4*)(g + c + 4);
            orow[(c >> 2)] = (f32x4){f[0] * rs * g0.x, f[1] * rs * g0.y, f[2] * rs * g0.z, f[3] * rs * g0.w};
            orow[(c >> 2) + 1] = (f32x4){f[4] * rs * g1.x, f[5] * rs * g1.y, f[6] * rs * g1.z, f[7] * rs * g1.w};
        }
    }
}

constexpr size_t WS_BAR = 384 * 1024;
constexpr int XBST_OFF = PTAB_OFF + 256;
typedef __attribute__((address_space(1))) unsigned gu32;
#define XB_TMO      128
#define XB_XCNT(j)  (256  + 64 * (j))
#define XB_XSUB(j)  (1280 + 64 * (j))
#define XB_XGEN(j)  (2304 + 64 * (j))
#define XB_TOP      3328
#define XB_TOPGEN   3392
#define XCD_BAR_WORDS 3456
#define XB_SPIN_CAP (1u << 18)

__device__ __forceinline__ unsigned xb_ld(unsigned* p)              { return __hip_atomic_load(p, __ATOMIC_RELAXED, __HIP_MEMORY_SCOPE_AGENT); }
__device__ __forceinline__ unsigned xb_add(unsigned* p, unsigned v) { return __hip_atomic_fetch_add(p, v, __ATOMIC_RELAXED, __HIP_MEMORY_SCOPE_AGENT); }
__device__ __forceinline__ unsigned xb_xcc_id() { return (unsigned)__builtin_amdgcn_s_getreg((3 << 11) | 20) & 0xFu; }
#define XB_SPIN(cond, bar) do { unsigned _sp = 0; while (cond) { __builtin_amdgcn_s_sleep(1); \
    if ((++_sp & 255u) == 0u) { if (xb_ld(&(bar)[XB_TMO])) break; if (_sp > XB_SPIN_CAP) { atomicAdd(&(bar)[XB_TMO], 1u); break; } } } } while (0)

struct XcdBarrier {
    unsigned* bar; unsigned x;
    volatile LAS unsigned* st;
};

__device__ __forceinline__ XcdBarrier xcd_barrier_post(unsigned* bar, volatile LAS unsigned* st) {
    XcdBarrier b; b.bar = bar; b.x = xb_xcc_id(); b.st = st;
    if (threadIdx.x == 0) (void)xb_add(&bar[XB_XCNT(b.x)], 1u);
    return b;
}
__device__ __forceinline__ void xcd_barrier_complete(unsigned* bar, unsigned x, unsigned& nloc, unsigned& nx) {
    const unsigned G = gridDim.x * gridDim.y * gridDim.z;
    unsigned sum, cnt, mine, sp = 0u;
    for (;;) {
        sum = 0u; cnt = 0u; mine = 0u;
#pragma unroll
        for (unsigned j = 0; j < 16; ++j) { const unsigned c = xb_ld(&bar[XB_XCNT(j)]); sum += c; cnt += (c > 0u) ? 1u : 0u; mine = (j == x) ? c : mine; }
        if (sum == G) break;
        __builtin_amdgcn_s_sleep(1);
        if ((++sp & 255u) == 0u) { if (xb_ld(&bar[XB_TMO])) break; if (sp > XB_SPIN_CAP) { atomicAdd(&bar[XB_TMO], 1u); break; } }
    }
    nloc = mine > 0u ? mine : 1u; nx = cnt > 0u ? cnt : 1u;
}

__device__ __forceinline__ void xcd_barrier(const XcdBarrier& b) {
    asm volatile("s_waitcnt vmcnt(0)" ::: "memory");
    __syncthreads();
    if (threadIdx.x == 0) {
        unsigned* bar = b.bar;
        __builtin_amdgcn_s_waitcnt(0);
        unsigned nloc = b.st[0], nx = b.st[1];
        if (nloc == 0u) { xcd_barrier_complete(bar, b.x, nloc, nx); b.st[0] = nloc; b.st[1] = nx; }
        const unsigned old = xb_add(&bar[XB_XSUB(b.x)], 1u);
        const unsigned gen = old / nloc;
        if (old + 1u == (gen + 1u) * nloc) {
            __builtin_amdgcn_fence(__ATOMIC_RELEASE, "agent");
            asm volatile("s_waitcnt vmcnt(0)" ::: "memory");
            const unsigned og = xb_add(&bar[XB_TOP], 1u);
            const unsigned tg = og / nx;
            if (og + 1u == (tg + 1u) * nx) xb_add(&bar[XB_TOPGEN], 1u);
            else XB_SPIN(xb_ld(&bar[XB_TOPGEN]) == tg, bar);
            __builtin_amdgcn_fence(__ATOMIC_ACQUIRE, "agent");
            xb_add(&bar[XB_XGEN(b.x)], 1u);
            asm volatile("s_waitcnt vmcnt(0)" ::: "memory");
        } else {
            XB_SPIN(xb_ld(&bar[XB_XGEN(b.x)]) == gen, bar);
            __builtin_amdgcn_fence(__ATOMIC_ACQUIRE, "agent");
            asm volatile("s_waitcnt vmcnt(0)" ::: "memory");
        }
    }
    __syncthreads();
}

__global__ void __launch_bounds__(512) fwd_megakernel(Params pa) {
    extern __shared__ __attribute__((aligned(16))) unsigned char lds_raw[];
    cg::grid_group grid = cg::this_grid();
    LAS unsigned char* lds = (LAS unsigned char*)lds_raw;
    if (threadIdx.x < 25) {
        unsigned long long v = 0;
#pragma unroll
        for (int i = 0; i < 23; ++i) if ((int)threadIdx.x == i) v = (unsigned long long)pa.in[i];
        if (threadIdx.x == 23) v = (unsigned long long)pa.out;
        if (threadIdx.x == 24) v = (unsigned long long)pa.ws;
        ((LAS unsigned long long*)(lds + PTAB_OFF))[threadIdx.x] = v;
    }
    if (threadIdx.x < 2) ((LAS unsigned*)(lds + XBST_OFF))[threadIdx.x] = 0u;
    __syncthreads();
    const XcdBarrier bar = xcd_barrier_post((unsigned*)(pa.ws + WS_BAR), (volatile LAS unsigned*)(lds + XBST_OFF));
#ifndef PHMASK
#define PHMASK 0x3ff
#endif
#define PH(n) (((PHMASK) >> (n)) & 1)
#define TLW int tid_ = threadIdx.x; asm volatile("" : "+v"(tid_)); const int tid = tid_, lane = tid & 63, wave = __builtin_amdgcn_readfirstlane(tid >> 6); (void)tid; (void)lane; (void)wave
#define GRIDV const int G = gridDim.x, c = blockIdx.x
    if (PH(0)) { PT p; TLW; phase0(p, lds, tid, lane, wave); }
    if (gridDim.x == 0x7fffffffu) grid.sync();
    xcd_barrier(bar);
    if (PH(1)) {
        PT p; GRIDV; unsigned char* ws = p.ws; unsigned char* dob = (unsigned char*)p.out;
        pg8::Gemm g{(const pg8::bf16_t*)(ws + WS_H0), (const pg8::bf16_t*)(ws + WS_W0IN), M, N0P, 2048}; pg8::StaticOrder S; S.init(M, N0P, G, c);
        EpiIn0 E{(bf16*)(ws + WS_YCAT), (bf16*)(ws + WS_V), (bf16*)(ws + WS_ZA), (bf16*)(dob + DO_XBC), (float*)(ws + WS_ST0)};
        pg8::gemm_phase<EpiIn0, pg8::StaticOrder, true, true>(lds, g, S, E);
        { TLW; dt_tasks(p, lds, lane, wave); }
    }
    xcd_barrier(bar);
    if (PH(2)) { PT p; TLW; phase_layout(p, tid); }
    xcd_barrier(bar);
    if (PH(3)) { PT p; TLW; phase_mix(p, lds, tid, lane, wave); }
    xcd_barrier(bar);
    if (PH(4)) { PT p; TLW; phase_scan(p, tid); }
    xcd_barrier(bar);
    if (PH(5)) { PT p; TLW; phase_ssd_y(p, lds, tid, lane, wave); }
    xcd_barrier(bar);
    if (PH(6)) {
        PT p; GRIDV; unsigned char* ws = p.ws;
        pg8::Gemm g{(const pg8::bf16_t*)(ws + WS_YCAT), (const pg8::bf16_t*)(ws + WS_W0OUT), M, 2048, 4096}; pg8::StaticOrder S; S.init(M, 2048, G, c);
        EpiResT<2> E{(const void*)(ws + WS_H0), nullptr, (bf16*)(ws + WS_X1B), (float*)(ws + WS_ST1), (const float*)(ws + WS_RS0), p.in[1], p.in[0]};
        pg8::gemm_phase<EpiResT<2>, pg8::StaticOrder, true, true>(lds, g, S, E);
    }
    xcd_barrier(bar);
    if (PH(6)) {
        PT p; GRIDV; unsigned char* ws = p.ws; unsigned char* dob = (unsigned char*)p.out;
        pg8::Gemm g{(const pg8::bf16_t*)(ws + WS_X1B), (const pg8::bf16_t*)(ws + WS_W1IN), M, 8192, 2048}; pg8::StaticOrder S; S.init(M, 8192, G, c);
        EpiIn1 E{(bf16*)(ws + WS_Q), (bf16*)(ws + WS_K), (bf16*)(ws + WS_VV), (bf16*)(dob + DO_G), (const float*)(ws + WS_ST1)};
        pg8::gemm_phase<EpiIn1, pg8::StaticOrder, true, true>(lds, g, S, E);
    }
    xcd_barrier(bar);
    if (PH(7)) { PT p; TLW; phase_attn(p, lds, tid, lane, wave); }
    xcd_barrier(bar);
    if (PH(8)) {
        PT p; GRIDV; unsigned char* ws = p.ws;
        pg8::Gemm g{(const pg8::bf16_t*)(ws + WS_O), (const pg8::bf16_t*)(ws + WS_W1OUT), M, 2048, 2048}; pg8::StaticOrder S; S.init(M, 2048, G, c);
        EpiResT<1> E{(const void*)(ws + WS_X1B), nullptr, (bf16*)(ws + WS_X2B), (float*)(ws + WS_ST2), nullptr, nullptr, nullptr};
        pg8::gemm_phase<EpiResT<1>, pg8::StaticOrder, true, true>(lds, g, S, E);
    }
    xcd_barrier(bar);
    if (PH(9)) { PT p; TLW; phase_final(p, lane, wave); }
}

extern "C" void kernel_launch(void* const* d_in, const int* in_sizes, int n_in, void* d_out, int out_size, void* d_ws, size_t ws_size, hipStream_t stream) {
    static int grid = 0;
    if (grid == 0) {
        if (n_in != 23 || out_size != M * DM || ws_size < WS_END) { fprintf(stderr, "kernel_launch: unexpected shapes (n_in %d out %d ws %zu)\n", n_in, out_size, ws_size); grid = -1; return; }
        int dev = 0, cus = 0, per_cu = 0;
        hipGetDevice(&dev); hipDeviceGetAttribute(&cus, hipDeviceAttributeMultiprocessorCount, dev);
        hipFuncSetAttribute((const void*)fwd_megakernel, hipFuncAttributeMaxDynamicSharedMemorySize, LDS_BYTES);
        hipOccupancyMaxActiveBlocksPerMultiprocessor(&per_cu, (const void*)fwd_megakernel, 512, LDS_BYTES);
        if (per_cu < 1) { fprintf(stderr, "kernel_launch: occupancy query says %d blocks per CU\n", per_cu); per_cu = 1; }
        (void)hipGetLastError();
        grid = cus;
    }
    if (grid < 0) return;
    Params p{};
    for (int i = 0; i < 23; ++i) p.in[i] = (const float*)d_in[i];
    p.out = (float*)d_out; p.ws = (unsigned char*)d_ws;
    if (hipMemsetAsync((char*)d_ws + WS_BAR, 0, XCD_BAR_WORDS * 4, stream) != hipSuccess) { fprintf(stderr, "kernel_launch: memset of the barrier words failed\n"); return; }
    void* args[] = {&p};
    hipError_t e = hipLaunchCooperativeKernel((const void*)fwd_megakernel, dim3(grid), dim3(512), args, LDS_BYTES, stream);
    if (e != hipSuccess) fprintf(stderr, "cooperative launch failed: %s (grid %d)\n", hipGetErrorString(e), grid);
}
```

```cpp
#include <hip/hip_runtime.h>
#include <hip/hip_cooperative_groups.h>
#include <cstdio>
#include <cstdint>
#include <cmath>
namespace cg = cooperative_groups;
namespace pg8 {
#define PG8_LAS __attribute__((address_space(3)))
typedef unsigned short bf16_t;
typedef short bf16x8 __attribute__((ext_vector_type(8)));
typedef float f32x4 __attribute__((ext_vector_type(4)));
typedef unsigned u32x4 __attribute__((ext_vector_type(4)));
constexpr int BM = 256, BK = 64, HALF = 128, HTB = HALF * BK * 2  , STAGE_BYTES = 8 * HTB, NXCD = 8, WGM = 8;

__host__ __device__ __forceinline__ int lds_byte(int r, int c) { const int st = (r >> 4) * 2 + (c >> 5), rr = r & 15, cc = c & 31, ob = rr * 64 + cc * 2; return st * 1024 + (ob ^ (((ob >> 9) & 1) << 5)); }
__host__ __device__ __forceinline__ void stage_rc(int b, int& R, int& C) { const int st = b / 1024, sb = b % 1024, swz = sb ^ (((sb >> 9) & 1) << 5); R = (st >> 1) * 16 + swz / 64; C = (st & 1) * 32 + (swz % 64) / 2; }
__host__ __device__ __forceinline__ int perm32(int rho) { const int n = rho >> 4, i = rho & 15; return 8 * (i >> 2) + 4 * n + (i & 3); }

struct Unit { int pm, pn; };
struct Gemm { const bf16_t* A; const bf16_t* Bt; int M, N, K; };

struct StaticOrder {
    int nM, nN, nwg, G, c;
    __host__ __device__ void init(int M, int N, int G_, int c_) { nM = M / BM; nN = N / BM; nwg = nM * nN; G = G_; c = c_; }
    __host__ __device__ bool next(int i, Unit& u) const {
        const long L = (long)i * G + c; if (L >= nwg) return false;
        int wgid = (int)L; { const int q = nwg / NXCD, r = nwg % NXCD, xcd = wgid % NXCD, off = wgid / NXCD; wgid = (xcd < r ? xcd * (q + 1) : r * (q + 1) + (xcd - r) * q) + off; }
        const int nig = WGM * nN, gid = wgid / nig, fm = gid * WGM, gsz = (nM - fm) < WGM ? (nM - fm) : WGM;
        u.pm = fm + ((wgid % nig) % gsz); u.pn = (wgid % nig) / gsz; return true;
    }
    __device__ __forceinline__ void a_ready(const Unit&) const {}
    __device__ __forceinline__ void done(const Unit&) const {}
};

template <class Epi, class Sched, bool ALIGN_EPI = false, bool SP2 = false>
__device__ __forceinline__ void gemm_phase(PG8_LAS unsigned char* lds, const Gemm g, const Sched& S, const Epi& E) {
    int tid_ = threadIdx.x; asm volatile("" : "+v"(tid_));
    const int tid = tid_, wid = __builtin_amdgcn_readfirstlane(tid >> 6), lane = tid & 63, wr = wid >> 2, wc = wid & 3, fr = lane & 15, fq = lane >> 4;
    const int K = g.K, nt = K / BK;
    unsigned voffA[2], voffB[2];
#pragma unroll
    for (int i = 0; i < 2; ++i) { int R, C; stage_rc(tid * 16 + i * 8192, R, C); const int Rb = Epi::PERM ? ((R & ~31) + perm32(R & 31)) : R;
        voffA[i] = (unsigned)(R * K + C) * 2u; voffB[i] = (unsigned)(Rb * K + C) * 2u; }
    const size_t kstep = (size_t)(BK * 2);
    const size_t hstep = (size_t)HALF * K * 2;
    const size_t tstep = 2 * hstep;
    const unsigned ldsw = (unsigned)wid * 1024u;
    const int aoff = lds_byte(wr * 64 + fr, fq * 8), boff = lds_byte(wc * 32 + fr, fq * 8);
#define PG8_SA(b, h) (((b) * 2 + (h)) * HTB)
#define PG8_SB(b, h) ((4 + (b) * 2 + (h)) * HTB)
#define PG8_STAGE(bufoff, gbase, voff) do { _Pragma("unroll") for (int _i = 0; _i < 2; ++_i) \
        __builtin_amdgcn_global_load_lds((const unsigned*)((const char*)(gbase) + (voff)[_i]), (PG8_LAS unsigned*)(lds + (bufoff) + ldsw + _i * 8192), 16, 0, 0); } while (0)
#define PG8_LDA(dst, b, h) do { _Pragma("unroll") for (int m = 0; m < 4; ++m) _Pragma("unroll") for (int k = 0; k < 2; ++k) dst[m][k] = *(const PG8_LAS bf16x8*)(lds + PG8_SA(b, h) + aoff + m * 2048 + k * 1024); } while (0)
#define PG8_LDB(dst, b, h) do { _Pragma("unroll") for (int n = 0; n < 2; ++n) _Pragma("unroll") for (int k = 0; k < 2; ++k) dst[n][k] = *(const PG8_LAS bf16x8*)(lds + PG8_SB(b, h) + boff + n * 2048 + k * 1024); } while (0)
#define PG8_MMA(ai, bj, At, Bt) do { __builtin_amdgcn_s_setprio(1); _Pragma("unroll") for (int m = 0; m < 4; ++m) _Pragma("unroll") for (int n = 0; n < 2; ++n) _Pragma("unroll") for (int k = 0; k < 2; ++k) \
        acc[ai][bj][m][n] = __builtin_amdgcn_mfma_f32_16x16x32_bf16(Bt[n][k], At[m][k], acc[ai][bj][m][n], 0, 0, 0); __builtin_amdgcn_s_setprio(0); } while (0)
#define PG8_WAIT_V(n) asm volatile("s_waitcnt vmcnt(" #n ")" ::: "memory")
#define PG8_WAIT_L(n) asm volatile("s_waitcnt lgkmcnt(" #n ")" ::: "memory")
#define PG8_BAR __builtin_amdgcn_s_barrier()
#define PG8_SCHED __builtin_amdgcn_sched_barrier(0)
    Unit cur, nxt; int ui = 0;
    if (!S.next(0, cur)) return;
    f32x4 acc[2][2][4][2];
#pragma unroll
    for (int a = 0; a < 2; ++a)
#pragma unroll
        for (int b = 0; b < 2; ++b)
#pragma unroll
            for (int m = 0; m < 4; ++m)
#pragma unroll
                for (int n = 0; n < 2; ++n) acc[a][b][m][n] = (f32x4){0.f, 0.f, 0.f, 0.f};
    bf16x8 At[4][2], B0[2][2], B1[2][2];
    const char* cA = (const char*)g.A + (size_t)cur.pm * tstep; const char* cB = (const char*)g.Bt + (size_t)cur.pn * tstep;
    S.a_ready(cur);
    if constexpr (SP2) {
        PG8_STAGE(PG8_SB(0, 0), cB, voffB); PG8_STAGE(PG8_SB(0, 1), cB + hstep, voffB); PG8_STAGE(PG8_SA(0, 0), cA, voffA); PG8_STAGE(PG8_SA(0, 1), cA + hstep, voffA);
        if (wr == 1) PG8_BAR;
        PG8_WAIT_V(2); PG8_BAR;
        PG8_STAGE(PG8_SB(1, 0), cB + kstep, voffB); PG8_STAGE(PG8_SA(1, 0), cA + kstep, voffA); PG8_STAGE(PG8_SB(1, 1), cB + hstep + kstep, voffB);
        PG8_WAIT_V(6); PG8_BAR;
    } else {
        PG8_STAGE(PG8_SB(0, 0), cB, voffB); PG8_STAGE(PG8_SA(0, 0), cA, voffA); PG8_STAGE(PG8_SB(0, 1), cB + hstep, voffB); PG8_STAGE(PG8_SA(0, 1), cA + hstep, voffA);
        if (wr == 1) PG8_BAR;
        PG8_WAIT_V(4); PG8_BAR;
        PG8_STAGE(PG8_SB(1, 0), cB + kstep, voffB); PG8_STAGE(PG8_SA(1, 0), cA + kstep, voffA); PG8_STAGE(PG8_SB(1, 1), cB + hstep + kstep, voffB);
        PG8_WAIT_V(6); PG8_BAR;
    }
    for (;;) {
        const bool has_next = S.next(ui + 1, nxt);
        const char* nA = has_next ? (const char*)g.A + (size_t)nxt.pm * tstep : cA; const char* nB = has_next ? (const char*)g.Bt + (size_t)nxt.pn * tstep : cB;
        for (int t = 0; t < nt; t += 2) {
            const bool last = (t == nt - 2);
            const char* a1 = cA + (size_t)(t + 1) * kstep;
            const char* a2 = last ? nA : cA + (size_t)(t + 2) * kstep; const char* b2 = last ? nB : cB + (size_t)(t + 2) * kstep;
            const char* a3 = a2 + kstep; const char* b3 = b2 + kstep;
            if (last && has_next) S.a_ready(nxt);
            if constexpr (SP2) {
            PG8_LDB(B0, 0, 0); PG8_LDB(B1, 0, 1); PG8_SCHED; PG8_LDA(At, 0, 0); PG8_STAGE(PG8_SA(1, 1), a1 + hstep, voffA);
            PG8_WAIT_V(8); PG8_WAIT_L(0); PG8_BAR; PG8_MMA(0, 0, At, B0); PG8_MMA(0, 1, At, B1); PG8_BAR; PG8_SCHED;
            PG8_LDA(At, 0, 1); PG8_STAGE(PG8_SB(0, 0), b2, voffB); PG8_STAGE(PG8_SB(0, 1), b2 + hstep, voffB); PG8_STAGE(PG8_SA(0, 0), a2, voffA);
            PG8_WAIT_V(8); PG8_WAIT_L(0); PG8_BAR; PG8_MMA(1, 0, At, B0); PG8_MMA(1, 1, At, B1); PG8_BAR; PG8_SCHED;
            PG8_LDB(B0, 1, 0); PG8_LDB(B1, 1, 1); PG8_SCHED; PG8_LDA(At, 1, 0); PG8_STAGE(PG8_SA(0, 1), a2 + hstep, voffA);
            PG8_WAIT_V(8); PG8_WAIT_L(0); PG8_BAR; PG8_MMA(0, 0, At, B0); PG8_MMA(0, 1, At, B1); PG8_BAR; PG8_SCHED;
            PG8_LDA(At, 1, 1); PG8_STAGE(PG8_SB(1, 0), b3, voffB); PG8_STAGE(PG8_SB(1, 1), b3 + hstep, voffB); PG8_STAGE(PG8_SA(1, 0), a3, voffA);
            PG8_WAIT_V(8); PG8_WAIT_L(0); PG8_BAR; PG8_MMA(1, 0, At, B0); PG8_MMA(1, 1, At, B1); PG8_BAR; PG8_SCHED;
            } else {
            PG8_LDB(B0, 0, 0); PG8_SCHED; PG8_LDA(At, 0, 0); PG8_STAGE(PG8_SA(1, 1), a1 + hstep, voffA);
            PG8_WAIT_L(8); PG8_BAR; PG8_WAIT_L(0); PG8_MMA(0, 0, At, B0); PG8_BAR; PG8_SCHED;
            PG8_LDB(B1, 0, 1); PG8_STAGE(PG8_SB(0, 0), b2, voffB);
            PG8_BAR; PG8_WAIT_L(0); PG8_MMA(0, 1, At, B1); PG8_BAR;
            PG8_LDA(At, 0, 1); PG8_STAGE(PG8_SA(0, 0), a2, voffA);
            PG8_BAR; PG8_WAIT_L(0); PG8_MMA(1, 0, At, B0); PG8_BAR; PG8_SCHED;
            PG8_STAGE(PG8_SB(0, 1), b2 + hstep, voffB);
            PG8_WAIT_V(6); PG8_BAR; PG8_MMA(1, 1, At, B1); PG8_BAR;
            PG8_LDB(B0, 1, 0); PG8_SCHED; PG8_LDA(At, 1, 0); PG8_STAGE(PG8_SA(0, 1), a2 + hstep, voffA);
            PG8_WAIT_L(8); PG8_BAR; PG8_WAIT_L(0); PG8_MMA(0, 0, At, B0); PG8_BAR; PG8_SCHED;
            PG8_LDB(B1, 1, 1); PG8_STAGE(PG8_SB(1, 0), b3, voffB);
            PG8_BAR; PG8_WAIT_L(0); PG8_MMA(0, 1, At, B1); PG8_BAR;
            PG8_LDA(At, 1, 1); PG8_STAGE(PG8_SA(1, 0), a3, voffA);
            PG8_BAR; PG8_WAIT_L(0); PG8_MMA(1, 0, At, B0); PG8_BAR; PG8_SCHED;
            PG8_STAGE(PG8_SB(1, 1), b3 + hstep, voffB);
            PG8_WAIT_V(6); PG8_BAR; PG8_MMA(1, 1, At, B1); PG8_BAR;
            }
        }
        if constexpr (ALIGN_EPI) { if (wr == 0) PG8_BAR; }
        if constexpr (!Epi::AFTER_DRAIN) { E(acc, cur, wr, wc, fr, fq); S.done(cur); }
        if (!has_next) break;
#pragma unroll
        for (int a = 0; a < 2; ++a)
#pragma unroll
            for (int b = 0; b < 2; ++b)
#pragma unroll
                for (int m = 0; m < 4; ++m)
#pragma unroll
                    for (int n = 0; n < 2; ++n) acc[a][b][m][n] = (f32x4){0.f, 0.f, 0.f, 0.f};
        cur = nxt; cA = nA; cB = nB; ++ui;
        if constexpr (ALIGN_EPI) { if (wr == 1) PG8_BAR; }
    }
    PG8_WAIT_V(0);
    if constexpr (!ALIGN_EPI) { if (wr == 0) PG8_BAR; }
    PG8_BAR;
    if constexpr (Epi::AFTER_DRAIN) { E.fused(acc, cur, wr, wc, fr, fq, lds, wid, lane); S.done(cur); }
#undef PG8_SA
#undef PG8_SB
#undef PG8_STAGE
#undef PG8_LDA
#undef PG8_LDB
#undef PG8_MMA
#undef PG8_WAIT_V
#undef PG8_WAIT_L
#undef PG8_BAR
#undef PG8_SCHED
}
}

#define LAS __attribute__((address_space(3)))
typedef unsigned short bf16;
typedef unsigned u32x4 __attribute__((ext_vector_type(4)));
typedef unsigned u32x2 __attribute__((ext_vector_type(2)));
typedef float f32x4 __attribute__((ext_vector_type(4)));
typedef float f32x16 __attribute__((ext_vector_type(16)));
typedef short bf16x8 __attribute__((ext_vector_type(8)));
typedef short v4i16_t __attribute__((ext_vector_type(4)));

constexpr int M = 16384, DM = 2048, SEQ = 2048, NBATCH = 8, NCH = 16;
constexpr int N0P = 11264, N0R = 11296;
constexpr float EPS = 1e-5f;
constexpr float LOG2E = 1.4426950408889634f;
constexpr float QSCALE = 0.125f * LOG2E;
constexpr float LAMBDA_INIT = 0.35550906f;
constexpr size_t MiB = 1u << 20;
constexpr size_t WS_ST0 = 0, WS_ST1 = 128 * 1024, WS_ST2 = 192 * 1024, WS_CD = 256 * 1024, WS_LAM = 300 * 1024;
constexpr size_t WS_RS0 = 320 * 1024;
constexpr size_t WS_DT = 1 * MiB, WS_WSP = 3 * MiB, WS_W0IN = 4 * MiB, WS_W0OUT = 49 * MiB, WS_W1IN = 65 * MiB, WS_W1OUT = 97 * MiB;
constexpr size_t WS_YCAT = 105 * MiB, WS_ZA = 233 * MiB, WS_V = 297 * MiB, WS_H0 = 361 * MiB, WS_XT = 425 * MiB, WS_CN = 489 * MiB, WS_END = 505 * MiB;
constexpr size_t WS_Q = WS_YCAT, WS_K = WS_YCAT + 64 * MiB, WS_X1 = WS_ZA, WS_STATES = WS_V, WS_VT = WS_H0, WS_X1B = WS_H0, WS_O = WS_ZA, WS_VV = WS_XT, WS_X2B = WS_YCAT;
constexpr size_t DO_XBC = 0, DO_BN = 96 * MiB, DO_BT = 112 * MiB, DO_PREV = 0, DO_G = 0;
constexpr int LDS_BYTES = 147456;
constexpr int ST_BOFF = 4096;
constexpr int GM_UOFF = 128 * 272, GM_ZOFF = 2 * 128 * 272, GM_WOFF = 3 * 128 * 272;
static_assert(4 * 128 * 272 <= LDS_BYTES - 512, "gMLP LDS map");

__device__ __forceinline__ unsigned pk2(float lo, float hi) {
    typedef float f2 __attribute__((ext_vector_type(2))); typedef __bf16 b2 __attribute__((ext_vector_type(2)));
    f2 v = {lo, hi}; b2 b = __builtin_convertvector(v, b2); return __builtin_bit_cast(unsigned, b);
}
__device__ __forceinline__ float bflo(unsigned u) { return __uint_as_float(u << 16); }
__device__ __forceinline__ float bfhi(unsigned u) { return __uint_as_float(u & 0xffff0000u); }
__device__ __forceinline__ void unpack8(u32x4 r, float* f) { f[0] = bflo(r.x); f[1] = bfhi(r.x); f[2] = bflo(r.y); f[3] = bfhi(r.y); f[4] = bflo(r.z); f[5] = bfhi(r.z); f[6] = bflo(r.w); f[7] = bfhi(r.w); }
__device__ __forceinline__ u32x4 pack8(const float* f) { u32x4 o; o.x = pk2(f[0], f[1]); o.y = pk2(f[2], f[3]); o.z = pk2(f[4], f[5]); o.w = pk2(f[6], f[7]); return o; }
__device__ __forceinline__ float fexp2(float x) { return __builtin_amdgcn_exp2f(x); }
__device__ __forceinline__ float gelu_f(float x) { const float z = 1.5957691216057308f * (x + 0.044715f * x * x * x); return x * __builtin_amdgcn_rcpf(1.0f + __expf(-z)); }
__device__ __forceinline__ float silu_f(float x) { return x * __builtin_amdgcn_rcpf(1.0f + __expf(-x)); }
__device__ __forceinline__ int crow(int r, int h) { return (r & 3) + 8 * (r >> 2) + 4 * h; }
__device__ __forceinline__ f32x16 mfma32(bf16x8 a, bf16x8 b, f32x16 c) { return __builtin_amdgcn_mfma_f32_32x32x16_bf16(a, b, c, 0, 0, 0); }
__device__ __forceinline__ bf16x8 ld_frag16(const bf16* p) { return __builtin_bit_cast(bf16x8, *(const u32x4*)p); }
__device__ __forceinline__ bf16x8 ld_frag8x2(const bf16* p) { const u32x2 lo = *(const u32x2*)p, hi = *(const u32x2*)(p + 8); u32x4 v; v.x = lo.x; v.y = lo.y; v.z = hi.x; v.w = hi.y; return __builtin_bit_cast(bf16x8, v); }
__device__ __forceinline__ bf16x8 pack_frag(const f32x16& x, int s) {
    u32x4 v; v.x = pk2(x[8 * s], x[8 * s + 1]); v.y = pk2(x[8 * s + 2], x[8 * s + 3]); v.z = pk2(x[8 * s + 4], x[8 * s + 5]); v.w = pk2(x[8 * s + 6], x[8 * s + 7]); return __builtin_bit_cast(bf16x8, v);
}
__device__ __forceinline__ float wave_sum(float v) {
#pragma unroll
    for (int o = 1; o < 64; o <<= 1) v += __shfl_xor(v, o);
    return v;
}
#define LDS_WAIT() asm volatile("s_waitcnt lgkmcnt(0)" ::: "memory")
__device__ __forceinline__ void atomic_addf(float* p, float v) { __hip_atomic_fetch_add(p, v, __ATOMIC_RELAXED, __HIP_MEMORY_SCOPE_AGENT); }

struct Params { const float* in[23]; float* out; unsigned char* ws; };
constexpr int PTAB_OFF = LDS_BYTES - 512;
__device__ __forceinline__ unsigned long long ptab_get(int i) {
    const unsigned long long v = ((const LAS unsigned long long*)(PTAB_OFF))[i];
    const unsigned lo = __builtin_amdgcn_readfirstlane((unsigned)v), hi = __builtin_amdgcn_readfirstlane((unsigned)(v >> 32));
    return ((unsigned long long)hi << 32) | lo;
}
struct PT {
    struct InTab { __device__ __forceinline__ const float* operator[](int i) const { return (const float*)(const __attribute__((address_space(1))) float*)ptab_get(i); } } in;
    float* out; unsigned char* ws;
    __device__ __forceinline__ PT() { out = (float*)(__attribute__((address_space(1))) float*)ptab_get(23); ws = (unsigned char*)(__attribute__((address_space(1))) unsigned char*)ptab_get(24); }
};

template <int ACT>
__device__ __forceinline__ void epi_tile_bf16(const f32x4 (&acc)[2][2][4][2], bf16* base, int pitch, int col0, int row0, float sc) {
#pragma unroll
    for (int ai = 0; ai < 2; ++ai)
#pragma unroll
        for (int m = 0; m < 4; ++m) {
            bf16* rowp = base + (size_t)(row0 + ai * 128 + m * 16) * pitch + col0;
#pragma unroll
            for (int bj = 0; bj < 2; ++bj) {
                float v[8];
#pragma unroll
                for (int j = 0; j < 4; ++j) { v[j] = acc[ai][bj][m][0][j]; v[4 + j] = acc[ai][bj][m][1][j]; }
#pragma unroll
                for (int j = 0; j < 8; ++j) { if (ACT == 1) v[j] = gelu_f(v[j]); else if (ACT == 2) v[j] = silu_f(v[j]); else if (ACT == 3) v[j] *= sc; }
                *(u32x4*)(rowp + bj * 128) = pack8(v);
            }
        }
}

struct EpiIn0 {
    static constexpr bool PERM = true, AFTER_DRAIN = false;
    bf16 *ycat, *vbuf, *za, *xbc; float* stats0;
    __device__ __forceinline__ void operator()(const f32x4 (&acc)[2][2][4][2], const pg8::Unit& u, int wr, int wc, int fr, int fq) const {
        const int pn = u.pn, row0 = u.pm * 256 + wr * 64 + fr, cl = wc * 32 + 8 * fq;
        if (pn < 16) {
#pragma unroll
            for (int ai = 0; ai < 2; ++ai)
#pragma unroll
                for (int m = 0; m < 4; ++m) {
                    const int row = row0 + ai * 128 + m * 16; float v[8];
#pragma unroll
                    for (int j = 0; j < 4; ++j) { v[j] = gelu_f(acc[ai][0][m][0][j]) * silu_f(acc[ai][1][m][0][j]); v[4 + j] = gelu_f(acc[ai][0][m][1][j]) * silu_f(acc[ai][1][m][1][j]); }
                    *(u32x4*)(ycat + (size_t)row * 4096 + pn * 128 + cl) = pack8(v);
                }
        }
        else if (pn < 24) {
#pragma unroll
            for (int ai = 0; ai < 2; ++ai)
#pragma unroll
                for (int m = 0; m < 4; ++m) {
                    const int row = row0 + ai * 128 + m * 16;
                    bf16* rowp = vbuf + (size_t)row * 2048 + (pn - 16) * 256 + cl;
                    float s = 0.f, ss = 0.f;
#pragma unroll
                    for (int bj = 0; bj < 2; ++bj) {
                        float v[8];
#pragma unroll
                        for (int j = 0; j < 4; ++j) { v[j] = gelu_f(acc[ai][bj][m][0][j]); v[4 + j] = gelu_f(acc[ai][bj][m][1][j]); }
#pragma unroll
                        for (int j = 0; j < 8; ++j) { s += v[j]; ss += v[j] * v[j]; }
                        *(u32x4*)(rowp + bj * 128) = pack8(v);
                    }
                    s += __shfl_xor(s, 16); s += __shfl_xor(s, 32); ss += __shfl_xor(ss, 16); ss += __shfl_xor(ss, 32);
                    if (fq == 0) { atomic_addf(stats0 + 2 * row, s); atomic_addf(stats0 + 2 * row + 1, ss); }
                }
        }
        else if (pn < 32) { epi_tile_bf16<2>(acc, ycat, 4096, 2048 + (pn - 24) * 256 + cl, row0, 1.f); }
        else { epi_tile_bf16<0>(acc, xbc, 3072, (pn - 32) * 256 + cl, row0, 1.f); }
    }
};

__device__ __forceinline__ void dt_tasks(const PT& p, LAS unsigned char* lds, int lane, int wave) {
    unsigned char* ws = p.ws; const bf16* H0 = (const bf16*)(ws + WS_H0); const bf16* Wdt = (const bf16*)(ws + WS_W0IN) + (size_t)11264 * 2048; float* DT = (float*)(ws + WS_DT);
    const int r32 = lane & 31, h = lane >> 5, kq = wave & 3;
    for (int base = blockIdx.x * 2; base < 512; base += gridDim.x * 2) {
        const int task = base + (wave >> 2);
        const bf16* ap = Wdt + (size_t)r32 * 2048 + 512 * kq + 8 * h; const bf16* bp = H0 + (size_t)(task * 32 + r32) * 2048 + 512 * kq + 8 * h;
        f32x16 acc;
#pragma unroll
        for (int i = 0; i < 16; ++i) acc[i] = 0.f;
#pragma unroll 8
        for (int st = 0; st < 32; ++st) acc = mfma32(ld_frag16(ap + 16 * st), ld_frag16(bp + 16 * st), acc);
        LAS float* part = (LAS float*)lds + wave * 1024;
        __syncthreads();
        if (kq != 0) {
#pragma unroll
            for (int i = 0; i < 16; ++i) part[i * 64 + lane] = acc[i]; }
        __syncthreads();
        if (kq == 0) {
#pragma unroll
            for (int i = 0; i < 16; ++i) acc[i] += part[1024 + i * 64 + lane] + part[2048 + i * 64 + lane] + part[3072 + i * 64 + lane];
#pragma unroll
            for (int qd = 0; qd < 4; ++qd) {
                const int j0 = 8 * qd + 4 * h; const f32x4 bb = *(const f32x4*)(p.in[9] + j0); f32x4 v;
#pragma unroll
                for (int j = 0; j < 4; ++j) { const float x = acc[4 * qd + j] + bb[j]; v[j] = x > 20.f ? x : log1pf(__expf(x)); }
                *(f32x4*)(DT + (size_t)(task * 32 + r32) * 32 + j0) = v;
            }
        }
    }
}

template <int RMODE> struct EpiResT {
    static constexpr bool PERM = true, AFTER_DRAIN = false;
    const void* resid; float* outf; bf16* outb; float* stats; const float* rs0; const float* g0; const float* xf;
    __device__ __forceinline__ void operator()(const f32x4 (&acc)[2][2][4][2], const pg8::Unit& u, int wr, int wc, int fr, int fq) const {
        const int row0 = u.pm * 256 + wr * 64 + fr, col0 = u.pn * 256 + wc * 32 + 8 * fq;
        float gi[2][8]; unsigned gz = 0u;
        if (RMODE == 2) {
#pragma unroll
            for (int bj = 0; bj < 2; ++bj)
#pragma unroll
                for (int j = 0; j < 8; ++j) { const float g = g0[col0 + bj * 128 + j]; if (g == 0.f) gz |= 1u << (bj * 8 + j); gi[bj][j] = __builtin_amdgcn_rcpf(g); }
        }
#pragma unroll
        for (int ai = 0; ai < 2; ++ai)
#pragma unroll
            for (int m = 0; m < 4; ++m) {
                const int row = row0 + ai * 128 + m * 16; const size_t off = (size_t)row * 2048 + col0;
                float ss = 0.f, ri = 1.f;
                if (RMODE == 2) ri = __builtin_amdgcn_rcpf(rs0[row]);
#pragma unroll
                for (int bj = 0; bj < 2; ++bj) {
                    f32x4 r0, r1;
                    if (RMODE != 0) { float f[8]; unpack8(*(const u32x4*)((const bf16*)resid + off + bj * 128), f);
                        if (RMODE == 2) {
#pragma unroll
                            for (int j = 0; j < 8; ++j) f[j] *= ri * gi[bj][j];
                            if (gz != 0u) {
#pragma unroll
                                for (int j = 0; j < 8; ++j) if ((gz >> (bj * 8 + j)) & 1u) f[j] = xf[off + bj * 128 + j]; } }
                        r0 = (f32x4){f[0], f[1], f[2], f[3]}; r1 = (f32x4){f[4], f[5], f[6], f[7]}; }
                    else { r0 = *(const f32x4*)((const float*)resid + off + bj * 128); r1 = *(const f32x4*)((const float*)resid + off + bj * 128 + 4); }
                    r0 = r0 + acc[ai][bj][m][0]; r1 = r1 + acc[ai][bj][m][1];
                    if (outf) { *(f32x4*)(outf + off + bj * 128) = r0; *(f32x4*)(outf + off + bj * 128 + 4) = r1; }
                    ss += (r0[0] * r0[0] + r0[1] * r0[1]) + (r0[2] * r0[2] + r0[3] * r0[3]) + (r1[0] * r1[0] + r1[1] * r1[1]) + (r1[2] * r1[2] + r1[3] * r1[3]);
                    if (outb) { u32x4 w; w.x = pk2(r0[0], r0[1]); w.y = pk2(r0[2], r0[3]); w.z = pk2(r1[0], r1[1]); w.w = pk2(r1[2], r1[3]); *(u32x4*)(outb + off + bj * 128) = w; }
                }
                ss += __shfl_xor(ss, 16); ss += __shfl_xor(ss, 32);
                if (fq == 0) atomic_addf(stats + row, ss);
            }
    }
};

struct EpiIn1 {
    static constexpr bool PERM = true, AFTER_DRAIN = false;
    bf16 *q, *k, *v, *g; const float* stats1;
    __device__ __forceinline__ void operator()(const f32x4 (&acc)[2][2][4][2], const pg8::Unit& u, int wr, int wc, int fr, int fq) const {
        const int seg = u.pn >> 3, row0 = u.pm * 256 + wr * 64 + fr, col0 = (u.pn & 7) * 256 + wc * 32 + 8 * fq;
        bf16* base = seg == 0 ? q : (seg == 1 ? k : (seg == 2 ? v : g));
        const float sc = seg == 0 ? QSCALE : 1.f;
#pragma unroll
        for (int ai = 0; ai < 2; ++ai)
#pragma unroll
            for (int m = 0; m < 4; ++m) {
                const int row = row0 + ai * 128 + m * 16;
                const float rs = rsqrtf(stats1[row] * (1.f / 2048.f) + EPS) * sc;
                bf16* rowp = base + (size_t)row * 2048 + col0;
#pragma unroll
                for (int bj = 0; bj < 2; ++bj) {
                    float v8[8];
#pragma unroll
                    for (int j = 0; j < 4; ++j) { v8[j] = acc[ai][bj][m][0][j] * rs; v8[4 + j] = acc[ai][bj][m][1][j] * rs; }
                    if (seg == 3) {
#pragma unroll
                        for (int j = 0; j < 8; ++j) v8[j] = silu_f(v8[j]);
                    }
                    *(u32x4*)(rowp + bj * 128) = pack8(v8);
                }
            }
    }
};

__device__ __forceinline__ int w0in_row(int n) { return n < 2048 ? ((n >> 7) << 8) + (n & 127) : (n < 4096 ? n + 2048 : (n < 6144 ? (((n - 4096) >> 7) << 8) + 128 + ((n - 4096) & 127) : n)); }
template <bool MAP0> __device__ __forceinline__ void transpose_item(const float* W, int K, int N, bf16* WT, int item, int lane, const float* kscale) {
    const int nblk = N / 32, kb = item / nblk, nb = item % nblk, kq = lane & 7, c4 = lane >> 3;
    const int k0 = 64 * kb + 8 * kq, n0 = 32 * nb + 4 * c4;
    f32x4 v[8];
#pragma unroll
    for (int i = 0; i < 8; ++i) v[i] = *(const f32x4*)(W + (size_t)(k0 + i) * N + n0);
    if (kscale) {
        const f32x4 g0 = *(const f32x4*)(kscale + k0), g1 = *(const f32x4*)(kscale + k0 + 4);
#pragma unroll
        for (int i = 0; i < 4; ++i) { v[i] = v[i] * g0[i]; v[4 + i] = v[4 + i] * g1[i]; }
    }
#pragma unroll
    for (int j = 0; j < 4; ++j) {
        u32x4 o; o.x = pk2(v[0][j], v[1][j]); o.y = pk2(v[2][j], v[3][j]); o.z = pk2(v[4][j], v[5][j]); o.w = pk2(v[6][j], v[7][j]);
        *(u32x4*)(WT + (size_t)((MAP0 ? w0in_row(n0) : n0) + j) * K + k0) = o;
    }
}

__device__ __forceinline__ void phase0(const PT& p, LAS unsigned char* lds, int tid, int lane, int wave) {
    unsigned char* ws = p.ws;
    const int gw = blockIdx.x * 8 + wave, NGW = gridDim.x * 8;
    const int gt = blockIdx.x * 512 + tid, NGT = gridDim.x * 512;
    for (int i = gt; i < 65536; i += NGT) ((float*)(ws + WS_ST0))[i] = 0.f;
    constexpr int I0 = 32 * (N0R / 32), I1 = 64 * 64, I2 = 32 * 256, I3 = 32 * 64;
    for (int it = gw; it < I0 + I1 + I2 + I3; it += NGW) {
        int r = it;
        if (r < I0) { transpose_item<true>(p.in[2], 2048, N0R, (bf16*)(ws + WS_W0IN), r, lane, nullptr); continue; } r -= I0;
        if (r < I1) { transpose_item<false>(p.in[13], 4096, 2048, (bf16*)(ws + WS_W0OUT), r, lane, nullptr); continue; } r -= I1;
        if (r < I2) { transpose_item<false>(p.in[15], 2048, 8192, (bf16*)(ws + WS_W1IN), r, lane, p.in[14]); continue; } r -= I2;
        transpose_item<false>(p.in[21], 2048, 2048, (bf16*)(ws + WS_W1OUT), r, lane, nullptr);
    }
    for (int i = gt; i < 16 * 128 * 128 / 8; i += NGT) {
        const int e = i * 8, t = (e >> 7) & 127, s0 = e & 127; const float* src = p.in[5] + e; float v[8];
#pragma unroll
        for (int j = 0; j < 8; ++j) v[j] = (s0 + j <= t) ? src[j] : 0.f;
        ((u32x4*)(ws + WS_WSP))[i] = pack8(v);
    }
    const float* g0 = p.in[1]; bf16* H0 = (bf16*)(ws + WS_H0);
    for (int m = gw; m < M; m += NGW) {
        const f32x4* xr = (const f32x4*)(p.in[0] + (size_t)m * 2048) + lane; f32x4 v[8]; float s = 0.f;
#pragma unroll
        for (int j = 0; j < 8; ++j) { v[j] = xr[64 * j]; s += (v[j].x * v[j].x + v[j].y * v[j].y) + (v[j].z * v[j].z + v[j].w * v[j].w); }
        const float rs = rsqrtf(wave_sum(s) * (1.f / 2048.f) + EPS);
        if (lane == 0) ((float*)(ws + WS_RS0))[m] = rs;
        u32x2* o = (u32x2*)(H0 + (size_t)m * 2048) + lane;
#pragma unroll
        for (int j = 0; j < 8; ++j) { const f32x4 g = ((const f32x4*)g0)[lane + 64 * j]; u32x2 w; w.x = pk2(v[j].x * rs * g.x, v[j].y * rs * g.y); w.y = pk2(v[j].z * rs * g.z, v[j].w * rs * g.w); o[64 * j] = w; }
    }
}

__device__ __forceinline__ void phase_layout(const PT& p, int tid) {
    unsigned char* ws = p.ws; unsigned char* dob = (unsigned char*)p.out;
    const bf16* Vb = (const bf16*)(ws + WS_V); const float* st0 = (const float*)(ws + WS_ST0);
    const bf16* XBC = (const bf16*)(dob + DO_XBC);
    bf16 *vT = (bf16*)(ws + WS_VT), *xT = (bf16*)(ws + WS_XT), *Bn = (bf16*)(dob + DO_BN), *BT = (bf16*)(dob + DO_BT), *Cn = (bf16*)(ws + WS_CN);
    const int t = tid & 255, so = t >> 4, co = t & 15;
    for (int pi = blockIdx.x * 2 + (tid >> 8); pi < 128 * 24; pi += gridDim.x * 2) {
        const int bc = pi / 24, k = 16 + pi % 24; const int tok0 = bc * 128 + so * 8;
        float o[8][8];
        if (k < 16) {
            const int ch0 = k * 128 + co * 8;
            float g[8], bb[8];
#pragma unroll
            for (int j = 0; j < 8; ++j) { g[j] = p.in[3][ch0 + j]; bb[j] = p.in[4][ch0 + j]; }
#pragma unroll
            for (int i = 0; i < 8; ++i) {
                const int row = tok0 + i; float f[8]; unpack8(*(const u32x4*)(Vb + (size_t)row * 2048 + ch0), f);
                const float mu = st0[2 * row] * (1.f / 2048.f), var = st0[2 * row + 1] * (1.f / 2048.f) - mu * mu, rs = rsqrtf(fmaxf(var, 0.f) + EPS);
#pragma unroll
                for (int j = 0; j < 8; ++j) o[i][j] = (f[j] - mu) * rs * g[j] + bb[j];
            }
#pragma unroll
            for (int j = 0; j < 8; ++j) { float c8[8];
#pragma unroll
                for (int i = 0; i < 8; ++i) c8[i] = o[i][j];
                *(u32x4*)(vT + ((size_t)bc * 2048 + ch0 + j) * 128 + so * 8) = pack8(c8); }
        } else {
            const int sc0 = (k - 16) * 128 + co * 8;
            float cw[4][8], cb[8];
#pragma unroll
            for (int j = 0; j < 8; ++j) { cb[j] = p.in[8][sc0 + j];
#pragma unroll
                for (int kk = 0; kk < 4; ++kk) cw[kk][j] = p.in[7][kk * 3072 + sc0 + j]; }
            const int pos0 = (bc & 15) * 128 + so * 8;
            float xw[11][8];
#pragma unroll
            for (int ii = 0; ii < 11; ++ii) {
                if (pos0 - 3 + ii >= 0) unpack8(*(const u32x4*)(XBC + (size_t)(tok0 - 3 + ii) * 3072 + sc0), xw[ii]);
                else {
#pragma unroll
                    for (int j = 0; j < 8; ++j) xw[ii][j] = 0.f;
                }
            }
#pragma unroll
            for (int i = 0; i < 8; ++i)
#pragma unroll
                for (int j = 0; j < 8; ++j) { float a = cb[j];
#pragma unroll
                    for (int kk = 0; kk < 4; ++kk) a += cw[kk][j] * xw[i + kk][j];
                    o[i][j] = silu_f(a); }
            if (k < 32) {
#pragma unroll
                for (int j = 0; j < 8; ++j) { float c8[8];
#pragma unroll
                    for (int i = 0; i < 8; ++i) c8[i] = o[i][j];
                    *(u32x4*)(xT + ((size_t)bc * 2048 + sc0 + j) * 128 + so * 8) = pack8(c8); }
            } else if (k < 36) {
                const int n0 = sc0 - 2048;
#pragma unroll
                for (int i = 0; i < 8; ++i) *(u32x4*)(Bn + (size_t)(tok0 + i) * 512 + n0) = pack8(o[i]);
#pragma unroll
                for (int j = 0; j < 8; ++j) { float c8[8];
#pragma unroll
                    for (int i = 0; i < 8; ++i) c8[i] = o[i][j];
                    *(u32x4*)(BT + ((size_t)bc * 512 + n0 + j) * 128 + so * 8) = pack8(c8); }
            } else {
                const int n0 = sc0 - 2560;
#pragma unroll
                for (int i = 0; i < 8; ++i) *(u32x4*)(Cn + (size_t)(tok0 + i) * 512 + n0) = pack8(o[i]);
            }
        }
    }
}

__device__ __forceinline__ void chunk_cumsum(const float* DT, const float* a_log, int tok0, int hh, int lane, float& d0, float& d1, float& c0, float& c1, float& tot) {
    d0 = DT[(size_t)(tok0 + 2 * lane) * 32 + hh]; d1 = DT[(size_t)(tok0 + 2 * lane + 1) * 32 + hh];
    const float A = -__expf(a_log[hh]); const float x0 = d0 * A, x1 = d1 * A; float ps = x0 + x1;
#pragma unroll
    for (int o = 1; o < 64; o <<= 1) { const float t = __shfl_up(ps, o); if (lane >= o) ps += t; }
    c1 = ps; c0 = ps - x1; tot = __shfl(ps, 63);
}

__device__ __forceinline__ void phase_mix(const PT& p, LAS unsigned char* lds, int tid, int lane, int wave) {
    unsigned char* ws = p.ws; unsigned char* dob = (unsigned char*)p.out;
    const int r32 = lane & 31, h = lane >> 5;
    bf16* Ycat = (bf16*)(ws + WS_YCAT); const bf16* ZA = (const bf16*)(ws + WS_ZA); const bf16* Vb = (const bf16*)(ws + WS_V); const float* st0 = (const float*)(ws + WS_ST0); const bf16* Wsp = (const bf16*)(ws + WS_WSP);
    const bf16* xT = (const bf16*)(ws + WS_XT); const bf16* BT = (const bf16*)(dob + DO_BT); const float* DT = (const float*)(ws + WS_DT);
    bf16* ST = (bf16*)(ws + WS_STATES); float* CD = (float*)(ws + WS_CD);
    LAS float* wtab = (LAS float*)lds;
    constexpr int NG = 128 * 16, NS = NBATCH * 15 * 4;
    for (int it = blockIdx.x; it < NG + NS; it += gridDim.x) {
        if (it < NG) {
            const int bc = it >> 4, g = it & 15, cb = wave & 3, th = wave >> 2;
            const int ch0 = g * 128 + cb * 32;
            __syncthreads();
            {
                const int c16 = tid & 15; float lg[8], lb[8];
#pragma unroll
                for (int j = 0; j < 8; ++j) { lg[j] = p.in[3][g * 128 + 8 * c16 + j]; lb[j] = p.in[4][g * 128 + 8 * c16 + j]; }
#pragma unroll
                for (int i = 0; i < 4; ++i) {
                    const int row = (tid >> 4) + 32 * i; const size_t tokr = (size_t)bc * 128 + row;
                    float f[8]; unpack8(*(const u32x4*)(Vb + tokr * 2048 + g * 128 + 8 * c16), f);
                    const float mu = st0[2 * tokr] * (1.f / 2048.f), var = st0[2 * tokr + 1] * (1.f / 2048.f) - mu * mu, rs = rsqrtf(fmaxf(var, 0.f) + EPS);
#pragma unroll
                    for (int j = 0; j < 8; ++j) f[j] = (f[j] - mu) * rs * lg[j] + lb[j];
                    *(LAS u32x4*)(lds + row * 272 + 16 * c16) = pack8(f);
                    *(LAS u32x4*)(lds + GM_UOFF + row * 272 + 16 * c16) = *(const u32x4*)(Ycat + tokr * 4096 + g * 128 + 8 * c16);
                    *(LAS u32x4*)(lds + GM_WOFF + row * 272 + 16 * c16) = *(const u32x4*)(Wsp + ((size_t)g * 128 + row) * 128 + 8 * c16);
                }
            }
            __syncthreads();
            const LAS unsigned char* ap = lds + (8 * h + ((lane & 15) >> 2)) * 272 + (cb * 32 + 16 * ((lane >> 4) & 1)) * 2 + (lane & 3) * 8;
            f32x16 acc[2];
#pragma unroll
            for (int i = 0; i < 16; ++i) { acc[0][i] = 0.f; acc[1][i] = 0.f; }
#pragma unroll
            for (int st = 0; st < 8; ++st) {
                const v4i16_t lo = __builtin_amdgcn_ds_read_tr16_b64_v4i16((LAS v4i16_t*)(ap + 16 * st * 272)), hi = __builtin_amdgcn_ds_read_tr16_b64_v4i16((LAS v4i16_t*)(ap + (16 * st + 4) * 272));
                const bf16x8 a = {lo[0], lo[1], lo[2], lo[3], hi[0], hi[1], hi[2], hi[3]};
#pragma unroll
                for (int t2 = 0; t2 < 2; ++t2) { const int tb = 2 * th + t2;
                    if (st < 2 * (tb + 1)) { const bf16x8 b = __builtin_bit_cast(bf16x8, *(const LAS u32x4*)(lds + GM_WOFF + (tb * 32 + r32) * 272 + (16 * st + 8 * h) * 2)); acc[t2] = mfma32(a, b, acc[t2]); } }
                __builtin_amdgcn_sched_barrier(0);
            }
#pragma unroll
            for (int t2 = 0; t2 < 2; ++t2) {
                const int t = (2 * th + t2) * 32 + r32; const float sb = p.in[6][g * 128 + t];
#pragma unroll
                for (int qd = 0; qd < 4; ++qd) {
                    const int cl = cb * 32 + 8 * qd + 4 * h;
                    LAS u32x2* up = (LAS u32x2*)(lds + GM_UOFF + t * 272 + cl * 2); const u32x2 uu = *up;
                    const float y0 = bflo(uu.x) * (acc[t2][4 * qd] + sb), y1 = bfhi(uu.x) * (acc[t2][4 * qd + 1] + sb);
                    const float y2 = bflo(uu.y) * (acc[t2][4 * qd + 2] + sb), y3 = bfhi(uu.y) * (acc[t2][4 * qd + 3] + sb);
                    u32x2 w; w.x = pk2(y0, y1); w.y = pk2(y2, y3); *up = w;
                }
            }
            __syncthreads();
            { const int c16 = tid & 15;
#pragma unroll
              for (int i = 0; i < 4; ++i) { const int row = (tid >> 4) + 32 * i; *(u32x4*)(Ycat + ((size_t)bc * 128 + row) * 4096 + g * 128 + 8 * c16) = *(const LAS u32x4*)(lds + GM_UOFF + row * 272 + 16 * c16); } }
        } else {
            const int id = it - NG, b = id / 60, c = (id / 4) % 15, grp = id & 3; const int bc = b * 16 + c, tok0 = bc * 128;
            __syncthreads();
            { const int hh = grp * 8 + wave; float d0, d1, c0, c1, tot; chunk_cumsum(DT, p.in[10], tok0, hh, lane, d0, d1, c0, c1, tot);
              wtab[wave * 128 + 2 * lane] = d0 * __expf(tot - c0); wtab[wave * 128 + 2 * lane + 1] = d1 * __expf(tot - c1);
              if (lane == 0) CD[bc * 32 + hh] = __expf(tot); }
#pragma unroll
            for (int i = 0; i < 4; ++i) { const int pid = tid + 512 * i, row = pid >> 4, c16 = pid & 15;
                *(LAS u32x4*)(lds + ST_BOFF + row * 272 + 16 * c16) = *(const u32x4*)(BT + ((size_t)bc * 512 + grp * 128 + row) * 128 + 8 * c16); }
            __syncthreads();
#pragma unroll 1
            for (int tk = 0; tk < 2; ++tk) {
                const int r = (wave >> 1) + 4 * tk, pb = wave & 1, hh = grp * 8 + r;
                const bf16* ap = xT + ((size_t)bc * 2048 + hh * 64 + pb * 32 + r32) * 128 + 8 * h;
                const LAS unsigned char* bp = lds + ST_BOFF + r32 * 272 + 16 * h;
                f32x16 acc[4];
#pragma unroll
                for (int nb = 0; nb < 4; ++nb)
#pragma unroll
                    for (int i = 0; i < 16; ++i) acc[nb][i] = 0.f;
#pragma unroll
                for (int st = 0; st < 8; ++st) {
                    float f[8]; unpack8(*(const u32x4*)(ap + 16 * st), f);
                    const f32x4 w0 = *(const LAS f32x4*)(wtab + r * 128 + 16 * st + 8 * h), w1 = *(const LAS f32x4*)(wtab + r * 128 + 16 * st + 8 * h + 4);
                    f[0] *= w0.x; f[1] *= w0.y; f[2] *= w0.z; f[3] *= w0.w; f[4] *= w1.x; f[5] *= w1.y; f[6] *= w1.z; f[7] *= w1.w;
                    const bf16x8 a = __builtin_bit_cast(bf16x8, pack8(f));
#pragma unroll
                    for (int nb = 0; nb < 4; ++nb) { const bf16x8 bfr = __builtin_bit_cast(bf16x8, *(const LAS u32x4*)(bp + nb * 32 * 272 + 32 * st)); acc[nb] = mfma32(a, bfr, acc[nb]); }
                    __builtin_amdgcn_sched_barrier(0);
                }
                bf16* sp = ST + ((size_t)(bc * 32 + hh) * 64 + pb * 32) * 128;
#pragma unroll
                for (int nb = 0; nb < 4; ++nb)
#pragma unroll
                    for (int i = 0; i < 16; ++i) sp[(size_t)crow(i, h) * 128 + nb * 32 + r32] = (bf16)(pk2(acc[nb][i], 0.f) & 0xffffu);
            }
        }
    }
}

__device__ __forceinline__ void phase_scan(const PT& p, int tid) {
    unsigned char* ws = p.ws; const bf16* ST = (const bf16*)(ws + WS_STATES); const float* CD = (const float*)(ws + WS_CD); bf16* PV = (bf16*)((unsigned char*)p.out + DO_PREV);
    for (int id = blockIdx.x * 512 + tid; id < NBATCH * 32 * 64 * 16; id += gridDim.x * 512) {
        const int b = id >> 15, rem = id & 32767, hh = rem >> 10;
        float run[8];
#pragma unroll
        for (int j = 0; j < 8; ++j) run[j] = 0.f;
#pragma unroll
        for (int c = 0; c < 16; ++c) {
            const size_t off = ((size_t)(b * 16 + c) * 32 * 64 * 16 + rem) * 8;
            *(u32x4*)(PV + off) = pack8(run);
            if (c < 15) { float s[8]; unpack8(*(const u32x4*)(ST + off), s); const float cd = CD[(b * 16 + c) * 32 + hh];
#pragma unroll
                for (int j = 0; j < 8; ++j) run[j] = run[j] * cd + s[j]; }
        }
    }
}

constexpr int SY_TILE = 9728, SY_TP = 1040;
static_assert(SY_TILE + 128 * SY_TP <= PTAB_OFF, "ssd_y LDS map");
__device__ __forceinline__ void phase_ssd_y(const PT& p, LAS unsigned char* lds, int tid, int lane, int wave) {
    unsigned char* ws = p.ws; unsigned char* dob = (unsigned char*)p.out;
    const int r32 = lane & 31, h = lane >> 5;
    bf16* Ycat = (bf16*)(ws + WS_YCAT); const bf16* xT = (const bf16*)(ws + WS_XT); const bf16* Bn = (const bf16*)(dob + DO_BN); const bf16* Cn = (const bf16*)(ws + WS_CN);
    const bf16* PV = (const bf16*)(dob + DO_PREV); const float* DT = (const float*)(ws + WS_DT);
    LAS float* acum = (LAS float*)lds; LAS float* dtt = acum + 1024; LAS float* ssqp = dtt + 1024; LAS float* rsT = ssqp + 256;
    LAS unsigned char* tile = lds + SY_TILE;
    for (int it = blockIdx.x; it < 128 * 4; it += gridDim.x) {
        const int bc = it >> 2, grp = it & 3, tok0 = bc * 128;
        __syncthreads();
        { const int hh = grp * 8 + wave; float d0, d1, c0, c1, tot; chunk_cumsum(DT, p.in[10], tok0, hh, lane, d0, d1, c0, c1, tot);
          acum[wave * 128 + 2 * lane] = c0; acum[wave * 128 + 2 * lane + 1] = c1; dtt[wave * 128 + 2 * lane] = d0; dtt[wave * 128 + 2 * lane + 1] = d1; }
#pragma unroll 4
        for (int i = 0; i < 16; ++i) { const int pid = tid + 512 * i, row = pid >> 6, c8 = pid & 63;
            *(LAS u32x4*)(tile + row * SY_TP + 16 * c8) = *(const u32x4*)(Ycat + ((size_t)tok0 + row) * 4096 + 2048 + grp * 512 + 8 * c8); }
        __syncthreads();
        const int pb = wave >> 2, lb = wave & 3, l = lb * 32 + r32; const size_t tok = (size_t)tok0 + l;
        bf16x8 cf[8];
#pragma unroll
        for (int st = 0; st < 8; ++st) cf[st] = ld_frag16(Cn + tok * 512 + grp * 128 + 16 * st + 8 * h);
        f32x16 X[4];
#pragma unroll
        for (int sb = 0; sb < 4; ++sb) {
#pragma unroll
            for (int i = 0; i < 16; ++i) X[sb][i] = 0.f;
            if (sb <= lb) {
#pragma unroll
                for (int st = 0; st < 8; ++st) X[sb] = mfma32(ld_frag16(Bn + ((size_t)tok0 + sb * 32 + r32) * 512 + grp * 128 + 16 * st + 8 * h), cf[st], X[sb]);
            }
        }
        float ssq = 0.f;
#pragma unroll 2
        for (int r = 0; r < 8; ++r) {
            const int hh = grp * 8 + r;
            f32x16 acc;
#pragma unroll
            for (int i = 0; i < 16; ++i) acc[i] = 0.f;
            const bf16* pp = PV + ((size_t)(bc * 32 + hh) * 64 + pb * 32 + r32) * 128 + 8 * h;
#pragma unroll
            for (int st = 0; st < 8; ++st) acc = mfma32(ld_frag16(pp + 16 * st), cf[st], acc);
            const float al = acum[r * 128 + l]; const float el = __expf(al); const float dsk = p.in[11][hh];
#pragma unroll
            for (int i = 0; i < 16; ++i) acc[i] *= el;
            const bf16* xrow = xT + ((size_t)bc * 2048 + hh * 64 + pb * 32 + r32) * 128 + 4 * h;
#pragma unroll
            for (int sb = 0; sb < 4; ++sb) {
                if (sb <= lb) {
                    f32x16 mm;
#pragma unroll
                    for (int qd = 0; qd < 4; ++qd) {
                        const int s0 = sb * 32 + 8 * qd + 4 * h;
                        const f32x4 as = *(const LAS f32x4*)(acum + r * 128 + s0), ds = *(const LAS f32x4*)(dtt + r * 128 + s0);
#pragma unroll
                        for (int j = 0; j < 4; ++j) { const float v = X[sb][4 * qd + j] * __expf(al - as[j]) * ds[j]; mm[4 * qd + j] = (s0 + j < l) ? v : ((s0 + j == l) ? v + dsk : 0.f); }
                    }
#pragma unroll
                    for (int s2 = 0; s2 < 2; ++s2) acc = mfma32(ld_frag8x2(xrow + sb * 32 + 16 * s2), pack_frag(mm, s2), acc);
                }
            }
#pragma unroll
            for (int qd = 0; qd < 4; ++qd) {
                LAS u32x2* yp = (LAS u32x2*)(tile + l * SY_TP + (r * 64 + pb * 32 + 8 * qd + 4 * h) * 2); const u32x2 zz = *yp;
                const float y0 = acc[4 * qd] * bflo(zz.x), y1 = acc[4 * qd + 1] * bfhi(zz.x);
                const float y2 = acc[4 * qd + 2] * bflo(zz.y), y3 = acc[4 * qd + 3] * bfhi(zz.y);
                ssq += (y0 * y0 + y1 * y1) + (y2 * y2 + y3 * y3);
                u32x2 w; w.x = pk2(y0, y1); w.y = pk2(y2, y3); *yp = w;
            }
        }
        ssq += __shfl_xor(ssq, 32);
        if (h == 0) ssqp[pb * 128 + l] = ssq;
        __syncthreads();
        if (pb == 0 && h == 0) rsT[l] = rsqrtf((ssqp[l] + ssqp[128 + l]) * (1.f / 512.f) + EPS);
        __syncthreads();
#pragma unroll 4
        for (int i = 0; i < 16; ++i) { const int pid = tid + 512 * i, row = pid >> 6, c8 = pid & 63; const int ch = grp * 512 + 8 * c8;
            float f[8]; unpack8(*(const LAS u32x4*)(tile + row * SY_TP + 16 * c8), f);
            const float rs = rsT[row]; const f32x4 g0 = *(const f32x4*)(p.in[12] + ch), g1 = *(const f32x4*)(p.in[12] + ch + 4);
            f[0] *= rs * g0.x; f[1] *= rs * g0.y; f[2] *= rs * g0.z; f[3] *= rs * g0.w; f[4] *= rs * g1.x; f[5] *= rs * g1.y; f[6] *= rs * g1.z; f[7] *= rs * g1.w;
            *(u32x4*)(Ycat + ((size_t)tok0 + row) * 4096 + 2048 + ch) = pack8(f); }
    }
}

constexpr int AK_PITCH = 272, AV_PITCH = 272, A_KOFF = 0, A_VOFF = 128 * AK_PITCH, A_STAGE = A_VOFF + 128 * AV_PITCH;
static_assert(2 * A_STAGE <= PTAB_OFF && 4 * 16384 <= A_STAGE, "attention LDS map");
__device__ __forceinline__ float max3f(float a, float b, float c) { return fmaxf(fmaxf(a, b), c); }
__device__ __forceinline__ void attn_unit(const PT& p, LAS unsigned char* lds, int tid, int lane, int wave, int b, int hd, int qb, float lam) {
    unsigned char* ws = p.ws;
    const bf16* Qb = (const bf16*)(ws + WS_Q); const bf16* Kb = (const bf16*)(ws + WS_K); const bf16* Vb = (const bf16*)(ws + WS_VV); const bf16* Gb = (const bf16*)((unsigned char*)p.out + DO_G);
    bf16* Ob = (bf16*)(ws + WS_O);
    const int r32 = lane & 31, h = lane >> 5, mp = wave >> 2, wq = wave & 3;
    const int qw0 = qb * 128 + 32 * wq, q = qw0 + r32; const unsigned tokq = (unsigned)(b * SEQ + q), tokb = (unsigned)(b * SEQ);
    const float slope2 = fexp2(-0.5f * (float)(hd + 1)) * LOG2E;
    bf16x8 qf[4];
#pragma unroll
    for (int ds = 0; ds < 4; ++ds) qf[ds] = ld_frag16(Qb + (tokq * 2048u + (unsigned)(hd * 128 + mp * 64 + 16 * ds + 8 * h)));
    float mrun = -INFINITY, lsum = 0.f;
    f32x16 oT[4];
#pragma unroll
    for (int db = 0; db < 4; ++db)
#pragma unroll
        for (int i = 0; i < 16; ++i) oT[db][i] = 0.f;
    const int ntiles = qb + 1;
    u32x4 preV[4], preK[4];
#define PREFETCH(t) do { \
        _Pragma("unroll") for (int i_ = 0; i_ < 4; ++i_) { const int pid_ = tid + 512 * i_, row_ = pid_ >> 4, c16_ = pid_ & 15; const unsigned go_ = (tokb + (unsigned)((t) * 128 + row_)) * 2048u + (unsigned)(hd * 128 + 8 * c16_); \
            preK[i_] = *(const u32x4*)(Kb + go_); preV[i_] = *(const u32x4*)(Vb + go_); } \
    } while (0)
    PREFETCH(0);
    const LAS unsigned char* kbase0 = lds + A_KOFF + r32 * AK_PITCH + (mp * 64 + 8 * h) * 2;
    const LAS unsigned char* vbase0 = lds + A_VOFF + (4 * h + ((lane & 15) >> 2)) * AV_PITCH + ((lane >> 4) & 1) * 32 + (lane & 3) * 8;
#define STAGE_WRITE(stg) do { \
        _Pragma("unroll") for (int i_ = 0; i_ < 4; ++i_) { const int pid_ = tid + 512 * i_, row_ = pid_ >> 4, c16_ = pid_ & 15; \
            *(LAS u32x4*)(lds + (stg) * A_STAGE + A_KOFF + row_ * AK_PITCH + 16 * c16_) = preK[i_]; *(LAS u32x4*)(lds + (stg) * A_STAGE + A_VOFF + row_ * AV_PITCH + 16 * c16_) = preV[i_]; } \
    } while (0)
    __syncthreads();
    STAGE_WRITE(0);
    asm volatile("" : "+v"(qf[0]), "+v"(qf[1]), "+v"(qf[2]), "+v"(qf[3]));
    __syncthreads();
#pragma unroll 1
    for (int t = 0; t < ntiles; ++t) {
        const int stg = t & 1;
        if (t + 1 < ntiles) PREFETCH(t + 1);
        const LAS unsigned char* kbase = kbase0 + stg * A_STAGE; const LAS unsigned char* vbase = vbase0 + stg * A_STAGE;
        const bool diag = (t == qb);
#pragma unroll 2
        for (int sub = 0; sub < 2; ++sub) {
            const int nact = diag ? min(2, max(0, wq + 1 - 2 * sub)) : 2;
            if (nact > 0) {
                float sl = slope2; asm volatile("" : "+v"(sl));
                const float bq = sl * (float)(t * 128 + sub * 64 + 4 * h - q);
                const LAS unsigned char* kb0 = kbase + sub * 64 * AK_PITCH; const LAS unsigned char* vb0 = vbase + sub * 64 * AV_PITCH;
                f32x16 s[2];
#pragma unroll
                for (int kb = 0; kb < 2; ++kb) {
                    if (kb < nact) {
                        const float bk = bq + sl * (float)(32 * kb);
#pragma unroll
                        for (int i = 0; i < 16; ++i) s[kb][i] = __builtin_fmaf(sl, (float)((i & 3) + 8 * (i >> 2)), bk);
#pragma unroll
                        for (int ds = 0; ds < 4; ++ds) s[kb] = mfma32(__builtin_bit_cast(bf16x8, *(const LAS u32x4*)(kb0 + kb * 32 * AK_PITCH + ds * 32)), qf[ds], s[kb]);
                    } else {
#pragma unroll
                        for (int i = 0; i < 16; ++i) s[kb][i] = -INFINITY;
                    }
                }
                if (diag) {
#pragma unroll
                    for (int kb = 0; kb < 2; ++kb) if (2 * sub + kb == wq) {
#pragma unroll
                        for (int i = 0; i < 16; ++i) if (crow(i, h) > r32) s[kb][i] = -INFINITY; }
                }
                float mx = -INFINITY;
#pragma unroll
                for (int kb = 0; kb < 2; ++kb)
#pragma unroll
                    for (int i = 0; i < 16; i += 2) mx = max3f(mx, s[kb][i], s[kb][i + 1]);
                mx = fmaxf(mx, __shfl_xor(mx, 32));
                const float mnew = fmaxf(mrun, mx), alpha = fexp2(mrun - mnew); mrun = mnew;
                float rs0 = 0.f, rs1 = 0.f, rs2 = 0.f, rs3 = 0.f;
#pragma unroll
                for (int kb = 0; kb < 2; ++kb)
#pragma unroll
                    for (int i = 0; i < 16; i += 4) { s[kb][i] = fexp2(s[kb][i] - mnew); s[kb][i + 1] = fexp2(s[kb][i + 1] - mnew); s[kb][i + 2] = fexp2(s[kb][i + 2] - mnew); s[kb][i + 3] = fexp2(s[kb][i + 3] - mnew);
                        rs0 += s[kb][i]; rs1 += s[kb][i + 1]; rs2 += s[kb][i + 2]; rs3 += s[kb][i + 3]; }
                lsum = lsum * alpha + ((rs0 + rs1) + (rs2 + rs3));
                if (__builtin_amdgcn_ballot_w64(alpha != 1.0f) != 0ull) {
#pragma unroll
                    for (int db = 0; db < 4; ++db)
#pragma unroll
                        for (int i = 0; i < 16; ++i) oT[db][i] *= alpha;
                }
#pragma unroll
                for (int kb = 0; kb < 2; ++kb) if (kb < nact) {
#pragma unroll
                    for (int s2 = 0; s2 < 2; ++s2) {
                        const bf16x8 pf = pack_frag(s[kb], s2);
#pragma unroll
                        for (int db = 0; db < 4; ++db) {
                            const LAS unsigned char* vp = vb0 + (kb * 32 + 16 * s2) * AV_PITCH + db * 64;
                            const v4i16_t lo = __builtin_amdgcn_ds_read_tr16_b64_v4i16((LAS v4i16_t*)vp), hi = __builtin_amdgcn_ds_read_tr16_b64_v4i16((LAS v4i16_t*)(vp + 8 * AV_PITCH));
                            const bf16x8 vf = {lo[0], lo[1], lo[2], lo[3], hi[0], hi[1], hi[2], hi[3]};
                            oT[db] = mfma32(vf, pf, oT[db]);
                        }
                    }
                }
            }
        }
        if (t + 1 < ntiles) STAGE_WRITE(stg ^ 1);
        __syncthreads();
    }
#undef PREFETCH
#undef STAGE_WRITE
    const float lt = lsum + __shfl_xor(lsum, 32);
    LAS float* xch = (LAS float*)(lds + (ntiles & 1) * A_STAGE + wq * 16384);
    if (mp == 1) { const float sc = lam / lt;
#pragma unroll
        for (int db = 0; db < 4; ++db)
#pragma unroll
            for (int i = 0; i < 16; ++i) xch[(db * 16 + i) * 64 + lane] = oT[db][i] * sc; }
    __syncthreads();
    if (mp == 0) {
        const float i1 = 1.f / lt; float ss = 0.f;
#pragma unroll
        for (int db = 0; db < 4; ++db)
#pragma unroll
            for (int i = 0; i < 16; ++i) { const float o = oT[db][i] * i1 - xch[(db * 16 + i) * 64 + lane]; oT[db][i] = o; ss += o * o; }
        ss += __shfl_xor(ss, 32);
        const float rn = rsqrtf(ss * (1.f / 128.f) + EPS) * (1.f - LAMBDA_INIT);
#pragma unroll
        for (int db = 0; db < 4; ++db)
#pragma unroll
            for (int qd = 0; qd < 4; ++qd) {
                const int d = db * 32 + 8 * qd + 4 * h; const unsigned off = tokq * 2048u + (unsigned)(hd * 128 + d);
                const u32x2 gg = *(const u32x2*)(Gb + off); const f32x4 sg = *(const f32x4*)(p.in[20] + d);
                u32x2 w; w.x = pk2(oT[db][4 * qd] * rn * sg.x * bflo(gg.x), oT[db][4 * qd + 1] * rn * sg.y * bfhi(gg.x));
                w.y = pk2(oT[db][4 * qd + 2] * rn * sg.z * bflo(gg.y), oT[db][4 * qd + 3] * rn * sg.w * bfhi(gg.y));
                *(u32x2*)(Ob + off) = w;
            }
    }
}

__device__ __forceinline__ void phase_attn(const PT& p, LAS unsigned char* lds, int tid, int lane, int wave) {
    const float s1 = wave_sum(p.in[16][lane] * p.in[17][lane]), s2 = wave_sum(p.in[18][lane] * p.in[19][lane]);
    const float lam = __expf(s1) - __expf(s2) + LAMBDA_INIT;
#pragma unroll 1
    for (int u = blockIdx.x; u < NBATCH * 16 * 8; u += gridDim.x) {
        const int j = u & 7, hd = (u >> 3) & 15, b = u >> 7;
#pragma unroll 1
        for (int k = 0; k < 2; ++k) attn_unit(p, lds, tid, lane, wave, b, hd, k == 0 ? 15 - j : j, lam);
    }
}

__device__ __forceinline__ void phase_final(const PT& p, int lane, int wave) {
    const float* st2 = (const float*)(p.ws + WS_ST2); const float* g = p.in[22]; const bf16* X2 = (const bf16*)(p.ws + WS_X2B);
    for (int m = blockIdx.x * 8 + wave; m < M; m += gridDim.x * 8) {
        const float rs = rsqrtf(st2[m] * (1.f / 2048.f) + EPS);
        const u32x4* xr = (const u32x4*)(X2 + (size_t)m * 2048) + lane; f32x4* orow = (f32x4*)(p.out + (size_t)m * 2048);
#pragma unroll
        for (int j = 0; j < 4; ++j) {
            float f[8]; unpack8(xr[64 * j], f); const int c = 8 * (lane + 64 * j);
            const f32x4 g0 = *(const f32x4*)(g + c), g1 = *(const f32x4*)(g + c + 4);
            orow[(c >> 2)] = (f32x4){f[0] * rs * g0.x, f[1] * rs * g0.y, f[2] * rs * g0.z, f[3] * rs * g0.w};
            orow[(c >> 2) + 1] = (f32x4){f[4] * rs * g1.x, f[5] * rs * g1.y, f[6] * rs * g1.z, f[7] * rs * g1.w};
        }
    }
}

constexpr size_t WS_BAR = 384 * 1024;
constexpr int XBST_OFF = PTAB_OFF + 256;
typedef __attribute__((address_space(1))) unsigned gu32;
#define XB_TMO      128
#define XB_XCNT(j)  (256  + 64 * (j))
#define XB_XSUB(j)  (1280 + 64 * (j))
#define XB_XGEN(j)  (2304 + 64 * (j))
#define XB_TOP      3328
#define XB_TOPGEN   3392
#define XCD_BAR_WORDS 3456
#define XB_SPIN_CAP (1u << 18)

__device__ __forceinline__ unsigned xb_ld(unsigned* p)              { return __hip_atomic_load(p, __ATOMIC_RELAXED, __HIP_MEMORY_SCOPE_AGENT); }
__device__ __forceinline__ unsigned xb_add(unsigned* p, unsigned v) { return __hip_atomic_fetch_add(p, v, __ATOMIC_RELAXED, __HIP_MEMORY_SCOPE_AGENT); }
__device__ __forceinline__ unsigned xb_xcc_id() { return (unsigned)__builtin_amdgcn_s_getreg((3 << 11) | 20) & 0xFu; }
#define XB_SPIN(cond, bar) do { unsigned _sp = 0; while (cond) { __builtin_amdgcn_s_sleep(1); \
    if ((++_sp & 255u) == 0u) { if (xb_ld(&(bar)[XB_TMO])) break; if (_sp > XB_SPIN_CAP) { atomicAdd(&(bar)[XB_TMO], 1u); break; } } } } while (0)

struct XcdBarrier {
    unsigned* bar; unsigned x;
    volatile LAS unsigned* st;
};

__device__ __forceinline__ XcdBarrier xcd_barrier_post(unsigned* bar, volatile LAS unsigned* st) {
    XcdBarrier b; b.bar = bar; b.x = xb_xcc_id(); b.st = st;
    if (threadIdx.x == 0) (void)xb_add(&bar[XB_XCNT(b.x)], 1u);
    return b;
}
__device__ __forceinline__ void xcd_barrier_complete(unsigned* bar, unsigned x, unsigned& nloc, unsigned& nx) {
    const unsigned G = gridDim.x * gridDim.y * gridDim.z;
    unsigned sum, cnt, mine, sp = 0u;
    for (;;) {
        sum = 0u; cnt = 0u; mine = 0u;
#pragma unroll
        for (unsigned j = 0; j < 16; ++j) { const unsigned c = xb_ld(&bar[XB_XCNT(j)]); sum += c; cnt += (c > 0u) ? 1u : 0u; mine = (j == x) ? c : mine; }
        if (sum == G) break;
        __builtin_amdgcn_s_sleep(1);
        if ((++sp & 255u) == 0u) { if (xb_ld(&bar[XB_TMO])) break; if (sp > XB_SPIN_CAP) { atomicAdd(&bar[XB_TMO], 1u); break; } }
    }
    nloc = mine > 0u ? mine : 1u; nx = cnt > 0u ? cnt : 1u;
}

__device__ __forceinline__ void xcd_barrier(const XcdBarrier& b) {
    asm volatile("s_waitcnt vmcnt(0)" ::: "memory");
    __syncthreads();
    if (threadIdx.x == 0) {
        unsigned* bar = b.bar;
        __builtin_amdgcn_s_waitcnt(0);
        unsigned nloc = b.st[0], nx = b.st[1];
        if (nloc == 0u) { xcd_barrier_complete(bar, b.x, nloc, nx); b.st[0] = nloc; b.st[1] = nx; }
        const unsigned old = xb_add(&bar[XB_XSUB(b.x)], 1u);
        const unsigned gen = old / nloc;
        if (old + 1u == (gen + 1u) * nloc) {
            __builtin_amdgcn_fence(__ATOMIC_RELEASE, "agent");
            asm volatile("s_waitcnt vmcnt(0)" ::: "memory");
            const unsigned og = xb_add(&bar[XB_TOP], 1u);
            const unsigned tg = og / nx;
            if (og + 1u == (tg + 1u) * nx) xb_add(&bar[XB_TOPGEN], 1u);
            else XB_SPIN(xb_ld(&bar[XB_TOPGEN]) == tg, bar);
            __builtin_amdgcn_fence(__ATOMIC_ACQUIRE, "agent");
            xb_add(&bar[XB_XGEN(b.x)], 1u);
            asm volatile("s_waitcnt vmcnt(0)" ::: "memory");
        } else {
            XB_SPIN(xb_ld(&bar[XB_XGEN(b.x)]) == gen, bar);
            __builtin_amdgcn_fence(__ATOMIC_ACQUIRE, "agent");
            asm volatile("s_waitcnt vmcnt(0)" ::: "memory");
        }
    }
    __syncthreads();
}

__global__ void __launch_bounds__(512) fwd_megakernel(Params pa) {
    extern __shared__ __attribute__((aligned(16))) unsigned char lds_raw[];
    cg::grid_group grid = cg::this_grid();
    LAS unsigned char* lds = (LAS unsigned char*)lds_raw;
    if (threadIdx.x < 25) {
        unsigned long long v = 0;
#pragma unroll
        for (int i = 0; i < 23; ++i) if ((int)threadIdx.x == i) v = (unsigned long long)pa.in[i];
        if (threadIdx.x == 23) v = (unsigned long long)pa.out;
        if (threadIdx.x == 24) v = (unsigned long long)pa.ws;
        ((LAS unsigned long long*)(lds + PTAB_OFF))[threadIdx.x] = v;
    }
    if (threadIdx.x < 2) ((LAS unsigned*)(lds + XBST_OFF))[threadIdx.x] = 0u;
    __syncthreads();
    const XcdBarrier bar = xcd_barrier_post((unsigned*)(pa.ws + WS_BAR), (volatile LAS unsigned*)(lds + XBST_OFF));
#ifndef PHMASK
#define PHMASK 0x3ff
#endif
#define PH(n) (((PHMASK) >> (n)) & 1)
#define TLW int tid_ = threadIdx.x; asm volatile("" : "+v"(tid_)); const int tid = tid_, lane = tid & 63, wave = __builtin_amdgcn_readfirstlane(tid >> 6); (void)tid; (void)lane; (void)wave
#define GRIDV const int G = gridDim.x, c = blockIdx.x
    if (PH(0)) { PT p; TLW; phase0(p, lds, tid, lane, wave); }
    if (gridDim.x == 0x7fffffffu) grid.sync();
    xcd_barrier(bar);
    if (PH(1)) {
        PT p; GRIDV; unsigned char* ws = p.ws; unsigned char* dob = (unsigned char*)p.out;
        pg8::Gemm g{(const pg8::bf16_t*)(ws + WS_H0), (const pg8::bf16_t*)(ws + WS_W0IN), M, N0P, 2048}; pg8::StaticOrder S; S.init(M, N0P, G, c);
        EpiIn0 E{(bf16*)(ws + WS_YCAT), (bf16*)(ws + WS_V), (bf16*)(ws + WS_ZA), (bf16*)(dob + DO_XBC), (float*)(ws + WS_ST0)};
        pg8::gemm_phase<EpiIn0, pg8::StaticOrder, true, true>(lds, g, S, E);
        { TLW; dt_tasks(p, lds, lane, wave); }
    }
    xcd_barrier(bar);
    if (PH(2)) { PT p; TLW; phase_layout(p, tid); }
    xcd_barrier(bar);
    if (PH(3)) { PT p; TLW; phase_mix(p, lds, tid, lane, wave); }
    xcd_barrier(bar);
    if (PH(4)) { PT p; TLW; phase_scan(p, tid); }
    xcd_barrier(bar);
    if (PH(5)) { PT p; TLW; phase_ssd_y(p, lds, tid, lane, wave); }
    xcd_barrier(bar);
    if (PH(6)) {
        PT p; GRIDV; unsigned char* ws = p.ws;
        pg8::Gemm g{(const pg8::bf16_t*)(ws + WS_YCAT), (const pg8::bf16_t*)(ws + WS_W0OUT), M, 2048, 4096}; pg8::StaticOrder S; S.init(M, 2048, G, c);
        EpiResT<2> E{(const void*)(ws + WS_H0), nullptr, (bf16*)(ws + WS_X1B), (float*)(ws + WS_ST1), (const float*)(ws + WS_RS0), p.in[1], p.in[0]};
        pg8::gemm_phase<EpiResT<2>, pg8::StaticOrder, true, true>(lds, g, S, E);
    }
    xcd_barrier(bar);
    if (PH(6)) {
        PT p; GRIDV; unsigned char* ws = p.ws; unsigned char* dob = (unsigned char*)p.out;
        pg8::Gemm g{(const pg8::bf16_t*)(ws + WS_X1B), (const pg8::bf16_t*)(ws + WS_W1IN), M, 8192, 2048}; pg8::StaticOrder S; S.init(M, 8192, G, c);
        EpiIn1 E{(bf16*)(ws + WS_Q), (bf16*)(ws + WS_K), (bf16*)(ws + WS_VV), (bf16*)(dob + DO_G), (const float*)(ws + WS_ST1)};
        pg8::gemm_phase<EpiIn1, pg8::StaticOrder, true, true>(lds, g, S, E);
    }
    xcd_barrier(bar);
    if (PH(7)) { PT p; TLW; phase_attn(p, lds, tid, lane, wave); }
    xcd_barrier(bar);
    if (PH(8)) {
        PT p; GRIDV; unsigned char* ws = p.ws;
        pg8::Gemm g{(const pg8::bf16_t*)(ws + WS_O), (const pg8::bf16_t*)(ws + WS_W1OUT), M, 2048, 2048}; pg8::StaticOrder S; S.init(M, 2048, G, c);
        EpiResT<1> E{(const void*)(ws + WS_X1B), nullptr, (bf16*)(ws + WS_X2B), (float*)(ws + WS_ST2), nullptr, nullptr, nullptr};
        pg8::gemm_phase<EpiResT<1>, pg8::StaticOrder, true, true>(lds, g, S, E);
    }
    xcd_barrier(bar);
    if (PH(9)) { PT p; TLW; phase_final(p, lane, wave); }
}

extern "C" void kernel_launch(void* const* d_in, const int* in_sizes, int n_in, void* d_out, int out_size, void* d_ws, size_t ws_size, hipStream_t stream) {
    static int grid = 0;
    if (grid == 0) {
        if (n_in != 23 || out_size != M * DM || ws_size < WS_END) { fprintf(stderr, "kernel_launch: unexpected shapes (n_in %d out %d ws %zu)\n", n_in, out_size, ws_size); grid = -1; return; }
        int dev = 0, cus = 0, per_cu = 0;
        hipGetDevice(&dev); hipDeviceGetAttribute(&cus, hipDeviceAttributeMultiprocessorCount, dev);
        hipFuncSetAttribute((const void*)fwd_megakernel, hipFuncAttributeMaxDynamicSharedMemorySize, LDS_BYTES);
        hipOccupancyMaxActiveBlocksPerMultiprocessor(&per_cu, (const void*)fwd_megakernel, 512, LDS_BYTES);
        if (per_cu < 1) { fprintf(stderr, "kernel_launch: occupancy query says %d blocks per CU\n", per_cu); per_cu = 1; }
        (void)hipGetLastError();
        grid = cus;
    }
    if (grid < 0) return;
    Params p{};
    for (int i = 0; i < 23; ++i) p.in[i] = (const float*)d_in[i];
    p.out = (float*)d_out; p.ws = (unsigned char*)d_ws;
    if (hipMemsetAsync((char*)d_ws + WS_BAR, 0, XCD_BAR_WORDS * 4, stream) != hipSuccess) { fprintf(stderr, "kernel_launch: memset of the barrier words failed\n"); return; }
    void* args[] = {&p};
    hipError_t e = hipLaunchCooperativeKernel((const void*)fwd_megakernel, dim3(grid), dim3(512), args, LDS_BYTES, stream);
    if (e != hipSuccess) fprintf(stderr, "cooperative launch failed: %s (grid %d)\n", hipGetErrorString(e), grid);
}
```
